# Optimizing an MI355X kernel written in HIP

```python
import math
import jax, jax.numpy as jnp
from jax import lax
import numpy as np

D_MODEL = 1024
BATCH = 2
SEQ = 16384
DEPTH = 2
DEC_BATCH = 8
DEC_SEQ = 4096
PAST_LEN = 128

MIX_WIDTH = D_MODEL
POOL_WIDTH = MIX_WIDTH // 2
ATTN_WIDTH = MIX_WIDTH - POOL_WIDTH
POOL_WINDOWS = (2, 4, 8, 16)
N_POOL_GROUPS = len(POOL_WINDOWS)
POOL_GROUP_DIM = POOL_WIDTH // N_POOL_GROUPS
DIFF_HEAD_DIM = 64
N_HEADS = ATTN_WIDTH // (2 * DIFF_HEAD_DIM)
V_HEAD_DIM = 2 * DIFF_HEAD_DIM
ROPE_THETA = 10000.0
Q_BLOCK = 128
NORM_EPS = 1e-6
SUBLN_EPS = 1e-5
IN_WIDTH = 2 * POOL_WIDTH + 4 * ATTN_WIDTH
SPLIT_POINTS = (POOL_WIDTH, 2 * POOL_WIDTH, 2 * POOL_WIDTH + ATTN_WIDTH,
                2 * POOL_WIDTH + 2 * ATTN_WIDTH, 2 * POOL_WIDTH + 3 * ATTN_WIDTH)

kernel_name = "hybrid_pool_diffattn_encoder"


def rms_norm(x, g, eps=NORM_EPS):
    xf = x.astype(jnp.float32)
    y = xf * lax.rsqrt(jnp.mean(xf * xf, axis=-1, keepdims=True) + eps)
    return (y * g.astype(jnp.float32)).astype(x.dtype)


def rope(x, S):
    dh = x.shape[-1]
    pos = jnp.arange(S, dtype=jnp.float32)
    inv_freq = ROPE_THETA ** (-jnp.arange(0, dh, 2, dtype=jnp.float32) / dh)
    ang = pos[:, None] * inv_freq[None, :]
    cos = jnp.concatenate([jnp.cos(ang), jnp.cos(ang)], -1)[None, :, None, None, :].astype(x.dtype)
    sin = jnp.concatenate([jnp.sin(ang), jnp.sin(ang)], -1)[None, :, None, None, :].astype(x.dtype)
    x1, x2 = jnp.split(x, 2, axis=-1)
    return x * cos + jnp.concatenate([-x2, x1], axis=-1) * sin


def multiscale_pool(u, pool_w, pool_scale):
    B, S, _ = u.shape
    uf = u.astype(jnp.float32).reshape(B, S, N_POOL_GROUPS, POOL_GROUP_DIM)
    cs = jnp.concatenate([jnp.zeros((B, 1, N_POOL_GROUPS, POOL_GROUP_DIM), jnp.float32),
                          jnp.cumsum(uf, axis=1)], axis=1)
    t = jnp.arange(S)
    means = []
    for g, w in enumerate(POOL_WINDOWS):
        lo = jnp.clip(t - w // 2, 0, S)
        hi = jnp.clip(t - w // 2 + w, 0, S)
        csg = cs[:, :, g]
        s = jnp.take(csg, hi, axis=1) - jnp.take(csg, lo, axis=1)
        means.append(s / (hi - lo).astype(jnp.float32)[None, :, None])
    diff = (jnp.stack(means, axis=2) - uf).astype(u.dtype)
    out = jnp.einsum('bsgc,gcd->bsgd', diff, pool_w).reshape(B, S, POOL_WIDTH)
    return out * pool_scale


def diff_attention(q, k, v, lam, subln_g, lambda_init):
    B, S, H, _, dh = q.shape
    nblk = S // Q_BLOCK
    qb = q.reshape(B, nblk, Q_BLOCK, H, 2, dh).transpose(1, 0, 2, 3, 4, 5)
    scale = dh ** -0.5

    def block(qblk):
        s = jnp.einsum('bqhcd,bkhcd->bhcqk', qblk, k,
                       preferred_element_type=jnp.float32) * scale
        p = jax.nn.softmax(s, axis=-1)
        a = p[:, :, 0] - lam * p[:, :, 1]
        return jnp.einsum('bhqk,bkhe->bqhe', a.astype(v.dtype), v)

    o = lax.map(block, qb)
    o = o.transpose(1, 0, 2, 3, 4).reshape(B, S, H, V_HEAD_DIM)
    o = rms_norm(o, subln_g, SUBLN_EPS) * (1.0 - lambda_init)
    return o.reshape(B, S, ATTN_WIDTH)


def layer(x, l, pre_g, w_in, pool_w, pool_scale, lq1, lk1, lq2, lk2, subln_g, w_out, post_g):
    B, S, _ = x.shape
    h = rms_norm(x, pre_g)
    proj = h @ w_in
    u, zp, q, k, v, za = jnp.split(proj, SPLIT_POINTS, axis=-1)
    pool_out = multiscale_pool(u, pool_w, pool_scale) * jax.nn.silu(zp)
    q = rope(q.reshape(B, S, N_HEADS, 2, DIFF_HEAD_DIM), S)
    k = rope(k.reshape(B, S, N_HEADS, 2, DIFF_HEAD_DIM), S)
    v = v.reshape(B, S, N_HEADS, V_HEAD_DIM)
    lambda_init = 0.8 - 0.6 * math.exp(-0.3 * l)
    lam = (jnp.exp(jnp.sum(lq1.astype(jnp.float32) * lk1.astype(jnp.float32)))
           - jnp.exp(jnp.sum(lq2.astype(jnp.float32) * lk2.astype(jnp.float32)))
           + lambda_init)
    attn_out = diff_attention(q, k, v, lam, subln_g, lambda_init) * jax.nn.silu(za)
    y = jnp.concatenate([pool_out, attn_out], axis=-1) @ w_out
    return x + rms_norm(y, post_g)


def trunk(x, pre_norm_g, w_in, pool_w, pool_scale, lambda_q1, lambda_k1,
          lambda_q2, lambda_k2, subln_g, w_out, post_norm_g):
    for l in range(DEPTH):
        x = layer(x, l, pre_norm_g[l], w_in[l], pool_w[l], pool_scale[l],
                  lambda_q1[l], lambda_k1[l], lambda_q2[l], lambda_k2[l],
                  subln_g[l], w_out[l], post_norm_g[l])
    return x


def setup_inputs(seed: int = 0) -> dict:
    key = jax.random.key(seed)
    ks = jax.random.split(key, 14)
    f32 = jnp.float32
    return {
        "x_prompt": jax.random.normal(ks[0], (BATCH, SEQ, D_MODEL), f32),
        "x_sample": jax.random.normal(ks[1], (DEC_BATCH, DEC_SEQ, D_MODEL), f32),
        "pre_norm_g": 1.0 + 0.02 * jax.random.normal(ks[2], (DEPTH, D_MODEL), f32),
        "w_in": jax.random.normal(ks[3], (DEPTH, D_MODEL, IN_WIDTH), f32) * D_MODEL ** -0.5,
        "pool_w": jax.random.normal(ks[4], (DEPTH, N_POOL_GROUPS, POOL_GROUP_DIM, POOL_GROUP_DIM), f32) * POOL_GROUP_DIM ** -0.5,
        "pool_scale": 1.0 + 0.02 * jax.random.normal(ks[5], (DEPTH, POOL_WIDTH), f32),
        "lambda_q1": 0.1 * jax.random.normal(ks[6], (DEPTH, DIFF_HEAD_DIM), f32),
        "lambda_k1": 0.1 * jax.random.normal(ks[7], (DEPTH, DIFF_HEAD_DIM), f32),
        "lambda_q2": 0.1 * jax.random.normal(ks[8], (DEPTH, DIFF_HEAD_DIM), f32),
        "lambda_k2": 0.1 * jax.random.normal(ks[9], (DEPTH, DIFF_HEAD_DIM), f32),
        "subln_g": 1.0 + 0.02 * jax.random.normal(ks[10], (DEPTH, V_HEAD_DIM), f32),
        "w_out": jax.random.normal(ks[11], (DEPTH, MIX_WIDTH, D_MODEL), f32) * MIX_WIDTH ** -0.5,
        "post_norm_g": 1.0 + 0.02 * jax.random.normal(ks[12], (DEPTH, D_MODEL), f32),
    }


def reference(x_prompt, x_sample, pre_norm_g, w_in, pool_w, pool_scale, lambda_q1, lambda_k1,
              lambda_q2, lambda_k2, subln_g, w_out, post_norm_g):
    y_prompt = trunk(x_prompt, pre_norm_g, w_in, pool_w, pool_scale, lambda_q1, lambda_k1,
                     lambda_q2, lambda_k2, subln_g, w_out, post_norm_g)
    y_sample = trunk(x_sample, pre_norm_g, w_in, pool_w, pool_scale, lambda_q1, lambda_k1,
                     lambda_q2, lambda_k2, subln_g, w_out, post_norm_g)
    return (y_prompt, y_sample)
```

```cpp
#include <hip/hip_runtime.h>
#include <hip/hip_cooperative_groups.h>
#include <cstdio>
#include <cstdint>
namespace cg = cooperative_groups;

#ifndef MK_MULTI
#define MK_MULTI 1
#endif

typedef unsigned short bf16_t;
using bf16x8 = __attribute__((ext_vector_type(8))) short;
using s16x4  = __attribute__((ext_vector_type(4))) short;
using f32x16 = __attribute__((ext_vector_type(16))) float;
using f32x4  = __attribute__((ext_vector_type(4))) float;
using u32x4  = __attribute__((ext_vector_type(4))) unsigned;
using u32x2  = __attribute__((ext_vector_type(2))) unsigned;

constexpr int NT_THREADS = 512;
constexpr int T_TOK = 65536, TP = 32768, DM = 1024, NPROJ = 3072, DEPTH = 2;
constexpr int S_P = 16384, S_S = 4096;
constexpr int C_ZP = 0, C_ZA = 512, C_U = 1024, C_Q = 1536, C_K = 2048, C_V = 2560;
constexpr int LDX = 2048;
constexpr float QSCALE = 0.125f * 1.4426950408889634f;
constexpr size_t SHM_BYTES = 131072 + 4096;

struct Params {
  const float* xp; const float* xs; const float* pre_g; const float* w_in; const float* pool_w; const float* pool_scale;
  const float* lq1; const float* lk1; const float* lq2; const float* lk2; const float* subln_g; const float* w_out; const float* post_g;
  float* out; bf16_t* WinT; bf16_t* WoutT; bf16_t* proj; float* rinv; float* rope; float* lam;
};

#define SBAR() __builtin_amdgcn_sched_barrier(0)
__device__ __forceinline__ unsigned cvtpk(float lo, float hi) {
  unsigned r; asm volatile("v_cvt_pk_bf16_f32 %0, %1, %2" : "=v"(r) : "v"(lo), "v"(hi)); return r;
}
__device__ __forceinline__ float bf2f(unsigned short b) { return __uint_as_float(((unsigned)b) << 16); }
__device__ __forceinline__ float bflo(unsigned w) { return __uint_as_float(w << 16); }
__device__ __forceinline__ float bfhi(unsigned w) { return __uint_as_float(w & 0xffff0000u); }
__device__ __forceinline__ bf16_t f2bf(float f) { return (bf16_t)(cvtpk(f, 0.f) & 0xffffu); }
__host__ __device__ __forceinline__ int perm32(int rho) { const int n = rho >> 4, i = rho & 15; return 8 * (i >> 2) + 4 * n + (i & 3); }
__device__ __forceinline__ float silu(float z) { return z * __builtin_amdgcn_rcpf(1.f + __builtin_amdgcn_exp2f(-1.4426950408889634f * z)); }
__device__ __forceinline__ float wave_sum(float v) {
#pragma unroll
  for (int o = 32; o >= 1; o >>= 1) v += __shfl_xor(v, o);
  return v;
}

__device__ __forceinline__ int src_col_in(int s) {
  const int type = s >> 9, within = s & 511;
  if (type == 0) return 512 + within;
  if (type == 1) return 2560 + within;
  if (type == 5) return 2048 + within;
  const int p = within & 63, wcl = p >> 5, fq = (p >> 3) & 3, n = (p >> 2) & 1, jj = p & 3;
  const int d = wcl * 16 + fq * 4 + jj + 32 * n;
  return (type == 3 ? 1024 : 1536) + (within & ~63) + d;
}

__device__ void phase0(const Params& p, char* shm) {
  const int tid = threadIdx.x, nth = blockDim.x;
  float* tile = (float*)shm;
  constexpr int NT_IN = DEPTH * 48 * 16, NT_OUT = DEPTH * 16 * 16;
  for (int it = blockIdx.x; it < NT_IN + NT_OUT; it += gridDim.x) {
    __syncthreads();
    if (it < NT_IN) {
      const int l = it / (48 * 16), r = it % (48 * 16), n0 = (r / 16) * 64, k0 = (r % 16) * 64;
      const float* W = p.w_in + (size_t)l * DM * NPROJ; const float* g = p.pre_g + l * DM;
      for (int e = tid; e < 4096; e += nth) {
        const int nn = e & 63, kk = e >> 6, k = k0 + kk, nrow = n0 + nn;
        const int s = (nrow & ~31) + perm32(nrow & 31);
        float v;
        if ((s >> 9) == 2) {
          const int within = s & 511, gi = within >> 7, d = within & 127;
          const float* wr = W + (size_t)k * NPROJ + gi * 128; const float* pw = p.pool_w + ((size_t)(l * 4 + gi) * 128) * 128 + d;
          float a = 0.f;
          for (int c = 0; c < 128; ++c) a = fmaf(wr[c], pw[(size_t)c * 128], a);
          v = a;
        } else v = W[(size_t)k * NPROJ + src_col_in(s)];
        tile[kk * 65 + nn] = v * g[k];
      }
      __syncthreads();
      bf16_t* O = p.WinT + (size_t)l * NPROJ * DM;
      for (int e = tid; e < 4096; e += nth) { const int kk = e & 63, nn = e >> 6; O[(size_t)(n0 + nn) * DM + k0 + kk] = f2bf(tile[kk * 65 + nn]); }
    } else {
      const int it2 = it - NT_IN, l = it2 / 256, r = it2 % 256, n0 = (r / 16) * 64, k0 = (r % 16) * 64;
      const float* W = p.w_out + (size_t)l * DM * DM;
      for (int e = tid; e < 4096; e += nth) {
        const int nn = e & 63, kk = e >> 6, nrow = n0 + nn; const int s = (nrow & ~31) + perm32(nrow & 31);
        tile[kk * 65 + nn] = W[(size_t)(k0 + kk) * DM + s];
      }
      __syncthreads();
      bf16_t* O = p.WoutT + (size_t)l * DM * DM;
      for (int e = tid; e < 4096; e += nth) { const int kk = e & 63, nn = e >> 6; O[(size_t)(n0 + nn) * DM + k0 + kk] = f2bf(tile[kk * 65 + nn]); }
    }
  }
  if (blockIdx.x == 0) {
    if (tid < 32) { const double c = exp(-(double)tid * (9.210340371976184 / 32.0)) * 0.15915494309189535; const float h = (float)c; p.rope[2 * tid] = h; p.rope[2 * tid + 1] = (float)(c - (double)h); }
    if (tid >= 64 && tid < 64 + 64 * DEPTH) {
      const int l = (tid >> 6) - 1, i = tid & 63;
      float a = p.lq1[l * 64 + i] * p.lk1[l * 64 + i], b = p.lq2[l * 64 + i] * p.lk2[l * 64 + i];
      a = wave_sum(a); b = wave_sum(b);
      const float li = 0.8f - 0.6f * expf(-0.3f * (float)l);
      if (i == 0) p.lam[l] = expf(a) - expf(b) + li;
    }
  }
  const int wid = tid >> 6, lane = tid & 63, nw = nth >> 6;
  for (int row = blockIdx.x * nw + wid; row < T_TOK; row += gridDim.x * nw) {
    const float* xr = row < TP ? p.xp + (size_t)row * DM : p.xs + (size_t)(row - TP) * DM;
    bf16_t* xo = (bf16_t*)p.out + (size_t)row * LDX;
    float ss = 0.f;
#pragma unroll
    for (int i = 0; i < 4; ++i) {
      const f32x4 v = *(const f32x4*)(xr + i * 256 + lane * 4);
      ss += v[0] * v[0] + v[1] * v[1] + v[2] * v[2] + v[3] * v[3];
      u32x2 w = {cvtpk(v[0], v[1]), cvtpk(v[2], v[3])};
      *(u32x2*)(xo + i * 256 + lane * 4) = w;
    }
    ss = wave_sum(ss);
    if (lane == 0) p.rinv[row] = __builtin_amdgcn_rsqf(ss * (1.f / DM) + 1e-6f);
  }
}

namespace gm {
constexpr int BM = 256, BK = 64, HALF = 128, NXCD = 8, WGM = 8, HT = HALF * BK;
__device__ __forceinline__ int lds_byte(int r, int c) { int st = (r >> 4) * 2 + (c >> 5), rr = r & 15, cc = c & 31, ob = rr * 64 + cc * 2; return st * 1024 + (ob ^ (((ob >> 9) & 1) << 5)); }
__device__ __forceinline__ void stage_rc(int b, int& R, int& C) { int st = b / 1024, sb = b % 1024, swz = sb ^ (((sb >> 9) & 1) << 5); R = (st >> 1) * 16 + swz / 64; C = (st & 1) * 32 + (swz % 64) / 2; }

#define LAS __attribute__((address_space(3)))
template <class Epi>
__device__ __forceinline__ void gemm_phase(const bf16_t* __restrict__ A, const int lda, const bf16_t* __restrict__ Bt, const int N, const Epi& E, char* shmc) {
  constexpr int K = 1024, nt = K / BK, HTB = HALF * BK * 2;
  LAS unsigned char* lds = (LAS unsigned char*)shmc;
  const int tid = threadIdx.x, wid = __builtin_amdgcn_readfirstlane(tid >> 6), lane = tid & 63, wr = wid >> 2, wc = wid & 3, fr = lane & 15, fq = lane >> 4;
  unsigned voffA[2], voffB[2];
#pragma unroll
  for (int i = 0; i < 2; ++i) { int R, C; stage_rc(tid * 16 + i * 8192, R, C); voffA[i] = (unsigned)(R * lda + C) * 2u; voffB[i] = (unsigned)(R * K + C) * 2u; }
  const size_t kstep = (size_t)(BK * 2);
  const size_t hstepA = (size_t)HALF * lda * 2, hstepB = (size_t)HALF * K * 2;
  const size_t tstepA = 2 * hstepA, tstepB = 2 * hstepB;
  const unsigned ldsw = (unsigned)wid * 1024u;
  const int aoff = lds_byte(wr * 64 + fr, fq * 8), boff = lds_byte(wc * 32 + fr, fq * 8);
#define PG8_SA(b, h) (((b) * 2 + (h)) * HTB)
#define PG8_SB(b, h) ((4 + (b) * 2 + (h)) * HTB)
#define PG8_STAGE(bufoff, gbase, voff) do { _Pragma("unroll") for (int _i = 0; _i < 2; ++_i) \
        __builtin_amdgcn_global_load_lds((const unsigned*)((const char*)(gbase) + (voff)[_i]), (LAS unsigned*)(lds + (bufoff) + ldsw + _i * 8192), 16, 0, 0); } while (0)
#define PG8_LDA(dst, b, h) do { _Pragma("unroll") for (int m = 0; m < 4; ++m) _Pragma("unroll") for (int k = 0; k < 2; ++k) dst[m][k] = *(const LAS bf16x8*)(lds + PG8_SA(b, h) + aoff + m * 2048 + k * 1024); } while (0)
#define PG8_LDB(dst, b, h) do { _Pragma("unroll") for (int n = 0; n < 2; ++n) _Pragma("unroll") for (int k = 0; k < 2; ++k) dst[n][k] = *(const LAS bf16x8*)(lds + PG8_SB(b, h) + boff + n * 2048 + k * 1024); } while (0)
#define PG8_MMA(ai, bj, At, Bx) do { __builtin_amdgcn_s_setprio(1); _Pragma("unroll") for (int m = 0; m < 4; ++m) _Pragma("unroll") for (int n = 0; n < 2; ++n) _Pragma("unroll") for (int k = 0; k < 2; ++k) \
        acc[ai][bj][m][n] = __builtin_amdgcn_mfma_f32_16x16x32_bf16(Bx[n][k], At[m][k], acc[ai][bj][m][n], 0, 0, 0); __builtin_amdgcn_s_setprio(0); } while (0)
#define PG8_WAIT_V(n) asm volatile("s_waitcnt vmcnt(" #n ")" ::: "memory")
#define PG8_WAIT_L(n) asm volatile("s_waitcnt lgkmcnt(" #n ")" ::: "memory")
#define PG8_BAR __builtin_amdgcn_s_barrier()
#define PG8_SCHED __builtin_amdgcn_sched_barrier(0)
  const int nM = T_TOK / BM, nN = N / BM, nwg = nM * nN, G = gridDim.x, cblk = blockIdx.x;
  auto next_unit = [&](int i, int& pm, int& pn) -> bool {
    const long L = (long)i * G + cblk; if (L >= nwg) return false;
    int wgid = (int)L; { const int q = nwg / NXCD, r = nwg % NXCD, xcd = wgid % NXCD, off = wgid / NXCD; wgid = (xcd < r ? xcd * (q + 1) : r * (q + 1) + (xcd - r) * q) + off; }
    const int nig = WGM * nN, gid = wgid / nig, fm = gid * WGM, gsz = (nM - fm) < WGM ? (nM - fm) : WGM;
    pm = fm + ((wgid % nig) % gsz); pn = (wgid % nig) / gsz; return true;
  };
  int cpm, cpn, npm = 0, npn = 0, ui = 0;
  if (!next_unit(0, cpm, cpn)) return;
  f32x4 acc[2][2][4][2];
#pragma unroll
  for (int a = 0; a < 2; ++a)
#pragma unroll
    for (int b = 0; b < 2; ++b)
#pragma unroll
      for (int m = 0; m < 4; ++m)
#pragma unroll
        for (int n = 0; n < 2; ++n) acc[a][b][m][n] = (f32x4){0.f, 0.f, 0.f, 0.f};
  bf16x8 At[4][2], B0[2][2], B1[2][2];
  const char* cA = (const char*)A + (size_t)cpm * tstepA; const char* cB = (const char*)Bt + (size_t)cpn * tstepB;
  PG8_STAGE(PG8_SB(0, 0), cB, voffB); PG8_STAGE(PG8_SB(0, 1), cB + hstepB, voffB); PG8_STAGE(PG8_SA(0, 0), cA, voffA); PG8_STAGE(PG8_SA(0, 1), cA + hstepA, voffA);
  if (wr == 1) PG8_BAR;
  PG8_WAIT_V(2); PG8_BAR;
  PG8_STAGE(PG8_SB(1, 0), cB + kstep, voffB); PG8_STAGE(PG8_SA(1, 0), cA + kstep, voffA); PG8_STAGE(PG8_SB(1, 1), cB + hstepB + kstep, voffB);
  PG8_WAIT_V(6); PG8_BAR;
  for (;;) {
    const bool has_next = next_unit(ui + 1, npm, npn);
    const char* nA = has_next ? (const char*)A + (size_t)npm * tstepA : cA; const char* nB = has_next ? (const char*)Bt + (size_t)npn * tstepB : cB;
    for (int t = 0; t < nt; t += 2) {
      const bool last = (t == nt - 2);
      const char* a1 = cA + (size_t)(t + 1) * kstep;
      const char* a2 = last ? nA : cA + (size_t)(t + 2) * kstep; const char* b2 = last ? nB : cB + (size_t)(t + 2) * kstep;
      const char* a3 = a2 + kstep; const char* b3 = b2 + kstep;
      PG8_LDB(B0, 0, 0); PG8_LDB(B1, 0, 1); PG8_SCHED; PG8_LDA(At, 0, 0); PG8_STAGE(PG8_SA(1, 1), a1 + hstepA, voffA);
      PG8_WAIT_V(8); PG8_WAIT_L(0); PG8_BAR; PG8_MMA(0, 0, At, B0); PG8_MMA(0, 1, At, B1); PG8_BAR; PG8_SCHED;
      PG8_LDA(At, 0, 1); PG8_STAGE(PG8_SB(0, 0), b2, voffB); PG8_STAGE(PG8_SB(0, 1), b2 + hstepB, voffB); PG8_STAGE(PG8_SA(0, 0), a2, voffA);
      PG8_WAIT_V(8); PG8_WAIT_L(0); PG8_BAR; PG8_MMA(1, 0, At, B0); PG8_MMA(1, 1, At, B1); PG8_BAR; PG8_SCHED;
      PG8_LDB(B0, 1, 0); PG8_LDB(B1, 1, 1); PG8_SCHED; PG8_LDA(At, 1, 0); PG8_STAGE(PG8_SA(0, 1), a2 + hstepA, voffA);
      PG8_WAIT_V(8); PG8_WAIT_L(0); PG8_BAR; PG8_MMA(0, 0, At, B0); PG8_MMA(0, 1, At, B1); PG8_BAR; PG8_SCHED;
      PG8_LDA(At, 1, 1); PG8_STAGE(PG8_SB(1, 0), b3, voffB); PG8_STAGE(PG8_SB(1, 1), b3 + hstepB, voffB); PG8_STAGE(PG8_SA(1, 0), a3, voffA);
      PG8_WAIT_V(8); PG8_WAIT_L(0); PG8_BAR; PG8_MMA(1, 0, At, B0); PG8_MMA(1, 1, At, B1); PG8_BAR; PG8_SCHED;
    }
    if (wr == 0) PG8_BAR;
    E(acc, cpm, cpn, wr, wc, fr, fq);
    if (!has_next) break;
#pragma unroll
    for (int a = 0; a < 2; ++a)
#pragma unroll
      for (int b = 0; b < 2; ++b)
#pragma unroll
        for (int m = 0; m < 4; ++m)
#pragma unroll
          for (int n = 0; n < 2; ++n) acc[a][b][m][n] = (f32x4){0.f, 0.f, 0.f, 0.f};
    cpm = npm; cpn = npn; cA = nA; cB = nB; ++ui;
    if (wr == 1) PG8_BAR;
  }
  PG8_WAIT_V(0);
  PG8_BAR;
#undef PG8_SA
#undef PG8_SB
#undef PG8_STAGE
#undef PG8_LDA
#undef PG8_LDB
#undef PG8_MMA
}

struct EpiIn {
  const float* rinv; const float* rope; bf16_t* proj;
  __device__ __forceinline__ void operator()(const f32x4 (&acc)[2][2][4][2], int pm, int pn, int wr, int wc, int fr, int fq) const {
    const bool isrope = (pn >= 6 && pn <= 9); const float qs = (pn == 6 || pn == 7) ? QSCALE : 1.f;
    float ch[4], cl[4];
    if (isrope) {
#pragma unroll
      for (int jj = 0; jj < 4; ++jj) { const int i = (wc & 1) * 16 + fq * 4 + jj; ch[jj] = rope[2 * i]; cl[jj] = rope[2 * i + 1]; }
    }
#pragma unroll
    for (int ai = 0; ai < 2; ++ai)
#pragma unroll
      for (int m = 0; m < 4; ++m) {
        const int row = pm * BM + ai * HALF + wr * 64 + m * 16 + fr;
        const float ri = rinv[row];
        float cs[4], sn[4];
        if (isrope) {
          const float pos = (float)(row < TP ? (row & (S_P - 1)) : (row & (S_S - 1)));
#pragma unroll
          for (int jj = 0; jj < 4; ++jj) {
            const float h = pos * ch[jj], e = fmaf(pos, ch[jj], -h) + pos * cl[jj];
            const float rev = (h - floorf(h)) + e;
            sn[jj] = __builtin_amdgcn_sinf(rev); cs[jj] = __builtin_amdgcn_cosf(rev);
          }
        }
        bf16_t* rowp = proj + (size_t)row * NPROJ + pn * BM + wc * 32 + 8 * fq;
#pragma unroll
        for (int bj = 0; bj < 2; ++bj) {
          f32x4 v0 = acc[ai][bj][m][0] * ri, v1 = acc[ai][bj][m][1] * ri;
          if (isrope) {
#pragma unroll
            for (int jj = 0; jj < 4; ++jj) { const float a = v0[jj], b = v1[jj]; v0[jj] = (a * cs[jj] - b * sn[jj]) * qs; v1[jj] = (b * cs[jj] + a * sn[jj]) * qs; }
          }
          u32x4 w; w.x = cvtpk(v0[0], v0[1]); w.y = cvtpk(v0[2], v0[3]); w.z = cvtpk(v1[0], v1[1]); w.w = cvtpk(v1[2], v1[3]);
          *(u32x4*)(rowp + bj * HALF) = w;
        }
      }
  }
};
struct EpiOut {
  bf16_t* proj;
  __device__ __forceinline__ void operator()(const f32x4 (&acc)[2][2][4][2], int pm, int pn, int wr, int wc, int fr, int fq) const {
#pragma unroll
    for (int ai = 0; ai < 2; ++ai)
#pragma unroll
      for (int m = 0; m < 4; ++m) {
        const int row = pm * BM + ai * HALF + wr * 64 + m * 16 + fr;
        float* rowp = (float*)(proj + (size_t)row * NPROJ + C_U) + pn * BM + wc * 32 + 8 * fq;
#pragma unroll
        for (int bj = 0; bj < 2; ++bj) { *(f32x4*)(rowp + bj * HALF) = acc[ai][bj][m][0]; *(f32x4*)(rowp + bj * HALF + 4) = acc[ai][bj][m][1]; }
      }
  }
};
}

__device__ void pool_phase(const Params& p, int l) {
  const int tid = threadIdx.x, c8 = tid & 63, tq = tid >> 6;
  const int g = c8 >> 4, hw = 1 << g;
  const float* sc = p.pool_scale + l * 512 + c8 * 8;
  float scl[8];
#pragma unroll
  for (int e = 0; e < 8; ++e) scl[e] = sc[e];
  for (int ch = blockIdx.x; ch < T_TOK / 64; ch += gridDim.x) {
    for (int i = 0; i < 8; ++i) {
      const int t = ch * 64 + tq * 8 + i;
      const int S = t < TP ? S_P : S_S, pos = t & (S - 1), s0 = t - pos;
      const int lo = max(pos - hw, 0), hi = min(pos + hw, S);
      float sum[8] = {0, 0, 0, 0, 0, 0, 0, 0};
      for (int j = lo; j < hi; ++j) {
        const u32x4 w = *(const u32x4*)(p.proj + (size_t)(s0 + j) * NPROJ + C_U + c8 * 8);
        sum[0] += bflo(w.x); sum[1] += bfhi(w.x); sum[2] += bflo(w.y); sum[3] += bfhi(w.y);
        sum[4] += bflo(w.z); sum[5] += bfhi(w.z); sum[6] += bflo(w.w); sum[7] += bfhi(w.w);
      }
      const float inv = 1.f / (float)(hi - lo);
      const u32x4 uc = *(const u32x4*)(p.proj + (size_t)t * NPROJ + C_U + c8 * 8);
      bf16_t* zpp = p.proj + (size_t)t * NPROJ + C_ZP + c8 * 8;
      const u32x4 z = *(const u32x4*)zpp;
      float o[8];
      o[0] = (sum[0] * inv - bflo(uc.x)) * scl[0] * silu(bflo(z.x)); o[1] = (sum[1] * inv - bfhi(uc.x)) * scl[1] * silu(bfhi(z.x));
      o[2] = (sum[2] * inv - bflo(uc.y)) * scl[2] * silu(bflo(z.y)); o[3] = (sum[3] * inv - bfhi(uc.y)) * scl[3] * silu(bfhi(z.y));
      o[4] = (sum[4] * inv - bflo(uc.z)) * scl[4] * silu(bflo(z.z)); o[5] = (sum[5] * inv - bfhi(uc.z)) * scl[5] * silu(bfhi(z.z));
      o[6] = (sum[6] * inv - bflo(uc.w)) * scl[6] * silu(bflo(z.w)); o[7] = (sum[7] * inv - bfhi(uc.w)) * scl[7] * silu(bfhi(z.w));
      u32x4 w = {cvtpk(o[0], o[1]), cvtpk(o[2], o[3]), cvtpk(o[4], o[5]), cvtpk(o[6], o[7])};
      *(u32x4*)zpp = w;
    }
  }
}

namespace at {
constexpr int KVBLK = 64, LDK = NPROJ;
constexpr size_t SHM_V = KVBLK * 128 * 2, SHM_K = KVBLK * 128 * 2;
constexpr float THRL = 11.5f;
#define KSWZ(row, colB) ((row) * 256 + ((colB) ^ (((row) & 7) << 4)))
__device__ __forceinline__ int crow(int r, int hi) { return (r & 3) + 8 * (r >> 2) + 4 * hi; }
__device__ __forceinline__ void partialSM(f32x16& p0, f32x16& p1, float& m_reg, float& mn, float& alpha) {
  float pmax = p0[0];
#pragma unroll
  for (int r = 1; r < 16; ++r) pmax = fmaxf(pmax, p0[r]);
#pragma unroll
  for (int r = 0; r < 16; ++r) pmax = fmaxf(pmax, p1[r]);
  { auto rr = __builtin_amdgcn_permlane32_swap(__float_as_uint(pmax), __float_as_uint(pmax), false, false);
    pmax = fmaxf(__uint_as_float(rr[0]), __uint_as_float(rr[1])); }
  if (__builtin_expect(__all(pmax - m_reg <= THRL), 1)) { mn = m_reg; alpha = 1.f; }
  else { mn = fmaxf(m_reg, pmax); alpha = __builtin_amdgcn_exp2f(m_reg - mn); m_reg = mn; }
#pragma unroll
  for (int r = 0; r < 16; ++r) p0[r] = p0[r] - mn;
#pragma unroll
  for (int r = 0; r < 16; ++r) p1[r] = p1[r] - mn;
#pragma unroll
  for (int r = 0; r < 16; ++r) p0[r] = __builtin_amdgcn_exp2f(p0[r]);
}
__device__ __forceinline__ void finishSM(f32x16& p0, f32x16& p1, float alpha, float& l_reg, bf16x8& pa0, bf16x8& pa1, bf16x8& pa2, bf16x8& pa3) {
#pragma unroll
  for (int r = 0; r < 16; ++r) p1[r] = __builtin_amdgcn_exp2f(p1[r]);
  float ps = 0;
#pragma unroll
  for (int r = 0; r < 16; ++r) ps += p0[r];
#pragma unroll
  for (int r = 0; r < 16; ++r) ps += p1[r];
  { auto rr = __builtin_amdgcn_permlane32_swap(__float_as_uint(ps), __float_as_uint(ps), false, false);
    ps = __uint_as_float(rr[0]) + __uint_as_float(rr[1]); }
  l_reg = l_reg * alpha + ps;
#define PK4(P, BASE, OUT) do { unsigned a0 = cvtpk(P[BASE + 0], P[BASE + 1]), a1 = cvtpk(P[BASE + 2], P[BASE + 3]);   \
    unsigned b0 = cvtpk(P[BASE + 4], P[BASE + 5]), b1 = cvtpk(P[BASE + 6], P[BASE + 7]);                              \
    auto r0 = __builtin_amdgcn_permlane32_swap(a0, b0, false, false); auto r1 = __builtin_amdgcn_permlane32_swap(a1, b1, false, false); \
    u32x4 w = {r0[0], r1[0], r0[1], r1[1]}; OUT = *reinterpret_cast<bf16x8*>(&w); } while (0)
  PK4(p0, 0, pa0); PK4(p0, 8, pa1); PK4(p1, 0, pa2); PK4(p1, 8, pa3);
#undef PK4
}
__device__ __forceinline__ void qkt(f32x16& p0, f32x16& p1, const char* Ks, const bf16x8* qr, int r32, int hi, int mapB) {
  p0 = f32x16{}; p1 = f32x16{};
#pragma unroll
  for (int d0 = 0; d0 < 4; ++d0) { const int cb = (d0 * 16 + hi * 8) * 2 + mapB;
    bf16x8 b0 = *reinterpret_cast<const bf16x8*>(Ks + KSWZ(r32, cb));
    bf16x8 b1 = *reinterpret_cast<const bf16x8*>(Ks + KSWZ(32 + r32, cb));
    p0 = __builtin_amdgcn_mfma_f32_32x32x16_bf16(b0, qr[d0], p0, 0, 0, 0);
    p1 = __builtin_amdgcn_mfma_f32_32x32x16_bf16(b1, qr[d0], p1, 0, 0, 0); }
}
__device__ __forceinline__ int v_st(int k, int c) { const int kk = (k & ~0xC) | ((k & 4) << 1) | ((k & 8) >> 1); return ((kk >> 3) * 4 + (c >> 5)) * 512 + ((kk & 7) * 32 + (c & 31)) * 2; }
__device__ __forceinline__ int v_rd_base(int lane) { return ((lane & 3) << 3) | (((lane >> 2) & 3) << 6) | (((lane >> 4) & 1) << 5) | (((lane >> 5) & 1) << 8); }
constexpr int v_rd_off(int d0, int ks, int half) { return d0 * 512 + ks * 4096 + half * 2048; }
template <int OFF> __device__ __forceinline__ s16x4 tr_read(int vb) {
  s16x4 r; asm volatile("ds_read_b64_tr_b16 %0, %1 offset:%2" : "=&v"(r) : "v"(vb), "i"(OFF) : "memory"); return r;
}
template <int D0> __device__ __forceinline__ void pv_one(f32x16& od, int vb, bf16x8 pa0, bf16x8 pa1, bf16x8 pa2, bf16x8 pa3) {
  const s16x4 l0 = tr_read<v_rd_off(D0, 0, 0)>(vb), h0 = tr_read<v_rd_off(D0, 0, 1)>(vb), l1 = tr_read<v_rd_off(D0, 1, 0)>(vb), h1 = tr_read<v_rd_off(D0, 1, 1)>(vb);
  const s16x4 l2 = tr_read<v_rd_off(D0, 2, 0)>(vb), h2 = tr_read<v_rd_off(D0, 2, 1)>(vb), l3 = tr_read<v_rd_off(D0, 3, 0)>(vb), h3 = tr_read<v_rd_off(D0, 3, 1)>(vb);
  asm volatile("s_waitcnt lgkmcnt(0)" ::: "memory"); SBAR();
#define PK(L, H) (bf16x8){L[0], L[1], L[2], L[3], H[0], H[1], H[2], H[3]}
  od = __builtin_amdgcn_mfma_f32_32x32x16_bf16(pa0, PK(l0, h0), od, 0, 0, 0);
  od = __builtin_amdgcn_mfma_f32_32x32x16_bf16(pa1, PK(l1, h1), od, 0, 0, 0);
  od = __builtin_amdgcn_mfma_f32_32x32x16_bf16(pa2, PK(l2, h2), od, 0, 0, 0);
  od = __builtin_amdgcn_mfma_f32_32x32x16_bf16(pa3, PK(l3, h3), od, 0, 0, 0);
#undef PK
}
__device__ __forceinline__ void pv_d0(f32x16* o, int vb, bf16x8 pa0, bf16x8 pa1, bf16x8 pa2, bf16x8 pa3) {
  pv_one<0>(o[0], vb, pa0, pa1, pa2, pa3); pv_one<1>(o[1], vb, pa0, pa1, pa2, pa3); pv_one<2>(o[2], vb, pa0, pa1, pa2, pa3); pv_one<3>(o[3], vb, pa0, pa1, pa2, pa3);
}

__device__ __forceinline__ void attn_unit(bf16_t* __restrict__ proj, int tok0, int kv0, int seq, int h, float lam, float oscale, const float* __restrict__ subg, char* lds) {
  const int tid = threadIdx.x, wid = tid >> 6, lane = tid & 63, r32 = lane & 31, hi = lane >> 5;
  const int wq = wid & 3, mp = wid >> 2, mapB = mp * 128;
  char* V_lds = lds; char* K_lds = lds + 2 * SHM_V;
  float* ws = (float*)(lds + 2 * SHM_V + 2 * SHM_K) + wid * 64; float* li_l = ws; float* al_l = ws + 32;
  const bf16_t* Kh = proj + (size_t)kv0 * NPROJ + C_K + h * 128;
  const bf16_t* Vh = proj + (size_t)kv0 * NPROJ + C_V + h * 128;
  float m_reg = -1e30f, l_reg = 0; f32x16 o[4] = {}; bf16x8 qr[4];
  const bf16_t* Qw = proj + (size_t)(tok0 + wq * 32 + r32) * NPROJ + C_Q + h * 128 + mp * 64 + hi * 8;
#pragma unroll
  for (int d0 = 0; d0 < 4; ++d0) qr[d0] = *reinterpret_cast<const bf16x8*>(Qw + d0 * 16);
  const int sr = tid >> 4, sc = (tid & 15) * 8, vst0 = v_st(sr, sc), vst1 = v_st(32 + sr, sc);
  const int vb0 = (int)(uintptr_t)V_lds + v_rd_base(lane);
  struct { bf16x8 vs0, vs1, ks0, ks1; } sr_[2];
#define LD8(ptr) (*reinterpret_cast<const bf16x8*>(ptr))
#define SLOAD(i, k0) do { sr_[i].vs0 = LD8(&Vh[(size_t)((k0) + sr) * LDK + sc]); sr_[i].vs1 = LD8(&Vh[(size_t)((k0) + 32 + sr) * LDK + sc]); \
    sr_[i].ks0 = LD8(&Kh[(size_t)((k0) + sr) * LDK + sc]); sr_[i].ks1 = LD8(&Kh[(size_t)((k0) + 32 + sr) * LDK + sc]); } while (0)
#define SWRITE(b, i) do { *(bf16x8*)(V_lds + (b) * SHM_V + vst0) = sr_[i].vs0;          \
    *(bf16x8*)(V_lds + (b) * SHM_V + vst1) = sr_[i].vs1; int kc = sc * 2;               \
    *(bf16x8*)(K_lds + (b) * SHM_K + KSWZ(sr, kc)) = sr_[i].ks0;                       \
    *(bf16x8*)(K_lds + (b) * SHM_K + KSWZ(32 + sr, kc)) = sr_[i].ks1; } while (0)
#define SWAIT() asm volatile("s_waitcnt vmcnt(4)" ::: "memory")
#define RESC(a) do { if (__any((a) < 1.f)) { if (hi == 0) al_l[r32] = (a); asm volatile("s_waitcnt lgkmcnt(0)" ::: "memory"); \
    _Pragma("unroll") for (int d = 0; d < 4; ++d) _Pragma("unroll") for (int r = 0; r < 16; ++r) o[d][r] *= al_l[crow(r, hi)]; } } while (0)
  f32x16 pA0, pA1, pB0, pB1; float mnA, mnB, alA, alB; bf16x8 pa0, pa1, pa2, pa3; const int NT = seq / KVBLK;
  constexpr int SE = 0, SO = 1;
  SLOAD(SE, 0); asm volatile("s_waitcnt vmcnt(0)" ::: "memory"); SWRITE(0, SE); __syncthreads();
  qkt(pA0, pA1, K_lds, qr, r32, hi, mapB); partialSM(pA0, pA1, m_reg, mnA, alA);
  SLOAD(SO, KVBLK); if (2 < NT) SLOAD(SE, 2 * KVBLK);
  SWAIT(); SWRITE(1, SO); __syncthreads();
  for (int j = 1; j + 1 < NT; j += 2) {
    SBAR(); qkt(pB0, pB1, K_lds + SHM_K, qr, r32, hi, mapB);
    finishSM(pA0, pA1, alA, l_reg, pa0, pa1, pa2, pa3); SBAR();
    SLOAD(SO, (j + 2) * KVBLK); SBAR();
    pv_d0(o, vb0, pa0, pa1, pa2, pa3); partialSM(pB0, pB1, m_reg, mnB, alB);
    __syncthreads(); SWAIT(); SWRITE(0, SE);
    RESC(alB); __syncthreads();
    SBAR(); qkt(pA0, pA1, K_lds, qr, r32, hi, mapB);
    finishSM(pB0, pB1, alB, l_reg, pa0, pa1, pa2, pa3); SBAR();
    if (j + 3 < NT) SLOAD(SE, (j + 3) * KVBLK); SBAR();
    pv_d0(o, vb0 + (int)SHM_V, pa0, pa1, pa2, pa3); partialSM(pA0, pA1, m_reg, mnA, alA);
    __syncthreads(); SWAIT(); SWRITE(1, SO);
    RESC(alA); __syncthreads();
  }
  SBAR(); qkt(pB0, pB1, K_lds + SHM_K, qr, r32, hi, mapB);
  finishSM(pA0, pA1, alA, l_reg, pa0, pa1, pa2, pa3); SBAR();
  pv_d0(o, vb0, pa0, pa1, pa2, pa3); partialSM(pB0, pB1, m_reg, mnB, alB);
  __syncthreads(); RESC(alB);
  finishSM(pB0, pB1, alB, l_reg, pa0, pa1, pa2, pa3); SBAR();
  pv_d0(o, vb0 + (int)SHM_V, pa0, pa1, pa2, pa3);
  if (hi == 0) li_l[r32] = l_reg; asm volatile("s_waitcnt lgkmcnt(0)" ::: "memory");
  float rli[16];
#pragma unroll
  for (int r = 0; r < 16; ++r) rli[r] = __builtin_amdgcn_rcpf(li_l[crow(r, hi)]);
  __syncthreads();
  float* X = (float*)lds;
  if (mp == 1) {
#pragma unroll
    for (int d = 0; d < 4; ++d)
#pragma unroll
      for (int r = 0; r < 16; ++r) X[(wq * 64 + d * 16 + r) * 64 + lane] = o[d][r] * rli[r] * lam;
  }
  __syncthreads();
  if (mp == 0) {
#pragma unroll
    for (int d = 0; d < 4; ++d)
#pragma unroll
      for (int r = 0; r < 16; ++r) { const int ix = (wq * 64 + d * 16 + r) * 64 + lane; X[ix] = o[d][r] * rli[r] - X[ix]; }
  }
  __syncthreads();
  {
    const int row = tid >> 2, dq = tid & 3, rl = row & 31, w = row >> 5, hh = (rl >> 2) & 1, r = (rl & 3) + 4 * (rl >> 3);
    const float* xb = X + (w * 64 + dq * 16 + r) * 64 + hh * 32;
    f32x4 a[8]; float ss = 0.f;
#pragma unroll
    for (int i = 0; i < 8; ++i) { a[i] = *(const f32x4*)(xb + i * 4); ss += a[i][0] * a[i][0] + a[i][1] * a[i][1] + a[i][2] * a[i][2] + a[i][3] * a[i][3]; }
    ss += __shfl_xor(ss, 1); ss += __shfl_xor(ss, 2);
    const float rn = __builtin_amdgcn_rsqf(ss * (1.f / 128.f) + 1e-5f) * oscale;
    bf16_t* zp = proj + (size_t)(tok0 + row) * NPROJ + C_ZA + h * 128 + dq * 32;
    const float* gg = subg + dq * 32;
#pragma unroll
    for (int i = 0; i < 4; ++i) {
      const u32x4 z = *(const u32x4*)(zp + i * 8);
      const f32x4 a0 = a[2 * i], a1 = a[2 * i + 1]; const f32x4 g0 = *(const f32x4*)(gg + i * 8), g1 = *(const f32x4*)(gg + i * 8 + 4);
      u32x4 wv;
      wv.x = cvtpk(a0[0] * rn * g0[0] * silu(bflo(z.x)), a0[1] * rn * g0[1] * silu(bfhi(z.x)));
      wv.y = cvtpk(a0[2] * rn * g0[2] * silu(bflo(z.y)), a0[3] * rn * g0[3] * silu(bfhi(z.y)));
      wv.z = cvtpk(a1[0] * rn * g1[0] * silu(bflo(z.z)), a1[1] * rn * g1[1] * silu(bfhi(z.z)));
      wv.w = cvtpk(a1[2] * rn * g1[2] * silu(bflo(z.w)), a1[3] * rn * g1[3] * silu(bfhi(z.w)));
      *(u32x4*)(zp + i * 8) = wv;
    }
  }
  __syncthreads();
#undef SLOAD
#undef SWRITE
#undef SWAIT
#undef RESC
#undef LD8
}

__device__ void attn_phase(const Params& p, int l, char* lds) {
  const float lam = p.lam[l];
  const float oscale = 1.f - (0.8f - 0.6f * expf(-0.3f * (float)l));
  const float* subg = p.subln_g + l * 128;
  for (int u = blockIdx.x; u < 2048; u += gridDim.x) {
    int tok0, kv0, seq, h;
    if (u < 1024) { const int x = u & 7, j = u >> 3; const int b = x >> 2; h = x & 3; seq = S_P; kv0 = b * S_P; tok0 = kv0 + j * 128; }
    else { const int v = u - 1024, x = v & 7, j = v >> 3; const int pr = x * 4 + (j >> 5), b = pr >> 2; h = pr & 3; seq = S_S; kv0 = TP + b * S_S; tok0 = kv0 + (j & 31) * 128; }
    attn_unit(p.proj, tok0, kv0, seq, h, lam, oscale, subg, lds);
  }
}
}

__device__ void post_phase(const Params& p, int l) {
  const int tid = threadIdx.x, wid = tid >> 6, lane = tid & 63, nw = blockDim.x >> 6;
  const float* pg = p.post_g + l * DM;
  for (int row = blockIdx.x * nw + wid; row < T_TOK; row += gridDim.x * nw) {
    const float* yr = (const float*)(p.proj + (size_t)row * NPROJ + C_U);
    f32x4 y[4], x[4]; float ss = 0.f;
#pragma unroll
    for (int i = 0; i < 4; ++i) { y[i] = *(const f32x4*)(yr + i * 256 + lane * 4); ss += y[i][0] * y[i][0] + y[i][1] * y[i][1] + y[i][2] * y[i][2] + y[i][3] * y[i][3]; }
    bf16_t* xo = (bf16_t*)p.out + (size_t)row * LDX;
    if (l == 0) {
      const float* xr = row < TP ? p.xp + (size_t)row * DM : p.xs + (size_t)(row - TP) * DM;
#pragma unroll
      for (int i = 0; i < 4; ++i) x[i] = *(const f32x4*)(xr + i * 256 + lane * 4);
    } else {
#pragma unroll
      for (int i = 0; i < 4; ++i) {
        const u32x2 h = *(const u32x2*)(xo + i * 256 + lane * 4), lo = *(const u32x2*)(xo + DM + i * 256 + lane * 4);
        x[i][0] = bflo(h.x) + bflo(lo.x); x[i][1] = bfhi(h.x) + bfhi(lo.x); x[i][2] = bflo(h.y) + bflo(lo.y); x[i][3] = bfhi(h.y) + bfhi(lo.y);
      }
    }
    ss = wave_sum(ss);
    const float ry = __builtin_amdgcn_rsqf(ss * (1.f / DM) + 1e-6f);
    float s2 = 0.f;
#pragma unroll
    for (int i = 0; i < 4; ++i) {
      const f32x4 g = *(const f32x4*)(pg + i * 256 + lane * 4);
#pragma unroll
      for (int e = 0; e < 4; ++e) { x[i][e] = x[i][e] + y[i][e] * ry * g[e]; s2 += x[i][e] * x[i][e]; }
    }
    if (l == DEPTH - 1) {
      float* orow = p.out + (size_t)row * DM;
#pragma unroll
      for (int i = 0; i < 4; ++i) *(f32x4*)(orow + i * 256 + lane * 4) = x[i];
    } else {
      s2 = wave_sum(s2);
      if (lane == 0) p.rinv[row] = __builtin_amdgcn_rsqf(s2 * (1.f / DM) + 1e-6f);
#pragma unroll
      for (int i = 0; i < 4; ++i) {
        const unsigned h0 = cvtpk(x[i][0], x[i][1]), h1 = cvtpk(x[i][2], x[i][3]);
        const unsigned l0 = cvtpk(x[i][0] - bflo(h0), x[i][1] - bfhi(h0)), l1 = cvtpk(x[i][2] - bflo(h1), x[i][3] - bfhi(h1));
        *(u32x2*)(xo + i * 256 + lane * 4) = (u32x2){h0, h1}; *(u32x2*)(xo + DM + i * 256 + lane * 4) = (u32x2){l0, l1};
      }
    }
  }
}

__device__ __forceinline__ void run_phase(const Params& p, int ph, char* shm) {
  if (ph == 0) { phase0(p, shm); return; }
  const int l = (ph - 1) >> 2, s = (ph - 1) & 3;
  if (s == 0) { gm::EpiIn e{p.rinv, p.rope, p.proj}; gm::gemm_phase(( const bf16_t*)p.out, LDX, p.WinT + (size_t)l * NPROJ * DM, NPROJ, e, shm); }
  else if (s == 1) { pool_phase(p, l); at::attn_phase(p, l, shm); }
  else if (s == 2) { gm::EpiOut e{p.proj}; gm::gemm_phase(p.proj, NPROJ, p.WoutT + (size_t)l * DM * DM, DM, e, shm); }
  else post_phase(p, l);
}

#if MK_MULTI
template <int S> __global__ void __launch_bounds__(NT_THREADS, 1) k_phase(Params p, int l) {
  extern __shared__ __attribute__((aligned(16))) char shm[];
  if (S == 0) phase0(p, shm); else run_phase(p, 1 + 4 * l + (S - 1), shm);
}
#else
__global__ void __launch_bounds__(NT_THREADS, 1) k_mega(Params p) {
  extern __shared__ __attribute__((aligned(16))) char shm[];
  cg::grid_group grid = cg::this_grid();
  for (int ph = 0; ph <= 4 * DEPTH; ++ph) {
    run_phase(p, ph, shm);
    if (ph < 4 * DEPTH) grid.sync();
  }
}
#endif

extern "C" void kernel_launch(void* const* d_in, const int* in_sizes, int n_in, void* d_out, int out_size, void* d_ws, size_t ws_size, hipStream_t stream) {
  Params p{};
  p.xp = (const float*)d_in[0]; p.xs = (const float*)d_in[1]; p.pre_g = (const float*)d_in[2]; p.w_in = (const float*)d_in[3];
  p.pool_w = (const float*)d_in[4]; p.pool_scale = (const float*)d_in[5]; p.lq1 = (const float*)d_in[6]; p.lk1 = (const float*)d_in[7];
  p.lq2 = (const float*)d_in[8]; p.lk2 = (const float*)d_in[9]; p.subln_g = (const float*)d_in[10]; p.w_out = (const float*)d_in[11]; p.post_g = (const float*)d_in[12];
  p.out = (float*)d_out;
  char* w = (char*)d_ws; size_t off = 0;
  p.proj = (bf16_t*)(w + off); off += (size_t)T_TOK * NPROJ * 2;
  p.WinT = (bf16_t*)(w + off); off += (size_t)DEPTH * NPROJ * DM * 2;
  p.WoutT = (bf16_t*)(w + off); off += (size_t)DEPTH * DM * DM * 2;
  p.rinv = (float*)(w + off); off += (size_t)T_TOK * 4;
  p.rope = (float*)(w + off); off += 256;
  p.lam = (float*)(w + off); off += 256;
  if (off > ws_size) { fprintf(stderr, "kernel_launch: workspace too small (%zu > %zu)\n", off, ws_size); return; }
#if MK_MULTI
  static int ok = 0;
  if (!ok) {
    (void)hipFuncSetAttribute((const void*)k_phase<0>, hipFuncAttributeMaxDynamicSharedMemorySize, (int)SHM_BYTES);
    (void)hipFuncSetAttribute((const void*)k_phase<1>, hipFuncAttributeMaxDynamicSharedMemorySize, (int)SHM_BYTES);
    (void)hipFuncSetAttribute((const void*)k_phase<2>, hipFuncAttributeMaxDynamicSharedMemorySize, (int)SHM_BYTES);
    (void)hipFuncSetAttribute((const void*)k_phase<3>, hipFuncAttributeMaxDynamicSharedMemorySize, (int)SHM_BYTES);
    (void)hipFuncSetAttribute((const void*)k_phase<4>, hipFuncAttributeMaxDynamicSharedMemorySize, (int)SHM_BYTES);
    ok = 1; }
  hipLaunchKernelGGL(k_phase<0>, dim3(256), dim3(NT_THREADS), SHM_BYTES, stream, p, 0);
  for (int l = 0; l < DEPTH; ++l) {
    hipLaunchKernelGGL(k_phase<1>, dim3(256), dim3(NT_THREADS), SHM_BYTES, stream, p, l);
    hipLaunchKernelGGL(k_phase<2>, dim3(256), dim3(NT_THREADS), SHM_BYTES, stream, p, l);
    hipLaunchKernelGGL(k_phase<3>, dim3(256), dim3(NT_THREADS), SHM_BYTES, stream, p, l);
    hipLaunchKernelGGL(k_phase<4>, dim3(256), dim3(NT_THREADS), SHM_BYTES, stream, p, l);
  }
#else
  static int grid_blocks = 0;
  if (!grid_blocks) {
    (void)hipFuncSetAttribute((const void*)k_mega, hipFuncAttributeMaxDynamicSharedMemorySize, (int)SHM_BYTES);
    int dev = 0, cus = 0, per_cu = 0;
    (void)hipGetDevice(&dev);
    (void)hipDeviceGetAttribute(&cus, hipDeviceAttributeMultiprocessorCount, dev);
    (void)hipOccupancyMaxActiveBlocksPerMultiprocessor(&per_cu, k_mega, NT_THREADS, SHM_BYTES);
    if (per_cu > 1) per_cu = 1;
    grid_blocks = cus * per_cu;
  }
  void* args[] = {&p};
  hipError_t e = hipLaunchCooperativeKernel((void*)k_mega, dim3(grid_blocks), dim3(NT_THREADS), args, SHM_BYTES, stream);
  if (e != hipSuccess) fprintf(stderr, "cooperative launch failed: %s (grid %d)\n", hipGetErrorString(e), grid_blocks);
#endif
}
```

```cpp
#include <hip/hip_runtime.h>
#include <hip/hip_cooperative_groups.h>
#include <cstdio>
#include <cstdint>
namespace cg = cooperative_groups;

#ifndef MK_MULTI
#define MK_MULTI 0
#endif

typedef unsigned short bf16_t;
using bf16x8 = __attribute__((ext_vector_type(8))) short;
using s16x4  = __attribute__((ext_vector_type(4))) short;
using f32x16 = __attribute__((ext_vector_type(16))) float;
using f32x4  = __attribute__((ext_vector_type(4))) float;
using u32x4  = __attribute__((ext_vector_type(4))) unsigned;
using u32x2  = __attribute__((ext_vector_type(2))) unsigned;

constexpr int NT_THREADS = 512;
constexpr int T_TOK = 65536, TP = 32768, DM = 1024, NPROJ = 3072, DEPTH = 2;
constexpr int S_P = 16384, S_S = 4096;
constexpr int C_ZP = 0, C_ZA = 512, C_U = 1024, C_Q = 1536, C_K = 2048, C_V = 2560;
constexpr int LDX = 2048;
constexpr float QSCALE = 0.125f * 1.4426950408889634f;
constexpr size_t SHM_BYTES = 131072 + 4096;

struct Params {
  const float* xp; const float* xs; const float* pre_g; const float* w_in; const float* pool_w; const float* pool_scale;
  const float* lq1; const float* lk1; const float* lq2; const float* lk2; const float* subln_g; const float* w_out; const float* post_g;
  float* out; bf16_t* WinT; bf16_t* WoutT; bf16_t* proj; float* rinv; float* rope; float* lam;
};

#define SBAR() __builtin_amdgcn_sched_barrier(0)
__device__ __forceinline__ unsigned cvtpk(float lo, float hi) {
  unsigned r; asm volatile("v_cvt_pk_bf16_f32 %0, %1, %2" : "=v"(r) : "v"(lo), "v"(hi)); return r;
}
__device__ __forceinline__ float bf2f(unsigned short b) { return __uint_as_float(((unsigned)b) << 16); }
__device__ __forceinline__ float bflo(unsigned w) { return __uint_as_float(w << 16); }
__device__ __forceinline__ float bfhi(unsigned w) { return __uint_as_float(w & 0xffff0000u); }
__device__ __forceinline__ bf16_t f2bf(float f) { return (bf16_t)(cvtpk(f, 0.f) & 0xffffu); }
__host__ __device__ __forceinline__ int perm32(int rho) { const int n = rho >> 4, i = rho & 15; return 8 * (i >> 2) + 4 * n + (i & 3); }
__device__ __forceinline__ float silu(float z) { return z * __builtin_amdgcn_rcpf(1.f + __builtin_amdgcn_exp2f(-1.4426950408889634f * z)); }
__device__ __forceinline__ int opaque_tid() { int t = threadIdx.x; asm volatile("" : "+v"(t)); return t; }
__device__ __forceinline__ float wave_sum(float v) {
#pragma unroll
  for (int o = 32; o >= 1; o >>= 1) v += __shfl_xor(v, o);
  return v;
}

__device__ __forceinline__ int src_col_in(int s) {
  const int type = s >> 9, within = s & 511;
  if (type == 0) return 512 + within;
  if (type == 1) return 2560 + within;
  if (type == 5) return 2048 + within;
  const int p = within & 63, wcl = p >> 5, fq = (p >> 3) & 3, n = (p >> 2) & 1, jj = p & 3;
  const int d = wcl * 16 + fq * 4 + jj + 32 * n;
  return (type == 3 ? 1024 : 1536) + (within & ~63) + d;
}

__device__ void phase0(const Params& p, char* shm) {
  const int tid = opaque_tid(), nth = blockDim.x;
  float* tile = (float*)shm;
  constexpr int NT_IN = DEPTH * 48 * 16, NT_OUT = DEPTH * 16 * 16;
  for (int it = blockIdx.x; it < NT_IN + NT_OUT; it += gridDim.x) {
    __syncthreads();
    if (it < NT_IN) {
      const int l = it / (48 * 16), r = it % (48 * 16), n0 = (r / 16) * 64, k0 = (r % 16) * 64;
      const float* W = p.w_in + (size_t)l * DM * NPROJ; const float* g = p.pre_g + l * DM;
      for (int e = tid; e < 4096; e += nth) {
        const int nn = e & 63, kk = e >> 6, k = k0 + kk, nrow = n0 + nn;
        const int s = (nrow & ~31) + perm32(nrow & 31);
        float v;
        if ((s >> 9) == 2) {
          const int within = s & 511, gi = within >> 7, d = within & 127;
          const float* wr = W + (size_t)k * NPROJ + gi * 128; const float* pw = p.pool_w + ((size_t)(l * 4 + gi) * 128) * 128 + d;
          float a = 0.f;
          for (int c = 0; c < 128; ++c) a = fmaf(wr[c], pw[(size_t)c * 128], a);
          v = a;
        } else v = W[(size_t)k * NPROJ + src_col_in(s)];
        tile[kk * 65 + nn] = v * g[k];
      }
      __syncthreads();
      bf16_t* O = p.WinT + (size_t)l * NPROJ * DM;
      for (int e = tid; e < 4096; e += nth) { const int kk = e & 63, nn = e >> 6; O[(size_t)(n0 + nn) * DM + k0 + kk] = f2bf(tile[kk * 65 + nn]); }
    } else {
      const int it2 = it - NT_IN, l = it2 / 256, r = it2 % 256, n0 = (r / 16) * 64, k0 = (r % 16) * 64;
      const float* W = p.w_out + (size_t)l * DM * DM;
      for (int e = tid; e < 4096; e += nth) {
        const int nn = e & 63, kk = e >> 6, nrow = n0 + nn; const int s = (nrow & ~31) + perm32(nrow & 31);
        tile[kk * 65 + nn] = W[(size_t)(k0 + kk) * DM + s];
      }
      __syncthreads();
      bf16_t* O = p.WoutT + (size_t)l * DM * DM;
      for (int e = tid; e < 4096; e += nth) { const int kk = e & 63, nn = e >> 6; O[(size_t)(n0 + nn) * DM + k0 + kk] = f2bf(tile[kk * 65 + nn]); }
    }
  }
  if (blockIdx.x == 0) {
    if (tid < 32) { const double c = exp(-(double)tid * (9.210340371976184 / 32.0)) * 0.15915494309189535; const float h = (float)c; p.rope[2 * tid] = h; p.rope[2 * tid + 1] = (float)(c - (double)h); }
    if (tid >= 64 && tid < 64 + 64 * DEPTH) {
      const int l = (tid >> 6) - 1, i = tid & 63;
      float a = p.lq1[l * 64 + i] * p.lk1[l * 64 + i], b = p.lq2[l * 64 + i] * p.lk2[l * 64 + i];
      a = wave_sum(a); b = wave_sum(b);
      const float li = 0.8f - 0.6f * expf(-0.3f * (float)l);
      if (i == 0) p.lam[l] = expf(a) - expf(b) + li;
    }
  }
  const int wid = tid >> 6, lane = tid & 63, nw = nth >> 6;
  for (int row = blockIdx.x * nw + wid; row < T_TOK; row += gridDim.x * nw) {
    const float* xr = row < TP ? p.xp + (size_t)row * DM : p.xs + (size_t)(row - TP) * DM;
    bf16_t* xo = (bf16_t*)p.out + (size_t)row * LDX;
    float ss = 0.f;
#pragma unroll
    for (int i = 0; i < 4; ++i) {
      const f32x4 v = *(const f32x4*)(xr + i * 256 + lane * 4);
      ss += v[0] * v[0] + v[1] * v[1] + v[2] * v[2] + v[3] * v[3];
      u32x2 w = {cvtpk(v[0], v[1]), cvtpk(v[2], v[3])};
      *(u32x2*)(xo + i * 256 + lane * 4) = w;
    }
    ss = wave_sum(ss);
    if (lane == 0) p.rinv[row] = __builtin_amdgcn_rsqf(ss * (1.f / DM) + 1e-6f);
  }
}

namespace gm {
constexpr int BM = 256, BK = 64, HALF = 128, NXCD = 8, WGM = 8, HT = HALF * BK;
__device__ __forceinline__ int lds_byte(int r, int c) { int st = (r >> 4) * 2 + (c >> 5), rr = r & 15, cc = c & 31, ob = rr * 64 + cc * 2; return st * 1024 + (ob ^ (((ob >> 9) & 1) << 5)); }
__device__ __forceinline__ void stage_rc(int b, int& R, int& C) { int st = b / 1024, sb = b % 1024, swz = sb ^ (((sb >> 9) & 1) << 5); R = (st >> 1) * 16 + swz / 64; C = (st & 1) * 32 + (swz % 64) / 2; }

#define LAS __attribute__((address_space(3)))
template <class Epi>
__device__ __forceinline__ void gemm_phase(const bf16_t* __restrict__ A, const int lda, const bf16_t* __restrict__ Bt, const int N, const Epi& E, char* shmc) {
  constexpr int K = 1024, nt = K / BK, HTB = HALF * BK * 2;
  LAS unsigned char* lds = (LAS unsigned char*)shmc;
  const int tid = opaque_tid(), wid = __builtin_amdgcn_readfirstlane(tid >> 6), lane = tid & 63, wr = wid >> 2, wc = wid & 3, fr = lane & 15, fq = lane >> 4;
  unsigned voffA[2], voffB[2];
#pragma unroll
  for (int i = 0; i < 2; ++i) { int R, C; stage_rc(tid * 16 + i * 8192, R, C); voffA[i] = (unsigned)(R * lda + C) * 2u; voffB[i] = (unsigned)(R * K + C) * 2u; }
  const size_t kstep = (size_t)(BK * 2);
  const size_t hstepA = (size_t)HALF * lda * 2, hstepB = (size_t)HALF * K * 2;
  const size_t tstepA = 2 * hstepA, tstepB = 2 * hstepB;
  const unsigned ldsw = (unsigned)wid * 1024u;
  const int aoff = lds_byte(wr * 64 + fr, fq * 8), boff = lds_byte(wc * 32 + fr, fq * 8);
#define PG8_SA(b, h) (((b) * 2 + (h)) * HTB)
#define PG8_SB(b, h) ((4 + (b) * 2 + (h)) * HTB)
#define PG8_STAGE(bufoff, gbase, voff) do { _Pragma("unroll") for (int _i = 0; _i < 2; ++_i) \
        __builtin_amdgcn_global_load_lds((const unsigned*)((const char*)(gbase) + (voff)[_i]), (LAS unsigned*)(lds + (bufoff) + ldsw + _i * 8192), 16, 0, 0); } while (0)
#define PG8_LDA(dst, b, h) do { _Pragma("unroll") for (int m = 0; m < 4; ++m) _Pragma("unroll") for (int k = 0; k < 2; ++k) dst[m][k] = *(const LAS bf16x8*)(lds + PG8_SA(b, h) + aoff + m * 2048 + k * 1024); } while (0)
#define PG8_LDB(dst, b, h) do { _Pragma("unroll") for (int n = 0; n < 2; ++n) _Pragma("unroll") for (int k = 0; k < 2; ++k) dst[n][k] = *(const LAS bf16x8*)(lds + PG8_SB(b, h) + boff + n * 2048 + k * 1024); } while (0)
#define PG8_MMA(ai, bj, At, Bx) do { __builtin_amdgcn_s_setprio(1); _Pragma("unroll") for (int m = 0; m < 4; ++m) _Pragma("unroll") for (int n = 0; n < 2; ++n) _Pragma("unroll") for (int k = 0; k < 2; ++k) \
        acc[ai][bj][m][n] = __builtin_amdgcn_mfma_f32_16x16x32_bf16(Bx[n][k], At[m][k], acc[ai][bj][m][n], 0, 0, 0); __builtin_amdgcn_s_setprio(0); } while (0)
#define PG8_WAIT_V(n) asm volatile("s_waitcnt vmcnt(" #n ")" ::: "memory")
#define PG8_WAIT_L(n) asm volatile("s_waitcnt lgkmcnt(" #n ")" ::: "memory")
#define PG8_BAR __builtin_amdgcn_s_barrier()
#define PG8_SCHED __builtin_amdgcn_sched_barrier(0)
  const int nM = T_TOK / BM, nN = N / BM, nwg = nM * nN, G = gridDim.x, cblk = blockIdx.x;
  auto next_unit = [&](int i, int& pm, int& pn) -> bool {
    const long L = (long)i * G + cblk; if (L >= nwg) return false;
    int wgid = (int)L; { const int q = nwg / NXCD, r = nwg % NXCD, xcd = wgid % NXCD, off = wgid / NXCD; wgid = (xcd < r ? xcd * (q + 1) : r * (q + 1) + (xcd - r) * q) + off; }
    const int nig = WGM * nN, gid = wgid / nig, fm = gid * WGM, gsz = (nM - fm) < WGM ? (nM - fm) : WGM;
    pm = fm + ((wgid % nig) % gsz); pn = (wgid % nig) / gsz; return true;
  };
  int cpm, cpn, npm = 0, npn = 0, ui = 0;
  if (!next_unit(0, cpm, cpn)) return;
  f32x4 acc[2][2][4][2];
#pragma unroll
  for (int a = 0; a < 2; ++a)
#pragma unroll
    for (int b = 0; b < 2; ++b)
#pragma unroll
      for (int m = 0; m < 4; ++m)
#pragma unroll
        for (int n = 0; n < 2; ++n) acc[a][b][m][n] = (f32x4){0.f, 0.f, 0.f, 0.f};
  bf16x8 At[4][2], B0[2][2], B1[2][2];
  const char* cA = (const char*)A + (size_t)cpm * tstepA; const char* cB = (const char*)Bt + (size_t)cpn * tstepB;
  PG8_STAGE(PG8_SB(0, 0), cB, voffB); PG8_STAGE(PG8_SB(0, 1), cB + hstepB, voffB); PG8_STAGE(PG8_SA(0, 0), cA, voffA); PG8_STAGE(PG8_SA(0, 1), cA + hstepA, voffA);
  if (wr == 1) PG8_BAR;
  PG8_WAIT_V(2); PG8_BAR;
  PG8_STAGE(PG8_SB(1, 0), cB + kstep, voffB); PG8_STAGE(PG8_SA(1, 0), cA + kstep, voffA); PG8_STAGE(PG8_SB(1, 1), cB + hstepB + kstep, voffB);
  PG8_WAIT_V(6); PG8_BAR;
  for (;;) {
    const bool has_next = next_unit(ui + 1, npm, npn);
    const char* nA = has_next ? (const char*)A + (size_t)npm * tstepA : cA; const char* nB = has_next ? (const char*)Bt + (size_t)npn * tstepB : cB;
    for (int t = 0; t < nt; t += 2) {
      const bool last = (t == nt - 2);
      const char* a1 = cA + (size_t)(t + 1) * kstep;
      const char* a2 = last ? nA : cA + (size_t)(t + 2) * kstep; const char* b2 = last ? nB : cB + (size_t)(t + 2) * kstep;
      const char* a3 = a2 + kstep; const char* b3 = b2 + kstep;
      PG8_LDB(B0, 0, 0); PG8_LDB(B1, 0, 1); PG8_SCHED; PG8_LDA(At, 0, 0); PG8_STAGE(PG8_SA(1, 1), a1 + hstepA, voffA);
      PG8_WAIT_V(8); PG8_WAIT_L(0); PG8_BAR; PG8_MMA(0, 0, At, B0); PG8_MMA(0, 1, At, B1); PG8_BAR; PG8_SCHED;
      PG8_LDA(At, 0, 1); PG8_STAGE(PG8_SB(0, 0), b2, voffB); PG8_STAGE(PG8_SB(0, 1), b2 + hstepB, voffB); PG8_STAGE(PG8_SA(0, 0), a2, voffA);
      PG8_WAIT_V(8); PG8_WAIT_L(0); PG8_BAR; PG8_MMA(1, 0, At, B0); PG8_MMA(1, 1, At, B1); PG8_BAR; PG8_SCHED;
      PG8_LDB(B0, 1, 0); PG8_LDB(B1, 1, 1); PG8_SCHED; PG8_LDA(At, 1, 0); PG8_STAGE(PG8_SA(0, 1), a2 + hstepA, voffA);
      PG8_WAIT_V(8); PG8_WAIT_L(0); PG8_BAR; PG8_MMA(0, 0, At, B0); PG8_MMA(0, 1, At, B1); PG8_BAR; PG8_SCHED;
      PG8_LDA(At, 1, 1); PG8_STAGE(PG8_SB(1, 0), b3, voffB); PG8_STAGE(PG8_SB(1, 1), b3 + hstepB, voffB); PG8_STAGE(PG8_SA(1, 0), a3, voffA);
      PG8_WAIT_V(8); PG8_WAIT_L(0); PG8_BAR; PG8_MMA(1, 0, At, B0); PG8_MMA(1, 1, At, B1); PG8_BAR; PG8_SCHED;
    }
    if (wr == 0) PG8_BAR;
    E(acc, cpm, cpn, wr, wc, fr, fq);
    if (!has_next) break;
#pragma unroll
    for (int a = 0; a < 2; ++a)
#pragma unroll
      for (int b = 0; b < 2; ++b)
#pragma unroll
        for (int m = 0; m < 4; ++m)
#pragma unroll
          for (int n = 0; n < 2; ++n) acc[a][b][m][n] = (f32x4){0.f, 0.f, 0.f, 0.f};
    cpm = npm; cpn = npn; cA = nA; cB = nB; ++ui;
    if (wr == 1) PG8_BAR;
  }
  PG8_WAIT_V(0);
  PG8_BAR;
#undef PG8_SA
#undef PG8_SB
#undef PG8_STAGE
#undef PG8_LDA
#undef PG8_LDB
#undef PG8_MMA
}

struct EpiIn {
  const float* rinv; const float* rope; bf16_t* proj;
  __device__ __forceinline__ void operator()(const f32x4 (&acc)[2][2][4][2], int pm, int pn, int wr, int wc, int fr, int fq) const {
    const bool isrope = (pn >= 6 && pn <= 9); const float qs = (pn == 6 || pn == 7) ? QSCALE : 1.f;
    float ch[4], cl[4];
    if (isrope) {
#pragma unroll
      for (int jj = 0; jj < 4; ++jj) { const int i = (wc & 1) * 16 + fq * 4 + jj; ch[jj] = rope[2 * i]; cl[jj] = rope[2 * i + 1]; }
    }
#pragma unroll
    for (int ai = 0; ai < 2; ++ai)
#pragma unroll
      for (int m = 0; m < 4; ++m) {
        const int row = pm * BM + ai * HALF + wr * 64 + m * 16 + fr;
        const float ri = rinv[row];
        float cs[4], sn[4];
        if (isrope) {
          const float pos = (float)(row < TP ? (row & (S_P - 1)) : (row & (S_S - 1)));
#pragma unroll
          for (int jj = 0; jj < 4; ++jj) {
            const float h = pos * ch[jj], e = fmaf(pos, ch[jj], -h) + pos * cl[jj];
            const float rev = (h - floorf(h)) + e;
            sn[jj] = __builtin_amdgcn_sinf(rev); cs[jj] = __builtin_amdgcn_cosf(rev);
          }
        }
        bf16_t* rowp = proj + (size_t)row * NPROJ + pn * BM + wc * 32 + 8 * fq;
#pragma unroll
        for (int bj = 0; bj < 2; ++bj) {
          f32x4 v0 = acc[ai][bj][m][0] * ri, v1 = acc[ai][bj][m][1] * ri;
          if (isrope) {
#pragma unroll
            for (int jj = 0; jj < 4; ++jj) { const float a = v0[jj], b = v1[jj]; v0[jj] = (a * cs[jj] - b * sn[jj]) * qs; v1[jj] = (b * cs[jj] + a * sn[jj]) * qs; }
          }
          u32x4 w; w.x = cvtpk(v0[0], v0[1]); w.y = cvtpk(v0[2], v0[3]); w.z = cvtpk(v1[0], v1[1]); w.w = cvtpk(v1[2], v1[3]);
          *(u32x4*)(rowp + bj * HALF) = w;
        }
      }
  }
};
struct EpiOut {
  bf16_t* proj;
  __device__ __forceinline__ void operator()(const f32x4 (&acc)[2][2][4][2], int pm, int pn, int wr, int wc, int fr, int fq) const {
#pragma unroll
    for (int ai = 0; ai < 2; ++ai)
#pragma unroll
      for (int m = 0; m < 4; ++m) {
        const int row = pm * BM + ai * HALF + wr * 64 + m * 16 + fr;
        float* rowp = (float*)(proj + (size_t)row * NPROJ + C_U) + pn * BM + wc * 32 + 8 * fq;
#pragma unroll
        for (int bj = 0; bj < 2; ++bj) { *(f32x4*)(rowp + bj * HALF) = acc[ai][bj][m][0]; *(f32x4*)(rowp + bj * HALF + 4) = acc[ai][bj][m][1]; }
      }
  }
};
}

__device__ void pool_phase(const Params& p, int l) {
  const int tid = opaque_tid(), c8 = tid & 63, tq = tid >> 6;
  const int g = c8 >> 4, hw = 1 << g;
  const float* sc = p.pool_scale + l * 512 + c8 * 8;
  float scl[8];
#pragma unroll
  for (int e = 0; e < 8; ++e) scl[e] = sc[e];
  for (int ch = blockIdx.x; ch < T_TOK / 64; ch += gridDim.x) {
    for (int i = 0; i < 8; ++i) {
      const int t = ch * 64 + tq * 8 + i;
      const int S = t < TP ? S_P : S_S, pos = t & (S - 1), s0 = t - pos;
      const int lo = max(pos - hw, 0), hi = min(pos + hw, S);
      float sum[8] = {0, 0, 0, 0, 0, 0, 0, 0};
      for (int j = lo; j < hi; ++j) {
        const u32x4 w = *(const u32x4*)(p.proj + (size_t)(s0 + j) * NPROJ + C_U + c8 * 8);
        sum[0] += bflo(w.x); sum[1] += bfhi(w.x); sum[2] += bflo(w.y); sum[3] += bfhi(w.y);
        sum[4] += bflo(w.z); sum[5] += bfhi(w.z); sum[6] += bflo(w.w); sum[7] += bfhi(w.w);
      }
      const float inv = 1.f / (float)(hi - lo);
      const u32x4 uc = *(const u32x4*)(p.proj + (size_t)t * NPROJ + C_U + c8 * 8);
      bf16_t* zpp = p.proj + (size_t)t * NPROJ + C_ZP + c8 * 8;
      const u32x4 z = *(const u32x4*)zpp;
      float o[8];
      o[0] = (sum[0] * inv - bflo(uc.x)) * scl[0] * silu(bflo(z.x)); o[1] = (sum[1] * inv - bfhi(uc.x)) * scl[1] * silu(bfhi(z.x));
      o[2] = (sum[2] * inv - bflo(uc.y)) * scl[2] * silu(bflo(z.y)); o[3] = (sum[3] * inv - bfhi(uc.y)) * scl[3] * silu(bfhi(z.y));
      o[4] = (sum[4] * inv - bflo(uc.z)) * scl[4] * silu(bflo(z.z)); o[5] = (sum[5] * inv - bfhi(uc.z)) * scl[5] * silu(bfhi(z.z));
      o[6] = (sum[6] * inv - bflo(uc.w)) * scl[6] * silu(bflo(z.w)); o[7] = (sum[7] * inv - bfhi(uc.w)) * scl[7] * silu(bfhi(z.w));
      u32x4 w = {cvtpk(o[0], o[1]), cvtpk(o[2], o[3]), cvtpk(o[4], o[5]), cvtpk(o[6], o[7])};
      *(u32x4*)zpp = w;
    }
  }
}

namespace at {
constexpr int KVBLK = 64, LDK = NPROJ;
constexpr size_t SHM_V = KVBLK * 128 * 2, SHM_K = KVBLK * 128 * 2;
constexpr float THRL = 11.5f;
#define KSWZ(row, colB) ((row) * 256 + ((colB) ^ (((row) & 7) << 4)))
__device__ __forceinline__ int crow(int r, int hi) { return (r & 3) + 8 * (r >> 2) + 4 * hi; }
__device__ __forceinline__ void partialSM(f32x16& p0, f32x16& p1, float& m_reg, float& mn, float& alpha) {
  float pmax = p0[0];
#pragma unroll
  for (int r = 1; r < 16; ++r) pmax = fmaxf(pmax, p0[r]);
#pragma unroll
  for (int r = 0; r < 16; ++r) pmax = fmaxf(pmax, p1[r]);
  { auto rr = __builtin_amdgcn_permlane32_swap(__float_as_uint(pmax), __float_as_uint(pmax), false, false);
    pmax = fmaxf(__uint_as_float(rr[0]), __uint_as_float(rr[1])); }
  if (__builtin_expect(__all(pmax - m_reg <= THRL), 1)) { mn = m_reg; alpha = 1.f; }
  else { mn = fmaxf(m_reg, pmax); alpha = __builtin_amdgcn_exp2f(m_reg - mn); m_reg = mn; }
#pragma unroll
  for (int r = 0; r < 16; ++r) p0[r] = p0[r] - mn;
#pragma unroll
  for (int r = 0; r < 16; ++r) p1[r] = p1[r] - mn;
#pragma unroll
  for (int r = 0; r < 16; ++r) p0[r] = __builtin_amdgcn_exp2f(p0[r]);
}
__device__ __forceinline__ void finishSM(f32x16& p0, f32x16& p1, float alpha, float& l_reg, bf16x8& pa0, bf16x8& pa1, bf16x8& pa2, bf16x8& pa3) {
#pragma unroll
  for (int r = 0; r < 16; ++r) p1[r] = __builtin_amdgcn_exp2f(p1[r]);
  float ps = 0;
#pragma unroll
  for (int r = 0; r < 16; ++r) ps += p0[r];
#pragma unroll
  for (int r = 0; r < 16; ++r) ps += p1[r];
  { auto rr = __builtin_amdgcn_permlane32_swap(__float_as_uint(ps), __float_as_uint(ps), false, false);
    ps = __uint_as_float(rr[0]) + __uint_as_float(rr[1]); }
  l_reg = l_reg * alpha + ps;
#define PK4(P, BASE, OUT) do { unsigned a0 = cvtpk(P[BASE + 0], P[BASE + 1]), a1 = cvtpk(P[BASE + 2], P[BASE + 3]);   \
    unsigned b0 = cvtpk(P[BASE + 4], P[BASE + 5]), b1 = cvtpk(P[BASE + 6], P[BASE + 7]);                              \
    auto r0 = __builtin_amdgcn_permlane32_swap(a0, b0, false, false); auto r1 = __builtin_amdgcn_permlane32_swap(a1, b1, false, false); \
    u32x4 w = {r0[0], r1[0], r0[1], r1[1]}; OUT = *reinterpret_cast<bf16x8*>(&w); } while (0)
  PK4(p0, 0, pa0); PK4(p0, 8, pa1); PK4(p1, 0, pa2); PK4(p1, 8, pa3);
#undef PK4
}
__device__ __forceinline__ void qkt(f32x16& p0, f32x16& p1, const char* Ks, const bf16x8* qr, int r32, int hi, int mapB) {
  p0 = f32x16{}; p1 = f32x16{};
#pragma unroll
  for (int d0 = 0; d0 < 4; ++d0) { const int cb = (d0 * 16 + hi * 8) * 2 + mapB;
    bf16x8 b0 = *reinterpret_cast<const bf16x8*>(Ks + KSWZ(r32, cb));
    bf16x8 b1 = *reinterpret_cast<const bf16x8*>(Ks + KSWZ(32 + r32, cb));
    p0 = __builtin_amdgcn_mfma_f32_32x32x16_bf16(b0, qr[d0], p0, 0, 0, 0);
    p1 = __builtin_amdgcn_mfma_f32_32x32x16_bf16(b1, qr[d0], p1, 0, 0, 0); }
}
__device__ __forceinline__ int v_st(int k, int c) { const int kk = (k & ~0xC) | ((k & 4) << 1) | ((k & 8) >> 1); return ((kk >> 3) * 4 + (c >> 5)) * 512 + ((kk & 7) * 32 + (c & 31)) * 2; }
__device__ __forceinline__ int v_rd_base(int lane) { return ((lane & 3) << 3) | (((lane >> 2) & 3) << 6) | (((lane >> 4) & 1) << 5) | (((lane >> 5) & 1) << 8); }
constexpr int v_rd_off(int d0, int ks, int half) { return d0 * 512 + ks * 4096 + half * 2048; }
template <int OFF> __device__ __forceinline__ s16x4 tr_read(int vb) {
  s16x4 r; asm volatile("ds_read_b64_tr_b16 %0, %1 offset:%2" : "=&v"(r) : "v"(vb), "i"(OFF) : "memory"); return r;
}
template <int D0> __device__ __forceinline__ void pv_one(f32x16& od, int vb, bf16x8 pa0, bf16x8 pa1, bf16x8 pa2, bf16x8 pa3) {
  const s16x4 l0 = tr_read<v_rd_off(D0, 0, 0)>(vb), h0 = tr_read<v_rd_off(D0, 0, 1)>(vb), l1 = tr_read<v_rd_off(D0, 1, 0)>(vb), h1 = tr_read<v_rd_off(D0, 1, 1)>(vb);
  const s16x4 l2 = tr_read<v_rd_off(D0, 2, 0)>(vb), h2 = tr_read<v_rd_off(D0, 2, 1)>(vb), l3 = tr_read<v_rd_off(D0, 3, 0)>(vb), h3 = tr_read<v_rd_off(D0, 3, 1)>(vb);
  asm volatile("s_waitcnt lgkmcnt(0)" ::: "memory"); SBAR();
#define PK(L, H) (bf16x8){L[0], L[1], L[2], L[3], H[0], H[1], H[2], H[3]}
  od = __builtin_amdgcn_mfma_f32_32x32x16_bf16(pa0, PK(l0, h0), od, 0, 0, 0);
  od = __builtin_amdgcn_mfma_f32_32x32x16_bf16(pa1, PK(l1, h1), od, 0, 0, 0);
  od = __builtin_amdgcn_mfma_f32_32x32x16_bf16(pa2, PK(l2, h2), od, 0, 0, 0);
  od = __builtin_amdgcn_mfma_f32_32x32x16_bf16(pa3, PK(l3, h3), od, 0, 0, 0);
#undef PK
}
__device__ __forceinline__ void pv_d0(f32x16* o, int vb, bf16x8 pa0, bf16x8 pa1, bf16x8 pa2, bf16x8 pa3) {
  pv_one<0>(o[0], vb, pa0, pa1, pa2, pa3); pv_one<1>(o[1], vb, pa0, pa1, pa2, pa3); pv_one<2>(o[2], vb, pa0, pa1, pa2, pa3); pv_one<3>(o[3], vb, pa0, pa1, pa2, pa3);
}

__device__ __forceinline__ void attn_unit(bf16_t* __restrict__ proj, int tok0, int kv0, int seq, int h, float lam, float oscale, const float* __restrict__ subg, char* lds) {
  const int tid = opaque_tid(), wid = tid >> 6, lane = tid & 63, r32 = lane & 31, hi = lane >> 5;
  const int wq = wid & 3, mp = wid >> 2, mapB = mp * 128;
  char* V_lds = lds; char* K_lds = lds + 2 * SHM_V;
  float* ws = (float*)(lds + 2 * SHM_V + 2 * SHM_K) + wid * 64; float* li_l = ws; float* al_l = ws + 32;
  const bf16_t* Kh = proj + (size_t)kv0 * NPROJ + C_K + h * 128;
  const bf16_t* Vh = proj + (size_t)kv0 * NPROJ + C_V + h * 128;
  float m_reg = -1e30f, l_reg = 0; f32x16 o[4] = {}; bf16x8 qr[4];
  const bf16_t* Qw = proj + (size_t)(tok0 + wq * 32 + r32) * NPROJ + C_Q + h * 128 + mp * 64 + hi * 8;
#pragma unroll
  for (int d0 = 0; d0 < 4; ++d0) qr[d0] = *reinterpret_cast<const bf16x8*>(Qw + d0 * 16);
  const int sr = tid >> 4, sc = (tid & 15) * 8, vst0 = v_st(sr, sc), vst1 = v_st(32 + sr, sc);
  const int vb0 = (int)(uintptr_t)V_lds + v_rd_base(lane);
  struct { bf16x8 vs0, vs1, ks0, ks1; } sr_[2];
#define LD8(ptr) (*reinterpret_cast<const bf16x8*>(ptr))
#define SLOAD(i, k0) do { sr_[i].vs0 = LD8(&Vh[(size_t)((k0) + sr) * LDK + sc]); sr_[i].vs1 = LD8(&Vh[(size_t)((k0) + 32 + sr) * LDK + sc]); \
    sr_[i].ks0 = LD8(&Kh[(size_t)((k0) + sr) * LDK + sc]); sr_[i].ks1 = LD8(&Kh[(size_t)((k0) + 32 + sr) * LDK + sc]); } while (0)
#define SWRITE(b, i) do { *(bf16x8*)(V_lds + (b) * SHM_V + vst0) = sr_[i].vs0;          \
    *(bf16x8*)(V_lds + (b) * SHM_V + vst1) = sr_[i].vs1; int kc = sc * 2;               \
    *(bf16x8*)(K_lds + (b) * SHM_K + KSWZ(sr, kc)) = sr_[i].ks0;                       \
    *(bf16x8*)(K_lds + (b) * SHM_K + KSWZ(32 + sr, kc)) = sr_[i].ks1; } while (0)
#define SWAIT() asm volatile("s_waitcnt vmcnt(4)" ::: "memory")
#define RESC(a) do { if (__any((a) < 1.f)) { if (hi == 0) al_l[r32] = (a); asm volatile("s_waitcnt lgkmcnt(0)" ::: "memory"); \
    _Pragma("unroll") for (int d = 0; d < 4; ++d) _Pragma("unroll") for (int r = 0; r < 16; ++r) o[d][r] *= al_l[crow(r, hi)]; } } while (0)
  f32x16 pA0, pA1, pB0, pB1; float mnA, mnB, alA, alB; bf16x8 pa0, pa1, pa2, pa3; const int NT = seq / KVBLK;
  constexpr int SE = 0, SO = 1;
  SLOAD(SE, 0); asm volatile("s_waitcnt vmcnt(0)" ::: "memory"); SWRITE(0, SE); __syncthreads();
  qkt(pA0, pA1, K_lds, qr, r32, hi, mapB); partialSM(pA0, pA1, m_reg, mnA, alA);
  SLOAD(SO, KVBLK); if (2 < NT) SLOAD(SE, 2 * KVBLK);
  SWAIT(); SWRITE(1, SO); __syncthreads();
  for (int j = 1; j + 1 < NT; j += 2) {
    SBAR(); qkt(pB0, pB1, K_lds + SHM_K, qr, r32, hi, mapB);
    finishSM(pA0, pA1, alA, l_reg, pa0, pa1, pa2, pa3); SBAR();
    SLOAD(SO, (j + 2) * KVBLK); SBAR();
    pv_d0(o, vb0, pa0, pa1, pa2, pa3); partialSM(pB0, pB1, m_reg, mnB, alB);
    __syncthreads(); SWAIT(); SWRITE(0, SE);
    RESC(alB); __syncthreads();
    SBAR(); qkt(pA0, pA1, K_lds, qr, r32, hi, mapB);
    finishSM(pB0, pB1, alB, l_reg, pa0, pa1, pa2, pa3); SBAR();
    if (j + 3 < NT) SLOAD(SE, (j + 3) * KVBLK); SBAR();
    pv_d0(o, vb0 + (int)SHM_V, pa0, pa1, pa2, pa3); partialSM(pA0, pA1, m_reg, mnA, alA);
    __syncthreads(); SWAIT(); SWRITE(1, SO);
    RESC(alA); __syncthreads();
  }
  SBAR(); qkt(pB0, pB1, K_lds + SHM_K, qr, r32, hi, mapB);
  finishSM(pA0, pA1, alA, l_reg, pa0, pa1, pa2, pa3); SBAR();
  pv_d0(o, vb0, pa0, pa1, pa2, pa3); partialSM(pB0, pB1, m_reg, mnB, alB);
  __syncthreads(); RESC(alB);
  finishSM(pB0, pB1, alB, l_reg, pa0, pa1, pa2, pa3); SBAR();
  pv_d0(o, vb0 + (int)SHM_V, pa0, pa1, pa2, pa3);
  if (hi == 0) li_l[r32] = l_reg; asm volatile("s_waitcnt lgkmcnt(0)" ::: "memory");
  float rli[16];
#pragma unroll
  for (int r = 0; r < 16; ++r) rli[r] = __builtin_amdgcn_rcpf(li_l[crow(r, hi)]);
  __syncthreads();
  float* X = (float*)lds;
  if (mp == 1) {
#pragma unroll
    for (int d = 0; d < 4; ++d)
#pragma unroll
      for (int r = 0; r < 16; ++r) X[(wq * 64 + d * 16 + r) * 64 + lane] = o[d][r] * rli[r] * lam;
  }
  __syncthreads();
  if (mp == 0) {
#pragma unroll
    for (int d = 0; d < 4; ++d)
#pragma unroll
      for (int r = 0; r < 16; ++r) { const int ix = (wq * 64 + d * 16 + r) * 64 + lane; X[ix] = o[d][r] * rli[r] - X[ix]; }
  }
  __syncthreads();
  {
    const int row = tid >> 2, dq = tid & 3, rl = row & 31, w = row >> 5, hh = (rl >> 2) & 1, r = (rl & 3) + 4 * (rl >> 3);
    const float* xb = X + (w * 64 + dq * 16 + r) * 64 + hh * 32;
    f32x4 a[8]; float ss = 0.f;
#pragma unroll
    for (int i = 0; i < 8; ++i) { a[i] = *(const f32x4*)(xb + i * 4); ss += a[i][0] * a[i][0] + a[i][1] * a[i][1] + a[i][2] * a[i][2] + a[i][3] * a[i][3]; }
    ss += __shfl_xor(ss, 1); ss += __shfl_xor(ss, 2);
    const float rn = __builtin_amdgcn_rsqf(ss * (1.f / 128.f) + 1e-5f) * oscale;
    bf16_t* zp = proj + (size_t)(tok0 + row) * NPROJ + C_ZA + h * 128 + dq * 32;
    const float* gg = subg + dq * 32;
#pragma unroll
    for (int i = 0; i < 4; ++i) {
      const u32x4 z = *(const u32x4*)(zp + i * 8);
      const f32x4 a0 = a[2 * i], a1 = a[2 * i + 1]; const f32x4 g0 = *(const f32x4*)(gg + i * 8), g1 = *(const f32x4*)(gg + i * 8 + 4);
      u32x4 wv;
      wv.x = cvtpk(a0[0] * rn * g0[0] * silu(bflo(z.x)), a0[1] * rn * g0[1] * silu(bfhi(z.x)));
      wv.y = cvtpk(a0[2] * rn * g0[2] * silu(bflo(z.y)), a0[3] * rn * g0[3] * silu(bfhi(z.y)));
      wv.z = cvtpk(a1[0] * rn * g1[0] * silu(bflo(z.z)), a1[1] * rn * g1[1] * silu(bfhi(z.z)));
      wv.w = cvtpk(a1[2] * rn * g1[2] * silu(bflo(z.w)), a1[3] * rn * g1[3] * silu(bfhi(z.w)));
      *(u32x4*)(zp + i * 8) = wv;
    }
  }
  __syncthreads();
#undef SLOAD
#undef SWRITE
#undef SWAIT
#undef RESC
#undef LD8
}

__device__ void attn_phase(const Params& p, int l, char* lds) {
  const float lam = p.lam[l];
  const float oscale = 1.f - (0.8f - 0.6f * expf(-0.3f * (float)l));
  const float* subg = p.subln_g + l * 128;
  for (int u = blockIdx.x; u < 2048; u += gridDim.x) {
    int tok0, kv0, seq, h;
    if (u < 1024) { const int x = u & 7, j = u >> 3; const int b = x >> 2; h = x & 3; seq = S_P; kv0 = b * S_P; tok0 = kv0 + j * 128; }
    else { const int v = u - 1024, x = v & 7, j = v >> 3; const int pr = x * 4 + (j >> 5), b = pr >> 2; h = pr & 3; seq = S_S; kv0 = TP + b * S_S; tok0 = kv0 + (j & 31) * 128; }
    attn_unit(p.proj, tok0, kv0, seq, h, lam, oscale, subg, lds);
  }
}
}

__device__ void post_phase(const Params& p, int l) {
  const int tid = opaque_tid(), wid = tid >> 6, lane = tid & 63, nw = blockDim.x >> 6;
  const float* pg = p.post_g + l * DM;
  for (int row = blockIdx.x * nw + wid; row < T_TOK; row += gridDim.x * nw) {
    const float* yr = (const float*)(p.proj + (size_t)row * NPROJ + C_U);
    f32x4 y[4], x[4]; float ss = 0.f;
#pragma unroll
    for (int i = 0; i < 4; ++i) { y[i] = *(const f32x4*)(yr + i * 256 + lane * 4); ss += y[i][0] * y[i][0] + y[i][1] * y[i][1] + y[i][2] * y[i][2] + y[i][3] * y[i][3]; }
    bf16_t* xo = (bf16_t*)p.out + (size_t)row * LDX;
    if (l == 0) {
      const float* xr = row < TP ? p.xp + (size_t)row * DM : p.xs + (size_t)(row - TP) * DM;
#pragma unroll
      for (int i = 0; i < 4; ++i) x[i] = *(const f32x4*)(xr + i * 256 + lane * 4);
    } else {
#pragma unroll
      for (int i = 0; i < 4; ++i) {
        const u32x2 h = *(const u32x2*)(xo + i * 256 + lane * 4), lo = *(const u32x2*)(xo + DM + i * 256 + lane * 4);
        x[i][0] = bflo(h.x) + bflo(lo.x); x[i][1] = bfhi(h.x) + bfhi(lo.x); x[i][2] = bflo(h.y) + bflo(lo.y); x[i][3] = bfhi(h.y) + bfhi(lo.y);
      }
    }
    ss = wave_sum(ss);
    const float ry = __builtin_amdgcn_rsqf(ss * (1.f / DM) + 1e-6f);
    float s2 = 0.f;
#pragma unroll
    for (int i = 0; i < 4; ++i) {
      const f32x4 g = *(const f32x4*)(pg + i * 256 + lane * 4);
#pragma unroll
      for (int e = 0; e < 4; ++e) { x[i][e] = x[i][e] + y[i][e] * ry * g[e]; s2 += x[i][e] * x[i][e]; }
    }
    if (l == DEPTH - 1) {
      float* orow = p.out + (size_t)row * DM;
#pragma unroll
      for (int i = 0; i < 4; ++i) *(f32x4*)(orow + i * 256 + lane * 4) = x[i];
    } else {
      s2 = wave_sum(s2);
      if (lane == 0) p.rinv[row] = __builtin_amdgcn_rsqf(s2 * (1.f / DM) + 1e-6f);
#pragma unroll
      for (int i = 0; i < 4; ++i) {
        const unsigned h0 = cvtpk(x[i][0], x[i][1]), h1 = cvtpk(x[i][2], x[i][3]);
        const unsigned l0 = cvtpk(x[i][0] - bflo(h0), x[i][1] - bfhi(h0)), l1 = cvtpk(x[i][2] - bflo(h1), x[i][3] - bfhi(h1));
        *(u32x2*)(xo + i * 256 + lane * 4) = (u32x2){h0, h1}; *(u32x2*)(xo + DM + i * 256 + lane * 4) = (u32x2){l0, l1};
      }
    }
  }
}

__device__ __forceinline__ void run_phase(const Params& p, int ph, char* shm) {
  if (ph == 0) { phase0(p, shm); return; }
  const int l = (ph - 1) >> 2, s = (ph - 1) & 3;
  if (s == 0) { gm::EpiIn e{p.rinv, p.rope, p.proj}; gm::gemm_phase(( const bf16_t*)p.out, LDX, p.WinT + (size_t)l * NPROJ * DM, NPROJ, e, shm); }
  else if (s == 1) { pool_phase(p, l); at::attn_phase(p, l, shm); }
  else if (s == 2) { gm::EpiOut e{p.proj}; gm::gemm_phase(p.proj, NPROJ, p.WoutT + (size_t)l * DM * DM, DM, e, shm); }
  else post_phase(p, l);
}

#if MK_MULTI
template <int S> __global__ void __launch_bounds__(NT_THREADS, 1) k_phase(Params p, int l) {
  extern __shared__ __attribute__((aligned(16))) char shm[];
  if (S == 0) phase0(p, shm); else run_phase(p, 1 + 4 * l + (S - 1), shm);
}
#else
__global__ void __launch_bounds__(NT_THREADS, 1) k_mega(Params p) {
  extern __shared__ __attribute__((aligned(16))) char shm[];
  cg::grid_group grid = cg::this_grid();
  phase0(p, shm);
  grid.sync();
  for (int l = 0; l < DEPTH; ++l) {
    { gm::EpiIn e{p.rinv, p.rope, p.proj}; gm::gemm_phase((const bf16_t*)p.out, LDX, p.WinT + (size_t)l * NPROJ * DM, NPROJ, e, shm); }
    grid.sync();
    pool_phase(p, l); at::attn_phase(p, l, shm);
    grid.sync();
    { gm::EpiOut e{p.proj}; gm::gemm_phase(p.proj, NPROJ, p.WoutT + (size_t)l * DM * DM, DM, e, shm); }
    grid.sync();
    post_phase(p, l);
    if (l + 1 < DEPTH) grid.sync();
  }
}
#endif

extern "C" void kernel_launch(void* const* d_in, const int* in_sizes, int n_in, void* d_out, int out_size, void* d_ws, size_t ws_size, hipStream_t stream) {
  Params p{};
  p.xp = (const float*)d_in[0]; p.xs = (const float*)d_in[1]; p.pre_g = (const float*)d_in[2]; p.w_in = (const float*)d_in[3];
  p.pool_w = (const float*)d_in[4]; p.pool_scale = (const float*)d_in[5]; p.lq1 = (const float*)d_in[6]; p.lk1 = (const float*)d_in[7];
  p.lq2 = (const float*)d_in[8]; p.lk2 = (const float*)d_in[9]; p.subln_g = (const float*)d_in[10]; p.w_out = (const float*)d_in[11]; p.post_g = (const float*)d_in[12];
  p.out = (float*)d_out;
  char* w = (char*)d_ws; size_t off = 0;
  p.proj = (bf16_t*)(w + off); off += (size_t)T_TOK * NPROJ * 2;
  p.WinT = (bf16_t*)(w + off); off += (size_t)DEPTH * NPROJ * DM * 2;
  p.WoutT = (bf16_t*)(w + off); off += (size_t)DEPTH * DM * DM * 2;
  p.rinv = (float*)(w + off); off += (size_t)T_TOK * 4;
  p.rope = (float*)(w + off); off += 256;
  p.lam = (float*)(w + off); off += 256;
  if (off > ws_size) { fprintf(stderr, "kernel_launch: workspace too small (%zu > %zu)\n", off, ws_size); return; }
#if MK_MULTI
  static int ok = 0;
  if (!ok) {
    (void)hipFuncSetAttribute((const void*)k_phase<0>, hipFuncAttributeMaxDynamicSharedMemorySize, (int)SHM_BYTES);
    (void)hipFuncSetAttribute((const void*)k_phase<1>, hipFuncAttributeMaxDynamicSharedMemorySize, (int)SHM_BYTES);
    (void)hipFuncSetAttribute((const void*)k_phase<2>, hipFuncAttributeMaxDynamicSharedMemorySize, (int)SHM_BYTES);
    (void)hipFuncSetAttribute((const void*)k_phase<3>, hipFuncAttributeMaxDynamicSharedMemorySize, (int)SHM_BYTES);
    (void)hipFuncSetAttribute((const void*)k_phase<4>, hipFuncAttributeMaxDynamicSharedMemorySize, (int)SHM_BYTES);
    ok = 1; }
  hipLaunchKernelGGL(k_phase<0>, dim3(256), dim3(NT_THREADS), SHM_BYTES, stream, p, 0);
  for (int l = 0; l < DEPTH; ++l) {
    hipLaunchKernelGGL(k_phase<1>, dim3(256), dim3(NT_THREADS), SHM_BYTES, stream, p, l);
    hipLaunchKernelGGL(k_phase<2>, dim3(256), dim3(NT_THREADS), SHM_BYTES, stream, p, l);
    hipLaunchKernelGGL(k_phase<3>, dim3(256), dim3(NT_THREADS), SHM_BYTES, stream, p, l);
    hipLaunchKernelGGL(k_phase<4>, dim3(256), dim3(NT_THREADS), SHM_BYTES, stream, p, l);
  }
#else
  static int grid_blocks = 0;
  if (!grid_blocks) {
    (void)hipFuncSetAttribute((const void*)k_mega, hipFuncAttributeMaxDynamicSharedMemorySize, (int)SHM_BYTES);
    int dev = 0, cus = 0, per_cu = 0;
    (void)hipGetDevice(&dev);
    (void)hipDeviceGetAttribute(&cus, hipDeviceAttributeMultiprocessorCount, dev);
    (void)hipOccupancyMaxActiveBlocksPerMultiprocessor(&per_cu, k_mega, NT_THREADS, SHM_BYTES);
    if (per_cu > 1) per_cu = 1;
    grid_blocks = cus * per_cu;
  }
  void* args[] = {&p};
  hipError_t e = hipLaunchCooperativeKernel((void*)k_mega, dim3(grid_blocks), dim3(NT_THREADS), args, SHM_BYTES, stream);
  if (e != hipSuccess) fprintf(stderr, "cooperative launch failed: %s (grid %d)\n", hipGetErrorString(e), grid_blocks);
#endif
}
```

```cpp
#include <hip/hip_runtime.h>
#include <hip/hip_cooperative_groups.h>
#include <cstdio>
#include <cstdint>
namespace cg = cooperative_groups;

#ifndef REP_ATT
#define REP_ATT 0
#endif
#ifndef REP_GEMM
#define REP_GEMM 0
#endif
#ifndef MK_MULTI
#define MK_MULTI 0
#endif

typedef unsigned short bf16_t;
using bf16x8 = __attribute__((ext_vector_type(8))) short;
using s16x4  = __attribute__((ext_vector_type(4))) short;
using f32x16 = __attribute__((ext_vector_type(16))) float;
using f32x4  = __attribute__((ext_vector_type(4))) float;
using u32x4  = __attribute__((ext_vector_type(4))) unsigned;
using u32x2  = __attribute__((ext_vector_type(2))) unsigned;

constexpr int NT_THREADS = 512;
constexpr int T_TOK = 65536, TP = 32768, DM = 1024, NPROJ = 3072, DEPTH = 2;
constexpr int S_P = 16384, S_S = 4096;
constexpr int C_ZP = 0, C_ZA = 512, C_U = 1024, C_Q = 1536, C_K = 2048, C_V = 2560;
constexpr int LDX = 2048;
constexpr float QSCALE = 0.125f * 1.4426950408889634f;
constexpr size_t SHM_BYTES = 131072 + 4096;

struct Params {
  const float* xp; const float* xs; const float* pre_g; const float* w_in; const float* pool_w; const float* pool_scale;
  const float* lq1; const float* lk1; const float* lq2; const float* lk2; const float* subln_g; const float* w_out; const float* post_g;
  float* out; bf16_t* WinT; bf16_t* WoutT; bf16_t* proj; float* rinv; float* rope; float* lam; float* kmax2;
};

#define SBAR() __builtin_amdgcn_sched_barrier(0)
__device__ __forceinline__ unsigned cvtpk(float lo, float hi) {
  unsigned r; asm volatile("v_cvt_pk_bf16_f32 %0, %1, %2" : "=v"(r) : "v"(lo), "v"(hi)); return r;
}
__device__ __forceinline__ float bf2f(unsigned short b) { return __uint_as_float(((unsigned)b) << 16); }
__device__ __forceinline__ float bflo(unsigned w) { return __uint_as_float(w << 16); }
__device__ __forceinline__ float bfhi(unsigned w) { return __uint_as_float(w & 0xffff0000u); }
__device__ __forceinline__ bf16_t f2bf(float f) { return (bf16_t)(cvtpk(f, 0.f) & 0xffffu); }
__host__ __device__ __forceinline__ int perm32(int rho) { const int n = rho >> 4, i = rho & 15; return 8 * (i >> 2) + 4 * n + (i & 3); }
__device__ __forceinline__ float silu(float z) { return z * __builtin_amdgcn_rcpf(1.f + __builtin_amdgcn_exp2f(-1.4426950408889634f * z)); }
__device__ __forceinline__ int opaque_tid() { int t = threadIdx.x; asm volatile("" : "+v"(t)); return t; }
__device__ __forceinline__ float wave_sum(float v) {
#pragma unroll
  for (int o = 32; o >= 1; o >>= 1) v += __shfl_xor(v, o);
  return v;
}

__device__ __forceinline__ int src_col_in(int s) {
  const int type = s >> 9, within = s & 511;
  if (type == 0) return 512 + within;
  if (type == 1) return 2560 + within;
  if (type == 5) return 2048 + within;
  const int p = within & 63, wcl = p >> 5, fq = (p >> 3) & 3, n = (p >> 2) & 1, jj = p & 3;
  const int d = wcl * 16 + fq * 4 + jj + 32 * n;
  return (type == 3 ? 1024 : 1536) + (within & ~63) + d;
}

__device__ void phase0(const Params& p, char* shm) {
  const int tid = opaque_tid(), nth = blockDim.x;
  float* tile = (float*)shm;
  constexpr int NT_IN = DEPTH * 48 * 16, NT_OUT = DEPTH * 16 * 16;
  for (int it = blockIdx.x; it < NT_IN + NT_OUT; it += gridDim.x) {
    __syncthreads();
    if (it < NT_IN) {
      const int l = it / (48 * 16), r = it % (48 * 16), n0 = (r / 16) * 64, k0 = (r % 16) * 64;
      const float* W = p.w_in + (size_t)l * DM * NPROJ; const float* g = p.pre_g + l * DM;
      for (int e = tid; e < 4096; e += nth) {
        const int nn = e & 63, kk = e >> 6, k = k0 + kk, nrow = n0 + nn;
        const int s = (nrow & ~31) + perm32(nrow & 31);
        float v;
        if ((s >> 9) == 2) {
          const int within = s & 511, gi = within >> 7, d = within & 127;
          const float* wr = W + (size_t)k * NPROJ + gi * 128; const float* pw = p.pool_w + ((size_t)(l * 4 + gi) * 128) * 128 + d;
          float a = 0.f;
          for (int c = 0; c < 128; ++c) a = fmaf(wr[c], pw[(size_t)c * 128], a);
          v = a;
        } else v = W[(size_t)k * NPROJ + src_col_in(s)];
        tile[kk * 65 + nn] = v * g[k];
      }
      __syncthreads();
      bf16_t* O = p.WinT + (size_t)l * NPROJ * DM;
      for (int e = tid; e < 4096; e += nth) { const int kk = e & 63, nn = e >> 6; O[(size_t)(n0 + nn) * DM + k0 + kk] = f2bf(tile[kk * 65 + nn]); }
    } else {
      const int it2 = it - NT_IN, l = it2 / 256, r = it2 % 256, n0 = (r / 16) * 64, k0 = (r % 16) * 64;
      const float* W = p.w_out + (size_t)l * DM * DM;
      for (int e = tid; e < 4096; e += nth) {
        const int nn = e & 63, kk = e >> 6, nrow = n0 + nn; const int s = (nrow & ~31) + perm32(nrow & 31);
        tile[kk * 65 + nn] = W[(size_t)(k0 + kk) * DM + s];
      }
      __syncthreads();
      bf16_t* O = p.WoutT + (size_t)l * DM * DM;
      for (int e = tid; e < 4096; e += nth) { const int kk = e & 63, nn = e >> 6; O[(size_t)(n0 + nn) * DM + k0 + kk] = f2bf(tile[kk * 65 + nn]); }
    }
  }
  if (blockIdx.x == 0) {
    if (tid < DEPTH * 160) p.kmax2[tid] = 0.f;
    if (tid < 32) { const double c = exp(-(double)tid * (9.210340371976184 / 32.0)) * 0.15915494309189535; const float h = (float)c; p.rope[2 * tid] = h; p.rope[2 * tid + 1] = (float)(c - (double)h); }
    if (tid >= 64 && tid < 64 + 64 * DEPTH) {
      const int l = (tid >> 6) - 1, i = tid & 63;
      float a = p.lq1[l * 64 + i] * p.lk1[l * 64 + i], b = p.lq2[l * 64 + i] * p.lk2[l * 64 + i];
      a = wave_sum(a); b = wave_sum(b);
      const float li = 0.8f - 0.6f * expf(-0.3f * (float)l);
      if (i == 0) p.lam[l] = expf(a) - expf(b) + li;
    }
  }
  const int wid = tid >> 6, lane = tid & 63, nw = nth >> 6;
  for (int row = blockIdx.x * nw + wid; row < T_TOK; row += gridDim.x * nw) {
    const float* xr = row < TP ? p.xp + (size_t)row * DM : p.xs + (size_t)(row - TP) * DM;
    bf16_t* xo = (bf16_t*)p.out + (size_t)row * LDX;
    float ss = 0.f;
#pragma unroll
    for (int i = 0; i < 4; ++i) {
      const f32x4 v = *(const f32x4*)(xr + i * 256 + lane * 4);
      ss += v[0] * v[0] + v[1] * v[1] + v[2] * v[2] + v[3] * v[3];
      u32x2 w = {cvtpk(v[0], v[1]), cvtpk(v[2], v[3])};
      *(u32x2*)(xo + i * 256 + lane * 4) = w;
    }
    ss = wave_sum(ss);
    if (lane == 0) p.rinv[row] = __builtin_amdgcn_rsqf(ss * (1.f / DM) + 1e-6f);
  }
}

namespace gm {
constexpr int BM = 256, BK = 64, HALF = 128, NXCD = 8, WGM = 8, HT = HALF * BK;
__device__ __forceinline__ int lds_byte(int r, int c) { int st = (r >> 4) * 2 + (c >> 5), rr = r & 15, cc = c & 31, ob = rr * 64 + cc * 2; return st * 1024 + (ob ^ (((ob >> 9) & 1) << 5)); }
__device__ __forceinline__ void stage_rc(int b, int& R, int& C) { int st = b / 1024, sb = b % 1024, swz = sb ^ (((sb >> 9) & 1) << 5); R = (st >> 1) * 16 + swz / 64; C = (st & 1) * 32 + (swz % 64) / 2; }

#define LAS __attribute__((address_space(3)))
template <class Epi>
__device__ __forceinline__ void gemm_phase(const bf16_t* __restrict__ A, const int lda, const bf16_t* __restrict__ Bt, const int N, const Epi& E, char* shmc) {
  constexpr int K = 1024, nt = K / BK, HTB = HALF * BK * 2;
  LAS unsigned char* lds = (LAS unsigned char*)shmc;
  const int tid = opaque_tid(), wid = __builtin_amdgcn_readfirstlane(tid >> 6), lane = tid & 63, wr = wid >> 2, wc = wid & 3, fr = lane & 15, fq = lane >> 4;
  unsigned voffA[2], voffB[2];
#pragma unroll
  for (int i = 0; i < 2; ++i) { int R, C; stage_rc(tid * 16 + i * 8192, R, C); voffA[i] = (unsigned)(R * lda + C) * 2u; voffB[i] = (unsigned)(R * K + C) * 2u; }
  const size_t kstep = (size_t)(BK * 2);
  const size_t hstepA = (size_t)HALF * lda * 2, hstepB = (size_t)HALF * K * 2;
  const size_t tstepA = 2 * hstepA, tstepB = 2 * hstepB;
  const unsigned ldsw = (unsigned)wid * 1024u;
  const int aoff = lds_byte(wr * 64 + fr, fq * 8), boff = lds_byte(wc * 32 + fr, fq * 8);
#define PG8_SA(b, h) (((b) * 2 + (h)) * HTB)
#define PG8_SB(b, h) ((4 + (b) * 2 + (h)) * HTB)
#define PG8_STAGE(bufoff, gbase, voff) do { _Pragma("unroll") for (int _i = 0; _i < 2; ++_i) \
        __builtin_amdgcn_global_load_lds((const unsigned*)((const char*)(gbase) + (voff)[_i]), (LAS unsigned*)(lds + (bufoff) + ldsw + _i * 8192), 16, 0, 0); } while (0)
#define PG8_LDA(dst, b, h) do { _Pragma("unroll") for (int m = 0; m < 4; ++m) _Pragma("unroll") for (int k = 0; k < 2; ++k) dst[m][k] = *(const LAS bf16x8*)(lds + PG8_SA(b, h) + aoff + m * 2048 + k * 1024); } while (0)
#define PG8_LDB(dst, b, h) do { _Pragma("unroll") for (int n = 0; n < 2; ++n) _Pragma("unroll") for (int k = 0; k < 2; ++k) dst[n][k] = *(const LAS bf16x8*)(lds + PG8_SB(b, h) + boff + n * 2048 + k * 1024); } while (0)
#define PG8_MMA(ai, bj, At, Bx) do { __builtin_amdgcn_s_setprio(1); _Pragma("unroll") for (int m = 0; m < 4; ++m) _Pragma("unroll") for (int n = 0; n < 2; ++n) _Pragma("unroll") for (int k = 0; k < 2; ++k) \
        acc[ai][bj][m][n] = __builtin_amdgcn_mfma_f32_16x16x32_bf16(Bx[n][k], At[m][k], acc[ai][bj][m][n], 0, 0, 0); __builtin_amdgcn_s_setprio(0); } while (0)
#define PG8_WAIT_V(n) asm volatile("s_waitcnt vmcnt(" #n ")" ::: "memory")
#define PG8_WAIT_L(n) asm volatile("s_waitcnt lgkmcnt(" #n ")" ::: "memory")
#define PG8_BAR __builtin_amdgcn_s_barrier()
#define PG8_SCHED __builtin_amdgcn_sched_barrier(0)
  const int nM = T_TOK / BM, nN = N / BM, nwg = nM * nN, G = gridDim.x, cblk = blockIdx.x;
  auto next_unit = [&](int i, int& pm, int& pn) -> bool {
    const long L = (long)i * G + cblk; if (L >= nwg) return false;
    int wgid = (int)L; { const int q = nwg / NXCD, r = nwg % NXCD, xcd = wgid % NXCD, off = wgid / NXCD; wgid = (xcd < r ? xcd * (q + 1) : r * (q + 1) + (xcd - r) * q) + off; }
    const int nig = WGM * nN, gid = wgid / nig, fm = gid * WGM, gsz = (nM - fm) < WGM ? (nM - fm) : WGM;
    pm = fm + ((wgid % nig) % gsz); pn = (wgid % nig) / gsz; return true;
  };
  int cpm, cpn, npm = 0, npn = 0, ui = 0;
  if (!next_unit(0, cpm, cpn)) return;
  f32x4 acc[2][2][4][2];
#pragma unroll
  for (int a = 0; a < 2; ++a)
#pragma unroll
    for (int b = 0; b < 2; ++b)
#pragma unroll
      for (int m = 0; m < 4; ++m)
#pragma unroll
        for (int n = 0; n < 2; ++n) acc[a][b][m][n] = (f32x4){0.f, 0.f, 0.f, 0.f};
  bf16x8 At[4][2], B0[2][2], B1[2][2];
  const char* cA = (const char*)A + (size_t)cpm * tstepA; const char* cB = (const char*)Bt + (size_t)cpn * tstepB;
  PG8_STAGE(PG8_SB(0, 0), cB, voffB); PG8_STAGE(PG8_SB(0, 1), cB + hstepB, voffB); PG8_STAGE(PG8_SA(0, 0), cA, voffA); PG8_STAGE(PG8_SA(0, 1), cA + hstepA, voffA);
  if (wr == 1) PG8_BAR;
  PG8_WAIT_V(2); PG8_BAR;
  PG8_STAGE(PG8_SB(1, 0), cB + kstep, voffB); PG8_STAGE(PG8_SA(1, 0), cA + kstep, voffA); PG8_STAGE(PG8_SB(1, 1), cB + hstepB + kstep, voffB);
  PG8_WAIT_V(6); PG8_BAR;
  for (;;) {
    const bool has_next = next_unit(ui + 1, npm, npn);
    const char* nA = has_next ? (const char*)A + (size_t)npm * tstepA : cA; const char* nB = has_next ? (const char*)Bt + (size_t)npn * tstepB : cB;
    for (int t = 0; t < nt; t += 2) {
      const bool last = (t == nt - 2);
      const char* a1 = cA + (size_t)(t + 1) * kstep;
      const char* a2 = last ? nA : cA + (size_t)(t + 2) * kstep; const char* b2 = last ? nB : cB + (size_t)(t + 2) * kstep;
      const char* a3 = a2 + kstep; const char* b3 = b2 + kstep;
      PG8_LDB(B0, 0, 0); PG8_LDB(B1, 0, 1); PG8_SCHED; PG8_LDA(At, 0, 0); PG8_STAGE(PG8_SA(1, 1), a1 + hstepA, voffA);
      PG8_WAIT_V(8); PG8_WAIT_L(0); PG8_BAR; PG8_MMA(0, 0, At, B0); PG8_MMA(0, 1, At, B1); PG8_BAR; PG8_SCHED;
      PG8_LDA(At, 0, 1); PG8_STAGE(PG8_SB(0, 0), b2, voffB); PG8_STAGE(PG8_SB(0, 1), b2 + hstepB, voffB); PG8_STAGE(PG8_SA(0, 0), a2, voffA);
      PG8_WAIT_V(8); PG8_WAIT_L(0); PG8_BAR; PG8_MMA(1, 0, At, B0); PG8_MMA(1, 1, At, B1); PG8_BAR; PG8_SCHED;
      PG8_LDB(B0, 1, 0); PG8_LDB(B1, 1, 1); PG8_SCHED; PG8_LDA(At, 1, 0); PG8_STAGE(PG8_SA(0, 1), a2 + hstepA, voffA);
      PG8_WAIT_V(8); PG8_WAIT_L(0); PG8_BAR; PG8_MMA(0, 0, At, B0); PG8_MMA(0, 1, At, B1); PG8_BAR; PG8_SCHED;
      PG8_LDA(At, 1, 1); PG8_STAGE(PG8_SB(1, 0), b3, voffB); PG8_STAGE(PG8_SB(1, 1), b3 + hstepB, voffB); PG8_STAGE(PG8_SA(1, 0), a3, voffA);
      PG8_WAIT_V(8); PG8_WAIT_L(0); PG8_BAR; PG8_MMA(1, 0, At, B0); PG8_MMA(1, 1, At, B1); PG8_BAR; PG8_SCHED;
    }
    if (wr == 0) PG8_BAR;
    E(acc, cpm, cpn, wr, wc, fr, fq);
    if (!has_next) break;
#pragma unroll
    for (int a = 0; a < 2; ++a)
#pragma unroll
      for (int b = 0; b < 2; ++b)
#pragma unroll
        for (int m = 0; m < 4; ++m)
#pragma unroll
          for (int n = 0; n < 2; ++n) acc[a][b][m][n] = (f32x4){0.f, 0.f, 0.f, 0.f};
    cpm = npm; cpn = npn; cA = nA; cB = nB; ++ui;
    if (wr == 1) PG8_BAR;
  }
  PG8_WAIT_V(0);
  PG8_BAR;
#undef PG8_SA
#undef PG8_SB
#undef PG8_STAGE
#undef PG8_LDA
#undef PG8_LDB
#undef PG8_MMA
}

struct EpiIn {
  const float* rinv; const float* rope; bf16_t* proj; float* kmax2;
  __device__ __forceinline__ void operator()(const f32x4 (&acc)[2][2][4][2], int pm, int pn, int wr, int wc, int fr, int fq) const {
    const bool isrope = (pn >= 6 && pn <= 9); const float qs = (pn == 6 || pn == 7) ? QSCALE : 1.f;
    const bool isk = (pn == 8 || pn == 9);
    float kmx[2] = {0.f, 0.f};
    float ch[4], cl[4];
    if (isrope) {
#pragma unroll
      for (int jj = 0; jj < 4; ++jj) { const int i = (wc & 1) * 16 + fq * 4 + jj; ch[jj] = rope[2 * i]; cl[jj] = rope[2 * i + 1]; }
    }
#pragma unroll
    for (int ai = 0; ai < 2; ++ai)
#pragma unroll
      for (int m = 0; m < 4; ++m) {
        const int row = pm * BM + ai * HALF + wr * 64 + m * 16 + fr;
        const float ri = rinv[row];
        float cs[4], sn[4];
        if (isrope) {
          const float pos = (float)(row < TP ? (row & (S_P - 1)) : (row & (S_S - 1)));
#pragma unroll
          for (int jj = 0; jj < 4; ++jj) {
            const float h = pos * ch[jj], e = fmaf(pos, ch[jj], -h) + pos * cl[jj];
            const float rev = (h - floorf(h)) + e;
            sn[jj] = __builtin_amdgcn_sinf(rev); cs[jj] = __builtin_amdgcn_cosf(rev);
          }
        }
        bf16_t* rowp = proj + (size_t)row * NPROJ + pn * BM + wc * 32 + 8 * fq;
#pragma unroll
        for (int bj = 0; bj < 2; ++bj) {
          f32x4 v0 = acc[ai][bj][m][0] * ri, v1 = acc[ai][bj][m][1] * ri;
          if (isrope) {
#pragma unroll
            for (int jj = 0; jj < 4; ++jj) { const float a = v0[jj], b = v1[jj]; v0[jj] = (a * cs[jj] - b * sn[jj]) * qs; v1[jj] = (b * cs[jj] + a * sn[jj]) * qs; }
          }
          u32x4 w; w.x = cvtpk(v0[0], v0[1]); w.y = cvtpk(v0[2], v0[3]); w.z = cvtpk(v1[0], v1[1]); w.w = cvtpk(v1[2], v1[3]);
          *(u32x4*)(rowp + bj * HALF) = w;
          if (isk) { float ss = v0[0] * v0[0] + v0[1] * v0[1] + v0[2] * v0[2] + v0[3] * v0[3] + v1[0] * v1[0] + v1[1] * v1[1] + v1[2] * v1[2] + v1[3] * v1[3];
            ss += __shfl_xor(ss, 16); ss += __shfl_xor(ss, 32); kmx[bj] = fmaxf(kmx[bj], ss); }
        }
      }
    if (isk) {
      const int row0 = pm * BM, sq = row0 < TP ? (row0 >> 14) : 2 + ((row0 - TP) >> 12);
#pragma unroll
      for (int bj = 0; bj < 2; ++bj) { float v = kmx[bj];
        v = fmaxf(v, __shfl_xor(v, 1)); v = fmaxf(v, __shfl_xor(v, 2)); v = fmaxf(v, __shfl_xor(v, 4)); v = fmaxf(v, __shfl_xor(v, 8));
        if ((fr | fq) == 0) atomicMax((unsigned*)(kmax2 + (sq * 4 + (pn - 8) * 2 + bj) * 4 + wc), __float_as_uint(v)); }
    }
  }
};
struct EpiOut {
  bf16_t* proj;
  __device__ __forceinline__ void operator()(const f32x4 (&acc)[2][2][4][2], int pm, int pn, int wr, int wc, int fr, int fq) const {
#pragma unroll
    for (int ai = 0; ai < 2; ++ai)
#pragma unroll
      for (int m = 0; m < 4; ++m) {
        const int row = pm * BM + ai * HALF + wr * 64 + m * 16 + fr;
        float* rowp = (float*)(proj + (size_t)row * NPROJ + C_U) + pn * BM + wc * 32 + 8 * fq;
#pragma unroll
        for (int bj = 0; bj < 2; ++bj) { *(f32x4*)(rowp + bj * HALF) = acc[ai][bj][m][0]; *(f32x4*)(rowp + bj * HALF + 4) = acc[ai][bj][m][1]; }
      }
  }
};
}

__device__ void pool_phase(const Params& p, int l) {
  const int tid = opaque_tid(), c8 = tid & 63, tq = tid >> 6;
  const int g = c8 >> 4, hw = 1 << g;
  const float* sc = p.pool_scale + l * 512 + c8 * 8;
  float scl[8];
#pragma unroll
  for (int e = 0; e < 8; ++e) scl[e] = sc[e];
  for (int ch = blockIdx.x; ch < T_TOK / 64; ch += gridDim.x) {
    for (int i = 0; i < 8; ++i) {
      const int t = ch * 64 + tq * 8 + i;
      const int S = t < TP ? S_P : S_S, pos = t & (S - 1), s0 = t - pos;
      const int lo = max(pos - hw, 0), hi = min(pos + hw, S);
      float sum[8] = {0, 0, 0, 0, 0, 0, 0, 0};
      for (int j = lo; j < hi; ++j) {
        const u32x4 w = *(const u32x4*)(p.proj + (size_t)(s0 + j) * NPROJ + C_U + c8 * 8);
        sum[0] += bflo(w.x); sum[1] += bfhi(w.x); sum[2] += bflo(w.y); sum[3] += bfhi(w.y);
        sum[4] += bflo(w.z); sum[5] += bfhi(w.z); sum[6] += bflo(w.w); sum[7] += bfhi(w.w);
      }
      const float inv = 1.f / (float)(hi - lo);
      const u32x4 uc = *(const u32x4*)(p.proj + (size_t)t * NPROJ + C_U + c8 * 8);
      bf16_t* zpp = p.proj + (size_t)t * NPROJ + C_ZP + c8 * 8;
      const u32x4 z = *(const u32x4*)zpp;
      float o[8];
      o[0] = (sum[0] * inv - bflo(uc.x)) * scl[0] * silu(bflo(z.x)); o[1] = (sum[1] * inv - bfhi(uc.x)) * scl[1] * silu(bfhi(z.x));
      o[2] = (sum[2] * inv - bflo(uc.y)) * scl[2] * silu(bflo(z.y)); o[3] = (sum[3] * inv - bfhi(uc.y)) * scl[3] * silu(bfhi(z.y));
      o[4] = (sum[4] * inv - bflo(uc.z)) * scl[4] * silu(bflo(z.z)); o[5] = (sum[5] * inv - bfhi(uc.z)) * scl[5] * silu(bfhi(z.z));
      o[6] = (sum[6] * inv - bflo(uc.w)) * scl[6] * silu(bflo(z.w)); o[7] = (sum[7] * inv - bfhi(uc.w)) * scl[7] * silu(bfhi(z.w));
      u32x4 w = {cvtpk(o[0], o[1]), cvtpk(o[2], o[3]), cvtpk(o[4], o[5]), cvtpk(o[6], o[7])};
      *(u32x4*)zpp = w;
    }
  }
}

namespace at {
constexpr int KVBLK = 64, LDK = NPROJ;
constexpr size_t SHM_V = KVBLK * 128 * 2, SHM_K = KVBLK * 128 * 2;
constexpr float THRL = 11.5f;
#define KSWZ(row, colB) ((row) * 256 + ((colB) ^ (((row) & 7) << 4)))
__device__ __forceinline__ int crow(int r, int hi) { return (r & 3) + 8 * (r >> 2) + 4 * hi; }
template <bool SH> __device__ __forceinline__ void partialSM(f32x16& p0, f32x16& p1, float& m_reg, float& mn, float& alpha) {
  if constexpr (!SH) {
    alpha = 1.f;
#pragma unroll
    for (int r = 0; r < 16; ++r) p0[r] = __builtin_amdgcn_exp2f(p0[r]);
    return;
  }
  float pmax = p0[0];
#pragma unroll
  for (int r = 1; r < 16; ++r) pmax = fmaxf(pmax, p0[r]);
#pragma unroll
  for (int r = 0; r < 16; ++r) pmax = fmaxf(pmax, p1[r]);
  { auto rr = __builtin_amdgcn_permlane32_swap(__float_as_uint(pmax), __float_as_uint(pmax), false, false);
    pmax = fmaxf(__uint_as_float(rr[0]), __uint_as_float(rr[1])); }
  if (__builtin_expect(__all(pmax - m_reg <= THRL), 1)) { mn = m_reg; alpha = 1.f; }
  else { mn = fmaxf(m_reg, pmax); alpha = __builtin_amdgcn_exp2f(m_reg - mn); m_reg = mn; }
#pragma unroll
  for (int r = 0; r < 16; ++r) p0[r] = p0[r] - mn;
#pragma unroll
  for (int r = 0; r < 16; ++r) p1[r] = p1[r] - mn;
#pragma unroll
  for (int r = 0; r < 16; ++r) p0[r] = __builtin_amdgcn_exp2f(p0[r]);
}
template <bool SH> __device__ __forceinline__ void finishSM(f32x16& p0, f32x16& p1, float alpha, float& l_reg, bf16x8& pa0, bf16x8& pa1, bf16x8& pa2, bf16x8& pa3) {
#pragma unroll
  for (int r = 0; r < 16; ++r) p1[r] = __builtin_amdgcn_exp2f(p1[r]);
  float ps = 0;
#pragma unroll
  for (int r = 0; r < 16; ++r) ps += p0[r];
#pragma unroll
  for (int r = 0; r < 16; ++r) ps += p1[r];
  { auto rr = __builtin_amdgcn_permlane32_swap(__float_as_uint(ps), __float_as_uint(ps), false, false);
    ps = __uint_as_float(rr[0]) + __uint_as_float(rr[1]); }
  if constexpr (SH) l_reg = l_reg * alpha + ps; else l_reg += ps;
#define PK4(P, BASE, OUT) do { unsigned a0 = cvtpk(P[BASE + 0], P[BASE + 1]), a1 = cvtpk(P[BASE + 2], P[BASE + 3]);   \
    unsigned b0 = cvtpk(P[BASE + 4], P[BASE + 5]), b1 = cvtpk(P[BASE + 6], P[BASE + 7]);                              \
    auto r0 = __builtin_amdgcn_permlane32_swap(a0, b0, false, false); auto r1 = __builtin_amdgcn_permlane32_swap(a1, b1, false, false); \
    u32x4 w = {r0[0], r1[0], r0[1], r1[1]}; OUT = *reinterpret_cast<bf16x8*>(&w); } while (0)
  PK4(p0, 0, pa0); PK4(p0, 8, pa1); PK4(p1, 0, pa2); PK4(p1, 8, pa3);
#undef PK4
}
__device__ __forceinline__ void qkt(f32x16& p0, f32x16& p1, const char* Ks, const bf16x8* qr, int r32, int hi, int mapB) {
  p0 = f32x16{}; p1 = f32x16{};
#pragma unroll
  for (int d0 = 0; d0 < 4; ++d0) { const int cb = (d0 * 16 + hi * 8) * 2 + mapB;
    bf16x8 b0 = *reinterpret_cast<const bf16x8*>(Ks + KSWZ(r32, cb));
    bf16x8 b1 = *reinterpret_cast<const bf16x8*>(Ks + KSWZ(32 + r32, cb));
    p0 = __builtin_amdgcn_mfma_f32_32x32x16_bf16(b0, qr[d0], p0, 0, 0, 0);
    p1 = __builtin_amdgcn_mfma_f32_32x32x16_bf16(b1, qr[d0], p1, 0, 0, 0); }
}
__device__ __forceinline__ int v_st(int k, int c) { const int kk = (k & ~0xC) | ((k & 4) << 1) | ((k & 8) >> 1); return ((kk >> 3) * 4 + (c >> 5)) * 512 + ((kk & 7) * 32 + (c & 31)) * 2; }
__device__ __forceinline__ int v_rd_base(int lane) { return ((lane & 3) << 3) | (((lane >> 2) & 3) << 6) | (((lane >> 4) & 1) << 5) | (((lane >> 5) & 1) << 8); }
constexpr int v_rd_off(int d0, int ks, int half) { return d0 * 512 + ks * 4096 + half * 2048; }
template <int OFF> __device__ __forceinline__ s16x4 tr_read(int vb) {
  s16x4 r; asm volatile("ds_read_b64_tr_b16 %0, %1 offset:%2" : "=&v"(r) : "v"(vb), "i"(OFF) : "memory"); return r;
}
template <int D0> __device__ __forceinline__ void pv_one(f32x16& od, int vb, bf16x8 pa0, bf16x8 pa1, bf16x8 pa2, bf16x8 pa3) {
  const s16x4 l0 = tr_read<v_rd_off(D0, 0, 0)>(vb), h0 = tr_read<v_rd_off(D0, 0, 1)>(vb), l1 = tr_read<v_rd_off(D0, 1, 0)>(vb), h1 = tr_read<v_rd_off(D0, 1, 1)>(vb);
  const s16x4 l2 = tr_read<v_rd_off(D0, 2, 0)>(vb), h2 = tr_read<v_rd_off(D0, 2, 1)>(vb), l3 = tr_read<v_rd_off(D0, 3, 0)>(vb), h3 = tr_read<v_rd_off(D0, 3, 1)>(vb);
  asm volatile("s_waitcnt lgkmcnt(0)" ::: "memory"); SBAR();
#define PK(L, H) (bf16x8){L[0], L[1], L[2], L[3], H[0], H[1], H[2], H[3]}
  od = __builtin_amdgcn_mfma_f32_32x32x16_bf16(pa0, PK(l0, h0), od, 0, 0, 0);
  od = __builtin_amdgcn_mfma_f32_32x32x16_bf16(pa1, PK(l1, h1), od, 0, 0, 0);
  od = __builtin_amdgcn_mfma_f32_32x32x16_bf16(pa2, PK(l2, h2), od, 0, 0, 0);
  od = __builtin_amdgcn_mfma_f32_32x32x16_bf16(pa3, PK(l3, h3), od, 0, 0, 0);
#undef PK
}
__device__ __forceinline__ void pv_d0(f32x16* o, int vb, bf16x8 pa0, bf16x8 pa1, bf16x8 pa2, bf16x8 pa3) {
  pv_one<0>(o[0], vb, pa0, pa1, pa2, pa3); pv_one<1>(o[1], vb, pa0, pa1, pa2, pa3); pv_one<2>(o[2], vb, pa0, pa1, pa2, pa3); pv_one<3>(o[3], vb, pa0, pa1, pa2, pa3);
}

template <bool SH> __device__ __forceinline__ void attn_unit(bf16_t* __restrict__ proj, int tok0, int kv0, int seq, int h, float lam, float oscale, const float* __restrict__ subg, char* lds, bool dry) {
  const int tid = opaque_tid(), wid = tid >> 6, lane = tid & 63, r32 = lane & 31, hi = lane >> 5;
  const int wq = wid & 3, mp = wid >> 2, mapB = mp * 128;
  char* V_lds = lds; char* K_lds = lds + 2 * SHM_V;
  float* ws = (float*)(lds + 2 * SHM_V + 2 * SHM_K) + wid * 64; float* li_l = ws; float* al_l = ws + 32;
  const bf16_t* Kh = proj + (size_t)kv0 * NPROJ + C_K + h * 128;
  const bf16_t* Vh = proj + (size_t)kv0 * NPROJ + C_V + h * 128;
  float m_reg = -1e30f, l_reg = 0; f32x16 o[4] = {}; bf16x8 qr[4];
  const bf16_t* Qw = proj + (size_t)(tok0 + wq * 32 + r32) * NPROJ + C_Q + h * 128 + mp * 64 + hi * 8;
#pragma unroll
  for (int d0 = 0; d0 < 4; ++d0) qr[d0] = *reinterpret_cast<const bf16x8*>(Qw + d0 * 16);
  const int sr = tid >> 4, sc = (tid & 15) * 8, vst0 = v_st(sr, sc), vst1 = v_st(32 + sr, sc);
  const int vb0 = (int)(uintptr_t)V_lds + v_rd_base(lane);
  struct { bf16x8 vs0, vs1, ks0, ks1; } sr_[2];
#define LD8(ptr) (*reinterpret_cast<const bf16x8*>(ptr))
#define SLOAD(i, k0) do { sr_[i].vs0 = LD8(&Vh[(size_t)((k0) + sr) * LDK + sc]); sr_[i].vs1 = LD8(&Vh[(size_t)((k0) + 32 + sr) * LDK + sc]); \
    sr_[i].ks0 = LD8(&Kh[(size_t)((k0) + sr) * LDK + sc]); sr_[i].ks1 = LD8(&Kh[(size_t)((k0) + 32 + sr) * LDK + sc]); } while (0)
#define SWRITE(b, i) do { *(bf16x8*)(V_lds + (b) * SHM_V + vst0) = sr_[i].vs0;          \
    *(bf16x8*)(V_lds + (b) * SHM_V + vst1) = sr_[i].vs1; int kc = sc * 2;               \
    *(bf16x8*)(K_lds + (b) * SHM_K + KSWZ(sr, kc)) = sr_[i].ks0;                       \
    *(bf16x8*)(K_lds + (b) * SHM_K + KSWZ(32 + sr, kc)) = sr_[i].ks1; } while (0)
#define SWAIT() asm volatile("s_waitcnt vmcnt(4)" ::: "memory")
#define RESC(a) do { if (SH && __any((a) < 1.f)) { if (hi == 0) al_l[r32] = (a); asm volatile("s_waitcnt lgkmcnt(0)" ::: "memory"); \
    _Pragma("unroll") for (int d = 0; d < 4; ++d) _Pragma("unroll") for (int r = 0; r < 16; ++r) o[d][r] *= al_l[crow(r, hi)]; } } while (0)
  f32x16 pA0, pA1, pB0, pB1; float mnA, mnB, alA, alB; bf16x8 pa0, pa1, pa2, pa3; const int NT = seq / KVBLK;
  constexpr int SE = 0, SO = 1;
  SLOAD(SE, 0); asm volatile("s_waitcnt vmcnt(0)" ::: "memory"); SWRITE(0, SE); __syncthreads();
  qkt(pA0, pA1, K_lds, qr, r32, hi, mapB); partialSM<SH>(pA0, pA1, m_reg, mnA, alA);
  SLOAD(SO, KVBLK); if (2 < NT) SLOAD(SE, 2 * KVBLK);
  SWAIT(); SWRITE(1, SO); __syncthreads();
  for (int j = 1; j + 1 < NT; j += 2) {
    SBAR(); qkt(pB0, pB1, K_lds + SHM_K, qr, r32, hi, mapB);
    finishSM<SH>(pA0, pA1, alA, l_reg, pa0, pa1, pa2, pa3); SBAR();
    SLOAD(SO, (j + 2) * KVBLK); SBAR();
    pv_d0(o, vb0, pa0, pa1, pa2, pa3); partialSM<SH>(pB0, pB1, m_reg, mnB, alB);
    __syncthreads(); SWAIT(); SWRITE(0, SE);
    RESC(alB); __syncthreads();
    SBAR(); qkt(pA0, pA1, K_lds, qr, r32, hi, mapB);
    finishSM<SH>(pB0, pB1, alB, l_reg, pa0, pa1, pa2, pa3); SBAR();
    if (j + 3 < NT) SLOAD(SE, (j + 3) * KVBLK); SBAR();
    pv_d0(o, vb0 + (int)SHM_V, pa0, pa1, pa2, pa3); partialSM<SH>(pA0, pA1, m_reg, mnA, alA);
    __syncthreads(); SWAIT(); SWRITE(1, SO);
    RESC(alA); __syncthreads();
  }
  SBAR(); qkt(pB0, pB1, K_lds + SHM_K, qr, r32, hi, mapB);
  finishSM<SH>(pA0, pA1, alA, l_reg, pa0, pa1, pa2, pa3); SBAR();
  pv_d0(o, vb0, pa0, pa1, pa2, pa3); partialSM<SH>(pB0, pB1, m_reg, mnB, alB);
  __syncthreads(); RESC(alB);
  finishSM<SH>(pB0, pB1, alB, l_reg, pa0, pa1, pa2, pa3); SBAR();
  pv_d0(o, vb0 + (int)SHM_V, pa0, pa1, pa2, pa3);
  if (hi == 0) li_l[r32] = l_reg; asm volatile("s_waitcnt lgkmcnt(0)" ::: "memory");
  float rli[16];
#pragma unroll
  for (int r = 0; r < 16; ++r) rli[r] = __builtin_amdgcn_rcpf(li_l[crow(r, hi)]);
  __syncthreads();
  float* X = (float*)lds;
  if (mp == 1) {
#pragma unroll
    for (int d = 0; d < 4; ++d)
#pragma unroll
      for (int r = 0; r < 16; ++r) X[(wq * 64 + d * 16 + r) * 64 + lane] = o[d][r] * rli[r] * lam;
  }
  __syncthreads();
  if (mp == 0) {
#pragma unroll
    for (int d = 0; d < 4; ++d)
#pragma unroll
      for (int r = 0; r < 16; ++r) { const int ix = (wq * 64 + d * 16 + r) * 64 + lane; X[ix] = o[d][r] * rli[r] - X[ix]; }
  }
  __syncthreads();
  {
    const int row = tid >> 2, dq = tid & 3, rl = row & 31, w = row >> 5, hh = (rl >> 2) & 1, r = (rl & 3) + 4 * (rl >> 3);
    const float* xb = X + (w * 64 + dq * 16 + r) * 64 + hh * 32;
    f32x4 a[8]; float ss = 0.f;
#pragma unroll
    for (int i = 0; i < 8; ++i) { a[i] = *(const f32x4*)(xb + i * 4); ss += a[i][0] * a[i][0] + a[i][1] * a[i][1] + a[i][2] * a[i][2] + a[i][3] * a[i][3]; }
    ss += __shfl_xor(ss, 1); ss += __shfl_xor(ss, 2);
    const float rn = __builtin_amdgcn_rsqf(ss * (1.f / 128.f) + 1e-5f) * oscale;
    bf16_t* zp = proj + (size_t)(tok0 + row) * NPROJ + C_ZA + h * 128 + dq * 32;
    const float* gg = subg + dq * 32;
#pragma unroll
    for (int i = 0; i < 4; ++i) {
      const u32x4 z = *(const u32x4*)(zp + i * 8);
      const f32x4 a0 = a[2 * i], a1 = a[2 * i + 1]; const f32x4 g0 = *(const f32x4*)(gg + i * 8), g1 = *(const f32x4*)(gg + i * 8 + 4);
      u32x4 wv;
      wv.x = cvtpk(a0[0] * rn * g0[0] * silu(bflo(z.x)), a0[1] * rn * g0[1] * silu(bfhi(z.x)));
      wv.y = cvtpk(a0[2] * rn * g0[2] * silu(bflo(z.y)), a0[3] * rn * g0[3] * silu(bfhi(z.y)));
      wv.z = cvtpk(a1[0] * rn * g1[0] * silu(bflo(z.z)), a1[1] * rn * g1[1] * silu(bfhi(z.z)));
      wv.w = cvtpk(a1[2] * rn * g1[2] * silu(bflo(z.w)), a1[3] * rn * g1[3] * silu(bfhi(z.w)));
      if (!dry) *(u32x4*)(zp + i * 8) = wv;
    }
  }
  __syncthreads();
#undef SLOAD
#undef SWRITE
#undef SWAIT
#undef RESC
#undef LD8
}

__device__ void attn_phase(const Params& p, int l, char* lds, bool dry = false) {
  const float lam = p.lam[l];
  const float oscale = 1.f - (0.8f - 0.6f * expf(-0.3f * (float)l));
  const float* subg = p.subln_g + l * 128;
  for (int u = blockIdx.x; u < 2048; u += gridDim.x) {
    int tok0, kv0, seq, h;
    if (u < 1024) { const int x = u & 7, j = u >> 3; const int b = x >> 2; h = x & 3; seq = S_P; kv0 = b * S_P; tok0 = kv0 + j * 128; }
    else { const int v = u - 1024, x = v & 7, j = v >> 3; const int pr = x * 4 + (j >> 5), b = pr >> 2; h = pr & 3; seq = S_S; kv0 = TP + b * S_S; tok0 = kv0 + (j & 31) * 128; }
    bool need;
    { const int tid = opaque_tid(), wid = tid >> 6, lane = tid & 63, r32 = lane & 31, hi = lane >> 5, wq = wid & 3, mp = wid >> 2;
      const int sq = tok0 < TP ? (tok0 >> 14) : 2 + ((tok0 - TP) >> 12);
      const float* km = p.kmax2 + ((l * 10 + sq) * 4 + h) * 4 + mp * 2;
      const float kmx = sqrtf(km[0] + km[1]) * 1.01f;
      const bf16_t* Qw = p.proj + (size_t)(tok0 + wq * 32 + r32) * NPROJ + C_Q + h * 128 + mp * 64 + hi * 8;
      float ss = 0.f;
#pragma unroll
      for (int d0 = 0; d0 < 4; ++d0) { const u32x4 w = *(const u32x4*)(Qw + d0 * 16);
        ss += bflo(w.x) * bflo(w.x) + bfhi(w.x) * bfhi(w.x) + bflo(w.y) * bflo(w.y) + bfhi(w.y) * bfhi(w.y) + bflo(w.z) * bflo(w.z) + bfhi(w.z) * bfhi(w.z) + bflo(w.w) * bflo(w.w) + bfhi(w.w) * bfhi(w.w); }
      ss += __shfl_xor(ss, 32);
      need = __any(!(sqrtf(ss) * kmx < 100.f)) != 0; }
    if (need) attn_unit<true>(p.proj, tok0, kv0, seq, h, lam, oscale, subg, lds, dry);
    else attn_unit<false>(p.proj, tok0, kv0, seq, h, lam, oscale, subg, lds, dry);
  }
}
}

__device__ void post_phase(const Params& p, int l) {
  const int tid = opaque_tid(), wid = tid >> 6, lane = tid & 63, nw = blockDim.x >> 6;
  const float* pg = p.post_g + l * DM;
  for (int row = blockIdx.x * nw + wid; row < T_TOK; row += gridDim.x * nw) {
    const float* yr = (const float*)(p.proj + (size_t)row * NPROJ + C_U);
    f32x4 y[4], x[4]; float ss = 0.f;
#pragma unroll
    for (int i = 0; i < 4; ++i) { y[i] = *(const f32x4*)(yr + i * 256 + lane * 4); ss += y[i][0] * y[i][0] + y[i][1] * y[i][1] + y[i][2] * y[i][2] + y[i][3] * y[i][3]; }
    bf16_t* xo = (bf16_t*)p.out + (size_t)row * LDX;
    if (l == 0) {
      const float* xr = row < TP ? p.xp + (size_t)row * DM : p.xs + (size_t)(row - TP) * DM;
#pragma unroll
      for (int i = 0; i < 4; ++i) x[i] = *(const f32x4*)(xr + i * 256 + lane * 4);
    } else {
#pragma unroll
      for (int i = 0; i < 4; ++i) {
        const u32x2 h = *(const u32x2*)(xo + i * 256 + lane * 4), lo = *(const u32x2*)(xo + DM + i * 256 + lane * 4);
        x[i][0] = bflo(h.x) + bflo(lo.x); x[i][1] = bfhi(h.x) + bfhi(lo.x); x[i][2] = bflo(h.y) + bflo(lo.y); x[i][3] = bfhi(h.y) + bfhi(lo.y);
      }
    }
    ss = wave_sum(ss);
    const float ry = __builtin_amdgcn_rsqf(ss * (1.f / DM) + 1e-6f);
    float s2 = 0.f;
#pragma unroll
    for (int i = 0; i < 4; ++i) {
      const f32x4 g = *(const f32x4*)(pg + i * 256 + lane * 4);
#pragma unroll
      for (int e = 0; e < 4; ++e) { x[i][e] = x[i][e] + y[i][e] * ry * g[e]; s2 += x[i][e] * x[i][e]; }
    }
    if (l == DEPTH - 1) {
      float* orow = p.out + (size_t)row * DM;
#pragma unroll
      for (int i = 0; i < 4; ++i) *(f32x4*)(orow + i * 256 + lane * 4) = x[i];
    } else {
      s2 = wave_sum(s2);
      if (lane == 0) p.rinv[row] = __builtin_amdgcn_rsqf(s2 * (1.f / DM) + 1e-6f);
#pragma unroll
      for (int i = 0; i < 4; ++i) {
        const unsigned h0 = cvtpk(x[i][0], x[i][1]), h1 = cvtpk(x[i][2], x[i][3]);
        const unsigned l0 = cvtpk(x[i][0] - bflo(h0), x[i][1] - bfhi(h0)), l1 = cvtpk(x[i][2] - bflo(h1), x[i][3] - bfhi(h1));
        *(u32x2*)(xo + i * 256 + lane * 4) = (u32x2){h0, h1}; *(u32x2*)(xo + DM + i * 256 + lane * 4) = (u32x2){l0, l1};
      }
    }
  }
}

__device__ __forceinline__ void run_phase(const Params& p, int ph, char* shm) {
  if (ph == 0) { phase0(p, shm); return; }
  const int l = (ph - 1) >> 2, s = (ph - 1) & 3;
  if (s == 0) { gm::EpiIn e{p.rinv, p.rope, p.proj, p.kmax2 + l * 160}; gm::gemm_phase(( const bf16_t*)p.out, LDX, p.WinT + (size_t)l * NPROJ * DM, NPROJ, e, shm); }
  else if (s == 1) { pool_phase(p, l); at::attn_phase(p, l, shm); }
  else if (s == 2) { gm::EpiOut e{p.proj}; gm::gemm_phase(p.proj, NPROJ, p.WoutT + (size_t)l * DM * DM, DM, e, shm); }
  else post_phase(p, l);
}

#if MK_MULTI
template <int S> __global__ void __launch_bounds__(NT_THREADS, 1) k_phase(Params p, int l) {
  extern __shared__ __attribute__((aligned(16))) char shm[];
  if (S == 0) phase0(p, shm); else run_phase(p, 1 + 4 * l + (S - 1), shm);
}
#else
__global__ void __launch_bounds__(NT_THREADS, 1) k_mega(Params p) {
  extern __shared__ __attribute__((aligned(16))) char shm[];
  cg::grid_group grid = cg::this_grid();
  phase0(p, shm);
  grid.sync();
  for (int l = 0; l < DEPTH; ++l) {
#if REP_GEMM
    { gm::EpiIn e{p.rinv, p.rope, p.proj, p.kmax2 + l * 160}; gm::gemm_phase((const bf16_t*)p.out, LDX, p.WinT + (size_t)l * NPROJ * DM, NPROJ, e, shm); }
    grid.sync();
#endif
    { gm::EpiIn e{p.rinv, p.rope, p.proj, p.kmax2 + l * 160}; gm::gemm_phase((const bf16_t*)p.out, LDX, p.WinT + (size_t)l * NPROJ * DM, NPROJ, e, shm); }
    grid.sync();
    pool_phase(p, l);
#if REP_ATT
    at::attn_phase(p, l, shm, true); grid.sync();
#endif
    at::attn_phase(p, l, shm);
    grid.sync();
#if REP_GEMM
    { gm::EpiOut e{p.proj}; gm::gemm_phase(p.proj, NPROJ, p.WoutT + (size_t)l * DM * DM, DM, e, shm); }
    grid.sync();
#endif
    { gm::EpiOut e{p.proj}; gm::gemm_phase(p.proj, NPROJ, p.WoutT + (size_t)l * DM * DM, DM, e, shm); }
    grid.sync();
    post_phase(p, l);
    if (l + 1 < DEPTH) grid.sync();
  }
}
#endif

extern "C" void kernel_launch(void* const* d_in, const int* in_sizes, int n_in, void* d_out, int out_size, void* d_ws, size_t ws_size, hipStream_t stream) {
  Params p{};
  p.xp = (const float*)d_in[0]; p.xs = (const float*)d_in[1]; p.pre_g = (const float*)d_in[2]; p.w_in = (const float*)d_in[3];
  p.pool_w = (const float*)d_in[4]; p.pool_scale = (const float*)d_in[5]; p.lq1 = (const float*)d_in[6]; p.lk1 = (const float*)d_in[7];
  p.lq2 = (const float*)d_in[8]; p.lk2 = (const float*)d_in[9]; p.subln_g = (const float*)d_in[10]; p.w_out = (const float*)d_in[11]; p.post_g = (const float*)d_in[12];
  p.out = (float*)d_out;
  char* w = (char*)d_ws; size_t off = 0;
  p.proj = (bf16_t*)(w + off); off += (size_t)T_TOK * NPROJ * 2;
  p.WinT = (bf16_t*)(w + off); off += (size_t)DEPTH * NPROJ * DM * 2;
  p.WoutT = (bf16_t*)(w + off); off += (size_t)DEPTH * DM * DM * 2;
  p.rinv = (float*)(w + off); off += (size_t)T_TOK * 4;
  p.rope = (float*)(w + off); off += 256;
  p.lam = (float*)(w + off); off += 256;
  p.kmax2 = (float*)(w + off); off += 2048;
  if (off > ws_size) { fprintf(stderr, "kernel_launch: workspace too small (%zu > %zu)\n", off, ws_size); return; }
#if MK_MULTI
  static int ok = 0;
  if (!ok) {
    (void)hipFuncSetAttribute((const void*)k_phase<0>, hipFuncAttributeMaxDynamicSharedMemorySize, (int)SHM_BYTES);
    (void)hipFuncSetAttribute((const void*)k_phase<1>, hipFuncAttributeMaxDynamicSharedMemorySize, (int)SHM_BYTES);
    (void)hipFuncSetAttribute((const void*)k_phase<2>, hipFuncAttributeMaxDynamicSharedMemorySize, (int)SHM_BYTES);
    (void)hipFuncSetAttribute((const void*)k_phase<3>, hipFuncAttributeMaxDynamicSharedMemorySize, (int)SHM_BYTES);
    (void)hipFuncSetAttribute((const void*)k_phase<4>, hipFuncAttributeMaxDynamicSharedMemorySize, (int)SHM_BYTES);
    ok = 1; }
  hipLaunchKernelGGL(k_phase<0>, dim3(256), dim3(NT_THREADS), SHM_BYTES, stream, p, 0);
  for (int l = 0; l < DEPTH; ++l) {
    hipLaunchKernelGGL(k_phase<1>, dim3(256), dim3(NT_THREADS), SHM_BYTES, stream, p, l);
    hipLaunchKernelGGL(k_phase<2>, dim3(256), dim3(NT_THREADS), SHM_BYTES, stream, p, l);
    hipLaunchKernelGGL(k_phase<3>, dim3(256), dim3(NT_THREADS), SHM_BYTES, stream, p, l);
    hipLaunchKernelGGL(k_phase<4>, dim3(256), dim3(NT_THREADS), SHM_BYTES, stream, p, l);
  }
#else
  static int grid_blocks = 0;
  if (!grid_blocks) {
    (void)hipFuncSetAttribute((const void*)k_mega, hipFuncAttributeMaxDynamicSharedMemorySize, (int)SHM_BYTES);
    int dev = 0, cus = 0, per_cu = 0;
    (void)hipGetDevice(&dev);
    (void)hipDeviceGetAttribute(&cus, hipDeviceAttributeMultiprocessorCount, dev);
    (void)hipOccupancyMaxActiveBlocksPerMultiprocessor(&per_cu, k_mega, NT_THREADS, SHM_BYTES);
    if (per_cu > 1) per_cu = 1;
    grid_blocks = cus * per_cu;
  }
  void* args[] = {&p};
  hipError_t e = hipLaunchCooperativeKernel((void*)k_mega, dim3(grid_blocks), dim3(NT_THREADS), args, SHM_BYTES, stream);
  if (e != hipSuccess) fprintf(stderr, "cooperative launch failed: %s (grid %d)\n", hipGetErrorString(e), grid_blocks);
#endif
}
```

```cpp
#include <hip/hip_runtime.h>
#include <hip/hip_cooperative_groups.h>
#include <cstdio>
#include <cstdint>
namespace cg = cooperative_groups;

#ifndef REP_ATT
#define REP_ATT 0
#endif
#ifndef REP_POST
#define REP_POST 0
#endif
#ifndef REP_GEMM
#define REP_GEMM 0
#endif
#ifndef MK_MULTI
#define MK_MULTI 0
#endif

typedef unsigned short bf16_t;
using bf16x8 = __attribute__((ext_vector_type(8))) short;
using s16x4  = __attribute__((ext_vector_type(4))) short;
using f32x16 = __attribute__((ext_vector_type(16))) float;
using f32x4  = __attribute__((ext_vector_type(4))) float;
using u32x4  = __attribute__((ext_vector_type(4))) unsigned;
using u32x2  = __attribute__((ext_vector_type(2))) unsigned;

#define XCD_BAR_WORDS 3456
constexpr int NT_THREADS = 512;
constexpr int T_TOK = 65536, TP = 32768, DM = 1024, NPROJ = 3072, DEPTH = 2;
constexpr int S_P = 16384, S_S = 4096;
constexpr int C_ZP = 0, C_ZA = 512, C_U = 1024, C_Q = 1536, C_K = 2048, C_V = 2560;
constexpr int LDX = 2048;
constexpr float QSCALE = 0.125f * 1.4426950408889634f;
constexpr size_t SHM_BYTES = 131072 + 4096;

struct Params {
  const float* xp; const float* xs; const float* pre_g; const float* w_in; const float* pool_w; const float* pool_scale;
  const float* lq1; const float* lk1; const float* lq2; const float* lk2; const float* subln_g; const float* w_out; const float* post_g;
  float* out; bf16_t* WinT; bf16_t* WoutT; bf16_t* proj; float* rinv; float* rope; float* lam; float* kmax2; unsigned* bar;
};

#define SBAR() __builtin_amdgcn_sched_barrier(0)
__device__ __forceinline__ unsigned cvtpk(float lo, float hi) {
  unsigned r; asm volatile("v_cvt_pk_bf16_f32 %0, %1, %2" : "=v"(r) : "v"(lo), "v"(hi)); return r;
}
__device__ __forceinline__ float bf2f(unsigned short b) { return __uint_as_float(((unsigned)b) << 16); }
__device__ __forceinline__ float bflo(unsigned w) { return __uint_as_float(w << 16); }
__device__ __forceinline__ float bfhi(unsigned w) { return __uint_as_float(w & 0xffff0000u); }
__device__ __forceinline__ bf16_t f2bf(float f) { return (bf16_t)(cvtpk(f, 0.f) & 0xffffu); }
__host__ __device__ __forceinline__ int perm32(int rho) { const int n = rho >> 4, i = rho & 15; return 8 * (i >> 2) + 4 * n + (i & 3); }
__device__ __forceinline__ float silu(float z) { return z * __builtin_amdgcn_rcpf(1.f + __builtin_amdgcn_exp2f(-1.4426950408889634f * z)); }
__device__ __forceinline__ int opaque_tid() { int t = threadIdx.x; asm volatile("" : "+v"(t)); return t; }
__device__ __forceinline__ float wave_sum(float v) {
#pragma unroll
  for (int o = 32; o >= 1; o >>= 1) v += __shfl_xor(v, o);
  return v;
}

__device__ __forceinline__ int src_col_in(int s) {
  const int type = s >> 9, within = s & 511;
  if (type == 0) return 512 + within;
  if (type == 1) return 2560 + within;
  if (type == 5) return 2048 + within;
  const int p = within & 63, wcl = p >> 5, fq = (p >> 3) & 3, n = (p >> 2) & 1, jj = p & 3;
  const int d = wcl * 16 + fq * 4 + jj + 32 * n;
  return (type == 3 ? 1024 : 1536) + (within & ~63) + d;
}

__device__ void phase0(const Params& p, char* shm) {
  const int tid = opaque_tid(), nth = blockDim.x;
  float* tile = (float*)shm;
  float* Wt = tile + 64 * 65 + 32;
  float* Pw = Wt + 64 * 128;
  constexpr int NT_U = DEPTH * 8 * 16, NT_IN = DEPTH * 40 * 16, NT_OUT = DEPTH * 16 * 16;
  for (int it = blockIdx.x; it < NT_U + NT_IN + NT_OUT; it += gridDim.x) {
    __syncthreads();
    if (it < NT_U + NT_IN) {
      int l, n0, k0; const bool isu = it < NT_U;
      if (isu) { l = it / 128; const int r = it % 128; n0 = C_U + (r / 16) * 64; k0 = (r % 16) * 64; }
      else { const int i2 = it - NT_U; l = i2 / 640; const int r = i2 % 640; int nt = r / 16; if (nt >= 16) nt += 8; n0 = nt * 64; k0 = (r % 16) * 64; }
      const float* W = p.w_in + (size_t)l * DM * NPROJ; const float* g = p.pre_g + l * DM;
      if (isu) {
        const int gi = (n0 - C_U) >> 7, d0 = (n0 - C_U) & 127;
        for (int e = tid; e < 64 * 128; e += nth) { const int c = e & 127, kk = e >> 7; Wt[e] = W[(size_t)(k0 + kk) * NPROJ + gi * 128 + c]; }
        for (int e = tid; e < 128 * 64; e += nth) { const int d = e & 63, c = e >> 6; Pw[e] = p.pool_w[((size_t)(l * 4 + gi) * 128 + c) * 128 + d0 + d]; }
        __syncthreads();
        for (int e = tid; e < 4096; e += nth) {
          const int nn = e & 63, kk = e >> 6, nrow = n0 + nn; const int s = (nrow & ~31) + perm32(nrow & 31), dl = s - n0;
          float a = 0.f;
#pragma unroll 8
          for (int c = 0; c < 128; ++c) a = fmaf(Wt[kk * 128 + c], Pw[c * 64 + dl], a);
          tile[kk * 65 + nn] = a * g[k0 + kk];
        }
      } else {
        for (int e = tid; e < 4096; e += nth) {
          const int nn = e & 63, kk = e >> 6, k = k0 + kk, nrow = n0 + nn;
          const int s = (nrow & ~31) + perm32(nrow & 31);
          tile[kk * 65 + nn] = W[(size_t)k * NPROJ + src_col_in(s)] * g[k];
        }
      }
      __syncthreads();
      bf16_t* O = p.WinT + (size_t)l * NPROJ * DM;
      for (int e = tid; e < 4096; e += nth) { const int kk = e & 63, nn = e >> 6; O[(size_t)(n0 + nn) * DM + k0 + kk] = f2bf(tile[kk * 65 + nn]); }
    } else {
      const int it2 = it - NT_U - NT_IN, l = it2 / 256, r = it2 % 256, n0 = (r / 16) * 64, k0 = (r % 16) * 64;
      const float* W = p.w_out + (size_t)l * DM * DM;
      for (int e = tid; e < 4096; e += nth) {
        const int nn = e & 63, kk = e >> 6, nrow = n0 + nn; const int s = (nrow & ~31) + perm32(nrow & 31);
        tile[kk * 65 + nn] = W[(size_t)(k0 + kk) * DM + s];
      }
      __syncthreads();
      bf16_t* O = p.WoutT + (size_t)l * DM * DM;
      for (int e = tid; e < 4096; e += nth) { const int kk = e & 63, nn = e >> 6; O[(size_t)(n0 + nn) * DM + k0 + kk] = f2bf(tile[kk * 65 + nn]); }
    }
  }
  if (blockIdx.x == 0) {
    for (int i = tid; i < XCD_BAR_WORDS; i += nth) p.bar[i] = 0u;
    if (tid < DEPTH * 160) p.kmax2[tid] = 0.f;
    if (tid < 32) { const double c = exp(-(double)tid * (9.210340371976184 / 32.0)) * 0.15915494309189535; const float h = (float)c; p.rope[2 * tid] = h; p.rope[2 * tid + 1] = (float)(c - (double)h); }
    if (tid >= 64 && tid < 64 + 64 * DEPTH) {
      const int l = (tid >> 6) - 1, i = tid & 63;
      float a = p.lq1[l * 64 + i] * p.lk1[l * 64 + i], b = p.lq2[l * 64 + i] * p.lk2[l * 64 + i];
      a = wave_sum(a); b = wave_sum(b);
      const float li = 0.8f - 0.6f * expf(-0.3f * (float)l);
      if (i == 0) p.lam[l] = expf(a) - expf(b) + li;
    }
  }
  const int wid = tid >> 6, lane = tid & 63, nw = nth >> 6;
  for (int row = blockIdx.x * nw + wid; row < T_TOK; row += gridDim.x * nw) {
    const float* xr = row < TP ? p.xp + (size_t)row * DM : p.xs + (size_t)(row - TP) * DM;
    bf16_t* xo = (bf16_t*)p.out + (size_t)row * LDX;
    float ss = 0.f;
#pragma unroll
    for (int i = 0; i < 4; ++i) {
      const f32x4 v = *(const f32x4*)(xr + i * 256 + lane * 4);
      ss += v[0] * v[0] + v[1] * v[1] + v[2] * v[2] + v[3] * v[3];
      u32x2 w = {cvtpk(v[0], v[1]), cvtpk(v[2], v[3])};
      *(u32x2*)(xo + i * 256 + lane * 4) = w;
    }
    ss = wave_sum(ss);
    if (lane == 0) p.rinv[row] = __builtin_amdgcn_rsqf(ss * (1.f / DM) + 1e-6f);
  }
}

namespace gm {
constexpr int BM = 256, BK = 64, HALF = 128, NXCD = 8, WGM = 8, HT = HALF * BK;
__device__ __forceinline__ int lds_byte(int r, int c) { int st = (r >> 4) * 2 + (c >> 5), rr = r & 15, cc = c & 31, ob = rr * 64 + cc * 2; return st * 1024 + (ob ^ (((ob >> 9) & 1) << 5)); }
__device__ __forceinline__ void stage_rc(int b, int& R, int& C) { int st = b / 1024, sb = b % 1024, swz = sb ^ (((sb >> 9) & 1) << 5); R = (st >> 1) * 16 + swz / 64; C = (st & 1) * 32 + (swz % 64) / 2; }

#define LAS __attribute__((address_space(3)))
template <class Epi>
__device__ __forceinline__ void gemm_phase(const bf16_t* __restrict__ A, const int lda, const bf16_t* __restrict__ Bt, const int N, const Epi& E, char* shmc) {
  constexpr int K = 1024, nt = K / BK, HTB = HALF * BK * 2;
  LAS unsigned char* lds = (LAS unsigned char*)shmc;
  const int tid = opaque_tid(), wid = __builtin_amdgcn_readfirstlane(tid >> 6), lane = tid & 63, wr = wid >> 2, wc = wid & 3, fr = lane & 15, fq = lane >> 4;
  unsigned voffA[2], voffB[2];
#pragma unroll
  for (int i = 0; i < 2; ++i) { int R, C; stage_rc(tid * 16 + i * 8192, R, C); voffA[i] = (unsigned)(R * lda + C) * 2u; voffB[i] = (unsigned)(R * K + C) * 2u; }
  const size_t kstep = (size_t)(BK * 2);
  const size_t hstepA = (size_t)HALF * lda * 2, hstepB = (size_t)HALF * K * 2;
  const size_t tstepA = 2 * hstepA, tstepB = 2 * hstepB;
  const unsigned ldsw = (unsigned)wid * 1024u;
  const int aoff = lds_byte(wr * 64 + fr, fq * 8), boff = lds_byte(wc * 32 + fr, fq * 8);
#define PG8_SA(b, h) (((b) * 2 + (h)) * HTB)
#define PG8_SB(b, h) ((4 + (b) * 2 + (h)) * HTB)
#define PG8_STAGE(bufoff, gbase, voff) do { _Pragma("unroll") for (int _i = 0; _i < 2; ++_i) \
        __builtin_amdgcn_global_load_lds((const unsigned*)((const char*)(gbase) + (voff)[_i]), (LAS unsigned*)(lds + (bufoff) + ldsw + _i * 8192), 16, 0, 0); } while (0)
#define PG8_LDA(dst, b, h) do { _Pragma("unroll") for (int m = 0; m < 4; ++m) _Pragma("unroll") for (int k = 0; k < 2; ++k) dst[m][k] = *(const LAS bf16x8*)(lds + PG8_SA(b, h) + aoff + m * 2048 + k * 1024); } while (0)
#define PG8_LDB(dst, b, h) do { _Pragma("unroll") for (int n = 0; n < 2; ++n) _Pragma("unroll") for (int k = 0; k < 2; ++k) dst[n][k] = *(const LAS bf16x8*)(lds + PG8_SB(b, h) + boff + n * 2048 + k * 1024); } while (0)
#define PG8_MMA(ai, bj, At, Bx) do { __builtin_amdgcn_s_setprio(1); _Pragma("unroll") for (int m = 0; m < 4; ++m) _Pragma("unroll") for (int n = 0; n < 2; ++n) _Pragma("unroll") for (int k = 0; k < 2; ++k) \
        acc[ai][bj][m][n] = __builtin_amdgcn_mfma_f32_16x16x32_bf16(Bx[n][k], At[m][k], acc[ai][bj][m][n], 0, 0, 0); __builtin_amdgcn_s_setprio(0); } while (0)
#define PG8_WAIT_V(n) asm volatile("s_waitcnt vmcnt(" #n ")" ::: "memory")
#define PG8_WAIT_L(n) asm volatile("s_waitcnt lgkmcnt(" #n ")" ::: "memory")
#define PG8_BAR __builtin_amdgcn_s_barrier()
#define PG8_SCHED __builtin_amdgcn_sched_barrier(0)
  const int nM = T_TOK / BM, nN = N / BM, nwg = nM * nN, G = gridDim.x, cblk = blockIdx.x;
  auto next_unit = [&](int i, int& pm, int& pn) -> bool {
    const long L = (long)i * G + cblk; if (L >= nwg) return false;
    int wgid = (int)L; { const int q = nwg / NXCD, r = nwg % NXCD, xcd = wgid % NXCD, off = wgid / NXCD; wgid = (xcd < r ? xcd * (q + 1) : r * (q + 1) + (xcd - r) * q) + off; }
    const int nig = WGM * nN, gid = wgid / nig, fm = gid * WGM, gsz = (nM - fm) < WGM ? (nM - fm) : WGM;
    pm = fm + ((wgid % nig) % gsz); pn = (wgid % nig) / gsz; return true;
  };
  int cpm, cpn, npm = 0, npn = 0, ui = 0;
  if (!next_unit(0, cpm, cpn)) return;
  f32x4 acc[2][2][4][2];
#pragma unroll
  for (int a = 0; a < 2; ++a)
#pragma unroll
    for (int b = 0; b < 2; ++b)
#pragma unroll
      for (int m = 0; m < 4; ++m)
#pragma unroll
        for (int n = 0; n < 2; ++n) acc[a][b][m][n] = (f32x4){0.f, 0.f, 0.f, 0.f};
  bf16x8 At[4][2], B0[2][2], B1[2][2];
  const char* cA = (const char*)A + (size_t)cpm * tstepA; const char* cB = (const char*)Bt + (size_t)cpn * tstepB;
  PG8_STAGE(PG8_SB(0, 0), cB, voffB); PG8_STAGE(PG8_SB(0, 1), cB + hstepB, voffB); PG8_STAGE(PG8_SA(0, 0), cA, voffA); PG8_STAGE(PG8_SA(0, 1), cA + hstepA, voffA);
  if (wr == 1) PG8_BAR;
  PG8_WAIT_V(2); PG8_BAR;
  PG8_STAGE(PG8_SB(1, 0), cB + kstep, voffB); PG8_STAGE(PG8_SA(1, 0), cA + kstep, voffA); PG8_STAGE(PG8_SB(1, 1), cB + hstepB + kstep, voffB);
  PG8_WAIT_V(6); PG8_BAR;
  for (;;) {
    const bool has_next = next_unit(ui + 1, npm, npn);
    const char* nA = has_next ? (const char*)A + (size_t)npm * tstepA : cA; const char* nB = has_next ? (const char*)Bt + (size_t)npn * tstepB : cB;
    for (int t = 0; t < nt; t += 2) {
      const bool last = (t == nt - 2);
      const char* a1 = cA + (size_t)(t + 1) * kstep;
      const char* a2 = last ? nA : cA + (size_t)(t + 2) * kstep; const char* b2 = last ? nB : cB + (size_t)(t + 2) * kstep;
      const char* a3 = a2 + kstep; const char* b3 = b2 + kstep;
      PG8_LDB(B0, 0, 0); PG8_LDB(B1, 0, 1); PG8_SCHED; PG8_LDA(At, 0, 0); PG8_STAGE(PG8_SA(1, 1), a1 + hstepA, voffA);
      PG8_WAIT_V(8); PG8_WAIT_L(0); PG8_BAR; PG8_MMA(0, 0, At, B0); PG8_MMA(0, 1, At, B1); PG8_BAR; PG8_SCHED;
      PG8_LDA(At, 0, 1); PG8_STAGE(PG8_SB(0, 0), b2, voffB); PG8_STAGE(PG8_SB(0, 1), b2 + hstepB, voffB); PG8_STAGE(PG8_SA(0, 0), a2, voffA);
      PG8_WAIT_V(8); PG8_WAIT_L(0); PG8_BAR; PG8_MMA(1, 0, At, B0); PG8_MMA(1, 1, At, B1); PG8_BAR; PG8_SCHED;
      PG8_LDB(B0, 1, 0); PG8_LDB(B1, 1, 1); PG8_SCHED; PG8_LDA(At, 1, 0); PG8_STAGE(PG8_SA(0, 1), a2 + hstepA, voffA);
      PG8_WAIT_V(8); PG8_WAIT_L(0); PG8_BAR; PG8_MMA(0, 0, At, B0); PG8_MMA(0, 1, At, B1); PG8_BAR; PG8_SCHED;
      PG8_LDA(At, 1, 1); PG8_STAGE(PG8_SB(1, 0), b3, voffB); PG8_STAGE(PG8_SB(1, 1), b3 + hstepB, voffB); PG8_STAGE(PG8_SA(1, 0), a3, voffA);
      PG8_WAIT_V(8); PG8_WAIT_L(0); PG8_BAR; PG8_MMA(1, 0, At, B0); PG8_MMA(1, 1, At, B1); PG8_BAR; PG8_SCHED;
    }
    if (wr == 0) PG8_BAR;
    E(acc, cpm, cpn, wr, wc, fr, fq);
    if (!has_next) break;
#pragma unroll
    for (int a = 0; a < 2; ++a)
#pragma unroll
      for (int b = 0; b < 2; ++b)
#pragma unroll
        for (int m = 0; m < 4; ++m)
#pragma unroll
          for (int n = 0; n < 2; ++n) acc[a][b][m][n] = (f32x4){0.f, 0.f, 0.f, 0.f};
    cpm = npm; cpn = npn; cA = nA; cB = nB; ++ui;
    if (wr == 1) PG8_BAR;
  }
  PG8_WAIT_V(0);
  PG8_BAR;
#undef PG8_SA
#undef PG8_SB
#undef PG8_STAGE
#undef PG8_LDA
#undef PG8_LDB
#undef PG8_MMA
}

struct EpiIn {
  const float* rinv; const float* rope; bf16_t* proj; float* kmax2;
  __device__ __forceinline__ void operator()(const f32x4 (&acc)[2][2][4][2], int pm, int pn, int wr, int wc, int fr, int fq) const {
    const bool isrope = (pn >= 6 && pn <= 9); const float qs = (pn == 6 || pn == 7) ? QSCALE : 1.f;
    const bool isk = (pn == 8 || pn == 9);
    float kmx[2] = {0.f, 0.f};
    float ch[4], cl[4];
    if (isrope) {
#pragma unroll
      for (int jj = 0; jj < 4; ++jj) { const int i = (wc & 1) * 16 + fq * 4 + jj; ch[jj] = rope[2 * i]; cl[jj] = rope[2 * i + 1]; }
    }
#pragma unroll
    for (int ai = 0; ai < 2; ++ai)
#pragma unroll
      for (int m = 0; m < 4; ++m) {
        const int row = pm * BM + ai * HALF + wr * 64 + m * 16 + fr;
        const float ri = rinv[row];
        float cs[4], sn[4];
        if (isrope) {
          const float pos = (float)(row < TP ? (row & (S_P - 1)) : (row & (S_S - 1)));
#pragma unroll
          for (int jj = 0; jj < 4; ++jj) {
            const float h = pos * ch[jj], e = fmaf(pos, ch[jj], -h) + pos * cl[jj];
            const float rev = (h - floorf(h)) + e;
            sn[jj] = __builtin_amdgcn_sinf(rev); cs[jj] = __builtin_amdgcn_cosf(rev);
          }
        }
        bf16_t* rowp = proj + (size_t)row * NPROJ + pn * BM + wc * 32 + 8 * fq;
#pragma unroll
        for (int bj = 0; bj < 2; ++bj) {
          f32x4 v0 = acc[ai][bj][m][0] * ri, v1 = acc[ai][bj][m][1] * ri;
          if (isrope) {
#pragma unroll
            for (int jj = 0; jj < 4; ++jj) { const float a = v0[jj], b = v1[jj]; v0[jj] = (a * cs[jj] - b * sn[jj]) * qs; v1[jj] = (b * cs[jj] + a * sn[jj]) * qs; }
          }
          u32x4 w; w.x = cvtpk(v0[0], v0[1]); w.y = cvtpk(v0[2], v0[3]); w.z = cvtpk(v1[0], v1[1]); w.w = cvtpk(v1[2], v1[3]);
          *(u32x4*)(rowp + bj * HALF) = w;
          if (isk) { float ss = v0[0] * v0[0] + v0[1] * v0[1] + v0[2] * v0[2] + v0[3] * v0[3] + v1[0] * v1[0] + v1[1] * v1[1] + v1[2] * v1[2] + v1[3] * v1[3];
            ss += __shfl_xor(ss, 16); ss += __shfl_xor(ss, 32); kmx[bj] = fmaxf(kmx[bj], ss); }
        }
      }
    if (isk) {
      const int row0 = pm * BM, sq = row0 < TP ? (row0 >> 14) : 2 + ((row0 - TP) >> 12);
#pragma unroll
      for (int bj = 0; bj < 2; ++bj) { float v = kmx[bj];
        v = fmaxf(v, __shfl_xor(v, 1)); v = fmaxf(v, __shfl_xor(v, 2)); v = fmaxf(v, __shfl_xor(v, 4)); v = fmaxf(v, __shfl_xor(v, 8));
        if ((fr | fq) == 0) atomicMax((unsigned*)(kmax2 + (sq * 4 + (pn - 8) * 2 + bj) * 4 + wc), __float_as_uint(v)); }
    }
  }
};
struct EpiOut {
  bf16_t* proj;
  __device__ __forceinline__ void operator()(const f32x4 (&acc)[2][2][4][2], int pm, int pn, int wr, int wc, int fr, int fq) const {
#pragma unroll
    for (int ai = 0; ai < 2; ++ai)
#pragma unroll
      for (int m = 0; m < 4; ++m) {
        const int row = pm * BM + ai * HALF + wr * 64 + m * 16 + fr;
        float* rowp = (float*)(proj + (size_t)row * NPROJ + C_U) + pn * BM + wc * 32 + 8 * fq;
#pragma unroll
        for (int bj = 0; bj < 2; ++bj) { *(f32x4*)(rowp + bj * HALF) = acc[ai][bj][m][0]; *(f32x4*)(rowp + bj * HALF + 4) = acc[ai][bj][m][1]; }
      }
  }
};
}

__device__ __forceinline__ void bf8_to_f(const u32x4 w, float* v) {
  v[0] = bflo(w.x); v[1] = bfhi(w.x); v[2] = bflo(w.y); v[3] = bfhi(w.y); v[4] = bflo(w.z); v[5] = bfhi(w.z); v[6] = bflo(w.w); v[7] = bfhi(w.w);
}
__device__ void pool_phase(const Params& p, int l, bool dry = false) {
  const int tid = opaque_tid(), c8 = tid & 63, tq = tid >> 6;
  const int g = c8 >> 4, hw = 1 << g;
  const float* sc = p.pool_scale + l * 512 + c8 * 8;
  float scl[8];
#pragma unroll
  for (int e = 0; e < 8; ++e) scl[e] = sc[e];
  for (int ch = blockIdx.x; ch < T_TOK / 128; ch += gridDim.x) {
    const int t0 = ch * 128 + tq * 16;
    const int S = t0 < TP ? S_P : S_S, pos0 = t0 & (S - 1), s0 = t0 - pos0;
    const bf16_t* ub = p.proj + (size_t)s0 * NPROJ + C_U + c8 * 8;
    float sum[8] = {0, 0, 0, 0, 0, 0, 0, 0};
#pragma unroll
    for (int j = 0; j < 16; ++j) {
      const int r = pos0 - hw + j; const bool ok = (j < 2 * hw) && r >= 0 && r < S; const int rc = min(max(r, 0), S - 1);
      float v[8]; bf8_to_f(*(const u32x4*)(ub + (size_t)rc * NPROJ), v); const float m = ok ? 1.f : 0.f;
#pragma unroll
      for (int e = 0; e < 8; ++e) sum[e] = fmaf(m, v[e], sum[e]);
    }
#pragma unroll
    for (int i4 = 0; i4 < 16; i4 += 4) {
      u32x4 wu[4], wz[4], wa[4], wsb[4];
#pragma unroll
      for (int q = 0; q < 4; ++q) {
        const int pos = pos0 + i4 + q, ra = pos + hw, rs = pos - hw;
        wu[q] = *(const u32x4*)(ub + (size_t)pos * NPROJ);
        wz[q] = *(const u32x4*)(p.proj + (size_t)(t0 + i4 + q) * NPROJ + C_ZP + c8 * 8);
        wa[q] = *(const u32x4*)(ub + (size_t)min(ra, S - 1) * NPROJ); wsb[q] = *(const u32x4*)(ub + (size_t)max(rs, 0) * NPROJ);
      }
#pragma unroll
      for (int q = 0; q < 4; ++q) {
        const int pos = pos0 + i4 + q, t = t0 + i4 + q;
        const int lo = max(pos - hw, 0), hi = min(pos + hw, S);
        const float inv = 1.f / (float)(hi - lo);
        float uc[8], z[8], va[8], vs[8], o[8];
        bf8_to_f(wu[q], uc); bf8_to_f(wz[q], z);
#pragma unroll
        for (int e = 0; e < 8; ++e) o[e] = (sum[e] * inv - uc[e]) * scl[e] * silu(z[e]);
        const u32x4 w = {cvtpk(o[0], o[1]), cvtpk(o[2], o[3]), cvtpk(o[4], o[5]), cvtpk(o[6], o[7])};
        if (!dry) *(u32x4*)(p.proj + (size_t)t * NPROJ + C_ZP + c8 * 8) = w;
        const int ra = pos + hw, rs = pos - hw; const float ma = ra < S ? 1.f : 0.f, ms = rs >= 0 ? 1.f : 0.f;
        bf8_to_f(wa[q], va); bf8_to_f(wsb[q], vs);
#pragma unroll
        for (int e = 0; e < 8; ++e) sum[e] = fmaf(ma, va[e], fmaf(-ms, vs[e], sum[e]));
      }
    }
  }
}

namespace at {
constexpr int KVBLK = 64, LDK = NPROJ;
constexpr size_t SHM_V = KVBLK * 128 * 2, SHM_K = KVBLK * 128 * 2;
constexpr float THRL = 11.5f;
#define KSWZ(row, colB) ((row) * 256 + ((colB) ^ (((row) & 7) << 4)))
__device__ __forceinline__ int crow(int r, int hi) { return (r & 3) + 8 * (r >> 2) + 4 * hi; }
template <bool SH> __device__ __forceinline__ void partialSM(f32x16& p0, f32x16& p1, float& m_reg, float& mn, float& alpha) {
  if constexpr (!SH) {
    alpha = 1.f;
#pragma unroll
    for (int r = 0; r < 16; ++r) p0[r] = __builtin_amdgcn_exp2f(p0[r]);
    return;
  }
  float pmax = p0[0];
#pragma unroll
  for (int r = 1; r < 16; ++r) pmax = fmaxf(pmax, p0[r]);
#pragma unroll
  for (int r = 0; r < 16; ++r) pmax = fmaxf(pmax, p1[r]);
  { auto rr = __builtin_amdgcn_permlane32_swap(__float_as_uint(pmax), __float_as_uint(pmax), false, false);
    pmax = fmaxf(__uint_as_float(rr[0]), __uint_as_float(rr[1])); }
  if (__builtin_expect(__all(pmax - m_reg <= THRL), 1)) { mn = m_reg; alpha = 1.f; }
  else { mn = fmaxf(m_reg, pmax); alpha = __builtin_amdgcn_exp2f(m_reg - mn); m_reg = mn; }
#pragma unroll
  for (int r = 0; r < 16; ++r) p0[r] = p0[r] - mn;
#pragma unroll
  for (int r = 0; r < 16; ++r) p1[r] = p1[r] - mn;
#pragma unroll
  for (int r = 0; r < 16; ++r) p0[r] = __builtin_amdgcn_exp2f(p0[r]);
}
template <bool SH> __device__ __forceinline__ void finishSM(f32x16& p0, f32x16& p1, float alpha, float& l_reg, bf16x8& pa0, bf16x8& pa1, bf16x8& pa2, bf16x8& pa3) {
#pragma unroll
  for (int r = 0; r < 16; ++r) p1[r] = __builtin_amdgcn_exp2f(p1[r]);
  float ps = 0;
#pragma unroll
  for (int r = 0; r < 16; ++r) ps += p0[r];
#pragma unroll
  for (int r = 0; r < 16; ++r) ps += p1[r];
  { auto rr = __builtin_amdgcn_permlane32_swap(__float_as_uint(ps), __float_as_uint(ps), false, false);
    ps = __uint_as_float(rr[0]) + __uint_as_float(rr[1]); }
  if constexpr (SH) l_reg = l_reg * alpha + ps; else l_reg += ps;
#define PK4(P, BASE, OUT) do { unsigned a0 = cvtpk(P[BASE + 0], P[BASE + 1]), a1 = cvtpk(P[BASE + 2], P[BASE + 3]);   \
    unsigned b0 = cvtpk(P[BASE + 4], P[BASE + 5]), b1 = cvtpk(P[BASE + 6], P[BASE + 7]);                              \
    auto r0 = __builtin_amdgcn_permlane32_swap(a0, b0, false, false); auto r1 = __builtin_amdgcn_permlane32_swap(a1, b1, false, false); \
    u32x4 w = {r0[0], r1[0], r0[1], r1[1]}; OUT = *reinterpret_cast<bf16x8*>(&w); } while (0)
  PK4(p0, 0, pa0); PK4(p0, 8, pa1); PK4(p1, 0, pa2); PK4(p1, 8, pa3);
#undef PK4
}
__device__ __forceinline__ void qkt(f32x16& p0, f32x16& p1, const char* Ks, const bf16x8* qr, int r32, int hi, int mapB) {
  p0 = f32x16{}; p1 = f32x16{};
#pragma unroll
  for (int d0 = 0; d0 < 4; ++d0) { const int cb = (d0 * 16 + hi * 8) * 2 + mapB;
    bf16x8 b0 = *reinterpret_cast<const bf16x8*>(Ks + KSWZ(r32, cb));
    bf16x8 b1 = *reinterpret_cast<const bf16x8*>(Ks + KSWZ(32 + r32, cb));
    p0 = __builtin_amdgcn_mfma_f32_32x32x16_bf16(b0, qr[d0], p0, 0, 0, 0);
    p1 = __builtin_amdgcn_mfma_f32_32x32x16_bf16(b1, qr[d0], p1, 0, 0, 0); }
}
__device__ __forceinline__ int v_st(int k, int c) { const int kk = (k & ~0xC) | ((k & 4) << 1) | ((k & 8) >> 1); return ((kk >> 3) * 4 + (c >> 5)) * 512 + ((kk & 7) * 32 + (c & 31)) * 2; }
__device__ __forceinline__ int v_rd_base(int lane) { return ((lane & 3) << 3) | (((lane >> 2) & 3) << 6) | (((lane >> 4) & 1) << 5) | (((lane >> 5) & 1) << 8); }
constexpr int v_rd_off(int d0, int ks, int half) { return d0 * 512 + ks * 4096 + half * 2048; }
template <int OFF> __device__ __forceinline__ s16x4 tr_read(int vb) {
  s16x4 r; asm volatile("ds_read_b64_tr_b16 %0, %1 offset:%2" : "=&v"(r) : "v"(vb), "i"(OFF) : "memory"); return r;
}
template <int D0> __device__ __forceinline__ void pv_one(f32x16& od, int vb, bf16x8 pa0, bf16x8 pa1, bf16x8 pa2, bf16x8 pa3) {
  const s16x4 l0 = tr_read<v_rd_off(D0, 0, 0)>(vb), h0 = tr_read<v_rd_off(D0, 0, 1)>(vb), l1 = tr_read<v_rd_off(D0, 1, 0)>(vb), h1 = tr_read<v_rd_off(D0, 1, 1)>(vb);
  const s16x4 l2 = tr_read<v_rd_off(D0, 2, 0)>(vb), h2 = tr_read<v_rd_off(D0, 2, 1)>(vb), l3 = tr_read<v_rd_off(D0, 3, 0)>(vb), h3 = tr_read<v_rd_off(D0, 3, 1)>(vb);
  asm volatile("s_waitcnt lgkmcnt(0)" ::: "memory"); SBAR();
#define PK(L, H) (bf16x8){L[0], L[1], L[2], L[3], H[0], H[1], H[2], H[3]}
  od = __builtin_amdgcn_mfma_f32_32x32x16_bf16(pa0, PK(l0, h0), od, 0, 0, 0);
  od = __builtin_amdgcn_mfma_f32_32x32x16_bf16(pa1, PK(l1, h1), od, 0, 0, 0);
  od = __builtin_amdgcn_mfma_f32_32x32x16_bf16(pa2, PK(l2, h2), od, 0, 0, 0);
  od = __builtin_amdgcn_mfma_f32_32x32x16_bf16(pa3, PK(l3, h3), od, 0, 0, 0);
#undef PK
}
__device__ __forceinline__ void pv_d0(f32x16* o, int vb, bf16x8 pa0, bf16x8 pa1, bf16x8 pa2, bf16x8 pa3) {
  pv_one<0>(o[0], vb, pa0, pa1, pa2, pa3); pv_one<1>(o[1], vb, pa0, pa1, pa2, pa3); pv_one<2>(o[2], vb, pa0, pa1, pa2, pa3); pv_one<3>(o[3], vb, pa0, pa1, pa2, pa3);
}

template <bool SH> __device__ __forceinline__ void attn_unit(bf16_t* __restrict__ proj, int tok0, int kv0, int seq, int h, float lam, float oscale, const float* __restrict__ subg, char* lds, bool dry) {
  const int tid = opaque_tid(), wid = tid >> 6, lane = tid & 63, r32 = lane & 31, hi = lane >> 5;
  const int wq = wid & 3, mp = wid >> 2, mapB = mp * 128;
  char* V_lds = lds; char* K_lds = lds + 2 * SHM_V;
  float* ws = (float*)(lds + 2 * SHM_V + 2 * SHM_K) + wid * 64; float* li_l = ws; float* al_l = ws + 32;
  const bf16_t* Kh = proj + (size_t)kv0 * NPROJ + C_K + h * 128;
  const bf16_t* Vh = proj + (size_t)kv0 * NPROJ + C_V + h * 128;
  float m_reg = -1e30f, l_reg = 0; f32x16 o[4] = {}; bf16x8 qr[4];
  const bf16_t* Qw = proj + (size_t)(tok0 + wq * 32 + r32) * NPROJ + C_Q + h * 128 + mp * 64 + hi * 8;
#pragma unroll
  for (int d0 = 0; d0 < 4; ++d0) qr[d0] = *reinterpret_cast<const bf16x8*>(Qw + d0 * 16);
  const int sr = tid >> 4, sc = (tid & 15) * 8, vst0 = v_st(sr, sc), vst1 = v_st(32 + sr, sc);
  const int vb0 = (int)(uintptr_t)V_lds + v_rd_base(lane);
  struct { bf16x8 vs0, vs1, ks0, ks1; } sr_[2];
#define LD8(ptr) (*reinterpret_cast<const bf16x8*>(ptr))
#define SLOAD(i, k0) do { sr_[i].vs0 = LD8(&Vh[(size_t)((k0) + sr) * LDK + sc]); sr_[i].vs1 = LD8(&Vh[(size_t)((k0) + 32 + sr) * LDK + sc]); \
    sr_[i].ks0 = LD8(&Kh[(size_t)((k0) + sr) * LDK + sc]); sr_[i].ks1 = LD8(&Kh[(size_t)((k0) + 32 + sr) * LDK + sc]); } while (0)
#define SWRITE(b, i) do { *(bf16x8*)(V_lds + (b) * SHM_V + vst0) = sr_[i].vs0;          \
    *(bf16x8*)(V_lds + (b) * SHM_V + vst1) = sr_[i].vs1; int kc = sc * 2;               \
    *(bf16x8*)(K_lds + (b) * SHM_K + KSWZ(sr, kc)) = sr_[i].ks0;                       \
    *(bf16x8*)(K_lds + (b) * SHM_K + KSWZ(32 + sr, kc)) = sr_[i].ks1; } while (0)
#define SWAIT() asm volatile("s_waitcnt vmcnt(4)" ::: "memory")
#define RESC(a) do { if (SH && __any((a) < 1.f)) { if (hi == 0) al_l[r32] = (a); asm volatile("s_waitcnt lgkmcnt(0)" ::: "memory"); \
    _Pragma("unroll") for (int d = 0; d < 4; ++d) _Pragma("unroll") for (int r = 0; r < 16; ++r) o[d][r] *= al_l[crow(r, hi)]; } } while (0)
  f32x16 pA0, pA1, pB0, pB1; float mnA, mnB, alA, alB; bf16x8 pa0, pa1, pa2, pa3; const int NT = seq / KVBLK;
  constexpr int SE = 0, SO = 1;
  SLOAD(SE, 0); asm volatile("s_waitcnt vmcnt(0)" ::: "memory"); SWRITE(0, SE); __syncthreads();
  qkt(pA0, pA1, K_lds, qr, r32, hi, mapB); partialSM<SH>(pA0, pA1, m_reg, mnA, alA);
  SLOAD(SO, KVBLK); if (2 < NT) SLOAD(SE, 2 * KVBLK);
  SWAIT(); SWRITE(1, SO); __syncthreads();
  for (int j = 1; j + 1 < NT; j += 2) {
    SBAR(); qkt(pB0, pB1, K_lds + SHM_K, qr, r32, hi, mapB);
    finishSM<SH>(pA0, pA1, alA, l_reg, pa0, pa1, pa2, pa3); SBAR();
    SLOAD(SO, (j + 2) * KVBLK); SBAR();
    pv_d0(o, vb0, pa0, pa1, pa2, pa3); partialSM<SH>(pB0, pB1, m_reg, mnB, alB);
    __syncthreads(); SWAIT(); SWRITE(0, SE);
    RESC(alB); __syncthreads();
    SBAR(); qkt(pA0, pA1, K_lds, qr, r32, hi, mapB);
    finishSM<SH>(pB0, pB1, alB, l_reg, pa0, pa1, pa2, pa3); SBAR();
    if (j + 3 < NT) SLOAD(SE, (j + 3) * KVBLK); SBAR();
    pv_d0(o, vb0 + (int)SHM_V, pa0, pa1, pa2, pa3); partialSM<SH>(pA0, pA1, m_reg, mnA, alA);
    __syncthreads(); SWAIT(); SWRITE(1, SO);
    RESC(alA); __syncthreads();
  }
  SBAR(); qkt(pB0, pB1, K_lds + SHM_K, qr, r32, hi, mapB);
  finishSM<SH>(pA0, pA1, alA, l_reg, pa0, pa1, pa2, pa3); SBAR();
  pv_d0(o, vb0, pa0, pa1, pa2, pa3); partialSM<SH>(pB0, pB1, m_reg, mnB, alB);
  __syncthreads(); RESC(alB);
  finishSM<SH>(pB0, pB1, alB, l_reg, pa0, pa1, pa2, pa3); SBAR();
  pv_d0(o, vb0 + (int)SHM_V, pa0, pa1, pa2, pa3);
  if (hi == 0) li_l[r32] = l_reg; asm volatile("s_waitcnt lgkmcnt(0)" ::: "memory");
  float rli[16];
#pragma unroll
  for (int r = 0; r < 16; ++r) rli[r] = __builtin_amdgcn_rcpf(li_l[crow(r, hi)]);
  __syncthreads();
  float* X = (float*)lds;
  if (mp == 1) {
#pragma unroll
    for (int d = 0; d < 4; ++d)
#pragma unroll
      for (int r = 0; r < 16; ++r) X[(wq * 64 + d * 16 + r) * 64 + lane] = o[d][r] * rli[r] * lam;
  }
  __syncthreads();
  if (mp == 0) {
#pragma unroll
    for (int d = 0; d < 4; ++d)
#pragma unroll
      for (int r = 0; r < 16; ++r) { const int ix = (wq * 64 + d * 16 + r) * 64 + lane; X[ix] = o[d][r] * rli[r] - X[ix]; }
  }
  __syncthreads();
  {
    const int row = tid >> 2, dq = tid & 3, rl = row & 31, w = row >> 5, hh = (rl >> 2) & 1, r = (rl & 3) + 4 * (rl >> 3);
    const float* xb = X + (w * 64 + dq * 16 + r) * 64 + hh * 32;
    f32x4 a[8]; float ss = 0.f;
#pragma unroll
    for (int i = 0; i < 8; ++i) { a[i] = *(const f32x4*)(xb + i * 4); ss += a[i][0] * a[i][0] + a[i][1] * a[i][1] + a[i][2] * a[i][2] + a[i][3] * a[i][3]; }
    ss += __shfl_xor(ss, 1); ss += __shfl_xor(ss, 2);
    const float rn = __builtin_amdgcn_rsqf(ss * (1.f / 128.f) + 1e-5f) * oscale;
    bf16_t* zp = proj + (size_t)(tok0 + row) * NPROJ + C_ZA + h * 128 + dq * 32;
    const float* gg = subg + dq * 32;
#pragma unroll
    for (int i = 0; i < 4; ++i) {
      const u32x4 z = *(const u32x4*)(zp + i * 8);
      const f32x4 a0 = a[2 * i], a1 = a[2 * i + 1]; const f32x4 g0 = *(const f32x4*)(gg + i * 8), g1 = *(const f32x4*)(gg + i * 8 + 4);
      u32x4 wv;
      wv.x = cvtpk(a0[0] * rn * g0[0] * silu(bflo(z.x)), a0[1] * rn * g0[1] * silu(bfhi(z.x)));
      wv.y = cvtpk(a0[2] * rn * g0[2] * silu(bflo(z.y)), a0[3] * rn * g0[3] * silu(bfhi(z.y)));
      wv.z = cvtpk(a1[0] * rn * g1[0] * silu(bflo(z.z)), a1[1] * rn * g1[1] * silu(bfhi(z.z)));
      wv.w = cvtpk(a1[2] * rn * g1[2] * silu(bflo(z.w)), a1[3] * rn * g1[3] * silu(bfhi(z.w)));
      if (!dry) *(u32x4*)(zp + i * 8) = wv;
    }
  }
  __syncthreads();
#undef SLOAD
#undef SWRITE
#undef SWAIT
#undef RESC
#undef LD8
}

__device__ void attn_phase(const Params& p, int l, char* lds, bool dry = false) {
  const float lam = p.lam[l];
  const float oscale = 1.f - (0.8f - 0.6f * expf(-0.3f * (float)l));
  const float* subg = p.subln_g + l * 128;
  for (int u = blockIdx.x; u < 2048; u += gridDim.x) {
    int tok0, kv0, seq, h;
    if (u < 1024) { const int x = u & 7, j = u >> 3; const int b = x >> 2; h = x & 3; seq = S_P; kv0 = b * S_P; tok0 = kv0 + j * 128; }
    else { const int v = u - 1024, x = v & 7, j = v >> 3; const int pr = x * 4 + (j >> 5), b = pr >> 2; h = pr & 3; seq = S_S; kv0 = TP + b * S_S; tok0 = kv0 + (j & 31) * 128; }
    bool need;
    { const int tid = opaque_tid(), wid = tid >> 6, lane = tid & 63, r32 = lane & 31, hi = lane >> 5, wq = wid & 3, mp = wid >> 2;
      const int sq = tok0 < TP ? (tok0 >> 14) : 2 + ((tok0 - TP) >> 12);
      const float* km = p.kmax2 + ((l * 10 + sq) * 4 + h) * 4 + mp * 2;
      const float kmx = sqrtf(km[0] + km[1]) * 1.01f;
      const bf16_t* Qw = p.proj + (size_t)(tok0 + wq * 32 + r32) * NPROJ + C_Q + h * 128 + mp * 64 + hi * 8;
      float ss = 0.f;
#pragma unroll
      for (int d0 = 0; d0 < 4; ++d0) { const u32x4 w = *(const u32x4*)(Qw + d0 * 16);
        ss += bflo(w.x) * bflo(w.x) + bfhi(w.x) * bfhi(w.x) + bflo(w.y) * bflo(w.y) + bfhi(w.y) * bfhi(w.y) + bflo(w.z) * bflo(w.z) + bfhi(w.z) * bfhi(w.z) + bflo(w.w) * bflo(w.w) + bfhi(w.w) * bfhi(w.w); }
      ss += __shfl_xor(ss, 32);
      need = __any(!(sqrtf(ss) * kmx < 100.f)) != 0; }
    if (need) attn_unit<true>(p.proj, tok0, kv0, seq, h, lam, oscale, subg, lds, dry);
    else attn_unit<false>(p.proj, tok0, kv0, seq, h, lam, oscale, subg, lds, dry);
  }
}
}

__device__ void post_phase(const Params& p, int l) {
  const int tid = opaque_tid(), wid = tid >> 6, lane = tid & 63, nw = blockDim.x >> 6;
  const float* pg = p.post_g + l * DM;
  for (int row = blockIdx.x * nw + wid; row < T_TOK; row += gridDim.x * nw) {
    const float* yr = (const float*)(p.proj + (size_t)row * NPROJ + C_U);
    f32x4 y[4], x[4]; float ss = 0.f;
#pragma unroll
    for (int i = 0; i < 4; ++i) { y[i] = *(const f32x4*)(yr + i * 256 + lane * 4); ss += y[i][0] * y[i][0] + y[i][1] * y[i][1] + y[i][2] * y[i][2] + y[i][3] * y[i][3]; }
    bf16_t* xo = (bf16_t*)p.out + (size_t)row * LDX;
    if (l == 0) {
      const float* xr = row < TP ? p.xp + (size_t)row * DM : p.xs + (size_t)(row - TP) * DM;
#pragma unroll
      for (int i = 0; i < 4; ++i) x[i] = *(const f32x4*)(xr + i * 256 + lane * 4);
    } else {
#pragma unroll
      for (int i = 0; i < 4; ++i) {
        const u32x2 h = *(const u32x2*)(xo + i * 256 + lane * 4), lo = *(const u32x2*)(xo + DM + i * 256 + lane * 4);
        x[i][0] = bflo(h.x) + bflo(lo.x); x[i][1] = bfhi(h.x) + bfhi(lo.x); x[i][2] = bflo(h.y) + bflo(lo.y); x[i][3] = bfhi(h.y) + bfhi(lo.y);
      }
    }
    ss = wave_sum(ss);
    const float ry = __builtin_amdgcn_rsqf(ss * (1.f / DM) + 1e-6f);
    float s2 = 0.f;
#pragma unroll
    for (int i = 0; i < 4; ++i) {
      const f32x4 g = *(const f32x4*)(pg + i * 256 + lane * 4);
#pragma unroll
      for (int e = 0; e < 4; ++e) { x[i][e] = x[i][e] + y[i][e] * ry * g[e]; s2 += x[i][e] * x[i][e]; }
    }
    if (l == DEPTH - 1) {
      float* orow = p.out + (size_t)row * DM;
#pragma unroll
      for (int i = 0; i < 4; ++i) *(f32x4*)(orow + i * 256 + lane * 4) = x[i];
    } else {
      s2 = wave_sum(s2);
      if (lane == 0) p.rinv[row] = __builtin_amdgcn_rsqf(s2 * (1.f / DM) + 1e-6f);
#pragma unroll
      for (int i = 0; i < 4; ++i) {
        const unsigned h0 = cvtpk(x[i][0], x[i][1]), h1 = cvtpk(x[i][2], x[i][3]);
        const unsigned l0 = cvtpk(x[i][0] - bflo(h0), x[i][1] - bfhi(h0)), l1 = cvtpk(x[i][2] - bflo(h1), x[i][3] - bfhi(h1));
        *(u32x2*)(xo + i * 256 + lane * 4) = (u32x2){h0, h1}; *(u32x2*)(xo + DM + i * 256 + lane * 4) = (u32x2){l0, l1};
      }
    }
  }
}


#define XB_TMO      128
#define XB_XCNT(j)  (256  + 64 * (j))
#define XB_XSUB(j)  (1280 + 64 * (j))
#define XB_XGEN(j)  (2304 + 64 * (j))
#define XB_TOP      3328
#define XB_TOPGEN   3392
#define XB_SPIN_CAP (1u << 22)
#define XLAS __attribute__((address_space(3)))
__device__ __forceinline__ unsigned xb_ld(unsigned* p)              { return __hip_atomic_load(p, __ATOMIC_RELAXED, __HIP_MEMORY_SCOPE_AGENT); }
__device__ __forceinline__ unsigned xb_add(unsigned* p, unsigned v) { return __hip_atomic_fetch_add(p, v, __ATOMIC_RELAXED, __HIP_MEMORY_SCOPE_AGENT); }
__device__ __forceinline__ unsigned xb_xcc_id() { return (unsigned)__builtin_amdgcn_s_getreg((3 << 11) | 20) & 0xFu; }
#define XB_SPIN(cond, bar) do { unsigned _sp = 0; while (cond) { __builtin_amdgcn_s_sleep(1); \
    if ((++_sp & 255u) == 0u) { if (xb_ld(&(bar)[XB_TMO])) break; if (_sp > XB_SPIN_CAP) { atomicAdd(&(bar)[XB_TMO], 1u); break; } } } } while (0)
struct XcdBarrier { unsigned* bar; unsigned x; volatile XLAS unsigned* st; };
__device__ __forceinline__ XcdBarrier xcd_barrier_post(unsigned* bar, volatile XLAS unsigned* st) {
  XcdBarrier b; b.bar = bar; b.x = xb_xcc_id(); b.st = st;
  if (threadIdx.x == 0) (void)xb_add(&bar[XB_XCNT(b.x)], 1u);
  return b;
}
__device__ __forceinline__ void xcd_barrier_complete(unsigned* bar, unsigned x, unsigned& nloc, unsigned& nx) {
  const unsigned G = gridDim.x * gridDim.y * gridDim.z;
  unsigned sum, cnt, mine, sp = 0u;
  for (;;) {
    sum = 0u; cnt = 0u; mine = 0u;
#pragma unroll
    for (unsigned j = 0; j < 16; ++j) { const unsigned c = xb_ld(&bar[XB_XCNT(j)]); sum += c; cnt += (c > 0u) ? 1u : 0u; mine = (j == x) ? c : mine; }
    if (sum == G) break;
    __builtin_amdgcn_s_sleep(1);
    if ((++sp & 255u) == 0u) { if (xb_ld(&bar[XB_TMO])) break; if (sp > XB_SPIN_CAP) { atomicAdd(&bar[XB_TMO], 1u); break; } }
  }
  nloc = mine > 0u ? mine : 1u; nx = cnt > 0u ? cnt : 1u;
}
__device__ __forceinline__ void xcd_barrier(const XcdBarrier& b) {
  asm volatile("s_waitcnt vmcnt(0)" ::: "memory");
  __syncthreads();
  if (threadIdx.x == 0) {
    unsigned* bar = b.bar;
    __builtin_amdgcn_s_waitcnt(0);
    unsigned nloc = b.st[0], nx = b.st[1];
    if (nloc == 0u) { xcd_barrier_complete(bar, b.x, nloc, nx); b.st[0] = nloc; b.st[1] = nx; }
    const unsigned old = xb_add(&bar[XB_XSUB(b.x)], 1u);
    const unsigned gen = old / nloc;
    if (old + 1u == (gen + 1u) * nloc) {
      __builtin_amdgcn_fence(__ATOMIC_RELEASE, "agent");
      asm volatile("s_waitcnt vmcnt(0)" ::: "memory");
      const unsigned og = xb_add(&bar[XB_TOP], 1u);
      const unsigned tg = og / nx;
      if (og + 1u == (tg + 1u) * nx) xb_add(&bar[XB_TOPGEN], 1u);
      else XB_SPIN(xb_ld(&bar[XB_TOPGEN]) == tg, bar);
      __builtin_amdgcn_fence(__ATOMIC_ACQUIRE, "agent");
      xb_add(&bar[XB_XGEN(b.x)], 1u);
      asm volatile("s_waitcnt vmcnt(0)" ::: "memory");
    } else {
      XB_SPIN(xb_ld(&bar[XB_XGEN(b.x)]) == gen, bar);
      __builtin_amdgcn_fence(__ATOMIC_ACQUIRE, "agent");
      asm volatile("s_waitcnt vmcnt(0)" ::: "memory");
    }
  }
  __syncthreads();
}

__device__ __forceinline__ void run_phase(const Params& p, int ph, char* shm) {
  if (ph == 0) { phase0(p, shm); return; }
  const int l = (ph - 1) >> 2, s = (ph - 1) & 3;
  if (s == 0) { gm::EpiIn e{p.rinv, p.rope, p.proj, p.kmax2 + l * 160}; gm::gemm_phase(( const bf16_t*)p.out, LDX, p.WinT + (size_t)l * NPROJ * DM, NPROJ, e, shm); }
  else if (s == 1) { pool_phase(p, l); at::attn_phase(p, l, shm); }
  else if (s == 2) { gm::EpiOut e{p.proj}; gm::gemm_phase(p.proj, NPROJ, p.WoutT + (size_t)l * DM * DM, DM, e, shm); }
  else post_phase(p, l);
}

#if MK_MULTI
template <int S> __global__ void __launch_bounds__(NT_THREADS, 1) k_phase(Params p, int l) {
  extern __shared__ __attribute__((aligned(16))) char shm[];
  if (S == 0) phase0(p, shm); else run_phase(p, 1 + 4 * l + (S - 1), shm);
}
#else
__global__ void __launch_bounds__(NT_THREADS, 1) k_mega(Params p) {
  extern __shared__ __attribute__((aligned(16))) char shm[];
  cg::grid_group grid = cg::this_grid();
  volatile XLAS unsigned* xst = (volatile XLAS unsigned*)(XLAS char*)(shm + 131072 + 3072);
  if (threadIdx.x == 0) { xst[0] = 0u; xst[1] = 0u; xst[2] = 0u; xst[3] = 0u; }
  phase0(p, shm);
  grid.sync();
  const XcdBarrier xb = xcd_barrier_post(p.bar, xst);
#define GSYNC() xcd_barrier(xb)
  for (int l = 0; l < DEPTH; ++l) {
#if REP_GEMM
    { gm::EpiIn e{p.rinv, p.rope, p.proj, p.kmax2 + l * 160}; gm::gemm_phase((const bf16_t*)p.out, LDX, p.WinT + (size_t)l * NPROJ * DM, NPROJ, e, shm); }
    GSYNC();
#endif
    { gm::EpiIn e{p.rinv, p.rope, p.proj, p.kmax2 + l * 160}; gm::gemm_phase((const bf16_t*)p.out, LDX, p.WinT + (size_t)l * NPROJ * DM, NPROJ, e, shm); }
    GSYNC();
    pool_phase(p, l);
#if REP_ATT
    at::attn_phase(p, l, shm, true); GSYNC();
#endif
    at::attn_phase(p, l, shm);
    GSYNC();
#if REP_GEMM
    { gm::EpiOut e{p.proj}; gm::gemm_phase(p.proj, NPROJ, p.WoutT + (size_t)l * DM * DM, DM, e, shm); }
    GSYNC();
#endif
    { gm::EpiOut e{p.proj}; gm::gemm_phase(p.proj, NPROJ, p.WoutT + (size_t)l * DM * DM, DM, e, shm); }
    GSYNC();
#if REP_POST
    if (l == 0) { post_phase(p, l); GSYNC(); }
#endif
    post_phase(p, l);
    if (l + 1 < DEPTH) GSYNC();
  }
}
#endif

extern "C" void kernel_launch(void* const* d_in, const int* in_sizes, int n_in, void* d_out, int out_size, void* d_ws, size_t ws_size, hipStream_t stream) {
  Params p{};
  p.xp = (const float*)d_in[0]; p.xs = (const float*)d_in[1]; p.pre_g = (const float*)d_in[2]; p.w_in = (const float*)d_in[3];
  p.pool_w = (const float*)d_in[4]; p.pool_scale = (const float*)d_in[5]; p.lq1 = (const float*)d_in[6]; p.lk1 = (const float*)d_in[7];
  p.lq2 = (const float*)d_in[8]; p.lk2 = (const float*)d_in[9]; p.subln_g = (const float*)d_in[10]; p.w_out = (const float*)d_in[11]; p.post_g = (const float*)d_in[12];
  p.out = (float*)d_out;
  char* w = (char*)d_ws; size_t off = 0;
  p.proj = (bf16_t*)(w + off); off += (size_t)T_TOK * NPROJ * 2;
  p.WinT = (bf16_t*)(w + off); off += (size_t)DEPTH * NPROJ * DM * 2;
  p.WoutT = (bf16_t*)(w + off); off += (size_t)DEPTH * DM * DM * 2;
  p.rinv = (float*)(w + off); off += (size_t)T_TOK * 4;
  p.rope = (float*)(w + off); off += 256;
  p.lam = (float*)(w + off); off += 256;
  p.kmax2 = (float*)(w + off); off += 2048;
  p.bar = (unsigned*)(w + off); off += 16384;
  if (off > ws_size) { fprintf(stderr, "kernel_launch: workspace too small (%zu > %zu)\n", off, ws_size); return; }
#if MK_MULTI
  static int ok = 0;
  if (!ok) {
    (void)hipFuncSetAttribute((const void*)k_phase<0>, hipFuncAttributeMaxDynamicSharedMemorySize, (int)SHM_BYTES);
    (void)hipFuncSetAttribute((const void*)k_phase<1>, hipFuncAttributeMaxDynamicSharedMemorySize, (int)SHM_BYTES);
    (void)hipFuncSetAttribute((const void*)k_phase<2>, hipFuncAttributeMaxDynamicSharedMemorySize, (int)SHM_BYTES);
    (void)hipFuncSetAttribute((const void*)k_phase<3>, hipFuncAttributeMaxDynamicSharedMemorySize, (int)SHM_BYTES);
    (void)hipFuncSetAttribute((const void*)k_phase<4>, hipFuncAttributeMaxDynamicSharedMemorySize, (int)SHM_BYTES);
    ok = 1; }
  hipLaunchKernelGGL(k_phase<0>, dim3(256), dim3(NT_THREADS), SHM_BYTES, stream, p, 0);
  for (int l = 0; l < DEPTH; ++l) {
    hipLaunchKernelGGL(k_phase<1>, dim3(256), dim3(NT_THREADS), SHM_BYTES, stream, p, l);
    hipLaunchKernelGGL(k_phase<2>, dim3(256), dim3(NT_THREADS), SHM_BYTES, stream, p, l);
    hipLaunchKernelGGL(k_phase<3>, dim3(256), dim3(NT_THREADS), SHM_BYTES, stream, p, l);
    hipLaunchKernelGGL(k_phase<4>, dim3(256), dim3(NT_THREADS), SHM_BYTES, stream, p, l);
  }
#else
  static int grid_blocks = 0;
  if (!grid_blocks) {
    (void)hipFuncSetAttribute((const void*)k_mega, hipFuncAttributeMaxDynamicSharedMemorySize, (int)SHM_BYTES);
    int dev = 0, cus = 0, per_cu = 0;
    (void)hipGetDevice(&dev);
    (void)hipDeviceGetAttribute(&cus, hipDeviceAttributeMultiprocessorCount, dev);
    (void)hipOccupancyMaxActiveBlocksPerMultiprocessor(&per_cu, k_mega, NT_THREADS, SHM_BYTES);
    if (per_cu > 1) per_cu = 1;
    grid_blocks = cus * per_cu;
  }
  void* args[] = {&p};
  hipError_t e = hipLaunchCooperativeKernel((void*)k_mega, dim3(grid_blocks), dim3(NT_THREADS), args, SHM_BYTES, stream);
  if (e != hipSuccess) fprintf(stderr, "cooperative launch failed: %s (grid %d)\n", hipGetErrorString(e), grid_blocks);
#endif
}
```

```cpp
#include <hip/hip_runtime.h>
#include <hip/hip_cooperative_groups.h>
#include <cstdio>
#include <cstdint>
namespace cg = cooperative_groups;

#ifndef REP_ATT
#define REP_ATT 0
#endif
#ifndef STAGGER_MAP
#define STAGGER_MAP 1
#endif
#ifndef REP_POST
#define REP_POST 0
#endif
#ifndef REP_GEMM
#define REP_GEMM 0
#endif
#ifndef MK_MULTI
#define MK_MULTI 0
#endif

typedef unsigned short bf16_t;
using bf16x8 = __attribute__((ext_vector_type(8))) short;
using s16x4  = __attribute__((ext_vector_type(4))) short;
using f32x16 = __attribute__((ext_vector_type(16))) float;
using f32x4  = __attribute__((ext_vector_type(4))) float;
using u32x4  = __attribute__((ext_vector_type(4))) unsigned;
using u32x2  = __attribute__((ext_vector_type(2))) unsigned;

#define XCD_BAR_WORDS 3456
constexpr int NT_THREADS = 512;
constexpr int T_TOK = 65536, TP = 32768, DM = 1024, NPROJ = 3072, DEPTH = 2;
constexpr int S_P = 16384, S_S = 4096;
constexpr int C_ZP = 0, C_ZA = 512, C_U = 1024, C_Q = 1536, C_K = 2048, C_V = 2560;
constexpr int LDX = 2048;
constexpr float QSCALE = 0.125f * 1.4426950408889634f;
constexpr size_t SHM_BYTES = 131072 + 4096;

struct Params {
  const float* xp; const float* xs; const float* pre_g; const float* w_in; const float* pool_w; const float* pool_scale;
  const float* lq1; const float* lk1; const float* lq2; const float* lk2; const float* subln_g; const float* w_out; const float* post_g;
  float* out; bf16_t* WinT; bf16_t* WoutT; bf16_t* proj; float* rinv; float* rope; float* lam; float* kmax2; unsigned* bar;
};

#define SBAR() __builtin_amdgcn_sched_barrier(0)
__device__ __forceinline__ unsigned cvtpk(float lo, float hi) {
  unsigned r; asm volatile("v_cvt_pk_bf16_f32 %0, %1, %2" : "=v"(r) : "v"(lo), "v"(hi)); return r;
}
__device__ __forceinline__ float bf2f(unsigned short b) { return __uint_as_float(((unsigned)b) << 16); }
__device__ __forceinline__ float bflo(unsigned w) { return __uint_as_float(w << 16); }
__device__ __forceinline__ float bfhi(unsigned w) { return __uint_as_float(w & 0xffff0000u); }
__device__ __forceinline__ bf16_t f2bf(float f) { return (bf16_t)(cvtpk(f, 0.f) & 0xffffu); }
__host__ __device__ __forceinline__ int perm32(int rho) { const int n = rho >> 4, i = rho & 15; return 8 * (i >> 2) + 4 * n + (i & 3); }
__device__ __forceinline__ float silu(float z) { return z * __builtin_amdgcn_rcpf(1.f + __builtin_amdgcn_exp2f(-1.4426950408889634f * z)); }
__device__ __forceinline__ int opaque_tid() { int t = threadIdx.x; asm volatile("" : "+v"(t)); return t; }
__device__ __forceinline__ float wave_sum(float v) {
#pragma unroll
  for (int o = 32; o >= 1; o >>= 1) v += __shfl_xor(v, o);
  return v;
}

__device__ __forceinline__ int src_col_in(int s) {
  const int type = s >> 9, within = s & 511;
  if (type == 0) return 512 + within;
  if (type == 1) return 2560 + within;
  if (type == 5) return 2048 + within;
  const int p = within & 63, wcl = p >> 5, fq = (p >> 3) & 3, n = (p >> 2) & 1, jj = p & 3;
  const int d = wcl * 16 + fq * 4 + jj + 32 * n;
  return (type == 3 ? 1024 : 1536) + (within & ~63) + d;
}

__device__ void phase0(const Params& p, char* shm) {
  const int tid = opaque_tid(), nth = blockDim.x;
  float* tile = (float*)shm;
  float* Wt = tile + 64 * 65 + 32;
  float* Pw = Wt + 64 * 128;
  constexpr int NT_U = DEPTH * 8 * 16, NT_IN = DEPTH * 40 * 16, NT_OUT = DEPTH * 16 * 16;
  for (int it = blockIdx.x; it < NT_U + NT_IN + NT_OUT; it += gridDim.x) {
    __syncthreads();
    if (it < NT_U + NT_IN) {
      int l, n0, k0; const bool isu = it < NT_U;
      if (isu) { l = it / 128; const int r = it % 128; n0 = C_U + (r / 16) * 64; k0 = (r % 16) * 64; }
      else { const int i2 = it - NT_U; l = i2 / 640; const int r = i2 % 640; int nt = r / 16; if (nt >= 16) nt += 8; n0 = nt * 64; k0 = (r % 16) * 64; }
      const float* W = p.w_in + (size_t)l * DM * NPROJ; const float* g = p.pre_g + l * DM;
      if (isu) {
        const int gi = (n0 - C_U) >> 7, d0 = (n0 - C_U) & 127;
        for (int e = tid; e < 64 * 128; e += nth) { const int c = e & 127, kk = e >> 7; Wt[e] = W[(size_t)(k0 + kk) * NPROJ + gi * 128 + c]; }
        for (int e = tid; e < 128 * 64; e += nth) { const int d = e & 63, c = e >> 6; Pw[e] = p.pool_w[((size_t)(l * 4 + gi) * 128 + c) * 128 + d0 + d]; }
        __syncthreads();
        for (int e = tid; e < 4096; e += nth) {
          const int nn = e & 63, kk = e >> 6, nrow = n0 + nn; const int s = (nrow & ~31) + perm32(nrow & 31), dl = s - n0;
          float a = 0.f;
#pragma unroll 8
          for (int c = 0; c < 128; ++c) a = fmaf(Wt[kk * 128 + c], Pw[c * 64 + dl], a);
          tile[kk * 65 + nn] = a * g[k0 + kk];
        }
      } else {
        for (int e = tid; e < 4096; e += nth) {
          const int nn = e & 63, kk = e >> 6, k = k0 + kk, nrow = n0 + nn;
          const int s = (nrow & ~31) + perm32(nrow & 31);
          tile[kk * 65 + nn] = W[(size_t)k * NPROJ + src_col_in(s)] * g[k];
        }
      }
      __syncthreads();
      bf16_t* O = p.WinT + (size_t)l * NPROJ * DM;
      for (int e = tid; e < 4096; e += nth) { const int kk = e & 63, nn = e >> 6; O[(size_t)(n0 + nn) * DM + k0 + kk] = f2bf(tile[kk * 65 + nn]); }
    } else {
      const int it2 = it - NT_U - NT_IN, l = it2 / 256, r = it2 % 256, n0 = (r / 16) * 64, k0 = (r % 16) * 64;
      const float* W = p.w_out + (size_t)l * DM * DM;
      for (int e = tid; e < 4096; e += nth) {
        const int nn = e & 63, kk = e >> 6, nrow = n0 + nn; const int s = (nrow & ~31) + perm32(nrow & 31);
        tile[kk * 65 + nn] = W[(size_t)(k0 + kk) * DM + s];
      }
      __syncthreads();
      bf16_t* O = p.WoutT + (size_t)l * DM * DM;
      for (int e = tid; e < 4096; e += nth) { const int kk = e & 63, nn = e >> 6; O[(size_t)(n0 + nn) * DM + k0 + kk] = f2bf(tile[kk * 65 + nn]); }
    }
  }
  if (blockIdx.x == 0) {
    for (int i = tid; i < XCD_BAR_WORDS; i += nth) p.bar[i] = 0u;
    if (tid < DEPTH * 160) p.kmax2[tid] = 0.f;
    if (tid < 32) { const double c = exp(-(double)tid * (9.210340371976184 / 32.0)) * 0.15915494309189535; const float h = (float)c; p.rope[2 * tid] = h; p.rope[2 * tid + 1] = (float)(c - (double)h); }
    if (tid >= 64 && tid < 64 + 64 * DEPTH) {
      const int l = (tid >> 6) - 1, i = tid & 63;
      float a = p.lq1[l * 64 + i] * p.lk1[l * 64 + i], b = p.lq2[l * 64 + i] * p.lk2[l * 64 + i];
      a = wave_sum(a); b = wave_sum(b);
      const float li = 0.8f - 0.6f * expf(-0.3f * (float)l);
      if (i == 0) p.lam[l] = expf(a) - expf(b) + li;
    }
  }
  const int wid = tid >> 6, lane = tid & 63, nw = nth >> 6;
  for (int row = blockIdx.x * nw + wid; row < T_TOK; row += gridDim.x * nw) {
    const float* xr = row < TP ? p.xp + (size_t)row * DM : p.xs + (size_t)(row - TP) * DM;
    bf16_t* xo = (bf16_t*)p.out + (size_t)row * LDX;
    float ss = 0.f;
#pragma unroll
    for (int i = 0; i < 4; ++i) {
      const f32x4 v = *(const f32x4*)(xr + i * 256 + lane * 4);
      ss += v[0] * v[0] + v[1] * v[1] + v[2] * v[2] + v[3] * v[3];
      u32x2 w = {cvtpk(v[0], v[1]), cvtpk(v[2], v[3])};
      *(u32x2*)(xo + i * 256 + lane * 4) = w;
    }
    ss = wave_sum(ss);
    if (lane == 0) p.rinv[row] = __builtin_amdgcn_rsqf(ss * (1.f / DM) + 1e-6f);
  }
}

namespace gm {
constexpr int BM = 256, BK = 64, HALF = 128, NXCD = 8, WGM = 8, HT = HALF * BK;
__device__ __forceinline__ int lds_byte(int r, int c) { int st = (r >> 4) * 2 + (c >> 5), rr = r & 15, cc = c & 31, ob = rr * 64 + cc * 2; return st * 1024 + (ob ^ (((ob >> 9) & 1) << 5)); }
__device__ __forceinline__ void stage_rc(int b, int& R, int& C) { int st = b / 1024, sb = b % 1024, swz = sb ^ (((sb >> 9) & 1) << 5); R = (st >> 1) * 16 + swz / 64; C = (st & 1) * 32 + (swz % 64) / 2; }

#define LAS __attribute__((address_space(3)))
template <class Epi>
__device__ __forceinline__ void gemm_phase(const bf16_t* __restrict__ A, const int lda, const bf16_t* __restrict__ Bt, const int N, const Epi& E, char* shmc) {
  constexpr int K = 1024, nt = K / BK, HTB = HALF * BK * 2;
  LAS unsigned char* lds = (LAS unsigned char*)shmc;
  const int tid = opaque_tid(), wid = __builtin_amdgcn_readfirstlane(tid >> 6), lane = tid & 63, wr = wid >> 2, wc = wid & 3, fr = lane & 15, fq = lane >> 4;
  unsigned voffA[2], voffB[2];
#pragma unroll
  for (int i = 0; i < 2; ++i) { int R, C; stage_rc(tid * 16 + i * 8192, R, C); voffA[i] = (unsigned)(R * lda + C) * 2u; voffB[i] = (unsigned)(R * K + C) * 2u; }
  const size_t kstep = (size_t)(BK * 2);
  const size_t hstepA = (size_t)HALF * lda * 2, hstepB = (size_t)HALF * K * 2;
  const size_t tstepA = 2 * hstepA, tstepB = 2 * hstepB;
  const unsigned ldsw = (unsigned)wid * 1024u;
  const int aoff = lds_byte(wr * 64 + fr, fq * 8), boff = lds_byte(wc * 32 + fr, fq * 8);
#define PG8_SA(b, h) (((b) * 2 + (h)) * HTB)
#define PG8_SB(b, h) ((4 + (b) * 2 + (h)) * HTB)
#define PG8_STAGE(bufoff, gbase, voff) do { _Pragma("unroll") for (int _i = 0; _i < 2; ++_i) \
        __builtin_amdgcn_global_load_lds((const unsigned*)((const char*)(gbase) + (voff)[_i]), (LAS unsigned*)(lds + (bufoff) + ldsw + _i * 8192), 16, 0, 0); } while (0)
#define PG8_LDA(dst, b, h) do { _Pragma("unroll") for (int m = 0; m < 4; ++m) _Pragma("unroll") for (int k = 0; k < 2; ++k) dst[m][k] = *(const LAS bf16x8*)(lds + PG8_SA(b, h) + aoff + m * 2048 + k * 1024); } while (0)
#define PG8_LDB(dst, b, h) do { _Pragma("unroll") for (int n = 0; n < 2; ++n) _Pragma("unroll") for (int k = 0; k < 2; ++k) dst[n][k] = *(const LAS bf16x8*)(lds + PG8_SB(b, h) + boff + n * 2048 + k * 1024); } while (0)
#define PG8_MMA(ai, bj, At, Bx) do { __builtin_amdgcn_s_setprio(1); _Pragma("unroll") for (int m = 0; m < 4; ++m) _Pragma("unroll") for (int n = 0; n < 2; ++n) _Pragma("unroll") for (int k = 0; k < 2; ++k) \
        acc[ai][bj][m][n] = __builtin_amdgcn_mfma_f32_16x16x32_bf16(Bx[n][k], At[m][k], acc[ai][bj][m][n], 0, 0, 0); __builtin_amdgcn_s_setprio(0); } while (0)
#define PG8_WAIT_V(n) asm volatile("s_waitcnt vmcnt(" #n ")" ::: "memory")
#define PG8_WAIT_L(n) asm volatile("s_waitcnt lgkmcnt(" #n ")" ::: "memory")
#define PG8_BAR __builtin_amdgcn_s_barrier()
#define PG8_SCHED __builtin_amdgcn_sched_barrier(0)
  const int nM = T_TOK / BM, nN = N / BM, nwg = nM * nN, G = gridDim.x, cblk = blockIdx.x;
  auto next_unit = [&](int i, int& pm, int& pn) -> bool {
    const long L = (long)i * G + cblk; if (L >= nwg) return false;
    int wgid = (int)L; { const int q = nwg / NXCD, r = nwg % NXCD, xcd = wgid % NXCD, off = wgid / NXCD; wgid = (xcd < r ? xcd * (q + 1) : r * (q + 1) + (xcd - r) * q) + off; }
    const int nig = WGM * nN, gid = wgid / nig, fm = gid * WGM, gsz = (nM - fm) < WGM ? (nM - fm) : WGM;
    pm = fm + ((wgid % nig) % gsz); pn = (wgid % nig) / gsz; return true;
  };
  int cpm, cpn, npm = 0, npn = 0, ui = 0;
  if (!next_unit(0, cpm, cpn)) return;
  f32x4 acc[2][2][4][2];
#pragma unroll
  for (int a = 0; a < 2; ++a)
#pragma unroll
    for (int b = 0; b < 2; ++b)
#pragma unroll
      for (int m = 0; m < 4; ++m)
#pragma unroll
        for (int n = 0; n < 2; ++n) acc[a][b][m][n] = (f32x4){0.f, 0.f, 0.f, 0.f};
  bf16x8 At[4][2], B0[2][2], B1[2][2];
  const char* cA = (const char*)A + (size_t)cpm * tstepA; const char* cB = (const char*)Bt + (size_t)cpn * tstepB;
  PG8_STAGE(PG8_SB(0, 0), cB, voffB); PG8_STAGE(PG8_SB(0, 1), cB + hstepB, voffB); PG8_STAGE(PG8_SA(0, 0), cA, voffA); PG8_STAGE(PG8_SA(0, 1), cA + hstepA, voffA);
  if (wr == 1) PG8_BAR;
  PG8_WAIT_V(2); PG8_BAR;
  PG8_STAGE(PG8_SB(1, 0), cB + kstep, voffB); PG8_STAGE(PG8_SA(1, 0), cA + kstep, voffA); PG8_STAGE(PG8_SB(1, 1), cB + hstepB + kstep, voffB);
  PG8_WAIT_V(6); PG8_BAR;
  for (;;) {
    const bool has_next = next_unit(ui + 1, npm, npn);
    const char* nA = has_next ? (const char*)A + (size_t)npm * tstepA : cA; const char* nB = has_next ? (const char*)Bt + (size_t)npn * tstepB : cB;
    for (int t = 0; t < nt; t += 2) {
      const bool last = (t == nt - 2);
      const char* a1 = cA + (size_t)(t + 1) * kstep;
      const char* a2 = last ? nA : cA + (size_t)(t + 2) * kstep; const char* b2 = last ? nB : cB + (size_t)(t + 2) * kstep;
      const char* a3 = a2 + kstep; const char* b3 = b2 + kstep;
      PG8_LDB(B0, 0, 0); PG8_LDB(B1, 0, 1); PG8_SCHED; PG8_LDA(At, 0, 0); PG8_STAGE(PG8_SA(1, 1), a1 + hstepA, voffA);
      PG8_WAIT_V(8); PG8_WAIT_L(0); PG8_BAR; PG8_MMA(0, 0, At, B0); PG8_MMA(0, 1, At, B1); PG8_BAR; PG8_SCHED;
      PG8_LDA(At, 0, 1); PG8_STAGE(PG8_SB(0, 0), b2, voffB); PG8_STAGE(PG8_SB(0, 1), b2 + hstepB, voffB); PG8_STAGE(PG8_SA(0, 0), a2, voffA);
      PG8_WAIT_V(8); PG8_WAIT_L(0); PG8_BAR; PG8_MMA(1, 0, At, B0); PG8_MMA(1, 1, At, B1); PG8_BAR; PG8_SCHED;
      PG8_LDB(B0, 1, 0); PG8_LDB(B1, 1, 1); PG8_SCHED; PG8_LDA(At, 1, 0); PG8_STAGE(PG8_SA(0, 1), a2 + hstepA, voffA);
      PG8_WAIT_V(8); PG8_WAIT_L(0); PG8_BAR; PG8_MMA(0, 0, At, B0); PG8_MMA(0, 1, At, B1); PG8_BAR; PG8_SCHED;
      PG8_LDA(At, 1, 1); PG8_STAGE(PG8_SB(1, 0), b3, voffB); PG8_STAGE(PG8_SB(1, 1), b3 + hstepB, voffB); PG8_STAGE(PG8_SA(1, 0), a3, voffA);
      PG8_WAIT_V(8); PG8_WAIT_L(0); PG8_BAR; PG8_MMA(1, 0, At, B0); PG8_MMA(1, 1, At, B1); PG8_BAR; PG8_SCHED;
    }
    if (wr == 0) PG8_BAR;
    E(acc, cpm, cpn, wr, wc, fr, fq);
    if (!has_next) break;
#pragma unroll
    for (int a = 0; a < 2; ++a)
#pragma unroll
      for (int b = 0; b < 2; ++b)
#pragma unroll
        for (int m = 0; m < 4; ++m)
#pragma unroll
          for (int n = 0; n < 2; ++n) acc[a][b][m][n] = (f32x4){0.f, 0.f, 0.f, 0.f};
    cpm = npm; cpn = npn; cA = nA; cB = nB; ++ui;
    if (wr == 1) PG8_BAR;
  }
  PG8_WAIT_V(0);
  PG8_BAR;
#undef PG8_SA
#undef PG8_SB
#undef PG8_STAGE
#undef PG8_LDA
#undef PG8_LDB
#undef PG8_MMA
}

struct EpiIn {
  const float* rinv; const float* rope; bf16_t* proj; float* kmax2;
  __device__ __forceinline__ void operator()(const f32x4 (&acc)[2][2][4][2], int pm, int pn, int wr, int wc, int fr, int fq) const {
    const bool isrope = (pn >= 6 && pn <= 9); const float qs = (pn == 6 || pn == 7) ? QSCALE : 1.f;
    const bool isk = (pn == 8 || pn == 9);
    float kmx[2] = {0.f, 0.f};
    float ch[4], cl[4];
    if (isrope) {
#pragma unroll
      for (int jj = 0; jj < 4; ++jj) { const int i = (wc & 1) * 16 + fq * 4 + jj; ch[jj] = rope[2 * i]; cl[jj] = rope[2 * i + 1]; }
    }
#pragma unroll
    for (int ai = 0; ai < 2; ++ai)
#pragma unroll
      for (int m = 0; m < 4; ++m) {
        const int row = pm * BM + ai * HALF + wr * 64 + m * 16 + fr;
        const float ri = rinv[row];
        float cs[4], sn[4];
        if (isrope) {
          const float pos = (float)(row < TP ? (row & (S_P - 1)) : (row & (S_S - 1)));
#pragma unroll
          for (int jj = 0; jj < 4; ++jj) {
            const float h = pos * ch[jj], e = fmaf(pos, ch[jj], -h) + pos * cl[jj];
            const float rev = (h - floorf(h)) + e;
            sn[jj] = __builtin_amdgcn_sinf(rev); cs[jj] = __builtin_amdgcn_cosf(rev);
          }
        }
        bf16_t* rowp = proj + (size_t)row * NPROJ + pn * BM + wc * 32 + 8 * fq;
#pragma unroll
        for (int bj = 0; bj < 2; ++bj) {
          f32x4 v0 = acc[ai][bj][m][0] * ri, v1 = acc[ai][bj][m][1] * ri;
          if (isrope) {
#pragma unroll
            for (int jj = 0; jj < 4; ++jj) { const float a = v0[jj], b = v1[jj]; v0[jj] = (a * cs[jj] - b * sn[jj]) * qs; v1[jj] = (b * cs[jj] + a * sn[jj]) * qs; }
          }
          u32x4 w; w.x = cvtpk(v0[0], v0[1]); w.y = cvtpk(v0[2], v0[3]); w.z = cvtpk(v1[0], v1[1]); w.w = cvtpk(v1[2], v1[3]);
          *(u32x4*)(rowp + bj * HALF) = w;
          if (isk) { float ss = v0[0] * v0[0] + v0[1] * v0[1] + v0[2] * v0[2] + v0[3] * v0[3] + v1[0] * v1[0] + v1[1] * v1[1] + v1[2] * v1[2] + v1[3] * v1[3];
            ss += __shfl_xor(ss, 16); ss += __shfl_xor(ss, 32); kmx[bj] = fmaxf(kmx[bj], ss); }
        }
      }
    if (isk) {
      const int row0 = pm * BM, sq = row0 < TP ? (row0 >> 14) : 2 + ((row0 - TP) >> 12);
#pragma unroll
      for (int bj = 0; bj < 2; ++bj) { float v = kmx[bj];
        v = fmaxf(v, __shfl_xor(v, 1)); v = fmaxf(v, __shfl_xor(v, 2)); v = fmaxf(v, __shfl_xor(v, 4)); v = fmaxf(v, __shfl_xor(v, 8));
        if ((fr | fq) == 0) atomicMax((unsigned*)(kmax2 + (sq * 4 + (pn - 8) * 2 + bj) * 4 + wc), __float_as_uint(v)); }
    }
  }
};
struct EpiOut {
  bf16_t* proj;
  __device__ __forceinline__ void operator()(const f32x4 (&acc)[2][2][4][2], int pm, int pn, int wr, int wc, int fr, int fq) const {
#pragma unroll
    for (int ai = 0; ai < 2; ++ai)
#pragma unroll
      for (int m = 0; m < 4; ++m) {
        const int row = pm * BM + ai * HALF + wr * 64 + m * 16 + fr;
        float* rowp = (float*)(proj + (size_t)row * NPROJ + C_U) + pn * BM + wc * 32 + 8 * fq;
#pragma unroll
        for (int bj = 0; bj < 2; ++bj) { *(f32x4*)(rowp + bj * HALF) = acc[ai][bj][m][0]; *(f32x4*)(rowp + bj * HALF + 4) = acc[ai][bj][m][1]; }
      }
  }
};
}

__device__ __forceinline__ void bf8_to_f(const u32x4 w, float* v) {
  v[0] = bflo(w.x); v[1] = bfhi(w.x); v[2] = bflo(w.y); v[3] = bfhi(w.y); v[4] = bflo(w.z); v[5] = bfhi(w.z); v[6] = bflo(w.w); v[7] = bfhi(w.w);
}
__device__ void pool_phase(const Params& p, int l, bool dry = false) {
  const int tid = opaque_tid(), c8 = tid & 63, tq = tid >> 6;
  const int g = c8 >> 4, hw = 1 << g;
  const float* sc = p.pool_scale + l * 512 + c8 * 8;
  float scl[8];
#pragma unroll
  for (int e = 0; e < 8; ++e) scl[e] = sc[e];
  for (int ch = blockIdx.x; ch < T_TOK / 128; ch += gridDim.x) {
    const int t0 = ch * 128 + tq * 16;
    const int S = t0 < TP ? S_P : S_S, pos0 = t0 & (S - 1), s0 = t0 - pos0;
    const bf16_t* ub = p.proj + (size_t)s0 * NPROJ + C_U + c8 * 8;
    float sum[8] = {0, 0, 0, 0, 0, 0, 0, 0};
#pragma unroll
    for (int j = 0; j < 16; ++j) {
      const int r = pos0 - hw + j; const bool ok = (j < 2 * hw) && r >= 0 && r < S; const int rc = min(max(r, 0), S - 1);
      float v[8]; bf8_to_f(*(const u32x4*)(ub + (size_t)rc * NPROJ), v); const float m = ok ? 1.f : 0.f;
#pragma unroll
      for (int e = 0; e < 8; ++e) sum[e] = fmaf(m, v[e], sum[e]);
    }
#pragma unroll
    for (int i4 = 0; i4 < 16; i4 += 4) {
      u32x4 wu[4], wz[4], wa[4], wsb[4];
#pragma unroll
      for (int q = 0; q < 4; ++q) {
        const int pos = pos0 + i4 + q, ra = pos + hw, rs = pos - hw;
        wu[q] = *(const u32x4*)(ub + (size_t)pos * NPROJ);
        wz[q] = *(const u32x4*)(p.proj + (size_t)(t0 + i4 + q) * NPROJ + C_ZP + c8 * 8);
        wa[q] = *(const u32x4*)(ub + (size_t)min(ra, S - 1) * NPROJ); wsb[q] = *(const u32x4*)(ub + (size_t)max(rs, 0) * NPROJ);
      }
#pragma unroll
      for (int q = 0; q < 4; ++q) {
        const int pos = pos0 + i4 + q, t = t0 + i4 + q;
        const int lo = max(pos - hw, 0), hi = min(pos + hw, S);
        const float inv = 1.f / (float)(hi - lo);
        float uc[8], z[8], va[8], vs[8], o[8];
        bf8_to_f(wu[q], uc); bf8_to_f(wz[q], z);
#pragma unroll
        for (int e = 0; e < 8; ++e) o[e] = (sum[e] * inv - uc[e]) * scl[e] * silu(z[e]);
        const u32x4 w = {cvtpk(o[0], o[1]), cvtpk(o[2], o[3]), cvtpk(o[4], o[5]), cvtpk(o[6], o[7])};
        if (!dry) *(u32x4*)(p.proj + (size_t)t * NPROJ + C_ZP + c8 * 8) = w;
        const int ra = pos + hw, rs = pos - hw; const float ma = ra < S ? 1.f : 0.f, ms = rs >= 0 ? 1.f : 0.f;
        bf8_to_f(wa[q], va); bf8_to_f(wsb[q], vs);
#pragma unroll
        for (int e = 0; e < 8; ++e) sum[e] = fmaf(ma, va[e], fmaf(-ms, vs[e], sum[e]));
      }
    }
  }
}

namespace at {
constexpr int KVBLK = 64, LDK = NPROJ;
constexpr size_t SHM_V = KVBLK * 128 * 2, SHM_K = KVBLK * 128 * 2;
constexpr float THRL = 11.5f;
#define KSWZ(row, colB) ((row) * 256 + ((colB) ^ (((row) & 7) << 4)))
__device__ __forceinline__ int crow(int r, int hi) { return (r & 3) + 8 * (r >> 2) + 4 * hi; }
template <bool SH> __device__ __forceinline__ void partialSM(f32x16& p0, f32x16& p1, float& m_reg, float& mn, float& alpha) {
  if constexpr (!SH) {
    alpha = 1.f;
#pragma unroll
    for (int r = 0; r < 16; ++r) { p0[r] = __builtin_amdgcn_exp2f(p0[r]); p1[r] = __builtin_amdgcn_exp2f(p1[r]); }
    return;
  }
  float pmax = p0[0];
#pragma unroll
  for (int r = 1; r < 16; ++r) pmax = fmaxf(pmax, p0[r]);
#pragma unroll
  for (int r = 0; r < 16; ++r) pmax = fmaxf(pmax, p1[r]);
  { auto rr = __builtin_amdgcn_permlane32_swap(__float_as_uint(pmax), __float_as_uint(pmax), false, false);
    pmax = fmaxf(__uint_as_float(rr[0]), __uint_as_float(rr[1])); }
  if (__builtin_expect(__all(pmax - m_reg <= THRL), 1)) { mn = m_reg; alpha = 1.f; }
  else { mn = fmaxf(m_reg, pmax); alpha = __builtin_amdgcn_exp2f(m_reg - mn); m_reg = mn; }
#pragma unroll
  for (int r = 0; r < 16; ++r) p0[r] = p0[r] - mn;
#pragma unroll
  for (int r = 0; r < 16; ++r) p1[r] = p1[r] - mn;
#pragma unroll
  for (int r = 0; r < 16; ++r) { p0[r] = __builtin_amdgcn_exp2f(p0[r]); p1[r] = __builtin_amdgcn_exp2f(p1[r]); }
}
template <bool SH> __device__ __forceinline__ void finishSM(f32x16& p0, f32x16& p1, float alpha, float& l_reg, bf16x8& pa0, bf16x8& pa1, bf16x8& pa2, bf16x8& pa3) {
  float ps = 0;
#pragma unroll
  for (int r = 0; r < 16; ++r) ps += p0[r];
#pragma unroll
  for (int r = 0; r < 16; ++r) ps += p1[r];
  { auto rr = __builtin_amdgcn_permlane32_swap(__float_as_uint(ps), __float_as_uint(ps), false, false);
    ps = __uint_as_float(rr[0]) + __uint_as_float(rr[1]); }
  if constexpr (SH) l_reg = l_reg * alpha + ps; else l_reg += ps;
#define PK4(P, BASE, OUT) do { unsigned a0 = cvtpk(P[BASE + 0], P[BASE + 1]), a1 = cvtpk(P[BASE + 2], P[BASE + 3]);   \
    unsigned b0 = cvtpk(P[BASE + 4], P[BASE + 5]), b1 = cvtpk(P[BASE + 6], P[BASE + 7]);                              \
    auto r0 = __builtin_amdgcn_permlane32_swap(a0, b0, false, false); auto r1 = __builtin_amdgcn_permlane32_swap(a1, b1, false, false); \
    u32x4 w = {r0[0], r1[0], r0[1], r1[1]}; OUT = *reinterpret_cast<bf16x8*>(&w); } while (0)
  PK4(p0, 0, pa0); PK4(p0, 8, pa1); PK4(p1, 0, pa2); PK4(p1, 8, pa3);
#undef PK4
}
__device__ __forceinline__ void qkt(f32x16& p0, f32x16& p1, const char* Ks, const bf16x8* qr, int r32, int hi, int mapB) {
  p0 = f32x16{}; p1 = f32x16{};
#pragma unroll
  for (int d0 = 0; d0 < 4; ++d0) { const int cb = (d0 * 16 + hi * 8) * 2 + mapB;
    bf16x8 b0 = *reinterpret_cast<const bf16x8*>(Ks + KSWZ(r32, cb));
    bf16x8 b1 = *reinterpret_cast<const bf16x8*>(Ks + KSWZ(32 + r32, cb));
    p0 = __builtin_amdgcn_mfma_f32_32x32x16_bf16(b0, qr[d0], p0, 0, 0, 0);
    p1 = __builtin_amdgcn_mfma_f32_32x32x16_bf16(b1, qr[d0], p1, 0, 0, 0); }
}
__device__ __forceinline__ int v_st(int k, int c) { const int kk = (k & ~0xC) | ((k & 4) << 1) | ((k & 8) >> 1); return ((kk >> 3) * 4 + (c >> 5)) * 512 + ((kk & 7) * 32 + (c & 31)) * 2; }
__device__ __forceinline__ int v_rd_base(int lane) { return ((lane & 3) << 3) | (((lane >> 2) & 3) << 6) | (((lane >> 4) & 1) << 5) | (((lane >> 5) & 1) << 8); }
constexpr int v_rd_off(int d0, int ks, int half) { return d0 * 512 + ks * 4096 + half * 2048; }
template <int OFF> __device__ __forceinline__ s16x4 tr_read(int vb) {
  s16x4 r; asm volatile("ds_read_b64_tr_b16 %0, %1 offset:%2" : "=&v"(r) : "v"(vb), "i"(OFF) : "memory"); return r;
}
template <int D0> __device__ __forceinline__ void pv_one(f32x16& od, int vb, bf16x8 pa0, bf16x8 pa1, bf16x8 pa2, bf16x8 pa3) {
  const s16x4 l0 = tr_read<v_rd_off(D0, 0, 0)>(vb), h0 = tr_read<v_rd_off(D0, 0, 1)>(vb), l1 = tr_read<v_rd_off(D0, 1, 0)>(vb), h1 = tr_read<v_rd_off(D0, 1, 1)>(vb);
  const s16x4 l2 = tr_read<v_rd_off(D0, 2, 0)>(vb), h2 = tr_read<v_rd_off(D0, 2, 1)>(vb), l3 = tr_read<v_rd_off(D0, 3, 0)>(vb), h3 = tr_read<v_rd_off(D0, 3, 1)>(vb);
  asm volatile("s_waitcnt lgkmcnt(0)" ::: "memory"); SBAR();
#define PK(L, H) (bf16x8){L[0], L[1], L[2], L[3], H[0], H[1], H[2], H[3]}
  od = __builtin_amdgcn_mfma_f32_32x32x16_bf16(pa0, PK(l0, h0), od, 0, 0, 0);
  od = __builtin_amdgcn_mfma_f32_32x32x16_bf16(pa1, PK(l1, h1), od, 0, 0, 0);
  od = __builtin_amdgcn_mfma_f32_32x32x16_bf16(pa2, PK(l2, h2), od, 0, 0, 0);
  od = __builtin_amdgcn_mfma_f32_32x32x16_bf16(pa3, PK(l3, h3), od, 0, 0, 0);
#undef PK
}
__device__ __forceinline__ void pv_d0(f32x16* o, int vb, bf16x8 pa0, bf16x8 pa1, bf16x8 pa2, bf16x8 pa3) {
  pv_one<0>(o[0], vb, pa0, pa1, pa2, pa3); pv_one<1>(o[1], vb, pa0, pa1, pa2, pa3); pv_one<2>(o[2], vb, pa0, pa1, pa2, pa3); pv_one<3>(o[3], vb, pa0, pa1, pa2, pa3);
}

template <bool SH> __device__ __forceinline__ void attn_unit(bf16_t* __restrict__ proj, int tok0, int kv0, int seq, int h, float lam, float oscale, const float* __restrict__ subg, char* lds, bool dry) {
  const int tid = opaque_tid(), wid = __builtin_amdgcn_readfirstlane(tid >> 6), lane = tid & 63, r32 = lane & 31, hi = lane >> 5;
  const int wq = wid & 3, mp = wid >> 2, mapB = mp * 128;
  constexpr int RING = 32768, NRING = 4;
  LAS char* ldsl = (LAS char*)lds;
  float* ws = (float*)(lds + NRING * RING) + wid * 64; float* li_l = ws; float* al_l = ws + 32;
  const bf16_t* Kh = proj + (size_t)kv0 * NPROJ + C_K + h * 128;
  const bf16_t* Vh = proj + (size_t)kv0 * NPROJ + C_V + h * 128;
  float m_reg = -1e30f, l_reg = 0; f32x16 o[4] = {}; bf16x8 qr[4];
  const bf16_t* Qw = proj + (size_t)(tok0 + wq * 32 + r32) * NPROJ + C_Q + h * 128 + mp * 64 + hi * 8;
#pragma unroll
  for (int d0 = 0; d0 < 4; ++d0) qr[d0] = *reinterpret_cast<const bf16x8*>(Qw + d0 * 16);
  int offK[2], offV[2];
#pragma unroll
  for (int i = 0; i < 2; ++i) {
    const int c = i * 512 + tid;
    { const int row = c >> 4, pc = c & 15, scn = pc ^ (row & 7); offK[i] = row * LDK + scn * 8; }
    { const int sub = c >> 5, kk = (sub >> 2) * 8 + ((c >> 2) & 7), col = (sub & 3) * 32 + (c & 3) * 8;
      const int k = (kk & ~0xC) | ((kk & 4) << 1) | ((kk & 8) >> 1); offV[i] = k * LDK + col; }
  }
  const int vbb = (int)(uintptr_t)ldsl + 16384 + v_rd_base(lane);
#define GLDS16(src, dst) __builtin_amdgcn_global_load_lds((const unsigned*)(src), (LAS unsigned*)(dst), 16, 0, 0)
#define DMA(t, b) do { const bf16_t* kg_ = Kh + (size_t)(t) * (KVBLK * LDK); const bf16_t* vg_ = Vh + (size_t)(t) * (KVBLK * LDK); LAS char* d_ = ldsl + (b) * RING + wid * 1024; \
    GLDS16(kg_ + offK[0], d_); GLDS16(kg_ + offK[1], d_ + 8192); GLDS16(vg_ + offV[0], d_ + 16384); GLDS16(vg_ + offV[1], d_ + 16384 + 8192); } while (0)
#define KBUF(b) ((const char*)lds + (b) * RING)
#define VBUF(b) (vbb + (b) * RING)
#define LANDED() do { asm volatile("s_waitcnt vmcnt(0)" ::: "memory"); __syncthreads(); } while (0)
#define RESC(a) do { if (SH && __any((a) < 1.f)) { if (hi == 0) al_l[r32] = (a); asm volatile("s_waitcnt lgkmcnt(0)" ::: "memory"); \
    _Pragma("unroll") for (int d = 0; d < 4; ++d) _Pragma("unroll") for (int r = 0; r < 16; ++r) o[d][r] *= al_l[crow(r, hi)]; } } while (0)
  f32x16 pA0, pA1, pB0, pB1; float mnA, mnB, alA, alB; bf16x8 pa0, pa1, pa2, pa3; const int NT = seq / KVBLK;
#define BLK_X(N0, N1, P0, P1, alP, t) do { SBAR(); qkt(N0, N1, KBUF((t) & 3), qr, r32, hi, mapB); finishSM<SH>(P0, P1, alP, l_reg, pa0, pa1, pa2, pa3); SBAR(); } while (0)
#define BLK_Y(C0, C1, mnC, alC, t) do { pv_d0(o, VBUF((t) & 3), pa0, pa1, pa2, pa3); partialSM<SH>(C0, C1, m_reg, mnC, alC); RESC(alC); } while (0)
  const int ty = STAGGER_MAP ? mp : (wid & 1);
  DMA(0, 0); LANDED();
  DMA(1, 1);
  if (ty == 0) {
    qkt(pA0, pA1, KBUF(0), qr, r32, hi, mapB); partialSM<SH>(pA0, pA1, m_reg, mnA, alA);
    LANDED();
    for (int j = 1; j + 1 < NT; j += 2) {
      DMA(j + 1, (j + 1) & 3); BLK_X(pB0, pB1, pA0, pA1, alA, j); BLK_Y(pB0, pB1, mnB, alB, j - 1); LANDED();
      DMA(j + 2, (j + 2) & 3); BLK_X(pA0, pA1, pB0, pB1, alB, j + 1); BLK_Y(pA0, pA1, mnA, alA, j); LANDED();
    }
    BLK_X(pB0, pB1, pA0, pA1, alA, NT - 1); BLK_Y(pB0, pB1, mnB, alB, NT - 2);
    finishSM<SH>(pB0, pB1, alB, l_reg, pa0, pa1, pa2, pa3); SBAR();
    pv_d0(o, VBUF((NT - 1) & 3), pa0, pa1, pa2, pa3);
  } else {
    qkt(pA0, pA1, KBUF(0), qr, r32, hi, mapB);
    LANDED();
    DMA(2, 2); partialSM<SH>(pA0, pA1, m_reg, mnA, alA); BLK_X(pB0, pB1, pA0, pA1, alA, 1); LANDED();
    for (int j = 2; j + 2 < NT; j += 2) {
      DMA(j + 1, (j + 1) & 3); BLK_Y(pB0, pB1, mnB, alB, j - 2); BLK_X(pA0, pA1, pB0, pB1, alB, j); LANDED();
      DMA(j + 2, (j + 2) & 3); BLK_Y(pA0, pA1, mnA, alA, j - 1); BLK_X(pB0, pB1, pA0, pA1, alA, j + 1); LANDED();
    }
    DMA(NT - 1, (NT - 1) & 3); BLK_Y(pB0, pB1, mnB, alB, NT - 4); BLK_X(pA0, pA1, pB0, pB1, alB, NT - 2); LANDED();
    BLK_Y(pA0, pA1, mnA, alA, NT - 3); BLK_X(pB0, pB1, pA0, pA1, alA, NT - 1);
    BLK_Y(pB0, pB1, mnB, alB, NT - 2);
    finishSM<SH>(pB0, pB1, alB, l_reg, pa0, pa1, pa2, pa3); SBAR();
    pv_d0(o, VBUF((NT - 1) & 3), pa0, pa1, pa2, pa3);
  }
#undef BLK_X
#undef BLK_Y
  if (hi == 0) li_l[r32] = l_reg; asm volatile("s_waitcnt lgkmcnt(0)" ::: "memory");
  float rli[16];
#pragma unroll
  for (int r = 0; r < 16; ++r) rli[r] = __builtin_amdgcn_rcpf(li_l[crow(r, hi)]);
  __syncthreads();
  float* X = (float*)lds;
  if (mp == 1) {
#pragma unroll
    for (int d = 0; d < 4; ++d)
#pragma unroll
      for (int r = 0; r < 16; ++r) X[(wq * 64 + d * 16 + r) * 64 + lane] = o[d][r] * rli[r] * lam;
  }
  __syncthreads();
  if (mp == 0) {
#pragma unroll
    for (int d = 0; d < 4; ++d)
#pragma unroll
      for (int r = 0; r < 16; ++r) { const int ix = (wq * 64 + d * 16 + r) * 64 + lane; X[ix] = o[d][r] * rli[r] - X[ix]; }
  }
  __syncthreads();
  {
    const int row = tid >> 2, dq = tid & 3, rl = row & 31, w = row >> 5, hh = (rl >> 2) & 1, r = (rl & 3) + 4 * (rl >> 3);
    const float* xb = X + (w * 64 + dq * 16 + r) * 64 + hh * 32;
    f32x4 a[8]; float ss = 0.f;
#pragma unroll
    for (int i = 0; i < 8; ++i) { a[i] = *(const f32x4*)(xb + i * 4); ss += a[i][0] * a[i][0] + a[i][1] * a[i][1] + a[i][2] * a[i][2] + a[i][3] * a[i][3]; }
    ss += __shfl_xor(ss, 1); ss += __shfl_xor(ss, 2);
    const float rn = __builtin_amdgcn_rsqf(ss * (1.f / 128.f) + 1e-5f) * oscale;
    bf16_t* zp = proj + (size_t)(tok0 + row) * NPROJ + C_ZA + h * 128 + dq * 32;
    const float* gg = subg + dq * 32;
#pragma unroll
    for (int i = 0; i < 4; ++i) {
      const u32x4 z = *(const u32x4*)(zp + i * 8);
      const f32x4 a0 = a[2 * i], a1 = a[2 * i + 1]; const f32x4 g0 = *(const f32x4*)(gg + i * 8), g1 = *(const f32x4*)(gg + i * 8 + 4);
      u32x4 wv;
      wv.x = cvtpk(a0[0] * rn * g0[0] * silu(bflo(z.x)), a0[1] * rn * g0[1] * silu(bfhi(z.x)));
      wv.y = cvtpk(a0[2] * rn * g0[2] * silu(bflo(z.y)), a0[3] * rn * g0[3] * silu(bfhi(z.y)));
      wv.z = cvtpk(a1[0] * rn * g1[0] * silu(bflo(z.z)), a1[1] * rn * g1[1] * silu(bfhi(z.z)));
      wv.w = cvtpk(a1[2] * rn * g1[2] * silu(bflo(z.w)), a1[3] * rn * g1[3] * silu(bfhi(z.w)));
      if (!dry) *(u32x4*)(zp + i * 8) = wv;
    }
  }
  __syncthreads();
#undef DMA
#undef GLDS16
#undef KBUF
#undef VBUF
#undef LANDED
#undef RESC
}

__device__ void attn_phase(const Params& p, int l, char* lds, bool dry = false) {
  const float lam = p.lam[l];
  const float oscale = 1.f - (0.8f - 0.6f * expf(-0.3f * (float)l));
  const float* subg = p.subln_g + l * 128;
  for (int u = blockIdx.x; u < 2048; u += gridDim.x) {
    int tok0, kv0, seq, h;
    if (u < 1024) { const int x = u & 7, j = u >> 3; const int b = x >> 2; h = x & 3; seq = S_P; kv0 = b * S_P; tok0 = kv0 + j * 128; }
    else { const int v = u - 1024, x = v & 7, j = v >> 3; const int pr = x * 4 + (j >> 5), b = pr >> 2; h = pr & 3; seq = S_S; kv0 = TP + b * S_S; tok0 = kv0 + (j & 31) * 128; }
    bool need;
    { const int tid = opaque_tid(), wid = tid >> 6, lane = tid & 63, r32 = lane & 31, hi = lane >> 5, wq = wid & 3, mp = wid >> 2;
      const int sq = tok0 < TP ? (tok0 >> 14) : 2 + ((tok0 - TP) >> 12);
      const float* km = p.kmax2 + ((l * 10 + sq) * 4 + h) * 4 + mp * 2;
      const float kmx = sqrtf(km[0] + km[1]) * 1.01f;
      const bf16_t* Qw = p.proj + (size_t)(tok0 + wq * 32 + r32) * NPROJ + C_Q + h * 128 + mp * 64 + hi * 8;
      float ss = 0.f;
#pragma unroll
      for (int d0 = 0; d0 < 4; ++d0) { const u32x4 w = *(const u32x4*)(Qw + d0 * 16);
        ss += bflo(w.x) * bflo(w.x) + bfhi(w.x) * bfhi(w.x) + bflo(w.y) * bflo(w.y) + bfhi(w.y) * bfhi(w.y) + bflo(w.z) * bflo(w.z) + bfhi(w.z) * bfhi(w.z) + bflo(w.w) * bflo(w.w) + bfhi(w.w) * bfhi(w.w); }
      ss += __shfl_xor(ss, 32);
      need = __any(!(sqrtf(ss) * kmx < 100.f)) != 0; }
    if (need) attn_unit<true>(p.proj, tok0, kv0, seq, h, lam, oscale, subg, lds, dry);
    else attn_unit<false>(p.proj, tok0, kv0, seq, h, lam, oscale, subg, lds, dry);
  }
}
}

__device__ void post_phase(const Params& p, int l) {
  const int tid = opaque_tid(), wid = tid >> 6, lane = tid & 63, nw = blockDim.x >> 6;
  const float* pg = p.post_g + l * DM;
  for (int row = blockIdx.x * nw + wid; row < T_TOK; row += gridDim.x * nw) {
    const float* yr = (const float*)(p.proj + (size_t)row * NPROJ + C_U);
    f32x4 y[4], x[4]; float ss = 0.f;
#pragma unroll
    for (int i = 0; i < 4; ++i) { y[i] = *(const f32x4*)(yr + i * 256 + lane * 4); ss += y[i][0] * y[i][0] + y[i][1] * y[i][1] + y[i][2] * y[i][2] + y[i][3] * y[i][3]; }
    bf16_t* xo = (bf16_t*)p.out + (size_t)row * LDX;
    if (l == 0) {
      const float* xr = row < TP ? p.xp + (size_t)row * DM : p.xs + (size_t)(row - TP) * DM;
#pragma unroll
      for (int i = 0; i < 4; ++i) x[i] = *(const f32x4*)(xr + i * 256 + lane * 4);
    } else {
#pragma unroll
      for (int i = 0; i < 4; ++i) {
        const u32x2 h = *(const u32x2*)(xo + i * 256 + lane * 4), lo = *(const u32x2*)(xo + DM + i * 256 + lane * 4);
        x[i][0] = bflo(h.x) + bflo(lo.x); x[i][1] = bfhi(h.x) + bfhi(lo.x); x[i][2] = bflo(h.y) + bflo(lo.y); x[i][3] = bfhi(h.y) + bfhi(lo.y);
      }
    }
    ss = wave_sum(ss);
    const float ry = __builtin_amdgcn_rsqf(ss * (1.f / DM) + 1e-6f);
    float s2 = 0.f;
#pragma unroll
    for (int i = 0; i < 4; ++i) {
      const f32x4 g = *(const f32x4*)(pg + i * 256 + lane * 4);
#pragma unroll
      for (int e = 0; e < 4; ++e) { x[i][e] = x[i][e] + y[i][e] * ry * g[e]; s2 += x[i][e] * x[i][e]; }
    }
    if (l == DEPTH - 1) {
      float* orow = p.out + (size_t)row * DM;
#pragma unroll
      for (int i = 0; i < 4; ++i) *(f32x4*)(orow + i * 256 + lane * 4) = x[i];
    } else {
      s2 = wave_sum(s2);
      if (lane == 0) p.rinv[row] = __builtin_amdgcn_rsqf(s2 * (1.f / DM) + 1e-6f);
#pragma unroll
      for (int i = 0; i < 4; ++i) {
        const unsigned h0 = cvtpk(x[i][0], x[i][1]), h1 = cvtpk(x[i][2], x[i][3]);
        const unsigned l0 = cvtpk(x[i][0] - bflo(h0), x[i][1] - bfhi(h0)), l1 = cvtpk(x[i][2] - bflo(h1), x[i][3] - bfhi(h1));
        *(u32x2*)(xo + i * 256 + lane * 4) = (u32x2){h0, h1}; *(u32x2*)(xo + DM + i * 256 + lane * 4) = (u32x2){l0, l1};
      }
    }
  }
}


#define XB_TMO      128
#define XB_XCNT(j)  (256  + 64 * (j))
#define XB_XSUB(j)  (1280 + 64 * (j))
#define XB_XGEN(j)  (2304 + 64 * (j))
#define XB_TOP      3328
#define XB_TOPGEN   3392
#define XB_SPIN_CAP (1u << 22)
#define XLAS __attribute__((address_space(3)))
__device__ __forceinline__ unsigned xb_ld(unsigned* p)              { return __hip_atomic_load(p, __ATOMIC_RELAXED, __HIP_MEMORY_SCOPE_AGENT); }
__device__ __forceinline__ unsigned xb_add(unsigned* p, unsigned v) { return __hip_atomic_fetch_add(p, v, __ATOMIC_RELAXED, __HIP_MEMORY_SCOPE_AGENT); }
__device__ __forceinline__ unsigned xb_xcc_id() { return (unsigned)__builtin_amdgcn_s_getreg((3 << 11) | 20) & 0xFu; }
#define XB_SPIN(cond, bar) do { unsigned _sp = 0; while (cond) { __builtin_amdgcn_s_sleep(1); \
    if ((++_sp & 255u) == 0u) { if (xb_ld(&(bar)[XB_TMO])) break; if (_sp > XB_SPIN_CAP) { atomicAdd(&(bar)[XB_TMO], 1u); break; } } } } while (0)
struct XcdBarrier { unsigned* bar; unsigned x; volatile XLAS unsigned* st; };
__device__ __forceinline__ XcdBarrier xcd_barrier_post(unsigned* bar, volatile XLAS unsigned* st) {
  XcdBarrier b; b.bar = bar; b.x = xb_xcc_id(); b.st = st;
  if (threadIdx.x == 0) (void)xb_add(&bar[XB_XCNT(b.x)], 1u);
  return b;
}
__device__ __forceinline__ void xcd_barrier_complete(unsigned* bar, unsigned x, unsigned& nloc, unsigned& nx) {
  const unsigned G = gridDim.x * gridDim.y * gridDim.z;
  unsigned sum, cnt, mine, sp = 0u;
  for (;;) {
    sum = 0u; cnt = 0u; mine = 0u;
#pragma unroll
    for (unsigned j = 0; j < 16; ++j) { const unsigned c = xb_ld(&bar[XB_XCNT(j)]); sum += c; cnt += (c > 0u) ? 1u : 0u; mine = (j == x) ? c : mine; }
    if (sum == G) break;
    __builtin_amdgcn_s_sleep(1);
    if ((++sp & 255u) == 0u) { if (xb_ld(&bar[XB_TMO])) break; if (sp > XB_SPIN_CAP) { atomicAdd(&bar[XB_TMO], 1u); break; } }
  }
  nloc = mine > 0u ? mine : 1u; nx = cnt > 0u ? cnt : 1u;
}
__device__ __forceinline__ void xcd_barrier(const XcdBarrier& b) {
  asm volatile("s_waitcnt vmcnt(0)" ::: "memory");
  __syncthreads();
  if (threadIdx.x == 0) {
    unsigned* bar = b.bar;
    __builtin_amdgcn_s_waitcnt(0);
    unsigned nloc = b.st[0], nx = b.st[1];
    if (nloc == 0u) { xcd_barrier_complete(bar, b.x, nloc, nx); b.st[0] = nloc; b.st[1] = nx; }
    const unsigned old = xb_add(&bar[XB_XSUB(b.x)], 1u);
    const unsigned gen = old / nloc;
    if (old + 1u == (gen + 1u) * nloc) {
      __builtin_amdgcn_fence(__ATOMIC_RELEASE, "agent");
      asm volatile("s_waitcnt vmcnt(0)" ::: "memory");
      const unsigned og = xb_add(&bar[XB_TOP], 1u);
      const unsigned tg = og / nx;
      if (og + 1u == (tg + 1u) * nx) xb_add(&bar[XB_TOPGEN], 1u);
      else XB_SPIN(xb_ld(&bar[XB_TOPGEN]) == tg, bar);
      __builtin_amdgcn_fence(__ATOMIC_ACQUIRE, "agent");
      xb_add(&bar[XB_XGEN(b.x)], 1u);
      asm volatile("s_waitcnt vmcnt(0)" ::: "memory");
    } else {
      XB_SPIN(xb_ld(&bar[XB_XGEN(b.x)]) == gen, bar);
      __builtin_amdgcn_fence(__ATOMIC_ACQUIRE, "agent");
      asm volatile("s_waitcnt vmcnt(0)" ::: "memory");
    }
  }
  __syncthreads();
}

__device__ __forceinline__ void run_phase(const Params& p, int ph, char* shm) {
  if (ph == 0) { phase0(p, shm); return; }
  const int l = (ph - 1) >> 2, s = (ph - 1) & 3;
  if (s == 0) { gm::EpiIn e{p.rinv, p.rope, p.proj, p.kmax2 + l * 160}; gm::gemm_phase(( const bf16_t*)p.out, LDX, p.WinT + (size_t)l * NPROJ * DM, NPROJ, e, shm); }
  else if (s == 1) { pool_phase(p, l); at::attn_phase(p, l, shm); }
  else if (s == 2) { gm::EpiOut e{p.proj}; gm::gemm_phase(p.proj, NPROJ, p.WoutT + (size_t)l * DM * DM, DM, e, shm); }
  else post_phase(p, l);
}

#if MK_MULTI
template <int S> __global__ void __launch_bounds__(NT_THREADS, 1) k_phase(Params p, int l) {
  extern __shared__ __attribute__((aligned(16))) char shm[];
  if (S == 0) phase0(p, shm); else run_phase(p, 1 + 4 * l + (S - 1), shm);
}
#else
__global__ void __launch_bounds__(NT_THREADS, 1) k_mega(Params p) {
  extern __shared__ __attribute__((aligned(16))) char shm[];
  cg::grid_group grid = cg::this_grid();
  volatile XLAS unsigned* xst = (volatile XLAS unsigned*)(XLAS char*)(shm + 131072 + 3072);
  if (threadIdx.x == 0) { xst[0] = 0u; xst[1] = 0u; xst[2] = 0u; xst[3] = 0u; }
  phase0(p, shm);
  grid.sync();
  const XcdBarrier xb = xcd_barrier_post(p.bar, xst);
#define GSYNC() xcd_barrier(xb)
  for (int l = 0; l < DEPTH; ++l) {
#if REP_GEMM
    { gm::EpiIn e{p.rinv, p.rope, p.proj, p.kmax2 + l * 160}; gm::gemm_phase((const bf16_t*)p.out, LDX, p.WinT + (size_t)l * NPROJ * DM, NPROJ, e, shm); }
    GSYNC();
#endif
    { gm::EpiIn e{p.rinv, p.rope, p.proj, p.kmax2 + l * 160}; gm::gemm_phase((const bf16_t*)p.out, LDX, p.WinT + (size_t)l * NPROJ * DM, NPROJ, e, shm); }
    GSYNC();
    pool_phase(p, l);
#if REP_ATT
    at::attn_phase(p, l, shm, true); GSYNC();
#endif
    at::attn_phase(p, l, shm);
    GSYNC();
#if REP_GEMM
    { gm::EpiOut e{p.proj}; gm::gemm_phase(p.proj, NPROJ, p.WoutT + (size_t)l * DM * DM, DM, e, shm); }
    GSYNC();
#endif
    { gm::EpiOut e{p.proj}; gm::gemm_phase(p.proj, NPROJ, p.WoutT + (size_t)l * DM * DM, DM, e, shm); }
    GSYNC();
#if REP_POST
    if (l == 0) { post_phase(p, l); GSYNC(); }
#endif
    post_phase(p, l);
    if (l + 1 < DEPTH) GSYNC();
  }
}
#endif

extern "C" void kernel_launch(void* const* d_in, const int* in_sizes, int n_in, void* d_out, int out_size, void* d_ws, size_t ws_size, hipStream_t stream) {
  Params p{};
  p.xp = (const float*)d_in[0]; p.xs = (const float*)d_in[1]; p.pre_g = (const float*)d_in[2]; p.w_in = (const float*)d_in[3];
  p.pool_w = (const float*)d_in[4]; p.pool_scale = (const float*)d_in[5]; p.lq1 = (const float*)d_in[6]; p.lk1 = (const float*)d_in[7];
  p.lq2 = (const float*)d_in[8]; p.lk2 = (const float*)d_in[9]; p.subln_g = (const float*)d_in[10]; p.w_out = (const float*)d_in[11]; p.post_g = (const float*)d_in[12];
  p.out = (float*)d_out;
  char* w = (char*)d_ws; size_t off = 0;
  p.proj = (bf16_t*)(w + off); off += (size_t)T_TOK * NPROJ * 2;
  p.WinT = (bf16_t*)(w + off); off += (size_t)DEPTH * NPROJ * DM * 2;
  p.WoutT = (bf16_t*)(w + off); off += (size_t)DEPTH * DM * DM * 2;
  p.rinv = (float*)(w + off); off += (size_t)T_TOK * 4;
  p.rope = (float*)(w + off); off += 256;
  p.lam = (float*)(w + off); off += 256;
  p.kmax2 = (float*)(w + off); off += 2048;
  p.bar = (unsigned*)(w + off); off += 16384;
  if (off > ws_size) { fprintf(stderr, "kernel_launch: workspace too small (%zu > %zu)\n", off, ws_size); return; }
#if MK_MULTI
  static int ok = 0;
  if (!ok) {
    (void)hipFuncSetAttribute((const void*)k_phase<0>, hipFuncAttributeMaxDynamicSharedMemorySize, (int)SHM_BYTES);
    (void)hipFuncSetAttribute((const void*)k_phase<1>, hipFuncAttributeMaxDynamicSharedMemorySize, (int)SHM_BYTES);
    (void)hipFuncSetAttribute((const void*)k_phase<2>, hipFuncAttributeMaxDynamicSharedMemorySize, (int)SHM_BYTES);
    (void)hipFuncSetAttribute((const void*)k_phase<3>, hipFuncAttributeMaxDynamicSharedMemorySize, (int)SHM_BYTES);
    (void)hipFuncSetAttribute((const void*)k_phase<4>, hipFuncAttributeMaxDynamicSharedMemorySize, (int)SHM_BYTES);
    ok = 1; }
  hipLaunchKernelGGL(k_phase<0>, dim3(256), dim3(NT_THREADS), SHM_BYTES, stream, p, 0);
  for (int l = 0; l < DEPTH; ++l) {
    hipLaunchKernelGGL(k_phase<1>, dim3(256), dim3(NT_THREADS), SHM_BYTES, stream, p, l);
    hipLaunchKernelGGL(k_phase<2>, dim3(256), dim3(NT_THREADS), SHM_BYTES, stream, p, l);
    hipLaunchKernelGGL(k_phase<3>, dim3(256), dim3(NT_THREADS), SHM_BYTES, stream, p, l);
    hipLaunchKernelGGL(k_phase<4>, dim3(256), dim3(NT_THREADS), SHM_BYTES, stream, p, l);
  }
#else
  static int grid_blocks = 0;
  if (!grid_blocks) {
    (void)hipFuncSetAttribute((const void*)k_mega, hipFuncAttributeMaxDynamicSharedMemorySize, (int)SHM_BYTES);
    int dev = 0, cus = 0, per_cu = 0;
    (void)hipGetDevice(&dev);
    (void)hipDeviceGetAttribute(&cus, hipDeviceAttributeMultiprocessorCount, dev);
    (void)hipOccupancyMaxActiveBlocksPerMultiprocessor(&per_cu, k_mega, NT_THREADS, SHM_BYTES);
    if (per_cu > 1) per_cu = 1;
    grid_blocks = cus * per_cu;
  }
  void* args[] = {&p};
  hipError_t e = hipLaunchCooperativeKernel((void*)k_mega, dim3(grid_blocks), dim3(NT_THREADS), args, SHM_BYTES, stream);
  if (e != hipSuccess) fprintf(stderr, "cooperative launch failed: %s (grid %d)\n", hipGetErrorString(e), grid_blocks);
#endif
}
```

```cpp
#include <hip/hip_runtime.h>
#include <hip/hip_cooperative_groups.h>
#include <cstdio>
#include <cstdint>
namespace cg = cooperative_groups;

#ifndef REP_ATT
#define REP_ATT 0
#endif
#ifndef STAGGER_MAP
#define STAGGER_MAP 1
#endif
#ifndef REP_POST
#define REP_POST 0
#endif
#ifndef REP_GEMM
#define REP_GEMM 0
#endif
#ifndef MK_MULTI
#define MK_MULTI 0
#endif

typedef unsigned short bf16_t;
using bf16x8 = __attribute__((ext_vector_type(8))) short;
using s16x4  = __attribute__((ext_vector_type(4))) short;
using f32x16 = __attribute__((ext_vector_type(16))) float;
using f32x4  = __attribute__((ext_vector_type(4))) float;
using u32x4  = __attribute__((ext_vector_type(4))) unsigned;
using u32x2  = __attribute__((ext_vector_type(2))) unsigned;

#define XCD_BAR_WORDS 3456
constexpr int NT_THREADS = 512;
constexpr int T_TOK = 65536, TP = 32768, DM = 1024, NPROJ = 3072, DEPTH = 2;
constexpr int S_P = 16384, S_S = 4096;
constexpr int C_ZP = 0, C_ZA = 512, C_U = 1024, C_Q = 1536, C_K = 2048, C_V = 2560;
constexpr int LDX = 2048;
constexpr float QSCALE = 0.125f * 1.4426950408889634f;
constexpr size_t SHM_BYTES = 131072 + 4096;

struct Params {
  const float* xp; const float* xs; const float* pre_g; const float* w_in; const float* pool_w; const float* pool_scale;
  const float* lq1; const float* lk1; const float* lq2; const float* lk2; const float* subln_g; const float* w_out; const float* post_g;
  float* out; bf16_t* WinT; bf16_t* WoutT; bf16_t* proj; float* rinv; float* rope; float* lam; float* kmax2; unsigned* bar;
};

#define SBAR() __builtin_amdgcn_sched_barrier(0)
__device__ __forceinline__ unsigned cvtpk(float lo, float hi) {
  unsigned r; asm volatile("v_cvt_pk_bf16_f32 %0, %1, %2" : "=v"(r) : "v"(lo), "v"(hi)); return r;
}
__device__ __forceinline__ float bf2f(unsigned short b) { return __uint_as_float(((unsigned)b) << 16); }
__device__ __forceinline__ float bflo(unsigned w) { return __uint_as_float(w << 16); }
__device__ __forceinline__ float bfhi(unsigned w) { return __uint_as_float(w & 0xffff0000u); }
__device__ __forceinline__ bf16_t f2bf(float f) { return (bf16_t)(cvtpk(f, 0.f) & 0xffffu); }
__host__ __device__ __forceinline__ int perm32(int rho) { const int n = rho >> 4, i = rho & 15; return 8 * (i >> 2) + 4 * n + (i & 3); }
__device__ __forceinline__ float silu(float z) { return z * __builtin_amdgcn_rcpf(1.f + __builtin_amdgcn_exp2f(-1.4426950408889634f * z)); }
__device__ __forceinline__ int opaque_tid() { int t = threadIdx.x; asm volatile("" : "+v"(t)); return t; }
__device__ __forceinline__ float wave_sum(float v) {
#pragma unroll
  for (int o = 32; o >= 1; o >>= 1) v += __shfl_xor(v, o);
  return v;
}

__device__ __forceinline__ int src_col_in(int s) {
  const int type = s >> 9, within = s & 511;
  if (type == 0) return 512 + within;
  if (type == 1) return 2560 + within;
  if (type == 5) return 2048 + within;
  const int p = within & 63, wcl = p >> 5, fq = (p >> 3) & 3, n = (p >> 2) & 1, jj = p & 3;
  const int d = wcl * 16 + fq * 4 + jj + 32 * n;
  return (type == 3 ? 1024 : 1536) + (within & ~63) + d;
}

__device__ void phase0(const Params& p, char* shm) {
  const int tid = opaque_tid(), nth = blockDim.x;
  float* tile = (float*)shm;
  float* Wt = tile + 64 * 65 + 32;
  float* Pw = Wt + 64 * 128;
  constexpr int NT_U = DEPTH * 8 * 16, NT_IN = DEPTH * 40 * 16, NT_OUT = DEPTH * 16 * 16;
  for (int it = blockIdx.x; it < NT_U + NT_IN + NT_OUT; it += gridDim.x) {
    __syncthreads();
    if (it < NT_U + NT_IN) {
      int l, n0, k0; const bool isu = it < NT_U;
      if (isu) { l = it / 128; const int r = it % 128; n0 = C_U + (r / 16) * 64; k0 = (r % 16) * 64; }
      else { const int i2 = it - NT_U; l = i2 / 640; const int r = i2 % 640; int nt = r / 16; if (nt >= 16) nt += 8; n0 = nt * 64; k0 = (r % 16) * 64; }
      const float* W = p.w_in + (size_t)l * DM * NPROJ; const float* g = p.pre_g + l * DM;
      if (isu) {
        const int gi = (n0 - C_U) >> 7, d0 = (n0 - C_U) & 127;
        for (int e = tid; e < 64 * 128; e += nth) { const int c = e & 127, kk = e >> 7; Wt[e] = W[(size_t)(k0 + kk) * NPROJ + gi * 128 + c]; }
        for (int e = tid; e < 128 * 64; e += nth) { const int d = e & 63, c = e >> 6; Pw[e] = p.pool_w[((size_t)(l * 4 + gi) * 128 + c) * 128 + d0 + d]; }
        __syncthreads();
        for (int e = tid; e < 4096; e += nth) {
          const int nn = e & 63, kk = e >> 6, nrow = n0 + nn; const int s = (nrow & ~31) + perm32(nrow & 31), dl = s - n0;
          float a = 0.f;
#pragma unroll 8
          for (int c = 0; c < 128; ++c) a = fmaf(Wt[kk * 128 + c], Pw[c * 64 + dl], a);
          tile[kk * 65 + nn] = a * g[k0 + kk];
        }
      } else {
        for (int e = tid; e < 4096; e += nth) {
          const int nn = e & 63, kk = e >> 6, k = k0 + kk, nrow = n0 + nn;
          const int s = (nrow & ~31) + perm32(nrow & 31);
          tile[kk * 65 + nn] = W[(size_t)k * NPROJ + src_col_in(s)] * g[k];
        }
      }
      __syncthreads();
      bf16_t* O = p.WinT + (size_t)l * NPROJ * DM;
      for (int e = tid; e < 4096; e += nth) { const int kk = e & 63, nn = e >> 6; O[(size_t)(n0 + nn) * DM + k0 + kk] = f2bf(tile[kk * 65 + nn]); }
    } else {
      const int it2 = it - NT_U - NT_IN, l = it2 / 256, r = it2 % 256, n0 = (r / 16) * 64, k0 = (r % 16) * 64;
      const float* W = p.w_out + (size_t)l * DM * DM;
      for (int e = tid; e < 4096; e += nth) {
        const int nn = e & 63, kk = e >> 6, nrow = n0 + nn; const int s = (nrow & ~31) + perm32(nrow & 31);
        tile[kk * 65 + nn] = W[(size_t)(k0 + kk) * DM + s];
      }
      __syncthreads();
      bf16_t* O = p.WoutT + (size_t)l * DM * DM;
      for (int e = tid; e < 4096; e += nth) { const int kk = e & 63, nn = e >> 6; O[(size_t)(n0 + nn) * DM + k0 + kk] = f2bf(tile[kk * 65 + nn]); }
    }
  }
  if (blockIdx.x == 0) {
    for (int i = tid; i < XCD_BAR_WORDS; i += nth) p.bar[i] = 0u;
    if (tid < DEPTH * 160) p.kmax2[tid] = 0.f;
    if (tid < 32) { const double c = exp(-(double)tid * (9.210340371976184 / 32.0)) * 0.15915494309189535; const float h = (float)c; p.rope[2 * tid] = h; p.rope[2 * tid + 1] = (float)(c - (double)h); }
    if (tid >= 64 && tid < 64 + 64 * DEPTH) {
      const int l = (tid >> 6) - 1, i = tid & 63;
      float a = p.lq1[l * 64 + i] * p.lk1[l * 64 + i], b = p.lq2[l * 64 + i] * p.lk2[l * 64 + i];
      a = wave_sum(a); b = wave_sum(b);
      const float li = 0.8f - 0.6f * expf(-0.3f * (float)l);
      if (i == 0) p.lam[l] = expf(a) - expf(b) + li;
    }
  }
  const int wid = tid >> 6, lane = tid & 63, nw = nth >> 6;
  for (int row0 = (blockIdx.x * nw + wid) * 2; row0 < T_TOK; row0 += gridDim.x * nw * 2) {
    f32x4 v[2][4];
#pragma unroll
    for (int q = 0; q < 2; ++q) {
      const int row = row0 + q;
      const float* xr = row < TP ? p.xp + (size_t)row * DM : p.xs + (size_t)(row - TP) * DM;
#pragma unroll
      for (int i = 0; i < 4; ++i) v[q][i] = *(const f32x4*)(xr + i * 256 + lane * 4);
    }
#pragma unroll
    for (int q = 0; q < 2; ++q) {
      const int row = row0 + q;
      bf16_t* xo = (bf16_t*)p.out + (size_t)row * LDX;
      float ss = 0.f;
#pragma unroll
      for (int i = 0; i < 4; ++i) {
        ss += v[q][i][0] * v[q][i][0] + v[q][i][1] * v[q][i][1] + v[q][i][2] * v[q][i][2] + v[q][i][3] * v[q][i][3];
        u32x2 w = {cvtpk(v[q][i][0], v[q][i][1]), cvtpk(v[q][i][2], v[q][i][3])};
        *(u32x2*)(xo + i * 256 + lane * 4) = w;
      }
      ss = wave_sum(ss);
      if (lane == 0) p.rinv[row] = __builtin_amdgcn_rsqf(ss * (1.f / DM) + 1e-6f);
    }
  }
}

namespace gm {
constexpr int BM = 256, BK = 64, HALF = 128, NXCD = 8, WGM = 8, HT = HALF * BK;
__device__ __forceinline__ int lds_byte(int r, int c) { int st = (r >> 4) * 2 + (c >> 5), rr = r & 15, cc = c & 31, ob = rr * 64 + cc * 2; return st * 1024 + (ob ^ (((ob >> 9) & 1) << 5)); }
__device__ __forceinline__ void stage_rc(int b, int& R, int& C) { int st = b / 1024, sb = b % 1024, swz = sb ^ (((sb >> 9) & 1) << 5); R = (st >> 1) * 16 + swz / 64; C = (st & 1) * 32 + (swz % 64) / 2; }

#define LAS __attribute__((address_space(3)))
template <class Epi>
__device__ __forceinline__ void gemm_phase(const bf16_t* __restrict__ A, const int lda, const bf16_t* __restrict__ Bt, const int N, const Epi& E, char* shmc) {
  constexpr int K = 1024, nt = K / BK, HTB = HALF * BK * 2;
  LAS unsigned char* lds = (LAS unsigned char*)shmc;
  const int tid = opaque_tid(), wid = __builtin_amdgcn_readfirstlane(tid >> 6), lane = tid & 63, wr = wid >> 2, wc = wid & 3, fr = lane & 15, fq = lane >> 4;
  unsigned voffA[2], voffB[2];
#pragma unroll
  for (int i = 0; i < 2; ++i) { int R, C; stage_rc(tid * 16 + i * 8192, R, C); voffA[i] = (unsigned)(R * lda + C) * 2u; voffB[i] = (unsigned)(R * K + C) * 2u; }
  const size_t kstep = (size_t)(BK * 2);
  const size_t hstepA = (size_t)HALF * lda * 2, hstepB = (size_t)HALF * K * 2;
  const size_t tstepA = 2 * hstepA, tstepB = 2 * hstepB;
  const unsigned ldsw = (unsigned)wid * 1024u;
  const int aoff = lds_byte(wr * 64 + fr, fq * 8), boff = lds_byte(wc * 32 + fr, fq * 8);
#define PG8_SA(b, h) (((b) * 2 + (h)) * HTB)
#define PG8_SB(b, h) ((4 + (b) * 2 + (h)) * HTB)
#define PG8_STAGE(bufoff, gbase, voff) do { _Pragma("unroll") for (int _i = 0; _i < 2; ++_i) \
        __builtin_amdgcn_global_load_lds((const unsigned*)((const char*)(gbase) + (voff)[_i]), (LAS unsigned*)(lds + (bufoff) + ldsw + _i * 8192), 16, 0, 0); } while (0)
#define PG8_LDA(dst, b, h) do { _Pragma("unroll") for (int m = 0; m < 4; ++m) _Pragma("unroll") for (int k = 0; k < 2; ++k) dst[m][k] = *(const LAS bf16x8*)(lds + PG8_SA(b, h) + aoff + m * 2048 + k * 1024); } while (0)
#define PG8_LDB(dst, b, h) do { _Pragma("unroll") for (int n = 0; n < 2; ++n) _Pragma("unroll") for (int k = 0; k < 2; ++k) dst[n][k] = *(const LAS bf16x8*)(lds + PG8_SB(b, h) + boff + n * 2048 + k * 1024); } while (0)
#define PG8_MMA(ai, bj, At, Bx) do { __builtin_amdgcn_s_setprio(1); _Pragma("unroll") for (int m = 0; m < 4; ++m) _Pragma("unroll") for (int n = 0; n < 2; ++n) _Pragma("unroll") for (int k = 0; k < 2; ++k) \
        acc[ai][bj][m][n] = __builtin_amdgcn_mfma_f32_16x16x32_bf16(Bx[n][k], At[m][k], acc[ai][bj][m][n], 0, 0, 0); __builtin_amdgcn_s_setprio(0); } while (0)
#define PG8_WAIT_V(n) asm volatile("s_waitcnt vmcnt(" #n ")" ::: "memory")
#define PG8_WAIT_L(n) asm volatile("s_waitcnt lgkmcnt(" #n ")" ::: "memory")
#define PG8_BAR __builtin_amdgcn_s_barrier()
#define PG8_SCHED __builtin_amdgcn_sched_barrier(0)
  const int nM = T_TOK / BM, nN = N / BM, nwg = nM * nN, G = gridDim.x, cblk = blockIdx.x;
  auto next_unit = [&](int i, int& pm, int& pn) -> bool {
    const long L = (long)i * G + cblk; if (L >= nwg) return false;
    int wgid = (int)L; { const int q = nwg / NXCD, r = nwg % NXCD, xcd = wgid % NXCD, off = wgid / NXCD; wgid = (xcd < r ? xcd * (q + 1) : r * (q + 1) + (xcd - r) * q) + off; }
    const int nig = WGM * nN, gid = wgid / nig, fm = gid * WGM, gsz = (nM - fm) < WGM ? (nM - fm) : WGM;
    pm = fm + ((wgid % nig) % gsz); pn = (wgid % nig) / gsz; return true;
  };
  int cpm, cpn, npm = 0, npn = 0, ui = 0;
  if (!next_unit(0, cpm, cpn)) return;
  f32x4 acc[2][2][4][2];
#pragma unroll
  for (int a = 0; a < 2; ++a)
#pragma unroll
    for (int b = 0; b < 2; ++b)
#pragma unroll
      for (int m = 0; m < 4; ++m)
#pragma unroll
        for (int n = 0; n < 2; ++n) acc[a][b][m][n] = (f32x4){0.f, 0.f, 0.f, 0.f};
  bf16x8 At[4][2], B0[2][2], B1[2][2];
  const char* cA = (const char*)A + (size_t)cpm * tstepA; const char* cB = (const char*)Bt + (size_t)cpn * tstepB;
  PG8_STAGE(PG8_SB(0, 0), cB, voffB); PG8_STAGE(PG8_SB(0, 1), cB + hstepB, voffB); PG8_STAGE(PG8_SA(0, 0), cA, voffA); PG8_STAGE(PG8_SA(0, 1), cA + hstepA, voffA);
  if (wr == 1) PG8_BAR;
  PG8_WAIT_V(2); PG8_BAR;
  PG8_STAGE(PG8_SB(1, 0), cB + kstep, voffB); PG8_STAGE(PG8_SA(1, 0), cA + kstep, voffA); PG8_STAGE(PG8_SB(1, 1), cB + hstepB + kstep, voffB);
  PG8_WAIT_V(6); PG8_BAR;
  for (;;) {
    const bool has_next = next_unit(ui + 1, npm, npn);
    const char* nA = has_next ? (const char*)A + (size_t)npm * tstepA : cA; const char* nB = has_next ? (const char*)Bt + (size_t)npn * tstepB : cB;
    for (int t = 0; t < nt; t += 2) {
      const bool last = (t == nt - 2);
      const char* a1 = cA + (size_t)(t + 1) * kstep;
      const char* a2 = last ? nA : cA + (size_t)(t + 2) * kstep; const char* b2 = last ? nB : cB + (size_t)(t + 2) * kstep;
      const char* a3 = a2 + kstep; const char* b3 = b2 + kstep;
      PG8_LDB(B0, 0, 0); PG8_LDB(B1, 0, 1); PG8_SCHED; PG8_LDA(At, 0, 0); PG8_STAGE(PG8_SA(1, 1), a1 + hstepA, voffA);
      PG8_WAIT_V(8); PG8_WAIT_L(0); PG8_BAR; PG8_MMA(0, 0, At, B0); PG8_MMA(0, 1, At, B1); PG8_BAR; PG8_SCHED;
      PG8_LDA(At, 0, 1); PG8_STAGE(PG8_SB(0, 0), b2, voffB); PG8_STAGE(PG8_SB(0, 1), b2 + hstepB, voffB); PG8_STAGE(PG8_SA(0, 0), a2, voffA);
      PG8_WAIT_V(8); PG8_WAIT_L(0); PG8_BAR; PG8_MMA(1, 0, At, B0); PG8_MMA(1, 1, At, B1); PG8_BAR; PG8_SCHED;
      PG8_LDB(B0, 1, 0); PG8_LDB(B1, 1, 1); PG8_SCHED; PG8_LDA(At, 1, 0); PG8_STAGE(PG8_SA(0, 1), a2 + hstepA, voffA);
      PG8_WAIT_V(8); PG8_WAIT_L(0); PG8_BAR; PG8_MMA(0, 0, At, B0); PG8_MMA(0, 1, At, B1); PG8_BAR; PG8_SCHED;
      PG8_LDA(At, 1, 1); PG8_STAGE(PG8_SB(1, 0), b3, voffB); PG8_STAGE(PG8_SB(1, 1), b3 + hstepB, voffB); PG8_STAGE(PG8_SA(1, 0), a3, voffA);
      PG8_WAIT_V(8); PG8_WAIT_L(0); PG8_BAR; PG8_MMA(1, 0, At, B0); PG8_MMA(1, 1, At, B1); PG8_BAR; PG8_SCHED;
    }
    if (wr == 0) PG8_BAR;
    E(acc, cpm, cpn, wr, wc, fr, fq);
    if (!has_next) break;
#pragma unroll
    for (int a = 0; a < 2; ++a)
#pragma unroll
      for (int b = 0; b < 2; ++b)
#pragma unroll
        for (int m = 0; m < 4; ++m)
#pragma unroll
          for (int n = 0; n < 2; ++n) acc[a][b][m][n] = (f32x4){0.f, 0.f, 0.f, 0.f};
    cpm = npm; cpn = npn; cA = nA; cB = nB; ++ui;
    if (wr == 1) PG8_BAR;
  }
  PG8_WAIT_V(0);
  PG8_BAR;
#undef PG8_SA
#undef PG8_SB
#undef PG8_STAGE
#undef PG8_LDA
#undef PG8_LDB
#undef PG8_MMA
}

struct EpiIn {
  const float* rinv; const float* rope; bf16_t* proj; float* kmax2;
  __device__ __forceinline__ void operator()(const f32x4 (&acc)[2][2][4][2], int pm, int pn, int wr, int wc, int fr, int fq) const {
    const bool isrope = (pn >= 6 && pn <= 9); const float qs = (pn == 6 || pn == 7) ? QSCALE : 1.f;
    const bool isk = (pn == 8 || pn == 9);
    float kmx[2] = {0.f, 0.f};
    float ch[4], cl[4];
    if (isrope) {
#pragma unroll
      for (int jj = 0; jj < 4; ++jj) { const int i = (wc & 1) * 16 + fq * 4 + jj; ch[jj] = rope[2 * i]; cl[jj] = rope[2 * i + 1]; }
    }
#pragma unroll
    for (int ai = 0; ai < 2; ++ai)
#pragma unroll
      for (int m = 0; m < 4; ++m) {
        const int row = pm * BM + ai * HALF + wr * 64 + m * 16 + fr;
        const float ri = rinv[row];
        float cs[4], sn[4];
        if (isrope) {
          const float pos = (float)(row < TP ? (row & (S_P - 1)) : (row & (S_S - 1)));
#pragma unroll
          for (int jj = 0; jj < 4; ++jj) {
            const float h = pos * ch[jj], e = fmaf(pos, ch[jj], -h) + pos * cl[jj];
            const float rev = (h - floorf(h)) + e;
            sn[jj] = __builtin_amdgcn_sinf(rev); cs[jj] = __builtin_amdgcn_cosf(rev);
          }
        }
        bf16_t* rowp = proj + (size_t)row * NPROJ + pn * BM + wc * 32 + 8 * fq;
#pragma unroll
        for (int bj = 0; bj < 2; ++bj) {
          f32x4 v0 = acc[ai][bj][m][0] * ri, v1 = acc[ai][bj][m][1] * ri;
          if (isrope) {
#pragma unroll
            for (int jj = 0; jj < 4; ++jj) { const float a = v0[jj], b = v1[jj]; v0[jj] = (a * cs[jj] - b * sn[jj]) * qs; v1[jj] = (b * cs[jj] + a * sn[jj]) * qs; }
          }
          u32x4 w; w.x = cvtpk(v0[0], v0[1]); w.y = cvtpk(v0[2], v0[3]); w.z = cvtpk(v1[0], v1[1]); w.w = cvtpk(v1[2], v1[3]);
          *(u32x4*)(rowp + bj * HALF) = w;
          if (isk) { float ss = v0[0] * v0[0] + v0[1] * v0[1] + v0[2] * v0[2] + v0[3] * v0[3] + v1[0] * v1[0] + v1[1] * v1[1] + v1[2] * v1[2] + v1[3] * v1[3];
            ss += __shfl_xor(ss, 16); ss += __shfl_xor(ss, 32); kmx[bj] = fmaxf(kmx[bj], ss); }
        }
      }
    if (isk) {
      const int row0 = pm * BM, sq = row0 < TP ? (row0 >> 14) : 2 + ((row0 - TP) >> 12);
#pragma unroll
      for (int bj = 0; bj < 2; ++bj) { float v = kmx[bj];
        v = fmaxf(v, __shfl_xor(v, 1)); v = fmaxf(v, __shfl_xor(v, 2)); v = fmaxf(v, __shfl_xor(v, 4)); v = fmaxf(v, __shfl_xor(v, 8));
        if ((fr | fq) == 0) atomicMax((unsigned*)(kmax2 + (sq * 4 + (pn - 8) * 2 + bj) * 4 + wc), __float_as_uint(v)); }
    }
  }
};
struct EpiOut {
  bf16_t* proj;
  __device__ __forceinline__ void operator()(const f32x4 (&acc)[2][2][4][2], int pm, int pn, int wr, int wc, int fr, int fq) const {
#pragma unroll
    for (int ai = 0; ai < 2; ++ai)
#pragma unroll
      for (int m = 0; m < 4; ++m) {
        const int row = pm * BM + ai * HALF + wr * 64 + m * 16 + fr;
        bf16_t* rowp = proj + (size_t)row * NPROJ + C_U + pn * BM + wc * 32 + 8 * fq;
#pragma unroll
        for (int bj = 0; bj < 2; ++bj) { const f32x4 v0 = acc[ai][bj][m][0], v1 = acc[ai][bj][m][1];
          u32x4 w; w.x = cvtpk(v0[0], v0[1]); w.y = cvtpk(v0[2], v0[3]); w.z = cvtpk(v1[0], v1[1]); w.w = cvtpk(v1[2], v1[3]);
          *(u32x4*)(rowp + bj * HALF) = w; }
      }
  }
};
}

__device__ __forceinline__ void bf8_to_f(const u32x4 w, float* v) {
  v[0] = bflo(w.x); v[1] = bfhi(w.x); v[2] = bflo(w.y); v[3] = bfhi(w.y); v[4] = bflo(w.z); v[5] = bfhi(w.z); v[6] = bflo(w.w); v[7] = bfhi(w.w);
}
__device__ void pool_phase(const Params& p, int l, bool dry = false) {
  const int tid = opaque_tid(), c8 = tid & 63, tq = tid >> 6;
  const int g = c8 >> 4, hw = 1 << g;
  const float* sc = p.pool_scale + l * 512 + c8 * 8;
  float scl[8];
#pragma unroll
  for (int e = 0; e < 8; ++e) scl[e] = sc[e];
  for (int ch = blockIdx.x; ch < T_TOK / 128; ch += gridDim.x) {
    const int t0 = ch * 128 + tq * 16;
    const int S = t0 < TP ? S_P : S_S, pos0 = t0 & (S - 1), s0 = t0 - pos0;
    const bf16_t* ub = p.proj + (size_t)s0 * NPROJ + C_U + c8 * 8;
    float sum[8] = {0, 0, 0, 0, 0, 0, 0, 0};
#pragma unroll
    for (int j = 0; j < 16; ++j) {
      const int r = pos0 - hw + j; const bool ok = (j < 2 * hw) && r >= 0 && r < S; const int rc = min(max(r, 0), S - 1);
      float v[8]; bf8_to_f(*(const u32x4*)(ub + (size_t)rc * NPROJ), v); const float m = ok ? 1.f : 0.f;
#pragma unroll
      for (int e = 0; e < 8; ++e) sum[e] = fmaf(m, v[e], sum[e]);
    }
#pragma unroll
    for (int i4 = 0; i4 < 16; i4 += 4) {
      u32x4 wu[4], wz[4], wa[4], wsb[4];
#pragma unroll
      for (int q = 0; q < 4; ++q) {
        const int pos = pos0 + i4 + q, ra = pos + hw, rs = pos - hw;
        wu[q] = *(const u32x4*)(ub + (size_t)pos * NPROJ);
        wz[q] = *(const u32x4*)(p.proj + (size_t)(t0 + i4 + q) * NPROJ + C_ZP + c8 * 8);
        wa[q] = *(const u32x4*)(ub + (size_t)min(ra, S - 1) * NPROJ); wsb[q] = *(const u32x4*)(ub + (size_t)max(rs, 0) * NPROJ);
      }
#pragma unroll
      for (int q = 0; q < 4; ++q) {
        const int pos = pos0 + i4 + q, t = t0 + i4 + q;
        const int lo = max(pos - hw, 0), hi = min(pos + hw, S);
        const float inv = 1.f / (float)(hi - lo);
        float uc[8], z[8], va[8], vs[8], o[8];
        bf8_to_f(wu[q], uc); bf8_to_f(wz[q], z);
#pragma unroll
        for (int e = 0; e < 8; ++e) o[e] = (sum[e] * inv - uc[e]) * scl[e] * silu(z[e]);
        const u32x4 w = {cvtpk(o[0], o[1]), cvtpk(o[2], o[3]), cvtpk(o[4], o[5]), cvtpk(o[6], o[7])};
        if (!dry) *(u32x4*)(p.proj + (size_t)t * NPROJ + C_ZP + c8 * 8) = w;
        const int ra = pos + hw, rs = pos - hw; const float ma = ra < S ? 1.f : 0.f, ms = rs >= 0 ? 1.f : 0.f;
        bf8_to_f(wa[q], va); bf8_to_f(wsb[q], vs);
#pragma unroll
        for (int e = 0; e < 8; ++e) sum[e] = fmaf(ma, va[e], fmaf(-ms, vs[e], sum[e]));
      }
    }
  }
}

namespace at {
constexpr int KVBLK = 64, LDK = NPROJ;
constexpr size_t SHM_V = KVBLK * 128 * 2, SHM_K = KVBLK * 128 * 2;
constexpr float THRL = 11.5f;
#define KSWZ(row, colB) ((row) * 256 + ((colB) ^ (((row) & 7) << 4)))
__device__ __forceinline__ int crow(int r, int hi) { return (r & 3) + 8 * (r >> 2) + 4 * hi; }
template <bool SH> __device__ __forceinline__ void partialSM(f32x16& p0, f32x16& p1, float& m_reg, float& mn, float& alpha) {
  if constexpr (!SH) {
    alpha = 1.f;
#pragma unroll
    for (int r = 0; r < 16; ++r) { p0[r] = __builtin_amdgcn_exp2f(p0[r]); p1[r] = __builtin_amdgcn_exp2f(p1[r]); }
    return;
  }
  float pmax = p0[0];
#pragma unroll
  for (int r = 1; r < 16; ++r) pmax = fmaxf(pmax, p0[r]);
#pragma unroll
  for (int r = 0; r < 16; ++r) pmax = fmaxf(pmax, p1[r]);
  { auto rr = __builtin_amdgcn_permlane32_swap(__float_as_uint(pmax), __float_as_uint(pmax), false, false);
    pmax = fmaxf(__uint_as_float(rr[0]), __uint_as_float(rr[1])); }
  if (__builtin_expect(__all(pmax - m_reg <= THRL), 1)) { mn = m_reg; alpha = 1.f; }
  else { mn = fmaxf(m_reg, pmax); alpha = __builtin_amdgcn_exp2f(m_reg - mn); m_reg = mn; }
#pragma unroll
  for (int r = 0; r < 16; ++r) p0[r] = p0[r] - mn;
#pragma unroll
  for (int r = 0; r < 16; ++r) p1[r] = p1[r] - mn;
#pragma unroll
  for (int r = 0; r < 16; ++r) { p0[r] = __builtin_amdgcn_exp2f(p0[r]); p1[r] = __builtin_amdgcn_exp2f(p1[r]); }
}
template <bool SH> __device__ __forceinline__ void finishSM(f32x16& p0, f32x16& p1, float alpha, float& l_reg, bf16x8& pa0, bf16x8& pa1, bf16x8& pa2, bf16x8& pa3) {
  float ps = 0;
#pragma unroll
  for (int r = 0; r < 16; ++r) ps += p0[r];
#pragma unroll
  for (int r = 0; r < 16; ++r) ps += p1[r];
  { auto rr = __builtin_amdgcn_permlane32_swap(__float_as_uint(ps), __float_as_uint(ps), false, false);
    ps = __uint_as_float(rr[0]) + __uint_as_float(rr[1]); }
  if constexpr (SH) l_reg = l_reg * alpha + ps; else l_reg += ps;
#define PK4(P, BASE, OUT) do { unsigned a0 = cvtpk(P[BASE + 0], P[BASE + 1]), a1 = cvtpk(P[BASE + 2], P[BASE + 3]);   \
    unsigned b0 = cvtpk(P[BASE + 4], P[BASE + 5]), b1 = cvtpk(P[BASE + 6], P[BASE + 7]);                              \
    auto r0 = __builtin_amdgcn_permlane32_swap(a0, b0, false, false); auto r1 = __builtin_amdgcn_permlane32_swap(a1, b1, false, false); \
    u32x4 w = {r0[0], r1[0], r0[1], r1[1]}; OUT = *reinterpret_cast<bf16x8*>(&w); } while (0)
  PK4(p0, 0, pa0); PK4(p0, 8, pa1); PK4(p1, 0, pa2); PK4(p1, 8, pa3);
#undef PK4
}
__device__ __forceinline__ void qkt(f32x16& p0, f32x16& p1, const char* Ks, const bf16x8* qr, int r32, int hi, int mapB) {
  p0 = f32x16{}; p1 = f32x16{};
#pragma unroll
  for (int d0 = 0; d0 < 4; ++d0) { const int cb = (d0 * 16 + hi * 8) * 2 + mapB;
    bf16x8 b0 = *reinterpret_cast<const bf16x8*>(Ks + KSWZ(r32, cb));
    bf16x8 b1 = *reinterpret_cast<const bf16x8*>(Ks + KSWZ(32 + r32, cb));
    p0 = __builtin_amdgcn_mfma_f32_32x32x16_bf16(b0, qr[d0], p0, 0, 0, 0);
    p1 = __builtin_amdgcn_mfma_f32_32x32x16_bf16(b1, qr[d0], p1, 0, 0, 0); }
}
__device__ __forceinline__ int v_st(int k, int c) { const int kk = (k & ~0xC) | ((k & 4) << 1) | ((k & 8) >> 1); return ((kk >> 3) * 4 + (c >> 5)) * 512 + ((kk & 7) * 32 + (c & 31)) * 2; }
__device__ __forceinline__ int v_rd_base(int lane) { return ((lane & 3) << 3) | (((lane >> 2) & 3) << 6) | (((lane >> 4) & 1) << 5) | (((lane >> 5) & 1) << 8); }
constexpr int v_rd_off(int d0, int ks, int half) { return d0 * 512 + ks * 4096 + half * 2048; }
template <int OFF> __device__ __forceinline__ s16x4 tr_read(int vb) {
  s16x4 r; asm volatile("ds_read_b64_tr_b16 %0, %1 offset:%2" : "=&v"(r) : "v"(vb), "i"(OFF) : "memory"); return r;
}
template <int D0> __device__ __forceinline__ void pv_one(f32x16& od, int vb, bf16x8 pa0, bf16x8 pa1, bf16x8 pa2, bf16x8 pa3) {
  const s16x4 l0 = tr_read<v_rd_off(D0, 0, 0)>(vb), h0 = tr_read<v_rd_off(D0, 0, 1)>(vb), l1 = tr_read<v_rd_off(D0, 1, 0)>(vb), h1 = tr_read<v_rd_off(D0, 1, 1)>(vb);
  const s16x4 l2 = tr_read<v_rd_off(D0, 2, 0)>(vb), h2 = tr_read<v_rd_off(D0, 2, 1)>(vb), l3 = tr_read<v_rd_off(D0, 3, 0)>(vb), h3 = tr_read<v_rd_off(D0, 3, 1)>(vb);
  asm volatile("s_waitcnt lgkmcnt(0)" ::: "memory"); SBAR();
#define PK(L, H) (bf16x8){L[0], L[1], L[2], L[3], H[0], H[1], H[2], H[3]}
  od = __builtin_amdgcn_mfma_f32_32x32x16_bf16(pa0, PK(l0, h0), od, 0, 0, 0);
  od = __builtin_amdgcn_mfma_f32_32x32x16_bf16(pa1, PK(l1, h1), od, 0, 0, 0);
  od = __builtin_amdgcn_mfma_f32_32x32x16_bf16(pa2, PK(l2, h2), od, 0, 0, 0);
  od = __builtin_amdgcn_mfma_f32_32x32x16_bf16(pa3, PK(l3, h3), od, 0, 0, 0);
#undef PK
}
__device__ __forceinline__ void pv_d0(f32x16* o, int vb, bf16x8 pa0, bf16x8 pa1, bf16x8 pa2, bf16x8 pa3) {
  pv_one<0>(o[0], vb, pa0, pa1, pa2, pa3); pv_one<1>(o[1], vb, pa0, pa1, pa2, pa3); pv_one<2>(o[2], vb, pa0, pa1, pa2, pa3); pv_one<3>(o[3], vb, pa0, pa1, pa2, pa3);
}

template <bool SH> __device__ __forceinline__ void attn_unit(bf16_t* __restrict__ proj, int tok0, int kv0, int seq, int h, float lam, float oscale, const float* __restrict__ subg, char* lds, bool dry) {
  const int tid = opaque_tid(), wid = __builtin_amdgcn_readfirstlane(tid >> 6), lane = tid & 63, r32 = lane & 31, hi = lane >> 5;
  const int wq = wid & 3, mp = wid >> 2, mapB = mp * 128;
  constexpr int RING = 32768, NRING = 4;
  LAS char* ldsl = (LAS char*)lds;
  float* ws = (float*)(lds + NRING * RING) + wid * 64; float* li_l = ws; float* al_l = ws + 32;
  const bf16_t* Kh = proj + (size_t)kv0 * NPROJ + C_K + h * 128;
  const bf16_t* Vh = proj + (size_t)kv0 * NPROJ + C_V + h * 128;
  float m_reg = -1e30f, l_reg = 0; f32x16 o[4] = {}; bf16x8 qr[4];
  const bf16_t* Qw = proj + (size_t)(tok0 + wq * 32 + r32) * NPROJ + C_Q + h * 128 + mp * 64 + hi * 8;
#pragma unroll
  for (int d0 = 0; d0 < 4; ++d0) qr[d0] = *reinterpret_cast<const bf16x8*>(Qw + d0 * 16);
  int offK[2], offV[2];
#pragma unroll
  for (int i = 0; i < 2; ++i) {
    const int c = i * 512 + tid;
    { const int row = c >> 4, pc = c & 15, scn = pc ^ (row & 7); offK[i] = row * LDK + scn * 8; }
    { const int sub = c >> 5, kk = (sub >> 2) * 8 + ((c >> 2) & 7), col = (sub & 3) * 32 + (c & 3) * 8;
      const int k = (kk & ~0xC) | ((kk & 4) << 1) | ((kk & 8) >> 1); offV[i] = k * LDK + col; }
  }
  const int vbb = (int)(uintptr_t)ldsl + 16384 + v_rd_base(lane);
#define GLDS16(src, dst) __builtin_amdgcn_global_load_lds((const unsigned*)(src), (LAS unsigned*)(dst), 16, 0, 0)
#define DMA(t, b) do { const bf16_t* kg_ = Kh + (size_t)(t) * (KVBLK * LDK); const bf16_t* vg_ = Vh + (size_t)(t) * (KVBLK * LDK); LAS char* d_ = ldsl + (b) * RING + wid * 1024; \
    GLDS16(kg_ + offK[0], d_); GLDS16(kg_ + offK[1], d_ + 8192); GLDS16(vg_ + offV[0], d_ + 16384); GLDS16(vg_ + offV[1], d_ + 16384 + 8192); } while (0)
#define KBUF(b) ((const char*)lds + (b) * RING)
#define VBUF(b) (vbb + (b) * RING)
#define LANDED() do { asm volatile("s_waitcnt vmcnt(0)" ::: "memory"); __syncthreads(); } while (0)
#define RESC(a) do { if (SH && __any((a) < 1.f)) { if (hi == 0) al_l[r32] = (a); asm volatile("s_waitcnt lgkmcnt(0)" ::: "memory"); \
    _Pragma("unroll") for (int d = 0; d < 4; ++d) _Pragma("unroll") for (int r = 0; r < 16; ++r) o[d][r] *= al_l[crow(r, hi)]; } } while (0)
  f32x16 pA0, pA1, pB0, pB1; float mnA, mnB, alA, alB; bf16x8 pa0, pa1, pa2, pa3; const int NT = seq / KVBLK;
#define BLK_X(N0, N1, P0, P1, alP, t) do { SBAR(); qkt(N0, N1, KBUF((t) & 3), qr, r32, hi, mapB); finishSM<SH>(P0, P1, alP, l_reg, pa0, pa1, pa2, pa3); SBAR(); } while (0)
#define BLK_Y(C0, C1, mnC, alC, t) do { pv_d0(o, VBUF((t) & 3), pa0, pa1, pa2, pa3); partialSM<SH>(C0, C1, m_reg, mnC, alC); RESC(alC); } while (0)
  const int ty = STAGGER_MAP ? mp : (wid & 1);
  DMA(0, 0); LANDED();
  DMA(1, 1);
  if (ty == 0) {
    qkt(pA0, pA1, KBUF(0), qr, r32, hi, mapB); partialSM<SH>(pA0, pA1, m_reg, mnA, alA);
    LANDED();
    for (int j = 1; j + 1 < NT; j += 2) {
      DMA(j + 1, (j + 1) & 3); BLK_X(pB0, pB1, pA0, pA1, alA, j); BLK_Y(pB0, pB1, mnB, alB, j - 1); LANDED();
      DMA(j + 2, (j + 2) & 3); BLK_X(pA0, pA1, pB0, pB1, alB, j + 1); BLK_Y(pA0, pA1, mnA, alA, j); LANDED();
    }
    BLK_X(pB0, pB1, pA0, pA1, alA, NT - 1); BLK_Y(pB0, pB1, mnB, alB, NT - 2);
    finishSM<SH>(pB0, pB1, alB, l_reg, pa0, pa1, pa2, pa3); SBAR();
    pv_d0(o, VBUF((NT - 1) & 3), pa0, pa1, pa2, pa3);
  } else {
    qkt(pA0, pA1, KBUF(0), qr, r32, hi, mapB);
    LANDED();
    DMA(2, 2); partialSM<SH>(pA0, pA1, m_reg, mnA, alA); BLK_X(pB0, pB1, pA0, pA1, alA, 1); LANDED();
    for (int j = 2; j + 2 < NT; j += 2) {
      DMA(j + 1, (j + 1) & 3); BLK_Y(pB0, pB1, mnB, alB, j - 2); BLK_X(pA0, pA1, pB0, pB1, alB, j); LANDED();
      DMA(j + 2, (j + 2) & 3); BLK_Y(pA0, pA1, mnA, alA, j - 1); BLK_X(pB0, pB1, pA0, pA1, alA, j + 1); LANDED();
    }
    DMA(NT - 1, (NT - 1) & 3); BLK_Y(pB0, pB1, mnB, alB, NT - 4); BLK_X(pA0, pA1, pB0, pB1, alB, NT - 2); LANDED();
    BLK_Y(pA0, pA1, mnA, alA, NT - 3); BLK_X(pB0, pB1, pA0, pA1, alA, NT - 1);
    BLK_Y(pB0, pB1, mnB, alB, NT - 2);
    finishSM<SH>(pB0, pB1, alB, l_reg, pa0, pa1, pa2, pa3); SBAR();
    pv_d0(o, VBUF((NT - 1) & 3), pa0, pa1, pa2, pa3);
  }
#undef BLK_X
#undef BLK_Y
  if (hi == 0) li_l[r32] = l_reg; asm volatile("s_waitcnt lgkmcnt(0)" ::: "memory");
  float rli[16];
#pragma unroll
  for (int r = 0; r < 16; ++r) rli[r] = __builtin_amdgcn_rcpf(li_l[crow(r, hi)]);
  __syncthreads();
  float* X = (float*)lds;
  if (mp == 1) {
#pragma unroll
    for (int d = 0; d < 4; ++d)
#pragma unroll
      for (int r = 0; r < 16; ++r) X[(wq * 64 + d * 16 + r) * 64 + lane] = o[d][r] * rli[r] * lam;
  }
  __syncthreads();
  if (mp == 0) {
#pragma unroll
    for (int d = 0; d < 4; ++d)
#pragma unroll
      for (int r = 0; r < 16; ++r) { const int ix = (wq * 64 + d * 16 + r) * 64 + lane; X[ix] = o[d][r] * rli[r] - X[ix]; }
  }
  __syncthreads();
  {
    const int row = tid >> 2, dq = tid & 3, rl = row & 31, w = row >> 5, hh = (rl >> 2) & 1, r = (rl & 3) + 4 * (rl >> 3);
    const float* xb = X + (w * 64 + dq * 16 + r) * 64 + hh * 32;
    f32x4 a[8]; float ss = 0.f;
#pragma unroll
    for (int i = 0; i < 8; ++i) { a[i] = *(const f32x4*)(xb + i * 4); ss += a[i][0] * a[i][0] + a[i][1] * a[i][1] + a[i][2] * a[i][2] + a[i][3] * a[i][3]; }
    ss += __shfl_xor(ss, 1); ss += __shfl_xor(ss, 2);
    const float rn = __builtin_amdgcn_rsqf(ss * (1.f / 128.f) + 1e-5f) * oscale;
    bf16_t* zp = proj + (size_t)(tok0 + row) * NPROJ + C_ZA + h * 128 + dq * 32;
    const float* gg = subg + dq * 32;
#pragma unroll
    for (int i = 0; i < 4; ++i) {
      const u32x4 z = *(const u32x4*)(zp + i * 8);
      const f32x4 a0 = a[2 * i], a1 = a[2 * i + 1]; const f32x4 g0 = *(const f32x4*)(gg + i * 8), g1 = *(const f32x4*)(gg + i * 8 + 4);
      u32x4 wv;
      wv.x = cvtpk(a0[0] * rn * g0[0] * silu(bflo(z.x)), a0[1] * rn * g0[1] * silu(bfhi(z.x)));
      wv.y = cvtpk(a0[2] * rn * g0[2] * silu(bflo(z.y)), a0[3] * rn * g0[3] * silu(bfhi(z.y)));
      wv.z = cvtpk(a1[0] * rn * g1[0] * silu(bflo(z.z)), a1[1] * rn * g1[1] * silu(bfhi(z.z)));
      wv.w = cvtpk(a1[2] * rn * g1[2] * silu(bflo(z.w)), a1[3] * rn * g1[3] * silu(bfhi(z.w)));
      if (!dry) *(u32x4*)(zp + i * 8) = wv;
    }
  }
  __syncthreads();
#undef DMA
#undef GLDS16
#undef KBUF
#undef VBUF
#undef LANDED
#undef RESC
}

__device__ void attn_phase(const Params& p, int l, char* lds, bool dry = false) {
  const float lam = p.lam[l];
  const float oscale = 1.f - (0.8f - 0.6f * expf(-0.3f * (float)l));
  const float* subg = p.subln_g + l * 128;
  for (int u = blockIdx.x; u < 2048; u += gridDim.x) {
    int tok0, kv0, seq, h;
    if (u < 1024) { const int x = u & 7, j = u >> 3; const int b = x >> 2; h = x & 3; seq = S_P; kv0 = b * S_P; tok0 = kv0 + j * 128; }
    else { const int v = u - 1024, x = v & 7, j = v >> 3; const int pr = x * 4 + (j >> 5), b = pr >> 2; h = pr & 3; seq = S_S; kv0 = TP + b * S_S; tok0 = kv0 + (j & 31) * 128; }
    bool need;
    { const int tid = opaque_tid(), wid = tid >> 6, lane = tid & 63, r32 = lane & 31, hi = lane >> 5, wq = wid & 3, mp = wid >> 2;
      const int sq = tok0 < TP ? (tok0 >> 14) : 2 + ((tok0 - TP) >> 12);
      const float* km = p.kmax2 + ((l * 10 + sq) * 4 + h) * 4 + mp * 2;
      const float kmx = sqrtf(km[0] + km[1]) * 1.01f;
      const bf16_t* Qw = p.proj + (size_t)(tok0 + wq * 32 + r32) * NPROJ + C_Q + h * 128 + mp * 64 + hi * 8;
      float ss = 0.f;
#pragma unroll
      for (int d0 = 0; d0 < 4; ++d0) { const u32x4 w = *(const u32x4*)(Qw + d0 * 16);
        ss += bflo(w.x) * bflo(w.x) + bfhi(w.x) * bfhi(w.x) + bflo(w.y) * bflo(w.y) + bfhi(w.y) * bfhi(w.y) + bflo(w.z) * bflo(w.z) + bfhi(w.z) * bfhi(w.z) + bflo(w.w) * bflo(w.w) + bfhi(w.w) * bfhi(w.w); }
      ss += __shfl_xor(ss, 32);
      need = __any(!(sqrtf(ss) * kmx < 100.f)) != 0; }
    if (need) attn_unit<true>(p.proj, tok0, kv0, seq, h, lam, oscale, subg, lds, dry);
    else attn_unit<false>(p.proj, tok0, kv0, seq, h, lam, oscale, subg, lds, dry);
  }
}
}

__device__ void post_phase(const Params& p, int l) {
  const int tid = opaque_tid(), wid = tid >> 6, lane = tid & 63, nw = blockDim.x >> 6;
  const float* pg = p.post_g + l * DM;
  constexpr int R = 2;
  for (int row0 = (blockIdx.x * nw + wid) * R; row0 < T_TOK; row0 += gridDim.x * nw * R) {
    f32x4 y[R][4], x[R][4]; u32x2 xh[R][4], xl[R][4], yb[R][4];
#pragma unroll
    for (int q = 0; q < R; ++q) {
      const int row = row0 + q;
      const bf16_t* yr = p.proj + (size_t)row * NPROJ + C_U;
#pragma unroll
      for (int i = 0; i < 4; ++i) yb[q][i] = *(const u32x2*)(yr + i * 256 + lane * 4);
      if (l == 0) {
        const float* xr = row < TP ? p.xp + (size_t)row * DM : p.xs + (size_t)(row - TP) * DM;
#pragma unroll
        for (int i = 0; i < 4; ++i) x[q][i] = *(const f32x4*)(xr + i * 256 + lane * 4);
      } else {
        const bf16_t* xo = (const bf16_t*)p.out + (size_t)row * LDX;
#pragma unroll
        for (int i = 0; i < 4; ++i) { xh[q][i] = *(const u32x2*)(xo + i * 256 + lane * 4); xl[q][i] = *(const u32x2*)(xo + DM + i * 256 + lane * 4); }
      }
    }
#pragma unroll
    for (int q = 0; q < R; ++q) {
      const int row = row0 + q;
      bf16_t* xo = (bf16_t*)p.out + (size_t)row * LDX;
      float ss = 0.f;
#pragma unroll
      for (int i = 0; i < 4; ++i) { y[q][i] = (f32x4){bflo(yb[q][i].x), bfhi(yb[q][i].x), bflo(yb[q][i].y), bfhi(yb[q][i].y)};
        ss += y[q][i][0] * y[q][i][0] + y[q][i][1] * y[q][i][1] + y[q][i][2] * y[q][i][2] + y[q][i][3] * y[q][i][3]; }
      if (l != 0) {
#pragma unroll
        for (int i = 0; i < 4; ++i) {
          const u32x2 h = xh[q][i], lo = xl[q][i];
          x[q][i][0] = bflo(h.x) + bflo(lo.x); x[q][i][1] = bfhi(h.x) + bfhi(lo.x); x[q][i][2] = bflo(h.y) + bflo(lo.y); x[q][i][3] = bfhi(h.y) + bfhi(lo.y);
        }
      }
      ss = wave_sum(ss);
      const float ry = __builtin_amdgcn_rsqf(ss * (1.f / DM) + 1e-6f);
      float s2 = 0.f;
#pragma unroll
      for (int i = 0; i < 4; ++i) {
        const f32x4 g = *(const f32x4*)(pg + i * 256 + lane * 4);
#pragma unroll
        for (int e = 0; e < 4; ++e) { x[q][i][e] = x[q][i][e] + y[q][i][e] * ry * g[e]; s2 += x[q][i][e] * x[q][i][e]; }
      }
      if (l == DEPTH - 1) {
        float* orow = p.out + (size_t)row * DM;
#pragma unroll
        for (int i = 0; i < 4; ++i) *(f32x4*)(orow + i * 256 + lane * 4) = x[q][i];
      } else {
        s2 = wave_sum(s2);
        if (lane == 0) p.rinv[row] = __builtin_amdgcn_rsqf(s2 * (1.f / DM) + 1e-6f);
#pragma unroll
        for (int i = 0; i < 4; ++i) {
          const unsigned h0 = cvtpk(x[q][i][0], x[q][i][1]), h1 = cvtpk(x[q][i][2], x[q][i][3]);
          const unsigned l0 = cvtpk(x[q][i][0] - bflo(h0), x[q][i][1] - bfhi(h0)), l1 = cvtpk(x[q][i][2] - bflo(h1), x[q][i][3] - bfhi(h1));
          *(u32x2*)(xo + i * 256 + lane * 4) = (u32x2){h0, h1}; *(u32x2*)(xo + DM + i * 256 + lane * 4) = (u32x2){l0, l1};
        }
      }
    }
  }
}

#define XB_TMO      128
#define XB_XCNT(j)  (256  + 64 * (j))
#define XB_XSUB(j)  (1280 + 64 * (j))
#define XB_XGEN(j)  (2304 + 64 * (j))
#define XB_TOP      3328
#define XB_TOPGEN   3392
#define XB_SPIN_CAP (1u << 22)
#define XLAS __attribute__((address_space(3)))
__device__ __forceinline__ unsigned xb_ld(unsigned* p)              { return __hip_atomic_load(p, __ATOMIC_RELAXED, __HIP_MEMORY_SCOPE_AGENT); }
__device__ __forceinline__ unsigned xb_add(unsigned* p, unsigned v) { return __hip_atomic_fetch_add(p, v, __ATOMIC_RELAXED, __HIP_MEMORY_SCOPE_AGENT); }
__device__ __forceinline__ unsigned xb_xcc_id() { return (unsigned)__builtin_amdgcn_s_getreg((3 << 11) | 20) & 0xFu; }
#define XB_SPIN(cond, bar) do { unsigned _sp = 0; while (cond) { __builtin_amdgcn_s_sleep(1); \
    if ((++_sp & 255u) == 0u) { if (xb_ld(&(bar)[XB_TMO])) break; if (_sp > XB_SPIN_CAP) { atomicAdd(&(bar)[XB_TMO], 1u); break; } } } } while (0)
struct XcdBarrier { unsigned* bar; unsigned x; volatile XLAS unsigned* st; };
__device__ __forceinline__ XcdBarrier xcd_barrier_post(unsigned* bar, volatile XLAS unsigned* st) {
  XcdBarrier b; b.bar = bar; b.x = xb_xcc_id(); b.st = st;
  if (threadIdx.x == 0) (void)xb_add(&bar[XB_XCNT(b.x)], 1u);
  return b;
}
__device__ __forceinline__ void xcd_barrier_complete(unsigned* bar, unsigned x, unsigned& nloc, unsigned& nx) {
  const unsigned G = gridDim.x * gridDim.y * gridDim.z;
  unsigned sum, cnt, mine, sp = 0u;
  for (;;) {
    sum = 0u; cnt = 0u; mine = 0u;
#pragma unroll
    for (unsigned j = 0; j < 16; ++j) { const unsigned c = xb_ld(&bar[XB_XCNT(j)]); sum += c; cnt += (c > 0u) ? 1u : 0u; mine = (j == x) ? c : mine; }
    if (sum == G) break;
    __builtin_amdgcn_s_sleep(1);
    if ((++sp & 255u) == 0u) { if (xb_ld(&bar[XB_TMO])) break; if (sp > XB_SPIN_CAP) { atomicAdd(&bar[XB_TMO], 1u); break; } }
  }
  nloc = mine > 0u ? mine : 1u; nx = cnt > 0u ? cnt : 1u;
}
__device__ __forceinline__ void xcd_barrier(const XcdBarrier& b) {
  asm volatile("s_waitcnt vmcnt(0)" ::: "memory");
  __syncthreads();
  if (threadIdx.x == 0) {
    unsigned* bar = b.bar;
    __builtin_amdgcn_s_waitcnt(0);
    unsigned nloc = b.st[0], nx = b.st[1];
    if (nloc == 0u) { xcd_barrier_complete(bar, b.x, nloc, nx); b.st[0] = nloc; b.st[1] = nx; }
    const unsigned old = xb_add(&bar[XB_XSUB(b.x)], 1u);
    const unsigned gen = old / nloc;
    if (old + 1u == (gen + 1u) * nloc) {
      __builtin_amdgcn_fence(__ATOMIC_RELEASE, "agent");
      asm volatile("s_waitcnt vmcnt(0)" ::: "memory");
      const unsigned og = xb_add(&bar[XB_TOP], 1u);
      const unsigned tg = og / nx;
      if (og + 1u == (tg + 1u) * nx) xb_add(&bar[XB_TOPGEN], 1u);
      else XB_SPIN(xb_ld(&bar[XB_TOPGEN]) == tg, bar);
      __builtin_amdgcn_fence(__ATOMIC_ACQUIRE, "agent");
      xb_add(&bar[XB_XGEN(b.x)], 1u);
      asm volatile("s_waitcnt vmcnt(0)" ::: "memory");
    } else {
      XB_SPIN(xb_ld(&bar[XB_XGEN(b.x)]) == gen, bar);
      __builtin_amdgcn_fence(__ATOMIC_ACQUIRE, "agent");
      asm volatile("s_waitcnt vmcnt(0)" ::: "memory");
    }
  }
  __syncthreads();
}

__device__ __forceinline__ void run_phase(const Params& p, int ph, char* shm) {
  if (ph == 0) { phase0(p, shm); return; }
  const int l = (ph - 1) >> 2, s = (ph - 1) & 3;
  if (s == 0) { gm::EpiIn e{p.rinv, p.rope, p.proj, p.kmax2 + l * 160}; gm::gemm_phase(( const bf16_t*)p.out, LDX, p.WinT + (size_t)l * NPROJ * DM, NPROJ, e, shm); }
  else if (s == 1) { pool_phase(p, l); at::attn_phase(p, l, shm); }
  else if (s == 2) { gm::EpiOut e{p.proj}; gm::gemm_phase(p.proj, NPROJ, p.WoutT + (size_t)l * DM * DM, DM, e, shm); }
  else post_phase(p, l);
}

#if MK_MULTI
template <int S> __global__ void __launch_bounds__(NT_THREADS, 1) k_phase(Params p, int l) {
  extern __shared__ __attribute__((aligned(16))) char shm[];
  if (S == 0) phase0(p, shm); else run_phase(p, 1 + 4 * l + (S - 1), shm);
}
#else
__global__ void __launch_bounds__(NT_THREADS, 1) k_mega(Params p) {
  extern __shared__ __attribute__((aligned(16))) char shm[];
  cg::grid_group grid = cg::this_grid();
  volatile XLAS unsigned* xst = (volatile XLAS unsigned*)(XLAS char*)(shm + 131072 + 3072);
  if (threadIdx.x == 0) { xst[0] = 0u; xst[1] = 0u; xst[2] = 0u; xst[3] = 0u; }
  phase0(p, shm);
  grid.sync();
  const XcdBarrier xb = xcd_barrier_post(p.bar, xst);
#define GSYNC() xcd_barrier(xb)
  for (int l = 0; l < DEPTH; ++l) {
#if REP_GEMM
    { gm::EpiIn e{p.rinv, p.rope, p.proj, p.kmax2 + l * 160}; gm::gemm_phase((const bf16_t*)p.out, LDX, p.WinT + (size_t)l * NPROJ * DM, NPROJ, e, shm); }
    GSYNC();
#endif
    { gm::EpiIn e{p.rinv, p.rope, p.proj, p.kmax2 + l * 160}; gm::gemm_phase((const bf16_t*)p.out, LDX, p.WinT + (size_t)l * NPROJ * DM, NPROJ, e, shm); }
    GSYNC();
    pool_phase(p, l);
#if REP_ATT
    at::attn_phase(p, l, shm, true); GSYNC();
#endif
    at::attn_phase(p, l, shm);
    GSYNC();
#if REP_GEMM
    { gm::EpiOut e{p.proj}; gm::gemm_phase(p.proj, NPROJ, p.WoutT + (size_t)l * DM * DM, DM, e, shm); }
    GSYNC();
#endif
    { gm::EpiOut e{p.proj}; gm::gemm_phase(p.proj, NPROJ, p.WoutT + (size_t)l * DM * DM, DM, e, shm); }
    GSYNC();
#if REP_POST
    if (l == 0) { post_phase(p, l); GSYNC(); }
#endif
    post_phase(p, l);
    if (l + 1 < DEPTH) GSYNC();
  }
}
#endif

extern "C" void kernel_launch(void* const* d_in, const int* in_sizes, int n_in, void* d_out, int out_size, void* d_ws, size_t ws_size, hipStream_t stream) {
  Params p{};
  p.xp = (const float*)d_in[0]; p.xs = (const float*)d_in[1]; p.pre_g = (const float*)d_in[2]; p.w_in = (const float*)d_in[3];
  p.pool_w = (const float*)d_in[4]; p.pool_scale = (const float*)d_in[5]; p.lq1 = (const float*)d_in[6]; p.lk1 = (const float*)d_in[7];
  p.lq2 = (const float*)d_in[8]; p.lk2 = (const float*)d_in[9]; p.subln_g = (const float*)d_in[10]; p.w_out = (const float*)d_in[11]; p.post_g = (const float*)d_in[12];
  p.out = (float*)d_out;
  char* w = (char*)d_ws; size_t off = 0;
  p.proj = (bf16_t*)(w + off); off += (size_t)T_TOK * NPROJ * 2;
  p.WinT = (bf16_t*)(w + off); off += (size_t)DEPTH * NPROJ * DM * 2;
  p.WoutT = (bf16_t*)(w + off); off += (size_t)DEPTH * DM * DM * 2;
  p.rinv = (float*)(w + off); off += (size_t)T_TOK * 4;
  p.rope = (float*)(w + off); off += 256;
  p.lam = (float*)(w + off); off += 256;
  p.kmax2 = (float*)(w + off); off += 2048;
  p.bar = (unsigned*)(w + off); off += 16384;
  if (off > ws_size) { fprintf(stderr, "kernel_launch: workspace too small (%zu > %zu)\n", off, ws_size); return; }
#if MK_MULTI
  static int ok = 0;
  if (!ok) {
    (void)hipFuncSetAttribute((const void*)k_phase<0>, hipFuncAttributeMaxDynamicSharedMemorySize, (int)SHM_BYTES);
    (void)hipFuncSetAttribute((const void*)k_phase<1>, hipFuncAttributeMaxDynamicSharedMemorySize, (int)SHM_BYTES);
    (void)hipFuncSetAttribute((const void*)k_phase<2>, hipFuncAttributeMaxDynamicSharedMemorySize, (int)SHM_BYTES);
    (void)hipFuncSetAttribute((const void*)k_phase<3>, hipFuncAttributeMaxDynamicSharedMemorySize, (int)SHM_BYTES);
    (void)hipFuncSetAttribute((const void*)k_phase<4>, hipFuncAttributeMaxDynamicSharedMemorySize, (int)SHM_BYTES);
    ok = 1; }
  hipLaunchKernelGGL(k_phase<0>, dim3(256), dim3(NT_THREADS), SHM_BYTES, stream, p, 0);
  for (int l = 0; l < DEPTH; ++l) {
    hipLaunchKernelGGL(k_phase<1>, dim3(256), dim3(NT_THREADS), SHM_BYTES, stream, p, l);
    hipLaunchKernelGGL(k_phase<2>, dim3(256), dim3(NT_THREADS), SHM_BYTES, stream, p, l);
    hipLaunchKernelGGL(k_phase<3>, dim3(256), dim3(NT_THREADS), SHM_BYTES, stream, p, l);
    hipLaunchKernelGGL(k_phase<4>, dim3(256), dim3(NT_THREADS), SHM_BYTES, stream, p, l);
  }
#else
  static int grid_blocks = 0;
  if (!grid_blocks) {
    (void)hipFuncSetAttribute((const void*)k_mega, hipFuncAttributeMaxDynamicSharedMemorySize, (int)SHM_BYTES);
    int dev = 0, cus = 0, per_cu = 0;
    (void)hipGetDevice(&dev);
    (void)hipDeviceGetAttribute(&cus, hipDeviceAttributeMultiprocessorCount, dev);
    (void)hipOccupancyMaxActiveBlocksPerMultiprocessor(&per_cu, k_mega, NT_THREADS, SHM_BYTES);
    if (per_cu > 1) per_cu = 1;
    grid_blocks = cus * per_cu;
  }
  void* args[] = {&p};
  hipError_t e = hipLaunchCooperativeKernel((void*)k_mega, dim3(grid_blocks), dim3(NT_THREADS), args, SHM_BYTES, stream);
  if (e != hipSuccess) fprintf(stderr, "cooperative launch failed: %s (grid %d)\n", hipGetErrorString(e), grid_blocks);
#endif
}
```

```cpp
#include <hip/hip_runtime.h>
#include <hip/hip_cooperative_groups.h>
#include <cstdio>
#include <cstdint>
namespace cg = cooperative_groups;

#ifndef REP_ATT
#define REP_ATT 0
#endif
#ifndef STAGGER_MAP
#define STAGGER_MAP 1
#endif
#ifndef REP_POST
#define REP_POST 0
#endif
#ifndef REP_GEMM
#define REP_GEMM 0
#endif
#ifndef MK_MULTI
#define MK_MULTI 0
#endif

typedef unsigned short bf16_t;
using bf16x8 = __attribute__((ext_vector_type(8))) short;
using s16x4  = __attribute__((ext_vector_type(4))) short;
using f32x16 = __attribute__((ext_vector_type(16))) float;
using f32x4  = __attribute__((ext_vector_type(4))) float;
using u32x4  = __attribute__((ext_vector_type(4))) unsigned;
using u32x2  = __attribute__((ext_vector_type(2))) unsigned;

#define XCD_BAR_WORDS 3456
constexpr int NT_THREADS = 512;
constexpr int T_TOK = 65536, TP = 32768, DM = 1024, NPROJ = 3072, DEPTH = 2;
constexpr int S_P = 16384, S_S = 4096;
constexpr int C_ZP = 0, C_ZA = 512, C_U = 1024, C_Q = 1536, C_K = 2048, C_V = 2560;
constexpr int LDX = 2048;
constexpr float QSCALE = 0.125f * 1.4426950408889634f;
constexpr size_t SHM_BYTES = 131072 + 4096;

struct Params {
  const float* xp; const float* xs; const float* pre_g; const float* w_in; const float* pool_w; const float* pool_scale;
  const float* lq1; const float* lk1; const float* lq2; const float* lk2; const float* subln_g; const float* w_out; const float* post_g;
  float* out; bf16_t* WinT; bf16_t* WoutT; bf16_t* proj; float* rinv; float* rope; float* lam; float* kmax2; unsigned* bar;
};

#define SBAR() __builtin_amdgcn_sched_barrier(0)
__device__ __forceinline__ unsigned cvtpk(float lo, float hi) {
  unsigned r; asm volatile("v_cvt_pk_bf16_f32 %0, %1, %2" : "=v"(r) : "v"(lo), "v"(hi)); return r;
}
__device__ __forceinline__ float bf2f(unsigned short b) { return __uint_as_float(((unsigned)b) << 16); }
__device__ __forceinline__ float bflo(unsigned w) { return __uint_as_float(w << 16); }
__device__ __forceinline__ float bfhi(unsigned w) { return __uint_as_float(w & 0xffff0000u); }
__device__ __forceinline__ bf16_t f2bf(float f) { return (bf16_t)(cvtpk(f, 0.f) & 0xffffu); }
__host__ __device__ __forceinline__ int perm32(int rho) { const int n = rho >> 4, i = rho & 15; return 8 * (i >> 2) + 4 * n + (i & 3); }
__device__ __forceinline__ float silu(float z) { return z * __builtin_amdgcn_rcpf(1.f + __builtin_amdgcn_exp2f(-1.4426950408889634f * z)); }
__device__ __forceinline__ int opaque_tid() { int t = threadIdx.x; asm volatile("" : "+v"(t)); return t; }
__device__ __forceinline__ float wave_sum(float v) {
#pragma unroll
  for (int o = 32; o >= 1; o >>= 1) v += __shfl_xor(v, o);
  return v;
}

__device__ __forceinline__ int src_col_in(int s) {
  const int type = s >> 9, within = s & 511;
  if (type == 0) return 512 + within;
  if (type == 1) return 2560 + within;
  if (type == 5) return 2048 + within;
  const int p = within & 63, wcl = p >> 5, fq = (p >> 3) & 3, n = (p >> 2) & 1, jj = p & 3;
  const int d = wcl * 16 + fq * 4 + jj + 32 * n;
  return (type == 3 ? 1024 : 1536) + (within & ~63) + d;
}

__device__ void phase0(const Params& p, char* shm) {
  const int tid = opaque_tid(), nth = blockDim.x;
  float* tile = (float*)shm;
  float* Wt = tile + 64 * 65 + 32;
  float* Pw = Wt + 64 * 128;
  constexpr int NT_U = DEPTH * 8 * 16, NT_IN = DEPTH * 40 * 16, NT_OUT = DEPTH * 16 * 16;
  for (int it = blockIdx.x; it < NT_U + NT_IN + NT_OUT; it += gridDim.x) {
    __syncthreads();
    if (it < NT_U + NT_IN) {
      int l, n0, k0; const bool isu = it < NT_U;
      if (isu) { l = it / 128; const int r = it % 128; n0 = C_U + (r / 16) * 64; k0 = (r % 16) * 64; }
      else { const int i2 = it - NT_U; l = i2 / 640; const int r = i2 % 640; int nt = r / 16; if (nt >= 16) nt += 8; n0 = nt * 64; k0 = (r % 16) * 64; }
      const float* W = p.w_in + (size_t)l * DM * NPROJ; const float* g = p.pre_g + l * DM;
      if (isu) {
        const int gi = (n0 - C_U) >> 7, d0 = (n0 - C_U) & 127;
        for (int e = tid; e < 64 * 128; e += nth) { const int c = e & 127, kk = e >> 7; Wt[e] = W[(size_t)(k0 + kk) * NPROJ + gi * 128 + c]; }
        for (int e = tid; e < 128 * 64; e += nth) { const int d = e & 63, c = e >> 6; Pw[e] = p.pool_w[((size_t)(l * 4 + gi) * 128 + c) * 128 + d0 + d]; }
        __syncthreads();
        for (int e = tid; e < 4096; e += nth) {
          const int nn = e & 63, kk = e >> 6, nrow = n0 + nn; const int s = (nrow & ~31) + perm32(nrow & 31), dl = s - n0;
          float a = 0.f;
#pragma unroll 8
          for (int c = 0; c < 128; ++c) a = fmaf(Wt[kk * 128 + c], Pw[c * 64 + dl], a);
          tile[kk * 65 + nn] = a * g[k0 + kk];
        }
      } else {
        for (int e = tid; e < 4096; e += nth) {
          const int nn = e & 63, kk = e >> 6, k = k0 + kk, nrow = n0 + nn;
          const int s = (nrow & ~31) + perm32(nrow & 31);
          tile[kk * 65 + nn] = W[(size_t)k * NPROJ + src_col_in(s)] * g[k];
        }
      }
      __syncthreads();
      bf16_t* O = p.WinT + (size_t)l * NPROJ * DM;
      for (int e = tid; e < 4096; e += nth) { const int kk = e & 63, nn = e >> 6; O[(size_t)(n0 + nn) * DM + k0 + kk] = f2bf(tile[kk * 65 + nn]); }
    } else {
      const int it2 = it - NT_U - NT_IN, l = it2 / 256, r = it2 % 256, n0 = (r / 16) * 64, k0 = (r % 16) * 64;
      const float* W = p.w_out + (size_t)l * DM * DM;
      for (int e = tid; e < 4096; e += nth) {
        const int nn = e & 63, kk = e >> 6, nrow = n0 + nn; const int s = (nrow & ~31) + perm32(nrow & 31);
        tile[kk * 65 + nn] = W[(size_t)(k0 + kk) * DM + s];
      }
      __syncthreads();
      bf16_t* O = p.WoutT + (size_t)l * DM * DM;
      for (int e = tid; e < 4096; e += nth) { const int kk = e & 63, nn = e >> 6; O[(size_t)(n0 + nn) * DM + k0 + kk] = f2bf(tile[kk * 65 + nn]); }
    }
  }
  if (blockIdx.x == 0) {
    for (int i = tid; i < XCD_BAR_WORDS; i += nth) p.bar[i] = 0u;
    if (tid < DEPTH * 160) p.kmax2[tid] = 0.f;
    if (tid < 32) { const double c = exp(-(double)tid * (9.210340371976184 / 32.0)) * 0.15915494309189535; const float h = (float)c; p.rope[2 * tid] = h; p.rope[2 * tid + 1] = (float)(c - (double)h); }
    if (tid >= 64 && tid < 64 + 64 * DEPTH) {
      const int l = (tid >> 6) - 1, i = tid & 63;
      float a = p.lq1[l * 64 + i] * p.lk1[l * 64 + i], b = p.lq2[l * 64 + i] * p.lk2[l * 64 + i];
      a = wave_sum(a); b = wave_sum(b);
      const float li = 0.8f - 0.6f * expf(-0.3f * (float)l);
      if (i == 0) p.lam[l] = expf(a) - expf(b) + li;
    }
  }
  const int wid = tid >> 6, lane = tid & 63, nw = nth >> 6;
  for (int row0 = (blockIdx.x * nw + wid) * 2; row0 < T_TOK; row0 += gridDim.x * nw * 2) {
    f32x4 v[2][4];
#pragma unroll
    for (int q = 0; q < 2; ++q) {
      const int row = row0 + q;
      const float* xr = row < TP ? p.xp + (size_t)row * DM : p.xs + (size_t)(row - TP) * DM;
#pragma unroll
      for (int i = 0; i < 4; ++i) v[q][i] = *(const f32x4*)(xr + i * 256 + lane * 4);
    }
#pragma unroll
    for (int q = 0; q < 2; ++q) {
      const int row = row0 + q;
      bf16_t* xo = (bf16_t*)p.out + (size_t)row * LDX;
      float ss = 0.f;
#pragma unroll
      for (int i = 0; i < 4; ++i) {
        ss += v[q][i][0] * v[q][i][0] + v[q][i][1] * v[q][i][1] + v[q][i][2] * v[q][i][2] + v[q][i][3] * v[q][i][3];
        u32x2 w = {cvtpk(v[q][i][0], v[q][i][1]), cvtpk(v[q][i][2], v[q][i][3])};
        *(u32x2*)(xo + i * 256 + lane * 4) = w;
      }
      ss = wave_sum(ss);
      if (lane == 0) p.rinv[row] = __builtin_amdgcn_rsqf(ss * (1.f / DM) + 1e-6f);
    }
  }
}

namespace gm {
constexpr int BM = 256, BK = 64, HALF = 128, NXCD = 8, WGM = 8, HT = HALF * BK;
__device__ __forceinline__ int lds_byte(int r, int c) { int st = (r >> 4) * 2 + (c >> 5), rr = r & 15, cc = c & 31, ob = rr * 64 + cc * 2; return st * 1024 + (ob ^ (((ob >> 9) & 1) << 5)); }
__device__ __forceinline__ void stage_rc(int b, int& R, int& C) { int st = b / 1024, sb = b % 1024, swz = sb ^ (((sb >> 9) & 1) << 5); R = (st >> 1) * 16 + swz / 64; C = (st & 1) * 32 + (swz % 64) / 2; }

#define LAS __attribute__((address_space(3)))
template <class Epi>
__device__ __forceinline__ void gemm_phase(const bf16_t* __restrict__ A, const int lda, const bf16_t* __restrict__ Bt, const int N, const Epi& E, char* shmc) {
  constexpr int K = 1024, nt = K / BK, HTB = HALF * BK * 2;
  LAS unsigned char* lds = (LAS unsigned char*)shmc;
  const int tid = opaque_tid(), wid = __builtin_amdgcn_readfirstlane(tid >> 6), lane = tid & 63, wr = wid >> 2, wc = wid & 3, fr = lane & 15, fq = lane >> 4;
  unsigned voffA[2], voffB[2];
#pragma unroll
  for (int i = 0; i < 2; ++i) { int R, C; stage_rc(tid * 16 + i * 8192, R, C); voffA[i] = (unsigned)(R * lda + C) * 2u; voffB[i] = (unsigned)(R * K + C) * 2u; }
  const size_t kstep = (size_t)(BK * 2);
  const size_t hstepA = (size_t)HALF * lda * 2, hstepB = (size_t)HALF * K * 2;
  const size_t tstepA = 2 * hstepA, tstepB = 2 * hstepB;
  const unsigned ldsw = (unsigned)wid * 1024u;
  const int aoff = lds_byte(wr * 64 + fr, fq * 8), boff = lds_byte(wc * 32 + fr, fq * 8);
#define PG8_SA(b, h) (((b) * 2 + (h)) * HTB)
#define PG8_SB(b, h) ((4 + (b) * 2 + (h)) * HTB)
#define PG8_STAGE(bufoff, gbase, voff) do { _Pragma("unroll") for (int _i = 0; _i < 2; ++_i) \
        __builtin_amdgcn_global_load_lds((const unsigned*)((const char*)(gbase) + (voff)[_i]), (LAS unsigned*)(lds + (bufoff) + ldsw + _i * 8192), 16, 0, 0); } while (0)
#define PG8_LDA(dst, b, h) do { _Pragma("unroll") for (int m = 0; m < 4; ++m) _Pragma("unroll") for (int k = 0; k < 2; ++k) dst[m][k] = *(const LAS bf16x8*)(lds + PG8_SA(b, h) + aoff + m * 2048 + k * 1024); } while (0)
#define PG8_LDB(dst, b, h) do { _Pragma("unroll") for (int n = 0; n < 2; ++n) _Pragma("unroll") for (int k = 0; k < 2; ++k) dst[n][k] = *(const LAS bf16x8*)(lds + PG8_SB(b, h) + boff + n * 2048 + k * 1024); } while (0)
#define PG8_MMA(ai, bj, At, Bx) do { __builtin_amdgcn_s_setprio(1); _Pragma("unroll") for (int m = 0; m < 4; ++m) _Pragma("unroll") for (int n = 0; n < 2; ++n) _Pragma("unroll") for (int k = 0; k < 2; ++k) \
        acc[ai][bj][m][n] = __builtin_amdgcn_mfma_f32_16x16x32_bf16(Bx[n][k], At[m][k], acc[ai][bj][m][n], 0, 0, 0); __builtin_amdgcn_s_setprio(0); } while (0)
#define PG8_WAIT_V(n) asm volatile("s_waitcnt vmcnt(" #n ")" ::: "memory")
#define PG8_WAIT_L(n) asm volatile("s_waitcnt lgkmcnt(" #n ")" ::: "memory")
#define PG8_BAR __builtin_amdgcn_s_barrier()
#define PG8_SCHED __builtin_amdgcn_sched_barrier(0)
  const int nM = T_TOK / BM, nN = N / BM, nwg = nM * nN, G = gridDim.x, cblk = blockIdx.x;
  auto next_unit = [&](int i, int& pm, int& pn) -> bool {
    const long L = (long)i * G + cblk; if (L >= nwg) return false;
    int wgid = (int)L; { const int q = nwg / NXCD, r = nwg % NXCD, xcd = wgid % NXCD, off = wgid / NXCD; wgid = (xcd < r ? xcd * (q + 1) : r * (q + 1) + (xcd - r) * q) + off; }
    const int nig = WGM * nN, gid = wgid / nig, fm = gid * WGM, gsz = (nM - fm) < WGM ? (nM - fm) : WGM;
    pm = fm + ((wgid % nig) % gsz); pn = (wgid % nig) / gsz; return true;
  };
  int cpm, cpn, npm = 0, npn = 0, ui = 0;
  if (!next_unit(0, cpm, cpn)) return;
  f32x4 acc[2][2][4][2];
#pragma unroll
  for (int a = 0; a < 2; ++a)
#pragma unroll
    for (int b = 0; b < 2; ++b)
#pragma unroll
      for (int m = 0; m < 4; ++m)
#pragma unroll
        for (int n = 0; n < 2; ++n) acc[a][b][m][n] = (f32x4){0.f, 0.f, 0.f, 0.f};
  bf16x8 At[4][2], B0[2][2], B1[2][2];
  const char* cA = (const char*)A + (size_t)cpm * tstepA; const char* cB = (const char*)Bt + (size_t)cpn * tstepB;
  PG8_STAGE(PG8_SB(0, 0), cB, voffB); PG8_STAGE(PG8_SB(0, 1), cB + hstepB, voffB); PG8_STAGE(PG8_SA(0, 0), cA, voffA); PG8_STAGE(PG8_SA(0, 1), cA + hstepA, voffA);
  if (wr == 1) PG8_BAR;
  PG8_WAIT_V(2); PG8_BAR;
  PG8_STAGE(PG8_SB(1, 0), cB + kstep, voffB); PG8_STAGE(PG8_SA(1, 0), cA + kstep, voffA); PG8_STAGE(PG8_SB(1, 1), cB + hstepB + kstep, voffB);
  PG8_WAIT_V(6); PG8_BAR;
  for (;;) {
    const bool has_next = next_unit(ui + 1, npm, npn);
    const char* nA = has_next ? (const char*)A + (size_t)npm * tstepA : cA; const char* nB = has_next ? (const char*)Bt + (size_t)npn * tstepB : cB;
    for (int t = 0; t < nt; t += 2) {
      const bool last = (t == nt - 2);
      const char* a1 = cA + (size_t)(t + 1) * kstep;
      const char* a2 = last ? nA : cA + (size_t)(t + 2) * kstep; const char* b2 = last ? nB : cB + (size_t)(t + 2) * kstep;
      const char* a3 = a2 + kstep; const char* b3 = b2 + kstep;
      PG8_LDB(B0, 0, 0); PG8_LDB(B1, 0, 1); PG8_SCHED; PG8_LDA(At, 0, 0); PG8_STAGE(PG8_SA(1, 1), a1 + hstepA, voffA);
      PG8_WAIT_V(8); PG8_WAIT_L(0); PG8_BAR; PG8_MMA(0, 0, At, B0); PG8_MMA(0, 1, At, B1); PG8_BAR; PG8_SCHED;
      PG8_LDA(At, 0, 1); PG8_STAGE(PG8_SB(0, 0), b2, voffB); PG8_STAGE(PG8_SB(0, 1), b2 + hstepB, voffB); PG8_STAGE(PG8_SA(0, 0), a2, voffA);
      PG8_WAIT_V(8); PG8_WAIT_L(0); PG8_BAR; PG8_MMA(1, 0, At, B0); PG8_MMA(1, 1, At, B1); PG8_BAR; PG8_SCHED;
      PG8_LDB(B0, 1, 0); PG8_LDB(B1, 1, 1); PG8_SCHED; PG8_LDA(At, 1, 0); PG8_STAGE(PG8_SA(0, 1), a2 + hstepA, voffA);
      PG8_WAIT_V(8); PG8_WAIT_L(0); PG8_BAR; PG8_MMA(0, 0, At, B0); PG8_MMA(0, 1, At, B1); PG8_BAR; PG8_SCHED;
      PG8_LDA(At, 1, 1); PG8_STAGE(PG8_SB(1, 0), b3, voffB); PG8_STAGE(PG8_SB(1, 1), b3 + hstepB, voffB); PG8_STAGE(PG8_SA(1, 0), a3, voffA);
      PG8_WAIT_V(8); PG8_WAIT_L(0); PG8_BAR; PG8_MMA(1, 0, At, B0); PG8_MMA(1, 1, At, B1); PG8_BAR; PG8_SCHED;
    }
    if (wr == 0) PG8_BAR;
    E(acc, cpm, cpn, wr, wc, fr, fq);
    if (!has_next) break;
#pragma unroll
    for (int a = 0; a < 2; ++a)
#pragma unroll
      for (int b = 0; b < 2; ++b)
#pragma unroll
        for (int m = 0; m < 4; ++m)
#pragma unroll
          for (int n = 0; n < 2; ++n) acc[a][b][m][n] = (f32x4){0.f, 0.f, 0.f, 0.f};
    cpm = npm; cpn = npn; cA = nA; cB = nB; ++ui;
    if (wr == 1) PG8_BAR;
  }
  PG8_WAIT_V(0);
  PG8_BAR;
#undef PG8_SA
#undef PG8_SB
#undef PG8_STAGE
#undef PG8_LDA
#undef PG8_LDB
#undef PG8_MMA
}

struct EpiIn {
  const float* rinv; const float* rope; bf16_t* proj; float* kmax2;
  __device__ __forceinline__ void operator()(const f32x4 (&acc)[2][2][4][2], int pm, int pn, int wr, int wc, int fr, int fq) const {
    const bool isrope = (pn >= 6 && pn <= 9); const float qs = (pn == 6 || pn == 7) ? QSCALE : 1.f;
    const bool isk = (pn == 8 || pn == 9);
    float kmx[2] = {0.f, 0.f};
    float ch[4], cl[4];
    if (isrope) {
#pragma unroll
      for (int jj = 0; jj < 4; ++jj) { const int i = (wc & 1) * 16 + fq * 4 + jj; ch[jj] = rope[2 * i]; cl[jj] = rope[2 * i + 1]; }
    }
#pragma unroll
    for (int ai = 0; ai < 2; ++ai)
#pragma unroll
      for (int m = 0; m < 4; ++m) {
        const int row = pm * BM + ai * HALF + wr * 64 + m * 16 + fr;
        const float ri = rinv[row];
        float cs[4], sn[4];
        if (isrope) {
          const float pos = (float)(row < TP ? (row & (S_P - 1)) : (row & (S_S - 1)));
#pragma unroll
          for (int jj = 0; jj < 4; ++jj) {
            const float h = pos * ch[jj], e = fmaf(pos, ch[jj], -h) + pos * cl[jj];
            const float rev = (h - floorf(h)) + e;
            sn[jj] = __builtin_amdgcn_sinf(rev); cs[jj] = __builtin_amdgcn_cosf(rev);
          }
        }
        bf16_t* rowp = proj + (size_t)row * NPROJ + pn * BM + wc * 32 + 8 * fq;
#pragma unroll
        for (int bj = 0; bj < 2; ++bj) {
          f32x4 v0 = acc[ai][bj][m][0] * ri, v1 = acc[ai][bj][m][1] * ri;
          if (isrope) {
#pragma unroll
            for (int jj = 0; jj < 4; ++jj) { const float a = v0[jj], b = v1[jj]; v0[jj] = (a * cs[jj] - b * sn[jj]) * qs; v1[jj] = (b * cs[jj] + a * sn[jj]) * qs; }
          }
          u32x4 w; w.x = cvtpk(v0[0], v0[1]); w.y = cvtpk(v0[2], v0[3]); w.z = cvtpk(v1[0], v1[1]); w.w = cvtpk(v1[2], v1[3]);
          *(u32x4*)(rowp + bj * HALF) = w;
          if (isk) { float ss = v0[0] * v0[0] + v0[1] * v0[1] + v0[2] * v0[2] + v0[3] * v0[3] + v1[0] * v1[0] + v1[1] * v1[1] + v1[2] * v1[2] + v1[3] * v1[3];
            ss += __shfl_xor(ss, 16); ss += __shfl_xor(ss, 32); kmx[bj] = fmaxf(kmx[bj], ss); }
        }
      }
    if (isk) {
      const int row0 = pm * BM, sq = row0 < TP ? (row0 >> 14) : 2 + ((row0 - TP) >> 12);
#pragma unroll
      for (int bj = 0; bj < 2; ++bj) { float v = kmx[bj];
        v = fmaxf(v, __shfl_xor(v, 1)); v = fmaxf(v, __shfl_xor(v, 2)); v = fmaxf(v, __shfl_xor(v, 4)); v = fmaxf(v, __shfl_xor(v, 8));
        if ((fr | fq) == 0) atomicMax((unsigned*)(kmax2 + (sq * 4 + (pn - 8) * 2 + bj) * 4 + wc), __float_as_uint(v)); }
    }
  }
};
struct EpiOut {
  bf16_t* proj;
  __device__ __forceinline__ void operator()(const f32x4 (&acc)[2][2][4][2], int pm, int pn, int wr, int wc, int fr, int fq) const {
#pragma unroll
    for (int ai = 0; ai < 2; ++ai)
#pragma unroll
      for (int m = 0; m < 4; ++m) {
        const int row = pm * BM + ai * HALF + wr * 64 + m * 16 + fr;
        bf16_t* rowp = proj + (size_t)row * NPROJ + C_U + pn * BM + wc * 32 + 8 * fq;
#pragma unroll
        for (int bj = 0; bj < 2; ++bj) { const f32x4 v0 = acc[ai][bj][m][0], v1 = acc[ai][bj][m][1];
          u32x4 w; w.x = cvtpk(v0[0], v0[1]); w.y = cvtpk(v0[2], v0[3]); w.z = cvtpk(v1[0], v1[1]); w.w = cvtpk(v1[2], v1[3]);
          *(u32x4*)(rowp + bj * HALF) = w; }
      }
  }
};
}

__device__ __forceinline__ void bf8_to_f(const u32x4 w, float* v) {
  v[0] = bflo(w.x); v[1] = bfhi(w.x); v[2] = bflo(w.y); v[3] = bfhi(w.y); v[4] = bflo(w.z); v[5] = bfhi(w.z); v[6] = bflo(w.w); v[7] = bfhi(w.w);
}
__device__ void pool_phase(const Params& p, int l, bool dry = false) {
  const int tid = opaque_tid(), c8 = tid & 63, tq = tid >> 6;
  const int g = c8 >> 4, hw = 1 << g;
  const float* sc = p.pool_scale + l * 512 + c8 * 8;
  float scl[8];
#pragma unroll
  for (int e = 0; e < 8; ++e) scl[e] = sc[e];
  for (int ch = blockIdx.x; ch < T_TOK / 128; ch += gridDim.x) {
    const int t0 = ch * 128 + tq * 16;
    const int S = t0 < TP ? S_P : S_S, pos0 = t0 & (S - 1), s0 = t0 - pos0;
    const bf16_t* ub = p.proj + (size_t)s0 * NPROJ + C_U + c8 * 8;
    float sum[8] = {0, 0, 0, 0, 0, 0, 0, 0};
#pragma unroll
    for (int j = 0; j < 16; ++j) {
      const int r = pos0 - hw + j; const bool ok = (j < 2 * hw) && r >= 0 && r < S; const int rc = min(max(r, 0), S - 1);
      float v[8]; bf8_to_f(*(const u32x4*)(ub + (size_t)rc * NPROJ), v); const float m = ok ? 1.f : 0.f;
#pragma unroll
      for (int e = 0; e < 8; ++e) sum[e] = fmaf(m, v[e], sum[e]);
    }
#pragma unroll
    for (int i4 = 0; i4 < 16; i4 += 4) {
      u32x4 wu[4], wz[4], wa[4], wsb[4];
#pragma unroll
      for (int q = 0; q < 4; ++q) {
        const int pos = pos0 + i4 + q, ra = pos + hw, rs = pos - hw;
        wu[q] = *(const u32x4*)(ub + (size_t)pos * NPROJ);
        wz[q] = *(const u32x4*)(p.proj + (size_t)(t0 + i4 + q) * NPROJ + C_ZP + c8 * 8);
        wa[q] = *(const u32x4*)(ub + (size_t)min(ra, S - 1) * NPROJ); wsb[q] = *(const u32x4*)(ub + (size_t)max(rs, 0) * NPROJ);
      }
#pragma unroll
      for (int q = 0; q < 4; ++q) {
        const int pos = pos0 + i4 + q, t = t0 + i4 + q;
        const int lo = max(pos - hw, 0), hi = min(pos + hw, S);
        const float inv = 1.f / (float)(hi - lo);
        float uc[8], z[8], va[8], vs[8], o[8];
        bf8_to_f(wu[q], uc); bf8_to_f(wz[q], z);
#pragma unroll
        for (int e = 0; e < 8; ++e) o[e] = (sum[e] * inv - uc[e]) * scl[e] * silu(z[e]);
        const u32x4 w = {cvtpk(o[0], o[1]), cvtpk(o[2], o[3]), cvtpk(o[4], o[5]), cvtpk(o[6], o[7])};
        if (!dry) *(u32x4*)(p.proj + (size_t)t * NPROJ + C_ZP + c8 * 8) = w;
        const int ra = pos + hw, rs = pos - hw; const float ma = ra < S ? 1.f : 0.f, ms = rs >= 0 ? 1.f : 0.f;
        bf8_to_f(wa[q], va); bf8_to_f(wsb[q], vs);
#pragma unroll
        for (int e = 0; e < 8; ++e) sum[e] = fmaf(ma, va[e], fmaf(-ms, vs[e], sum[e]));
      }
    }
  }
}

namespace at {
constexpr int KVBLK = 64, LDK = NPROJ;
constexpr size_t SHM_V = KVBLK * 128 * 2, SHM_K = KVBLK * 128 * 2;
constexpr float THRL = 11.5f;
#define KSWZ(row, colB) ((row) * 256 + ((colB) ^ (((row) & 7) << 4)))
__device__ __forceinline__ int crow(int r, int hi) { return (r & 3) + 8 * (r >> 2) + 4 * hi; }
template <bool SH> __device__ __forceinline__ void partialSM(f32x16& p0, f32x16& p1, float& m_reg, float& mn, float& alpha) {
  if constexpr (!SH) {
    alpha = 1.f;
#pragma unroll
    for (int r = 0; r < 16; ++r) { p0[r] = __builtin_amdgcn_exp2f(p0[r]); p1[r] = __builtin_amdgcn_exp2f(p1[r]); }
    return;
  }
  float pmax = p0[0];
#pragma unroll
  for (int r = 1; r < 16; ++r) pmax = fmaxf(pmax, p0[r]);
#pragma unroll
  for (int r = 0; r < 16; ++r) pmax = fmaxf(pmax, p1[r]);
  { auto rr = __builtin_amdgcn_permlane32_swap(__float_as_uint(pmax), __float_as_uint(pmax), false, false);
    pmax = fmaxf(__uint_as_float(rr[0]), __uint_as_float(rr[1])); }
  if (__builtin_expect(__all(pmax - m_reg <= THRL), 1)) { mn = m_reg; alpha = 1.f; }
  else { mn = fmaxf(m_reg, pmax); alpha = __builtin_amdgcn_exp2f(m_reg - mn); m_reg = mn; }
#pragma unroll
  for (int r = 0; r < 16; ++r) p0[r] = p0[r] - mn;
#pragma unroll
  for (int r = 0; r < 16; ++r) p1[r] = p1[r] - mn;
#pragma unroll
  for (int r = 0; r < 16; ++r) { p0[r] = __builtin_amdgcn_exp2f(p0[r]); p1[r] = __builtin_amdgcn_exp2f(p1[r]); }
}
template <bool SH> __device__ __forceinline__ void finishSM(f32x16& p0, f32x16& p1, float alpha, float& l_reg, bf16x8& pa0, bf16x8& pa1, bf16x8& pa2, bf16x8& pa3) {
  float ps = 0;
#pragma unroll
  for (int r = 0; r < 16; ++r) ps += p0[r];
#pragma unroll
  for (int r = 0; r < 16; ++r) ps += p1[r];
  { auto rr = __builtin_amdgcn_permlane32_swap(__float_as_uint(ps), __float_as_uint(ps), false, false);
    ps = __uint_as_float(rr[0]) + __uint_as_float(rr[1]); }
  if constexpr (SH) l_reg = l_reg * alpha + ps; else l_reg += ps;
#define PK4(P, BASE, OUT) do { unsigned a0 = cvtpk(P[BASE + 0], P[BASE + 1]), a1 = cvtpk(P[BASE + 2], P[BASE + 3]);   \
    unsigned b0 = cvtpk(P[BASE + 4], P[BASE + 5]), b1 = cvtpk(P[BASE + 6], P[BASE + 7]);                              \
    auto r0 = __builtin_amdgcn_permlane32_swap(a0, b0, false, false); auto r1 = __builtin_amdgcn_permlane32_swap(a1, b1, false, false); \
    u32x4 w = {r0[0], r1[0], r0[1], r1[1]}; OUT = *reinterpret_cast<bf16x8*>(&w); } while (0)
  PK4(p0, 0, pa0); PK4(p0, 8, pa1); PK4(p1, 0, pa2); PK4(p1, 8, pa3);
#undef PK4
}
__device__ __forceinline__ void qkt(f32x16& p0, f32x16& p1, const char* Ks, const bf16x8* qr, int r32, int hi, int mapB) {
  p0 = f32x16{}; p1 = f32x16{};
#pragma unroll
  for (int d0 = 0; d0 < 4; ++d0) { const int cb = (d0 * 16 + hi * 8) * 2 + mapB;
    bf16x8 b0 = *reinterpret_cast<const bf16x8*>(Ks + KSWZ(r32, cb));
    bf16x8 b1 = *reinterpret_cast<const bf16x8*>(Ks + KSWZ(32 + r32, cb));
    p0 = __builtin_amdgcn_mfma_f32_32x32x16_bf16(b0, qr[d0], p0, 0, 0, 0);
    p1 = __builtin_amdgcn_mfma_f32_32x32x16_bf16(b1, qr[d0], p1, 0, 0, 0); }
}
__device__ __forceinline__ int v_st(int k, int c) { const int kk = (k & ~0xC) | ((k & 4) << 1) | ((k & 8) >> 1); return ((kk >> 3) * 4 + (c >> 5)) * 512 + ((kk & 7) * 32 + (c & 31)) * 2; }
__device__ __forceinline__ int v_rd_base(int lane) { return ((lane & 3) << 3) | (((lane >> 2) & 3) << 6) | (((lane >> 4) & 1) << 5) | (((lane >> 5) & 1) << 8); }
constexpr int v_rd_off(int d0, int ks, int half) { return d0 * 512 + ks * 4096 + half * 2048; }
template <int OFF> __device__ __forceinline__ s16x4 tr_read(int vb) {
  s16x4 r; asm volatile("ds_read_b64_tr_b16 %0, %1 offset:%2" : "=&v"(r) : "v"(vb), "i"(OFF) : "memory"); return r;
}
template <int D0> __device__ __forceinline__ void pv_one(f32x16& od, int vb, bf16x8 pa0, bf16x8 pa1, bf16x8 pa2, bf16x8 pa3) {
  const s16x4 l0 = tr_read<v_rd_off(D0, 0, 0)>(vb), h0 = tr_read<v_rd_off(D0, 0, 1)>(vb), l1 = tr_read<v_rd_off(D0, 1, 0)>(vb), h1 = tr_read<v_rd_off(D0, 1, 1)>(vb);
  const s16x4 l2 = tr_read<v_rd_off(D0, 2, 0)>(vb), h2 = tr_read<v_rd_off(D0, 2, 1)>(vb), l3 = tr_read<v_rd_off(D0, 3, 0)>(vb), h3 = tr_read<v_rd_off(D0, 3, 1)>(vb);
  asm volatile("s_waitcnt lgkmcnt(0)" ::: "memory"); SBAR();
#define PK(L, H) (bf16x8){L[0], L[1], L[2], L[3], H[0], H[1], H[2], H[3]}
  od = __builtin_amdgcn_mfma_f32_32x32x16_bf16(pa0, PK(l0, h0), od, 0, 0, 0);
  od = __builtin_amdgcn_mfma_f32_32x32x16_bf16(pa1, PK(l1, h1), od, 0, 0, 0);
  od = __builtin_amdgcn_mfma_f32_32x32x16_bf16(pa2, PK(l2, h2), od, 0, 0, 0);
  od = __builtin_amdgcn_mfma_f32_32x32x16_bf16(pa3, PK(l3, h3), od, 0, 0, 0);
#undef PK
}
__device__ __forceinline__ void pv_d0(f32x16* o, int vb, bf16x8 pa0, bf16x8 pa1, bf16x8 pa2, bf16x8 pa3) {
  pv_one<0>(o[0], vb, pa0, pa1, pa2, pa3); pv_one<1>(o[1], vb, pa0, pa1, pa2, pa3); pv_one<2>(o[2], vb, pa0, pa1, pa2, pa3); pv_one<3>(o[3], vb, pa0, pa1, pa2, pa3);
}

template <bool SH> __device__ __forceinline__ void attn_unit(bf16_t* __restrict__ proj, int tok0, int kv0, int seq, int h, float lam, float oscale, const float* __restrict__ subg, char* lds, bool dry) {
  const int tid = opaque_tid(), wid = __builtin_amdgcn_readfirstlane(tid >> 6), lane = tid & 63, r32 = lane & 31, hi = lane >> 5;
  const int wq = wid & 3, mp = wid >> 2, mapB = mp * 128;
  constexpr int RING = 32768, NRING = 4;
  LAS char* ldsl = (LAS char*)lds;
  float* ws = (float*)(lds + NRING * RING) + wid * 64; float* li_l = ws; float* al_l = ws + 32;
  const bf16_t* Kh = proj + (size_t)kv0 * NPROJ + C_K + h * 128;
  const bf16_t* Vh = proj + (size_t)kv0 * NPROJ + C_V + h * 128;
  float m_reg = -1e30f, l_reg = 0; f32x16 o[4] = {}; bf16x8 qr[4];
  const bf16_t* Qw = proj + (size_t)(tok0 + wq * 32 + r32) * NPROJ + C_Q + h * 128 + mp * 64 + hi * 8;
#pragma unroll
  for (int d0 = 0; d0 < 4; ++d0) qr[d0] = *reinterpret_cast<const bf16x8*>(Qw + d0 * 16);
  int offK[2], offV[2];
#pragma unroll
  for (int i = 0; i < 2; ++i) {
    const int c = i * 512 + tid;
    { const int row = c >> 4, pc = c & 15, scn = pc ^ (row & 7); offK[i] = row * LDK + scn * 8; }
    { const int sub = c >> 5, kk = (sub >> 2) * 8 + ((c >> 2) & 7), col = (sub & 3) * 32 + (c & 3) * 8;
      const int k = (kk & ~0xC) | ((kk & 4) << 1) | ((kk & 8) >> 1); offV[i] = k * LDK + col; }
  }
  const int vbb = (int)(uintptr_t)ldsl + 16384 + v_rd_base(lane);
#define GLDS16(src, dst) __builtin_amdgcn_global_load_lds((const unsigned*)(src), (LAS unsigned*)(dst), 16, 0, 0)
#define DMA(t, b) do { const bf16_t* kg_ = Kh + (size_t)(t) * (KVBLK * LDK); const bf16_t* vg_ = Vh + (size_t)(t) * (KVBLK * LDK); LAS char* d_ = ldsl + (b) * RING + wid * 1024; \
    GLDS16(kg_ + offK[0], d_); GLDS16(kg_ + offK[1], d_ + 8192); GLDS16(vg_ + offV[0], d_ + 16384); GLDS16(vg_ + offV[1], d_ + 16384 + 8192); } while (0)
#define KBUF(b) ((const char*)lds + (b) * RING)
#define VBUF(b) (vbb + (b) * RING)
#define LANDED() do { asm volatile("s_waitcnt vmcnt(0)" ::: "memory"); __syncthreads(); } while (0)
#define RESC(a) do { if (SH && __any((a) < 1.f)) { if (hi == 0) al_l[r32] = (a); asm volatile("s_waitcnt lgkmcnt(0)" ::: "memory"); \
    _Pragma("unroll") for (int d = 0; d < 4; ++d) _Pragma("unroll") for (int r = 0; r < 16; ++r) o[d][r] *= al_l[crow(r, hi)]; } } while (0)
  f32x16 pA0, pA1, pB0, pB1; float mnA, mnB, alA, alB; bf16x8 pa0, pa1, pa2, pa3; const int NT = seq / KVBLK;
#define BLK_X(N0, N1, P0, P1, alP, t) do { SBAR(); __builtin_amdgcn_s_setprio(1); qkt(N0, N1, KBUF((t) & 3), qr, r32, hi, mapB); finishSM<SH>(P0, P1, alP, l_reg, pa0, pa1, pa2, pa3); __builtin_amdgcn_s_setprio(0); SBAR(); } while (0)
#define BLK_Y(C0, C1, mnC, alC, t) do { pv_d0(o, VBUF((t) & 3), pa0, pa1, pa2, pa3); partialSM<SH>(C0, C1, m_reg, mnC, alC); RESC(alC); } while (0)
  const int ty = STAGGER_MAP ? mp : (wid & 1);
  DMA(0, 0); LANDED();
  DMA(1, 1);
  if (ty == 0) {
    qkt(pA0, pA1, KBUF(0), qr, r32, hi, mapB); partialSM<SH>(pA0, pA1, m_reg, mnA, alA);
    LANDED();
    for (int j = 1; j + 1 < NT; j += 2) {
      DMA(j + 1, (j + 1) & 3); BLK_X(pB0, pB1, pA0, pA1, alA, j); BLK_Y(pB0, pB1, mnB, alB, j - 1); LANDED();
      DMA(j + 2, (j + 2) & 3); BLK_X(pA0, pA1, pB0, pB1, alB, j + 1); BLK_Y(pA0, pA1, mnA, alA, j); LANDED();
    }
    BLK_X(pB0, pB1, pA0, pA1, alA, NT - 1); BLK_Y(pB0, pB1, mnB, alB, NT - 2);
    finishSM<SH>(pB0, pB1, alB, l_reg, pa0, pa1, pa2, pa3); SBAR();
    pv_d0(o, VBUF((NT - 1) & 3), pa0, pa1, pa2, pa3);
  } else {
    qkt(pA0, pA1, KBUF(0), qr, r32, hi, mapB);
    LANDED();
    DMA(2, 2); partialSM<SH>(pA0, pA1, m_reg, mnA, alA); BLK_X(pB0, pB1, pA0, pA1, alA, 1); LANDED();
    for (int j = 2; j + 2 < NT; j += 2) {
      DMA(j + 1, (j + 1) & 3); BLK_Y(pB0, pB1, mnB, alB, j - 2); BLK_X(pA0, pA1, pB0, pB1, alB, j); LANDED();
      DMA(j + 2, (j + 2) & 3); BLK_Y(pA0, pA1, mnA, alA, j - 1); BLK_X(pB0, pB1, pA0, pA1, alA, j + 1); LANDED();
    }
    DMA(NT - 1, (NT - 1) & 3); BLK_Y(pB0, pB1, mnB, alB, NT - 4); BLK_X(pA0, pA1, pB0, pB1, alB, NT - 2); LANDED();
    BLK_Y(pA0, pA1, mnA, alA, NT - 3); BLK_X(pB0, pB1, pA0, pA1, alA, NT - 1);
    BLK_Y(pB0, pB1, mnB, alB, NT - 2);
    finishSM<SH>(pB0, pB1, alB, l_reg, pa0, pa1, pa2, pa3); SBAR();
    pv_d0(o, VBUF((NT - 1) & 3), pa0, pa1, pa2, pa3);
  }
#undef BLK_X
#undef BLK_Y
  if (hi == 0) li_l[r32] = l_reg; asm volatile("s_waitcnt lgkmcnt(0)" ::: "memory");
  float rli[16];
#pragma unroll
  for (int r = 0; r < 16; ++r) rli[r] = __builtin_amdgcn_rcpf(li_l[crow(r, hi)]);
  __syncthreads();
  float* X = (float*)lds;
  if (mp == 1) {
#pragma unroll
    for (int d = 0; d < 4; ++d)
#pragma unroll
      for (int r = 0; r < 16; ++r) X[(wq * 64 + d * 16 + r) * 64 + lane] = o[d][r] * rli[r] * lam;
  }
  __syncthreads();
  if (mp == 0) {
#pragma unroll
    for (int d = 0; d < 4; ++d)
#pragma unroll
      for (int r = 0; r < 16; ++r) { const int ix = (wq * 64 + d * 16 + r) * 64 + lane; X[ix] = o[d][r] * rli[r] - X[ix]; }
  }
  __syncthreads();
  {
    const int row = tid >> 2, dq = tid & 3, rl = row & 31, w = row >> 5, hh = (rl >> 2) & 1, r = (rl & 3) + 4 * (rl >> 3);
    const float* xb = X + (w * 64 + dq * 16 + r) * 64 + hh * 32;
    f32x4 a[8]; float ss = 0.f;
#pragma unroll
    for (int i = 0; i < 8; ++i) { a[i] = *(const f32x4*)(xb + i * 4); ss += a[i][0] * a[i][0] + a[i][1] * a[i][1] + a[i][2] * a[i][2] + a[i][3] * a[i][3]; }
    ss += __shfl_xor(ss, 1); ss += __shfl_xor(ss, 2);
    const float rn = __builtin_amdgcn_rsqf(ss * (1.f / 128.f) + 1e-5f) * oscale;
    bf16_t* zp = proj + (size_t)(tok0 + row) * NPROJ + C_ZA + h * 128 + dq * 32;
    const float* gg = subg + dq * 32;
#pragma unroll
    for (int i = 0; i < 4; ++i) {
      const u32x4 z = *(const u32x4*)(zp + i * 8);
      const f32x4 a0 = a[2 * i], a1 = a[2 * i + 1]; const f32x4 g0 = *(const f32x4*)(gg + i * 8), g1 = *(const f32x4*)(gg + i * 8 + 4);
      u32x4 wv;
      wv.x = cvtpk(a0[0] * rn * g0[0] * silu(bflo(z.x)), a0[1] * rn * g0[1] * silu(bfhi(z.x)));
      wv.y = cvtpk(a0[2] * rn * g0[2] * silu(bflo(z.y)), a0[3] * rn * g0[3] * silu(bfhi(z.y)));
      wv.z = cvtpk(a1[0] * rn * g1[0] * silu(bflo(z.z)), a1[1] * rn * g1[1] * silu(bfhi(z.z)));
      wv.w = cvtpk(a1[2] * rn * g1[2] * silu(bflo(z.w)), a1[3] * rn * g1[3] * silu(bfhi(z.w)));
      if (!dry) *(u32x4*)(zp + i * 8) = wv;
    }
  }
  __syncthreads();
#undef DMA
#undef GLDS16
#undef KBUF
#undef VBUF
#undef LANDED
#undef RESC
}

__device__ void attn_phase(const Params& p, int l, char* lds, bool dry = false) {
  const float lam = p.lam[l];
  const float oscale = 1.f - (0.8f - 0.6f * expf(-0.3f * (float)l));
  const float* subg = p.subln_g + l * 128;
  for (int u = blockIdx.x; u < 2048; u += gridDim.x) {
    int tok0, kv0, seq, h;
    if (u < 1024) { const int x = u & 7, j = u >> 3; const int b = x >> 2; h = x & 3; seq = S_P; kv0 = b * S_P; tok0 = kv0 + j * 128; }
    else { const int v = u - 1024, x = v & 7, j = v >> 3; const int pr = x * 4 + (j >> 5), b = pr >> 2; h = pr & 3; seq = S_S; kv0 = TP + b * S_S; tok0 = kv0 + (j & 31) * 128; }
    bool need;
    { const int tid = opaque_tid(), wid = tid >> 6, lane = tid & 63, r32 = lane & 31, hi = lane >> 5, wq = wid & 3, mp = wid >> 2;
      const int sq = tok0 < TP ? (tok0 >> 14) : 2 + ((tok0 - TP) >> 12);
      const float* km = p.kmax2 + ((l * 10 + sq) * 4 + h) * 4 + mp * 2;
      const float kmx = sqrtf(km[0] + km[1]) * 1.01f;
      const bf16_t* Qw = p.proj + (size_t)(tok0 + wq * 32 + r32) * NPROJ + C_Q + h * 128 + mp * 64 + hi * 8;
      float ss = 0.f;
#pragma unroll
      for (int d0 = 0; d0 < 4; ++d0) { const u32x4 w = *(const u32x4*)(Qw + d0 * 16);
        ss += bflo(w.x) * bflo(w.x) + bfhi(w.x) * bfhi(w.x) + bflo(w.y) * bflo(w.y) + bfhi(w.y) * bfhi(w.y) + bflo(w.z) * bflo(w.z) + bfhi(w.z) * bfhi(w.z) + bflo(w.w) * bflo(w.w) + bfhi(w.w) * bfhi(w.w); }
      ss += __shfl_xor(ss, 32);
      need = __any(!(sqrtf(ss) * kmx < 100.f)) != 0; }
    if (need) attn_unit<true>(p.proj, tok0, kv0, seq, h, lam, oscale, subg, lds, dry);
    else attn_unit<false>(p.proj, tok0, kv0, seq, h, lam, oscale, subg, lds, dry);
  }
}
}

__device__ void post_phase(const Params& p, int l) {
  const int tid = opaque_tid(), wid = tid >> 6, lane = tid & 63, nw = blockDim.x >> 6;
  const float* pg = p.post_g + l * DM;
  constexpr int R = 2;
  for (int row0 = (blockIdx.x * nw + wid) * R; row0 < T_TOK; row0 += gridDim.x * nw * R) {
    f32x4 y[R][4], x[R][4]; u32x2 xh[R][4], xl[R][4], yb[R][4];
#pragma unroll
    for (int q = 0; q < R; ++q) {
      const int row = row0 + q;
      const bf16_t* yr = p.proj + (size_t)row * NPROJ + C_U;
#pragma unroll
      for (int i = 0; i < 4; ++i) yb[q][i] = *(const u32x2*)(yr + i * 256 + lane * 4);
      if (l == 0) {
        const float* xr = row < TP ? p.xp + (size_t)row * DM : p.xs + (size_t)(row - TP) * DM;
#pragma unroll
        for (int i = 0; i < 4; ++i) x[q][i] = *(const f32x4*)(xr + i * 256 + lane * 4);
      } else {
        const bf16_t* xo = (const bf16_t*)p.out + (size_t)row * LDX;
#pragma unroll
        for (int i = 0; i < 4; ++i) { xh[q][i] = *(const u32x2*)(xo + i * 256 + lane * 4); xl[q][i] = *(const u32x2*)(xo + DM + i * 256 + lane * 4); }
      }
    }
#pragma unroll
    for (int q = 0; q < R; ++q) {
      const int row = row0 + q;
      bf16_t* xo = (bf16_t*)p.out + (size_t)row * LDX;
      float ss = 0.f;
#pragma unroll
      for (int i = 0; i < 4; ++i) { y[q][i] = (f32x4){bflo(yb[q][i].x), bfhi(yb[q][i].x), bflo(yb[q][i].y), bfhi(yb[q][i].y)};
        ss += y[q][i][0] * y[q][i][0] + y[q][i][1] * y[q][i][1] + y[q][i][2] * y[q][i][2] + y[q][i][3] * y[q][i][3]; }
      if (l != 0) {
#pragma unroll
        for (int i = 0; i < 4; ++i) {
          const u32x2 h = xh[q][i], lo = xl[q][i];
          x[q][i][0] = bflo(h.x) + bflo(lo.x); x[q][i][1] = bfhi(h.x) + bfhi(lo.x); x[q][i][2] = bflo(h.y) + bflo(lo.y); x[q][i][3] = bfhi(h.y) + bfhi(lo.y);
        }
      }
      ss = wave_sum(ss);
      const float ry = __builtin_amdgcn_rsqf(ss * (1.f / DM) + 1e-6f);
      float s2 = 0.f;
#pragma unroll
      for (int i = 0; i < 4; ++i) {
        const f32x4 g = *(const f32x4*)(pg + i * 256 + lane * 4);
#pragma unroll
        for (int e = 0; e < 4; ++e) { x[q][i][e] = x[q][i][e] + y[q][i][e] * ry * g[e]; s2 += x[q][i][e] * x[q][i][e]; }
      }
      if (l == DEPTH - 1) {
        float* orow = p.out + (size_t)row * DM;
#pragma unroll
        for (int i = 0; i < 4; ++i) *(f32x4*)(orow + i * 256 + lane * 4) = x[q][i];
      } else {
        s2 = wave_sum(s2);
        if (lane == 0) p.rinv[row] = __builtin_amdgcn_rsqf(s2 * (1.f / DM) + 1e-6f);
#pragma unroll
        for (int i = 0; i < 4; ++i) {
          const unsigned h0 = cvtpk(x[q][i][0], x[q][i][1]), h1 = cvtpk(x[q][i][2], x[q][i][3]);
          const unsigned l0 = cvtpk(x[q][i][0] - bflo(h0), x[q][i][1] - bfhi(h0)), l1 = cvtpk(x[q][i][2] - bflo(h1), x[q][i][3] - bfhi(h1));
          *(u32x2*)(xo + i * 256 + lane * 4) = (u32x2){h0, h1}; *(u32x2*)(xo + DM + i * 256 + lane * 4) = (u32x2){l0, l1};
        }
      }
    }
  }
}

#define XB_TMO      128
#define XB_XCNT(j)  (256  + 64 * (j))
#define XB_XSUB(j)  (1280 + 64 * (j))
#define XB_XGEN(j)  (2304 + 64 * (j))
#define XB_TOP      3328
#define XB_TOPGEN   3392
#define XB_SPIN_CAP (1u << 22)
#define XLAS __attribute__((address_space(3)))
__device__ __forceinline__ unsigned xb_ld(unsigned* p)              { return __hip_atomic_load(p, __ATOMIC_RELAXED, __HIP_MEMORY_SCOPE_AGENT); }
__device__ __forceinline__ unsigned xb_add(unsigned* p, unsigned v) { return __hip_atomic_fetch_add(p, v, __ATOMIC_RELAXED, __HIP_MEMORY_SCOPE_AGENT); }
__device__ __forceinline__ unsigned xb_xcc_id() { return (unsigned)__builtin_amdgcn_s_getreg((3 << 11) | 20) & 0xFu; }
#define XB_SPIN(cond, bar) do { unsigned _sp = 0; while (cond) { __builtin_amdgcn_s_sleep(1); \
    if ((++_sp & 255u) == 0u) { if (xb_ld(&(bar)[XB_TMO])) break; if (_sp > XB_SPIN_CAP) { atomicAdd(&(bar)[XB_TMO], 1u); break; } } } } while (0)
struct XcdBarrier { unsigned* bar; unsigned x; volatile XLAS unsigned* st; };
__device__ __forceinline__ XcdBarrier xcd_barrier_post(unsigned* bar, volatile XLAS unsigned* st) {
  XcdBarrier b; b.bar = bar; b.x = xb_xcc_id(); b.st = st;
  if (threadIdx.x == 0) (void)xb_add(&bar[XB_XCNT(b.x)], 1u);
  return b;
}
__device__ __forceinline__ void xcd_barrier_complete(unsigned* bar, unsigned x, unsigned& nloc, unsigned& nx) {
  const unsigned G = gridDim.x * gridDim.y * gridDim.z;
  unsigned sum, cnt, mine, sp = 0u;
  for (;;) {
    sum = 0u; cnt = 0u; mine = 0u;
#pragma unroll
    for (unsigned j = 0; j < 16; ++j) { const unsigned c = xb_ld(&bar[XB_XCNT(j)]); sum += c; cnt += (c > 0u) ? 1u : 0u; mine = (j == x) ? c : mine; }
    if (sum == G) break;
    __builtin_amdgcn_s_sleep(1);
    if ((++sp & 255u) == 0u) { if (xb_ld(&bar[XB_TMO])) break; if (sp > XB_SPIN_CAP) { atomicAdd(&bar[XB_TMO], 1u); break; } }
  }
  nloc = mine > 0u ? mine : 1u; nx = cnt > 0u ? cnt : 1u;
}
__device__ __forceinline__ void xcd_barrier(const XcdBarrier& b) {
  asm volatile("s_waitcnt vmcnt(0)" ::: "memory");
  __syncthreads();
  if (threadIdx.x == 0) {
    unsigned* bar = b.bar;
    __builtin_amdgcn_s_waitcnt(0);
    unsigned nloc = b.st[0], nx = b.st[1];
    if (nloc == 0u) { xcd_barrier_complete(bar, b.x, nloc, nx); b.st[0] = nloc; b.st[1] = nx; }
    const unsigned old = xb_add(&bar[XB_XSUB(b.x)], 1u);
    const unsigned gen = old / nloc;
    if (old + 1u == (gen + 1u) * nloc) {
      __builtin_amdgcn_fence(__ATOMIC_RELEASE, "agent");
      asm volatile("s_waitcnt vmcnt(0)" ::: "memory");
      const unsigned og = xb_add(&bar[XB_TOP], 1u);
      const unsigned tg = og / nx;
      if (og + 1u == (tg + 1u) * nx) xb_add(&bar[XB_TOPGEN], 1u);
      else XB_SPIN(xb_ld(&bar[XB_TOPGEN]) == tg, bar);
      __builtin_amdgcn_fence(__ATOMIC_ACQUIRE, "agent");
      xb_add(&bar[XB_XGEN(b.x)], 1u);
      asm volatile("s_waitcnt vmcnt(0)" ::: "memory");
    } else {
      XB_SPIN(xb_ld(&bar[XB_XGEN(b.x)]) == gen, bar);
      __builtin_amdgcn_fence(__ATOMIC_ACQUIRE, "agent");
      asm volatile("s_waitcnt vmcnt(0)" ::: "memory");
    }
  }
  __syncthreads();
}

__device__ __forceinline__ void run_phase(const Params& p, int ph, char* shm) {
  if (ph == 0) { phase0(p, shm); return; }
  const int l = (ph - 1) >> 2, s = (ph - 1) & 3;
  if (s == 0) { gm::EpiIn e{p.rinv, p.rope, p.proj, p.kmax2 + l * 160}; gm::gemm_phase(( const bf16_t*)p.out, LDX, p.WinT + (size_t)l * NPROJ * DM, NPROJ, e, shm); }
  else if (s == 1) { pool_phase(p, l); at::attn_phase(p, l, shm); }
  else if (s == 2) { gm::EpiOut e{p.proj}; gm::gemm_phase(p.proj, NPROJ, p.WoutT + (size_t)l * DM * DM, DM, e, shm); }
  else post_phase(p, l);
}

#if MK_MULTI
template <int S> __global__ void __launch_bounds__(NT_THREADS, 1) k_phase(Params p, int l) {
  extern __shared__ __attribute__((aligned(16))) char shm[];
  if (S == 0) phase0(p, shm); else run_phase(p, 1 + 4 * l + (S - 1), shm);
}
#else
__global__ void __launch_bounds__(NT_THREADS, 1) k_mega(Params p) {
  extern __shared__ __attribute__((aligned(16))) char shm[];
  cg::grid_group grid = cg::this_grid();
  volatile XLAS unsigned* xst = (volatile XLAS unsigned*)(XLAS char*)(shm + 131072 + 3072);
  if (threadIdx.x == 0) { xst[0] = 0u; xst[1] = 0u; xst[2] = 0u; xst[3] = 0u; }
  phase0(p, shm);
  grid.sync();
  const XcdBarrier xb = xcd_barrier_post(p.bar, xst);
#define GSYNC() xcd_barrier(xb)
  for (int l = 0; l < DEPTH; ++l) {
#if REP_GEMM
    { gm::EpiIn e{p.rinv, p.rope, p.proj, p.kmax2 + l * 160}; gm::gemm_phase((const bf16_t*)p.out, LDX, p.WinT + (size_t)l * NPROJ * DM, NPROJ, e, shm); }
    GSYNC();
#endif
    { gm::EpiIn e{p.rinv, p.rope, p.proj, p.kmax2 + l * 160}; gm::gemm_phase((const bf16_t*)p.out, LDX, p.WinT + (size_t)l * NPROJ * DM, NPROJ, e, shm); }
    GSYNC();
    pool_phase(p, l);
#if REP_ATT
    at::attn_phase(p, l, shm, true); GSYNC();
#endif
    at::attn_phase(p, l, shm);
    GSYNC();
#if REP_GEMM
    { gm::EpiOut e{p.proj}; gm::gemm_phase(p.proj, NPROJ, p.WoutT + (size_t)l * DM * DM, DM, e, shm); }
    GSYNC();
#endif
    { gm::EpiOut e{p.proj}; gm::gemm_phase(p.proj, NPROJ, p.WoutT + (size_t)l * DM * DM, DM, e, shm); }
    GSYNC();
#if REP_POST
    if (l == 0) { post_phase(p, l); GSYNC(); }
#endif
    post_phase(p, l);
    if (l + 1 < DEPTH) GSYNC();
  }
}
#endif

extern "C" void kernel_launch(void* const* d_in, const int* in_sizes, int n_in, void* d_out, int out_size, void* d_ws, size_t ws_size, hipStream_t stream) {
  Params p{};
  p.xp = (const float*)d_in[0]; p.xs = (const float*)d_in[1]; p.pre_g = (const float*)d_in[2]; p.w_in = (const float*)d_in[3];
  p.pool_w = (const float*)d_in[4]; p.pool_scale = (const float*)d_in[5]; p.lq1 = (const float*)d_in[6]; p.lk1 = (const float*)d_in[7];
  p.lq2 = (const float*)d_in[8]; p.lk2 = (const float*)d_in[9]; p.subln_g = (const float*)d_in[10]; p.w_out = (const float*)d_in[11]; p.post_g = (const float*)d_in[12];
  p.out = (float*)d_out;
  char* w = (char*)d_ws; size_t off = 0;
  p.proj = (bf16_t*)(w + off); off += (size_t)T_TOK * NPROJ * 2;
  p.WinT = (bf16_t*)(w + off); off += (size_t)DEPTH * NPROJ * DM * 2;
  p.WoutT = (bf16_t*)(w + off); off += (size_t)DEPTH * DM * DM * 2;
  p.rinv = (float*)(w + off); off += (size_t)T_TOK * 4;
  p.rope = (float*)(w + off); off += 256;
  p.lam = (float*)(w + off); off += 256;
  p.kmax2 = (float*)(w + off); off += 2048;
  p.bar = (unsigned*)(w + off); off += 16384;
  if (off > ws_size) { fprintf(stderr, "kernel_launch: workspace too small (%zu > %zu)\n", off, ws_size); return; }
#if MK_MULTI
  static int ok = 0;
  if (!ok) {
    (void)hipFuncSetAttribute((const void*)k_phase<0>, hipFuncAttributeMaxDynamicSharedMemorySize, (int)SHM_BYTES);
    (void)hipFuncSetAttribute((const void*)k_phase<1>, hipFuncAttributeMaxDynamicSharedMemorySize, (int)SHM_BYTES);
    (void)hipFuncSetAttribute((const void*)k_phase<2>, hipFuncAttributeMaxDynamicSharedMemorySize, (int)SHM_BYTES);
    (void)hipFuncSetAttribute((const void*)k_phase<3>, hipFuncAttributeMaxDynamicSharedMemorySize, (int)SHM_BYTES);
    (void)hipFuncSetAttribute((const void*)k_phase<4>, hipFuncAttributeMaxDynamicSharedMemorySize, (int)SHM_BYTES);
    ok = 1; }
  hipLaunchKernelGGL(k_phase<0>, dim3(256), dim3(NT_THREADS), SHM_BYTES, stream, p, 0);
  for (int l = 0; l < DEPTH; ++l) {
    hipLaunchKernelGGL(k_phase<1>, dim3(256), dim3(NT_THREADS), SHM_BYTES, stream, p, l);
    hipLaunchKernelGGL(k_phase<2>, dim3(256), dim3(NT_THREADS), SHM_BYTES, stream, p, l);
    hipLaunchKernelGGL(k_phase<3>, dim3(256), dim3(NT_THREADS), SHM_BYTES, stream, p, l);
    hipLaunchKernelGGL(k_phase<4>, dim3(256), dim3(NT_THREADS), SHM_BYTES, stream, p, l);
  }
#else
  static int grid_blocks = 0;
  if (!grid_blocks) {
    (void)hipFuncSetAttribute((const void*)k_mega, hipFuncAttributeMaxDynamicSharedMemorySize, (int)SHM_BYTES);
    int dev = 0, cus = 0, per_cu = 0;
    (void)hipGetDevice(&dev);
    (void)hipDeviceGetAttribute(&cus, hipDeviceAttributeMultiprocessorCount, dev);
    (void)hipOccupancyMaxActiveBlocksPerMultiprocessor(&per_cu, k_mega, NT_THREADS, SHM_BYTES);
    if (per_cu > 1) per_cu = 1;
    grid_blocks = cus * per_cu;
  }
  void* args[] = {&p};
  hipError_t e = hipLaunchCooperativeKernel((void*)k_mega, dim3(grid_blocks), dim3(NT_THREADS), args, SHM_BYTES, stream);
  if (e != hipSuccess) fprintf(stderr, "cooperative launch failed: %s (grid %d)\n", hipGetErrorString(e), grid_blocks);
#endif
}
```

```cpp
#include <hip/hip_runtime.h>
#include <hip/hip_cooperative_groups.h>
#include <cstdio>
#include <cstdint>
namespace cg = cooperative_groups;

#ifndef REP_ATT
#define REP_ATT 0
#endif
#ifndef STAGGER_MAP
#define STAGGER_MAP 1
#endif
#ifndef REP_POST
#define REP_POST 0
#endif
#ifndef REP_GEMM
#define REP_GEMM 0
#endif
#ifndef MK_MULTI
#define MK_MULTI 0
#endif

typedef unsigned short bf16_t;
using bf16x8 = __attribute__((ext_vector_type(8))) short;
using s16x4  = __attribute__((ext_vector_type(4))) short;
using f32x16 = __attribute__((ext_vector_type(16))) float;
using f32x4  = __attribute__((ext_vector_type(4))) float;
using u32x4  = __attribute__((ext_vector_type(4))) unsigned;
using u32x2  = __attribute__((ext_vector_type(2))) unsigned;

#define XCD_BAR_WORDS 3456
constexpr int NT_THREADS = 512;
constexpr int T_TOK = 65536, TP = 32768, DM = 1024, NPROJ = 3072, DEPTH = 2;
constexpr int S_P = 16384, S_S = 4096;
constexpr int C_ZP = 0, C_ZA = 512, C_U = 1024, C_Q = 1536, C_K = 2048, C_V = 2560;
constexpr int LDX = 2048;
constexpr float QSCALE = 0.125f * 1.4426950408889634f;
constexpr size_t SHM_BYTES = 131072 + 4096;

struct Params {
  const float* xp; const float* xs; const float* pre_g; const float* w_in; const float* pool_w; const float* pool_scale;
  const float* lq1; const float* lk1; const float* lq2; const float* lk2; const float* subln_g; const float* w_out; const float* post_g;
  float* out; bf16_t* WinT; bf16_t* WoutT; bf16_t* proj; float* rinv; float* rope; float* lam; float* kmax2; unsigned* bar;
};

#define SBAR() __builtin_amdgcn_sched_barrier(0)
__device__ __forceinline__ unsigned cvtpk(float lo, float hi) {
  unsigned r; asm volatile("v_cvt_pk_bf16_f32 %0, %1, %2" : "=v"(r) : "v"(lo), "v"(hi)); return r;
}
__device__ __forceinline__ float bf2f(unsigned short b) { return __uint_as_float(((unsigned)b) << 16); }
__device__ __forceinline__ float bflo(unsigned w) { return __uint_as_float(w << 16); }
__device__ __forceinline__ float bfhi(unsigned w) { return __uint_as_float(w & 0xffff0000u); }
__device__ __forceinline__ bf16_t f2bf(float f) { return (bf16_t)(cvtpk(f, 0.f) & 0xffffu); }
__host__ __device__ __forceinline__ int perm32(int rho) { const int n = rho >> 4, i = rho & 15; return 8 * (i >> 2) + 4 * n + (i & 3); }
__device__ __forceinline__ float silu(float z) { return z * __builtin_amdgcn_rcpf(1.f + __builtin_amdgcn_exp2f(-1.4426950408889634f * z)); }
__device__ __forceinline__ int opaque_tid() { int t = threadIdx.x; asm volatile("" : "+v"(t)); return t; }
__device__ __forceinline__ float wave_sum(float v) {
#pragma unroll
  for (int o = 32; o >= 1; o >>= 1) v += __shfl_xor(v, o);
  return v;
}

__device__ __forceinline__ int src_col_in(int s) {
  const int type = s >> 9, within = s & 511;
  if (type == 0) return 512 + within;
  if (type == 1) return 2560 + within;
  if (type == 5) return 2048 + within;
  const int p = within & 63, wcl = p >> 5, fq = (p >> 3) & 3, n = (p >> 2) & 1, jj = p & 3;
  const int d = wcl * 16 + fq * 4 + jj + 32 * n;
  return (type == 3 ? 1024 : 1536) + (within & ~63) + d;
}

__device__ void phase0(const Params& p, char* shm) {
  const int tid = opaque_tid(), nth = blockDim.x;
  float* tile = (float*)shm;
  float* Wt = tile + 64 * 65 + 32;
  float* Pw = Wt + 64 * 128;
  constexpr int NT_U = DEPTH * 8 * 16, NT_IN = DEPTH * 40 * 16, NT_OUT = DEPTH * 16 * 16;
  for (int it = blockIdx.x; it < NT_U + NT_IN + NT_OUT; it += gridDim.x) {
    __syncthreads();
    if (it < NT_U + NT_IN) {
      int l, n0, k0; const bool isu = it < NT_U;
      if (isu) { l = it / 128; const int r = it % 128; n0 = C_U + (r / 16) * 64; k0 = (r % 16) * 64; }
      else { const int i2 = it - NT_U; l = i2 / 640; const int r = i2 % 640; int nt = r / 16; if (nt >= 16) nt += 8; n0 = nt * 64; k0 = (r % 16) * 64; }
      const float* W = p.w_in + (size_t)l * DM * NPROJ; const float* g = p.pre_g + l * DM;
      if (isu) {
        const int gi = (n0 - C_U) >> 7, d0 = (n0 - C_U) & 127;
        for (int e = tid; e < 64 * 128; e += nth) { const int c = e & 127, kk = e >> 7; Wt[e] = W[(size_t)(k0 + kk) * NPROJ + gi * 128 + c]; }
        for (int e = tid; e < 128 * 64; e += nth) { const int d = e & 63, c = e >> 6; Pw[e] = p.pool_w[((size_t)(l * 4 + gi) * 128 + c) * 128 + d0 + d]; }
        __syncthreads();
        for (int e = tid; e < 4096; e += nth) {
          const int nn = e & 63, kk = e >> 6, nrow = n0 + nn; const int s = (nrow & ~31) + perm32(nrow & 31), dl = s - n0;
          float a = 0.f;
#pragma unroll 8
          for (int c = 0; c < 128; ++c) a = fmaf(Wt[kk * 128 + c], Pw[c * 64 + dl], a);
          tile[kk * 65 + nn] = a * g[k0 + kk];
        }
      } else {
        for (int e = tid; e < 4096; e += nth) {
          const int nn = e & 63, kk = e >> 6, k = k0 + kk, nrow = n0 + nn;
          const int s = (nrow & ~31) + perm32(nrow & 31);
          tile[kk * 65 + nn] = W[(size_t)k * NPROJ + src_col_in(s)] * g[k];
        }
      }
      __syncthreads();
      bf16_t* O = p.WinT + (size_t)l * NPROJ * DM;
      for (int e = tid; e < 4096; e += nth) { const int kk = e & 63, nn = e >> 6; O[(size_t)(n0 + nn) * DM + k0 + kk] = f2bf(tile[kk * 65 + nn]); }
    } else {
      const int it2 = it - NT_U - NT_IN, l = it2 / 256, r = it2 % 256, n0 = (r / 16) * 64, k0 = (r % 16) * 64;
      const float* W = p.w_out + (size_t)l * DM * DM;
      for (int e = tid; e < 4096; e += nth) {
        const int nn = e & 63, kk = e >> 6, nrow = n0 + nn; const int s = (nrow & ~31) + perm32(nrow & 31);
        tile[kk * 65 + nn] = W[(size_t)(k0 + kk) * DM + s];
      }
      __syncthreads();
      bf16_t* O = p.WoutT + (size_t)l * DM * DM;
      for (int e = tid; e < 4096; e += nth) { const int kk = e & 63, nn = e >> 6; O[(size_t)(n0 + nn) * DM + k0 + kk] = f2bf(tile[kk * 65 + nn]); }
    }
  }
  if (blockIdx.x == 0) {
    for (int i = tid; i < XCD_BAR_WORDS; i += nth) p.bar[i] = 0u;
    if (tid < DEPTH * 160) p.kmax2[tid] = 0.f;
    if (tid < 32) { const double c = exp(-(double)tid * (9.210340371976184 / 32.0)) * 0.15915494309189535; const float h = (float)c; p.rope[2 * tid] = h; p.rope[2 * tid + 1] = (float)(c - (double)h); }
    if (tid >= 64 && tid < 64 + 64 * DEPTH) {
      const int l = (tid >> 6) - 1, i = tid & 63;
      float a = p.lq1[l * 64 + i] * p.lk1[l * 64 + i], b = p.lq2[l * 64 + i] * p.lk2[l * 64 + i];
      a = wave_sum(a); b = wave_sum(b);
      const float li = 0.8f - 0.6f * expf(-0.3f * (float)l);
      if (i == 0) p.lam[l] = expf(a) - expf(b) + li;
    }
  }
  const int wid = tid >> 6, lane = tid & 63, nw = nth >> 6;
  for (int row0 = (blockIdx.x * nw + wid) * 2; row0 < T_TOK; row0 += gridDim.x * nw * 2) {
    f32x4 v[2][4];
#pragma unroll
    for (int q = 0; q < 2; ++q) {
      const int row = row0 + q;
      const float* xr = row < TP ? p.xp + (size_t)row * DM : p.xs + (size_t)(row - TP) * DM;
#pragma unroll
      for (int i = 0; i < 4; ++i) v[q][i] = *(const f32x4*)(xr + i * 256 + lane * 4);
    }
#pragma unroll
    for (int q = 0; q < 2; ++q) {
      const int row = row0 + q;
      bf16_t* xo = (bf16_t*)p.out + (size_t)row * LDX;
      float ss = 0.f;
#pragma unroll
      for (int i = 0; i < 4; ++i) {
        ss += v[q][i][0] * v[q][i][0] + v[q][i][1] * v[q][i][1] + v[q][i][2] * v[q][i][2] + v[q][i][3] * v[q][i][3];
        u32x2 w = {cvtpk(v[q][i][0], v[q][i][1]), cvtpk(v[q][i][2], v[q][i][3])};
        *(u32x2*)(xo + i * 256 + lane * 4) = w;
      }
      ss = wave_sum(ss);
      if (lane == 0) p.rinv[row] = __builtin_amdgcn_rsqf(ss * (1.f / DM) + 1e-6f);
    }
  }
}

namespace gm {
constexpr int BM = 256, BK = 64, HALF = 128, NXCD = 8, WGM = 8, HT = HALF * BK;
__device__ __forceinline__ int lds_byte(int r, int c) { int st = (r >> 4) * 2 + (c >> 5), rr = r & 15, cc = c & 31, ob = rr * 64 + cc * 2; return st * 1024 + (ob ^ (((ob >> 9) & 1) << 5)); }
__device__ __forceinline__ void stage_rc(int b, int& R, int& C) { int st = b / 1024, sb = b % 1024, swz = sb ^ (((sb >> 9) & 1) << 5); R = (st >> 1) * 16 + swz / 64; C = (st & 1) * 32 + (swz % 64) / 2; }

#define LAS __attribute__((address_space(3)))
template <class Epi>
__device__ __forceinline__ void gemm_phase(const bf16_t* __restrict__ A, const int lda, const bf16_t* __restrict__ Bt, const int N, const Epi& E, char* shmc) {
  constexpr int K = 1024, nt = K / BK, HTB = HALF * BK * 2;
  LAS unsigned char* lds = (LAS unsigned char*)shmc;
  const int tid = opaque_tid(), wid = __builtin_amdgcn_readfirstlane(tid >> 6), lane = tid & 63, wr = wid >> 2, wc = wid & 3, fr = lane & 15, fq = lane >> 4;
  unsigned voffA[2], voffB[2];
#pragma unroll
  for (int i = 0; i < 2; ++i) { int R, C; stage_rc(tid * 16 + i * 8192, R, C); voffA[i] = (unsigned)(R * lda + C) * 2u; voffB[i] = (unsigned)(R * K + C) * 2u; }
  const size_t kstep = (size_t)(BK * 2);
  const size_t hstepA = (size_t)HALF * lda * 2, hstepB = (size_t)HALF * K * 2;
  const size_t tstepA = 2 * hstepA, tstepB = 2 * hstepB;
  const unsigned ldsw = (unsigned)wid * 1024u;
  const int aoff = lds_byte(wr * 64 + fr, fq * 8), boff = lds_byte(wc * 32 + fr, fq * 8);
#define PG8_SA(b, h) (((b) * 2 + (h)) * HTB)
#define PG8_SB(b, h) ((4 + (b) * 2 + (h)) * HTB)
#define PG8_STAGE(bufoff, gbase, voff) do { _Pragma("unroll") for (int _i = 0; _i < 2; ++_i) \
        __builtin_amdgcn_global_load_lds((const unsigned*)((const char*)(gbase) + (voff)[_i]), (LAS unsigned*)(lds + (bufoff) + ldsw + _i * 8192), 16, 0, 0); } while (0)
#define PG8_LDA(dst, b, h) do { _Pragma("unroll") for (int m = 0; m < 4; ++m) _Pragma("unroll") for (int k = 0; k < 2; ++k) dst[m][k] = *(const LAS bf16x8*)(lds + PG8_SA(b, h) + aoff + m * 2048 + k * 1024); } while (0)
#define PG8_LDB(dst, b, h) do { _Pragma("unroll") for (int n = 0; n < 2; ++n) _Pragma("unroll") for (int k = 0; k < 2; ++k) dst[n][k] = *(const LAS bf16x8*)(lds + PG8_SB(b, h) + boff + n * 2048 + k * 1024); } while (0)
#define PG8_MMA(ai, bj, At, Bx) do { __builtin_amdgcn_s_setprio(1); _Pragma("unroll") for (int m = 0; m < 4; ++m) _Pragma("unroll") for (int n = 0; n < 2; ++n) _Pragma("unroll") for (int k = 0; k < 2; ++k) \
        acc[ai][bj][m][n] = __builtin_amdgcn_mfma_f32_16x16x32_bf16(Bx[n][k], At[m][k], acc[ai][bj][m][n], 0, 0, 0); __builtin_amdgcn_s_setprio(0); } while (0)
#define PG8_WAIT_V(n) asm volatile("s_waitcnt vmcnt(" #n ")" ::: "memory")
#define PG8_WAIT_L(n) asm volatile("s_waitcnt lgkmcnt(" #n ")" ::: "memory")
#define PG8_BAR __builtin_amdgcn_s_barrier()
#define PG8_SCHED __builtin_amdgcn_sched_barrier(0)
  const int nM = T_TOK / BM, nN = N / BM, nwg = nM * nN, G = gridDim.x, cblk = blockIdx.x;
  auto next_unit = [&](int i, int& pm, int& pn) -> bool {
    const long L = (long)i * G + cblk; if (L >= nwg) return false;
    int wgid = (int)L; { const int q = nwg / NXCD, r = nwg % NXCD, xcd = wgid % NXCD, off = wgid / NXCD; wgid = (xcd < r ? xcd * (q + 1) : r * (q + 1) + (xcd - r) * q) + off; }
    const int nig = WGM * nN, gid = wgid / nig, fm = gid * WGM, gsz = (nM - fm) < WGM ? (nM - fm) : WGM;
    pm = fm + ((wgid % nig) % gsz); pn = (wgid % nig) / gsz; return true;
  };
  int cpm, cpn, npm = 0, npn = 0, ui = 0;
  if (!next_unit(0, cpm, cpn)) return;
  f32x4 acc[2][2][4][2];
#pragma unroll
  for (int a = 0; a < 2; ++a)
#pragma unroll
    for (int b = 0; b < 2; ++b)
#pragma unroll
      for (int m = 0; m < 4; ++m)
#pragma unroll
        for (int n = 0; n < 2; ++n) acc[a][b][m][n] = (f32x4){0.f, 0.f, 0.f, 0.f};
  bf16x8 At[4][2], B0[2][2], B1[2][2];
  const char* cA = (const char*)A + (size_t)cpm * tstepA; const char* cB = (const char*)Bt + (size_t)cpn * tstepB;
  PG8_STAGE(PG8_SB(0, 0), cB, voffB); PG8_STAGE(PG8_SB(0, 1), cB + hstepB, voffB); PG8_STAGE(PG8_SA(0, 0), cA, voffA); PG8_STAGE(PG8_SA(0, 1), cA + hstepA, voffA);
  if (wr == 1) PG8_BAR;
  PG8_WAIT_V(2); PG8_BAR;
  PG8_STAGE(PG8_SB(1, 0), cB + kstep, voffB); PG8_STAGE(PG8_SA(1, 0), cA + kstep, voffA); PG8_STAGE(PG8_SB(1, 1), cB + hstepB + kstep, voffB);
  PG8_WAIT_V(6); PG8_BAR;
  for (;;) {
    const bool has_next = next_unit(ui + 1, npm, npn);
    const char* nA = has_next ? (const char*)A + (size_t)npm * tstepA : cA; const char* nB = has_next ? (const char*)Bt + (size_t)npn * tstepB : cB;
    for (int t = 0; t < nt; t += 2) {
      const bool last = (t == nt - 2);
      const char* a1 = cA + (size_t)(t + 1) * kstep;
      const char* a2 = last ? nA : cA + (size_t)(t + 2) * kstep; const char* b2 = last ? nB : cB + (size_t)(t + 2) * kstep;
      const char* a3 = a2 + kstep; const char* b3 = b2 + kstep;
      PG8_LDB(B0, 0, 0); PG8_LDB(B1, 0, 1); PG8_SCHED; PG8_LDA(At, 0, 0); PG8_STAGE(PG8_SA(1, 1), a1 + hstepA, voffA);
      PG8_WAIT_V(8); PG8_WAIT_L(0); PG8_BAR; PG8_MMA(0, 0, At, B0); PG8_MMA(0, 1, At, B1); PG8_BAR; PG8_SCHED;
      PG8_LDA(At, 0, 1); PG8_STAGE(PG8_SB(0, 0), b2, voffB); PG8_STAGE(PG8_SB(0, 1), b2 + hstepB, voffB); PG8_STAGE(PG8_SA(0, 0), a2, voffA);
      PG8_WAIT_V(8); PG8_WAIT_L(0); PG8_BAR; PG8_MMA(1, 0, At, B0); PG8_MMA(1, 1, At, B1); PG8_BAR; PG8_SCHED;
      PG8_LDB(B0, 1, 0); PG8_LDB(B1, 1, 1); PG8_SCHED; PG8_LDA(At, 1, 0); PG8_STAGE(PG8_SA(0, 1), a2 + hstepA, voffA);
      PG8_WAIT_V(8); PG8_WAIT_L(0); PG8_BAR; PG8_MMA(0, 0, At, B0); PG8_MMA(0, 1, At, B1); PG8_BAR; PG8_SCHED;
      PG8_LDA(At, 1, 1); PG8_STAGE(PG8_SB(1, 0), b3, voffB); PG8_STAGE(PG8_SB(1, 1), b3 + hstepB, voffB); PG8_STAGE(PG8_SA(1, 0), a3, voffA);
      PG8_WAIT_V(8); PG8_WAIT_L(0); PG8_BAR; PG8_MMA(1, 0, At, B0); PG8_MMA(1, 1, At, B1); PG8_BAR; PG8_SCHED;
    }
    if (wr == 0) PG8_BAR;
    E(acc, cpm, cpn, wr, wc, fr, fq);
    if (!has_next) break;
#pragma unroll
    for (int a = 0; a < 2; ++a)
#pragma unroll
      for (int b = 0; b < 2; ++b)
#pragma unroll
        for (int m = 0; m < 4; ++m)
#pragma unroll
          for (int n = 0; n < 2; ++n) acc[a][b][m][n] = (f32x4){0.f, 0.f, 0.f, 0.f};
    cpm = npm; cpn = npn; cA = nA; cB = nB; ++ui;
    if (wr == 1) PG8_BAR;
  }
  PG8_WAIT_V(0);
  PG8_BAR;
#undef PG8_SA
#undef PG8_SB
#undef PG8_STAGE
#undef PG8_LDA
#undef PG8_LDB
#undef PG8_MMA
}

struct EpiIn {
  const float* rinv; const float* rope; bf16_t* proj; float* kmax2;
  __device__ __forceinline__ void operator()(const f32x4 (&acc)[2][2][4][2], int pm, int pn, int wr, int wc, int fr, int fq) const {
    const bool isrope = (pn >= 6 && pn <= 9); const float qs = (pn == 6 || pn == 7) ? QSCALE : 1.f;
    const bool isk = (pn == 8 || pn == 9);
    float kmx[2] = {0.f, 0.f};
    float ch[4], cl[4];
    if (isrope) {
#pragma unroll
      for (int jj = 0; jj < 4; ++jj) { const int i = (wc & 1) * 16 + fq * 4 + jj; ch[jj] = rope[2 * i]; cl[jj] = rope[2 * i + 1]; }
    }
#pragma unroll
    for (int ai = 0; ai < 2; ++ai)
#pragma unroll
      for (int m = 0; m < 4; ++m) {
        const int row = pm * BM + ai * HALF + wr * 64 + m * 16 + fr;
        const float ri = rinv[row];
        float cs[4], sn[4];
        if (isrope) {
          const float pos = (float)(row < TP ? (row & (S_P - 1)) : (row & (S_S - 1)));
#pragma unroll
          for (int jj = 0; jj < 4; ++jj) {
            const float h = pos * ch[jj], e = fmaf(pos, ch[jj], -h) + pos * cl[jj];
            const float rev = (h - floorf(h)) + e;
            sn[jj] = __builtin_amdgcn_sinf(rev); cs[jj] = __builtin_amdgcn_cosf(rev);
          }
        }
        bf16_t* rowp = proj + (size_t)row * NPROJ + pn * BM + wc * 32 + 8 * fq;
#pragma unroll
        for (int bj = 0; bj < 2; ++bj) {
          f32x4 v0 = acc[ai][bj][m][0] * ri, v1 = acc[ai][bj][m][1] * ri;
          if (isrope) {
#pragma unroll
            for (int jj = 0; jj < 4; ++jj) { const float a = v0[jj], b = v1[jj]; v0[jj] = (a * cs[jj] - b * sn[jj]) * qs; v1[jj] = (b * cs[jj] + a * sn[jj]) * qs; }
          }
          u32x4 w; w.x = cvtpk(v0[0], v0[1]); w.y = cvtpk(v0[2], v0[3]); w.z = cvtpk(v1[0], v1[1]); w.w = cvtpk(v1[2], v1[3]);
          *(u32x4*)(rowp + bj * HALF) = w;
          if (isk) { float ss = v0[0] * v0[0] + v0[1] * v0[1] + v0[2] * v0[2] + v0[3] * v0[3] + v1[0] * v1[0] + v1[1] * v1[1] + v1[2] * v1[2] + v1[3] * v1[3];
            ss += __shfl_xor(ss, 16); ss += __shfl_xor(ss, 32); kmx[bj] = fmaxf(kmx[bj], ss); }
        }
      }
    if (isk) {
      const int row0 = pm * BM, sq = row0 < TP ? (row0 >> 14) : 2 + ((row0 - TP) >> 12);
#pragma unroll
      for (int bj = 0; bj < 2; ++bj) { float v = kmx[bj];
        v = fmaxf(v, __shfl_xor(v, 1)); v = fmaxf(v, __shfl_xor(v, 2)); v = fmaxf(v, __shfl_xor(v, 4)); v = fmaxf(v, __shfl_xor(v, 8));
        if ((fr | fq) == 0) atomicMax((unsigned*)(kmax2 + (sq * 4 + (pn - 8) * 2 + bj) * 4 + wc), __float_as_uint(v)); }
    }
  }
};
struct EpiOut {
  bf16_t* proj;
  __device__ __forceinline__ void operator()(const f32x4 (&acc)[2][2][4][2], int pm, int pn, int wr, int wc, int fr, int fq) const {
#pragma unroll
    for (int ai = 0; ai < 2; ++ai)
#pragma unroll
      for (int m = 0; m < 4; ++m) {
        const int row = pm * BM + ai * HALF + wr * 64 + m * 16 + fr;
        bf16_t* rowp = proj + (size_t)row * NPROJ + C_U + pn * BM + wc * 32 + 8 * fq;
#pragma unroll
        for (int bj = 0; bj < 2; ++bj) { const f32x4 v0 = acc[ai][bj][m][0], v1 = acc[ai][bj][m][1];
          u32x4 w; w.x = cvtpk(v0[0], v0[1]); w.y = cvtpk(v0[2], v0[3]); w.z = cvtpk(v1[0], v1[1]); w.w = cvtpk(v1[2], v1[3]);
          *(u32x4*)(rowp + bj * HALF) = w; }
      }
  }
};
}

__device__ __forceinline__ void bf8_to_f(const u32x4 w, float* v) {
  v[0] = bflo(w.x); v[1] = bfhi(w.x); v[2] = bflo(w.y); v[3] = bfhi(w.y); v[4] = bflo(w.z); v[5] = bfhi(w.z); v[6] = bflo(w.w); v[7] = bfhi(w.w);
}
__device__ void pool_phase(const Params& p, int l, bool dry = false) {
  const int tid = opaque_tid(), c8 = tid & 63, tq = tid >> 6;
  const int g = c8 >> 4, hw = 1 << g;
  const float* sc = p.pool_scale + l * 512 + c8 * 8;
  float scl[8];
#pragma unroll
  for (int e = 0; e < 8; ++e) scl[e] = sc[e];
  for (int ch = blockIdx.x; ch < T_TOK / 128; ch += gridDim.x) {
    const int t0 = ch * 128 + tq * 16;
    const int S = t0 < TP ? S_P : S_S, pos0 = t0 & (S - 1), s0 = t0 - pos0;
    const bf16_t* ub = p.proj + (size_t)s0 * NPROJ + C_U + c8 * 8;
    float sum[8] = {0, 0, 0, 0, 0, 0, 0, 0};
#pragma unroll
    for (int j = 0; j < 16; ++j) {
      const int r = pos0 - hw + j; const bool ok = (j < 2 * hw) && r >= 0 && r < S; const int rc = min(max(r, 0), S - 1);
      float v[8]; bf8_to_f(*(const u32x4*)(ub + (size_t)rc * NPROJ), v); const float m = ok ? 1.f : 0.f;
#pragma unroll
      for (int e = 0; e < 8; ++e) sum[e] = fmaf(m, v[e], sum[e]);
    }
#pragma unroll
    for (int i4 = 0; i4 < 16; i4 += 4) {
      u32x4 wu[4], wz[4], wa[4], wsb[4];
#pragma unroll
      for (int q = 0; q < 4; ++q) {
        const int pos = pos0 + i4 + q, ra = pos + hw, rs = pos - hw;
        wu[q] = *(const u32x4*)(ub + (size_t)pos * NPROJ);
        wz[q] = *(const u32x4*)(p.proj + (size_t)(t0 + i4 + q) * NPROJ + C_ZP + c8 * 8);
        wa[q] = *(const u32x4*)(ub + (size_t)min(ra, S - 1) * NPROJ); wsb[q] = *(const u32x4*)(ub + (size_t)max(rs, 0) * NPROJ);
      }
#pragma unroll
      for (int q = 0; q < 4; ++q) {
        const int pos = pos0 + i4 + q, t = t0 + i4 + q;
        const int lo = max(pos - hw, 0), hi = min(pos + hw, S);
        const float inv = 1.f / (float)(hi - lo);
        float uc[8], z[8], va[8], vs[8], o[8];
        bf8_to_f(wu[q], uc); bf8_to_f(wz[q], z);
#pragma unroll
        for (int e = 0; e < 8; ++e) o[e] = (sum[e] * inv - uc[e]) * scl[e] * silu(z[e]);
        const u32x4 w = {cvtpk(o[0], o[1]), cvtpk(o[2], o[3]), cvtpk(o[4], o[5]), cvtpk(o[6], o[7])};
        if (!dry) *(u32x4*)(p.proj + (size_t)t * NPROJ + C_ZP + c8 * 8) = w;
        const int ra = pos + hw, rs = pos - hw; const float ma = ra < S ? 1.f : 0.f, ms = rs >= 0 ? 1.f : 0.f;
        bf8_to_f(wa[q], va); bf8_to_f(wsb[q], vs);
#pragma unroll
        for (int e = 0; e < 8; ++e) sum[e] = fmaf(ma, va[e], fmaf(-ms, vs[e], sum[e]));
      }
    }
  }
}

namespace at {
constexpr int KVBLK = 64, LDK = NPROJ;
constexpr size_t SHM_V = KVBLK * 128 * 2, SHM_K = KVBLK * 128 * 2;
constexpr float THRL = 11.5f;
#define KSWZ(row, colB) ((row) * 256 + ((colB) ^ (((row) & 7) << 4)))
__device__ __forceinline__ int crow(int r, int hi) { return (r & 3) + 8 * (r >> 2) + 4 * hi; }
template <bool SH> __device__ __forceinline__ void partialSM(f32x16& p0, f32x16& p1, float& m_reg, float& mn, float& alpha) {
  if constexpr (!SH) {
    alpha = 1.f;
    return;
  }
  float pmax = p0[0];
#pragma unroll
  for (int r = 1; r < 16; ++r) pmax = fmaxf(pmax, p0[r]);
#pragma unroll
  for (int r = 0; r < 16; ++r) pmax = fmaxf(pmax, p1[r]);
  { auto rr = __builtin_amdgcn_permlane32_swap(__float_as_uint(pmax), __float_as_uint(pmax), false, false);
    pmax = fmaxf(__uint_as_float(rr[0]), __uint_as_float(rr[1])); }
  if (__builtin_expect(__all(pmax - m_reg <= THRL), 1)) { mn = m_reg; alpha = 1.f; }
  else { mn = fmaxf(m_reg, pmax); alpha = __builtin_amdgcn_exp2f(m_reg - mn); m_reg = mn; }
#pragma unroll
  for (int r = 0; r < 16; ++r) p0[r] = p0[r] - mn;
#pragma unroll
  for (int r = 0; r < 16; ++r) p1[r] = p1[r] - mn;
#pragma unroll
  for (int r = 0; r < 16; ++r) { p0[r] = __builtin_amdgcn_exp2f(p0[r]); p1[r] = __builtin_amdgcn_exp2f(p1[r]); }
}
template <bool SH> __device__ __forceinline__ void finishSM(f32x16& p0, f32x16& p1, float alpha, float& l_reg, bf16x8& pa0, bf16x8& pa1, bf16x8& pa2, bf16x8& pa3) {
  if constexpr (!SH) {
#pragma unroll
    for (int r = 0; r < 16; ++r) { p0[r] = __builtin_amdgcn_exp2f(p0[r]); p1[r] = __builtin_amdgcn_exp2f(p1[r]); }
  }
  float ps = 0;
#pragma unroll
  for (int r = 0; r < 16; ++r) ps += p0[r];
#pragma unroll
  for (int r = 0; r < 16; ++r) ps += p1[r];
  { auto rr = __builtin_amdgcn_permlane32_swap(__float_as_uint(ps), __float_as_uint(ps), false, false);
    ps = __uint_as_float(rr[0]) + __uint_as_float(rr[1]); }
  if constexpr (SH) l_reg = l_reg * alpha + ps; else l_reg += ps;
#define PK4(P, BASE, OUT) do { unsigned a0 = cvtpk(P[BASE + 0], P[BASE + 1]), a1 = cvtpk(P[BASE + 2], P[BASE + 3]);   \
    unsigned b0 = cvtpk(P[BASE + 4], P[BASE + 5]), b1 = cvtpk(P[BASE + 6], P[BASE + 7]);                              \
    auto r0 = __builtin_amdgcn_permlane32_swap(a0, b0, false, false); auto r1 = __builtin_amdgcn_permlane32_swap(a1, b1, false, false); \
    u32x4 w = {r0[0], r1[0], r0[1], r1[1]}; OUT = *reinterpret_cast<bf16x8*>(&w); } while (0)
  PK4(p0, 0, pa0); PK4(p0, 8, pa1); PK4(p1, 0, pa2); PK4(p1, 8, pa3);
#undef PK4
}
__device__ __forceinline__ void qkt(f32x16& p0, f32x16& p1, const char* Ks, const bf16x8* qr, int r32, int hi, int mapB) {
  p0 = f32x16{}; p1 = f32x16{};
#pragma unroll
  for (int d0 = 0; d0 < 4; ++d0) { const int cb = (d0 * 16 + hi * 8) * 2 + mapB;
    bf16x8 b0 = *reinterpret_cast<const bf16x8*>(Ks + KSWZ(r32, cb));
    bf16x8 b1 = *reinterpret_cast<const bf16x8*>(Ks + KSWZ(32 + r32, cb));
    p0 = __builtin_amdgcn_mfma_f32_32x32x16_bf16(b0, qr[d0], p0, 0, 0, 0);
    p1 = __builtin_amdgcn_mfma_f32_32x32x16_bf16(b1, qr[d0], p1, 0, 0, 0); }
}
__device__ __forceinline__ int v_st(int k, int c) { const int kk = (k & ~0xC) | ((k & 4) << 1) | ((k & 8) >> 1); return ((kk >> 3) * 4 + (c >> 5)) * 512 + ((kk & 7) * 32 + (c & 31)) * 2; }
__device__ __forceinline__ int v_rd_base(int lane) { return ((lane & 3) << 3) | (((lane >> 2) & 3) << 6) | (((lane >> 4) & 1) << 5) | (((lane >> 5) & 1) << 8); }
constexpr int v_rd_off(int d0, int ks, int half) { return d0 * 512 + ks * 4096 + half * 2048; }
template <int OFF> __device__ __forceinline__ s16x4 tr_read(int vb) {
  s16x4 r; asm volatile("ds_read_b64_tr_b16 %0, %1 offset:%2" : "=&v"(r) : "v"(vb), "i"(OFF) : "memory"); return r;
}
template <int D0> __device__ __forceinline__ void pv_one(f32x16& od, int vb, bf16x8 pa0, bf16x8 pa1, bf16x8 pa2, bf16x8 pa3) {
  const s16x4 l0 = tr_read<v_rd_off(D0, 0, 0)>(vb), h0 = tr_read<v_rd_off(D0, 0, 1)>(vb), l1 = tr_read<v_rd_off(D0, 1, 0)>(vb), h1 = tr_read<v_rd_off(D0, 1, 1)>(vb);
  const s16x4 l2 = tr_read<v_rd_off(D0, 2, 0)>(vb), h2 = tr_read<v_rd_off(D0, 2, 1)>(vb), l3 = tr_read<v_rd_off(D0, 3, 0)>(vb), h3 = tr_read<v_rd_off(D0, 3, 1)>(vb);
  asm volatile("s_waitcnt lgkmcnt(0)" ::: "memory"); SBAR();
#define PK(L, H) (bf16x8){L[0], L[1], L[2], L[3], H[0], H[1], H[2], H[3]}
  od = __builtin_amdgcn_mfma_f32_32x32x16_bf16(pa0, PK(l0, h0), od, 0, 0, 0);
  od = __builtin_amdgcn_mfma_f32_32x32x16_bf16(pa1, PK(l1, h1), od, 0, 0, 0);
  od = __builtin_amdgcn_mfma_f32_32x32x16_bf16(pa2, PK(l2, h2), od, 0, 0, 0);
  od = __builtin_amdgcn_mfma_f32_32x32x16_bf16(pa3, PK(l3, h3), od, 0, 0, 0);
#undef PK
}
__device__ __forceinline__ void pv_d0(f32x16* o, int vb, bf16x8 pa0, bf16x8 pa1, bf16x8 pa2, bf16x8 pa3) {
  pv_one<0>(o[0], vb, pa0, pa1, pa2, pa3); pv_one<1>(o[1], vb, pa0, pa1, pa2, pa3); pv_one<2>(o[2], vb, pa0, pa1, pa2, pa3); pv_one<3>(o[3], vb, pa0, pa1, pa2, pa3);
}

struct VFrag { s16x4 l0, h0, l1, h1, l2, h2, l3, h3; };
template <int D0> __device__ __forceinline__ void v_frag_read(VFrag& f, int vb) {
  f.l0 = tr_read<v_rd_off(D0, 0, 0)>(vb); f.h0 = tr_read<v_rd_off(D0, 0, 1)>(vb); f.l1 = tr_read<v_rd_off(D0, 1, 0)>(vb); f.h1 = tr_read<v_rd_off(D0, 1, 1)>(vb);
  f.l2 = tr_read<v_rd_off(D0, 2, 0)>(vb); f.h2 = tr_read<v_rd_off(D0, 2, 1)>(vb); f.l3 = tr_read<v_rd_off(D0, 3, 0)>(vb); f.h3 = tr_read<v_rd_off(D0, 3, 1)>(vb);
}
__device__ __forceinline__ void v_frag_mma(f32x16& od, const VFrag& f, bf16x8 pa0, bf16x8 pa1, bf16x8 pa2, bf16x8 pa3) {
#define PK(L, H) (bf16x8){L[0], L[1], L[2], L[3], H[0], H[1], H[2], H[3]}
  od = __builtin_amdgcn_mfma_f32_32x32x16_bf16(pa0, PK(f.l0, f.h0), od, 0, 0, 0);
  od = __builtin_amdgcn_mfma_f32_32x32x16_bf16(pa1, PK(f.l1, f.h1), od, 0, 0, 0);
  od = __builtin_amdgcn_mfma_f32_32x32x16_bf16(pa2, PK(f.l2, f.h2), od, 0, 0, 0);
  od = __builtin_amdgcn_mfma_f32_32x32x16_bf16(pa3, PK(f.l3, f.h3), od, 0, 0, 0);
#undef PK
}
template <bool PRE> __device__ __forceinline__ void pv_d0_pipe(f32x16* o, int vb, bf16x8 pa0, bf16x8 pa1, bf16x8 pa2, bf16x8 pa3, VFrag& fa) {
  VFrag fb;
  if constexpr (!PRE) v_frag_read<0>(fa, vb);
  asm volatile("s_waitcnt lgkmcnt(0)" ::: "memory"); SBAR();
  v_frag_read<1>(fb, vb); SBAR(); v_frag_mma(o[0], fa, pa0, pa1, pa2, pa3); SBAR(); asm volatile("s_waitcnt lgkmcnt(0)" ::: "memory"); SBAR();
  v_frag_read<2>(fa, vb); SBAR(); v_frag_mma(o[1], fb, pa0, pa1, pa2, pa3); SBAR(); asm volatile("s_waitcnt lgkmcnt(0)" ::: "memory"); SBAR();
  v_frag_read<3>(fb, vb); SBAR(); v_frag_mma(o[2], fa, pa0, pa1, pa2, pa3); SBAR(); asm volatile("s_waitcnt lgkmcnt(0)" ::: "memory"); SBAR();
  v_frag_mma(o[3], fb, pa0, pa1, pa2, pa3);
}

template <bool SH> __device__ __forceinline__ void attn_unit(bf16_t* __restrict__ proj, int tok0, int kv0, int seq, int h, float lam, float oscale, const float* __restrict__ subg, char* lds, bool dry) {
  const int tid = opaque_tid(), wid = __builtin_amdgcn_readfirstlane(tid >> 6), lane = tid & 63, r32 = lane & 31, hi = lane >> 5;
  const int wq = wid & 3, mp = wid >> 2, mapB = mp * 128;
  constexpr int RING = 32768, NRING = 4;
  LAS char* ldsl = (LAS char*)lds;
  float* ws = (float*)(lds + NRING * RING) + wid * 64; float* li_l = ws; float* al_l = ws + 32;
  const bf16_t* Kh = proj + (size_t)kv0 * NPROJ + C_K + h * 128;
  const bf16_t* Vh = proj + (size_t)kv0 * NPROJ + C_V + h * 128;
  float m_reg = -1e30f, l_reg = 0; f32x16 o[4] = {}; bf16x8 qr[4];
  const bf16_t* Qw = proj + (size_t)(tok0 + wq * 32 + r32) * NPROJ + C_Q + h * 128 + mp * 64 + hi * 8;
#pragma unroll
  for (int d0 = 0; d0 < 4; ++d0) qr[d0] = *reinterpret_cast<const bf16x8*>(Qw + d0 * 16);
  int offK[2], offV[2];
#pragma unroll
  for (int i = 0; i < 2; ++i) {
    const int c = i * 512 + tid;
    { const int row = c >> 4, pc = c & 15, scn = pc ^ (row & 7); offK[i] = row * LDK + scn * 8; }
    { const int sub = c >> 5, kk = (sub >> 2) * 8 + ((c >> 2) & 7), col = (sub & 3) * 32 + (c & 3) * 8;
      const int k = (kk & ~0xC) | ((kk & 4) << 1) | ((kk & 8) >> 1); offV[i] = k * LDK + col; }
  }
  const int vbb = (int)(uintptr_t)ldsl + 16384 + v_rd_base(lane);
#define GLDS16(src, dst) __builtin_amdgcn_global_load_lds((const unsigned*)(src), (LAS unsigned*)(dst), 16, 0, 0)
#define DMA(t, b) do { const bf16_t* kg_ = Kh + (size_t)(t) * (KVBLK * LDK); const bf16_t* vg_ = Vh + (size_t)(t) * (KVBLK * LDK); LAS char* d_ = ldsl + (b) * RING + wid * 1024; \
    GLDS16(kg_ + offK[0], d_); GLDS16(kg_ + offK[1], d_ + 8192); GLDS16(vg_ + offV[0], d_ + 16384); GLDS16(vg_ + offV[1], d_ + 16384 + 8192); } while (0)
#define KBUF(b) ((const char*)lds + (b) * RING)
#define VBUF(b) (vbb + (b) * RING)
#define LANDED() do { asm volatile("s_waitcnt vmcnt(0)" ::: "memory"); __syncthreads(); } while (0)
#define RESC(a) do { if (SH && __any((a) < 1.f)) { if (hi == 0) al_l[r32] = (a); asm volatile("s_waitcnt lgkmcnt(0)" ::: "memory"); \
    _Pragma("unroll") for (int d = 0; d < 4; ++d) _Pragma("unroll") for (int r = 0; r < 16; ++r) o[d][r] *= al_l[crow(r, hi)]; } } while (0)
  f32x16 pA0, pA1, pB0, pB1; float mnA, mnB, alA, alB; bf16x8 pa0, pa1, pa2, pa3; const int NT = seq / KVBLK;
#define BLK_X(N0, N1, P0, P1, alP, t) do { SBAR(); __builtin_amdgcn_s_setprio(1); qkt(N0, N1, KBUF((t) & 3), qr, r32, hi, mapB); \
    if constexpr (!SH) v_frag_read<0>(vfa, VBUF(((t) - 1) & 3)); \
    finishSM<SH>(P0, P1, alP, l_reg, pa0, pa1, pa2, pa3); __builtin_amdgcn_s_setprio(0); SBAR(); } while (0)
#define BLK_Y(C0, C1, mnC, alC, t) do { if constexpr (SH) pv_d0(o, VBUF((t) & 3), pa0, pa1, pa2, pa3); else pv_d0_pipe<true>(o, VBUF((t) & 3), pa0, pa1, pa2, pa3, vfa); partialSM<SH>(C0, C1, m_reg, mnC, alC); RESC(alC); } while (0)
  const int ty = STAGGER_MAP ? mp : (wid & 1);
  VFrag vfa;
  DMA(0, 0); LANDED();
  DMA(1, 1);
  if (ty == 0) {
    qkt(pA0, pA1, KBUF(0), qr, r32, hi, mapB); partialSM<SH>(pA0, pA1, m_reg, mnA, alA);
    LANDED();
    for (int j = 1; j + 1 < NT; j += 2) {
      DMA(j + 1, (j + 1) & 3); BLK_X(pB0, pB1, pA0, pA1, alA, j); BLK_Y(pB0, pB1, mnB, alB, j - 1); LANDED();
      DMA(j + 2, (j + 2) & 3); BLK_X(pA0, pA1, pB0, pB1, alB, j + 1); BLK_Y(pA0, pA1, mnA, alA, j); LANDED();
    }
    BLK_X(pB0, pB1, pA0, pA1, alA, NT - 1); BLK_Y(pB0, pB1, mnB, alB, NT - 2);
    finishSM<SH>(pB0, pB1, alB, l_reg, pa0, pa1, pa2, pa3); SBAR();
    if constexpr (SH) pv_d0(o, VBUF((NT - 1) & 3), pa0, pa1, pa2, pa3); else pv_d0_pipe<false>(o, VBUF((NT - 1) & 3), pa0, pa1, pa2, pa3, vfa);
  } else {
    qkt(pA0, pA1, KBUF(0), qr, r32, hi, mapB);
    LANDED();
    DMA(2, 2); partialSM<SH>(pA0, pA1, m_reg, mnA, alA); BLK_X(pB0, pB1, pA0, pA1, alA, 1); LANDED();
    for (int j = 2; j + 2 < NT; j += 2) {
      DMA(j + 1, (j + 1) & 3); BLK_Y(pB0, pB1, mnB, alB, j - 2); BLK_X(pA0, pA1, pB0, pB1, alB, j); LANDED();
      DMA(j + 2, (j + 2) & 3); BLK_Y(pA0, pA1, mnA, alA, j - 1); BLK_X(pB0, pB1, pA0, pA1, alA, j + 1); LANDED();
    }
    DMA(NT - 1, (NT - 1) & 3); BLK_Y(pB0, pB1, mnB, alB, NT - 4); BLK_X(pA0, pA1, pB0, pB1, alB, NT - 2); LANDED();
    BLK_Y(pA0, pA1, mnA, alA, NT - 3); BLK_X(pB0, pB1, pA0, pA1, alA, NT - 1);
    BLK_Y(pB0, pB1, mnB, alB, NT - 2);
    finishSM<SH>(pB0, pB1, alB, l_reg, pa0, pa1, pa2, pa3); SBAR();
    if constexpr (SH) pv_d0(o, VBUF((NT - 1) & 3), pa0, pa1, pa2, pa3); else pv_d0_pipe<false>(o, VBUF((NT - 1) & 3), pa0, pa1, pa2, pa3, vfa);
  }
#undef BLK_X
#undef BLK_Y
  if (hi == 0) li_l[r32] = l_reg; asm volatile("s_waitcnt lgkmcnt(0)" ::: "memory");
  float rli[16];
#pragma unroll
  for (int r = 0; r < 16; ++r) rli[r] = __builtin_amdgcn_rcpf(li_l[crow(r, hi)]);
  __syncthreads();
  float* X = (float*)lds;
  if (mp == 1) {
#pragma unroll
    for (int d = 0; d < 4; ++d)
#pragma unroll
      for (int r = 0; r < 16; ++r) X[(wq * 64 + d * 16 + r) * 64 + lane] = o[d][r] * rli[r] * lam;
  }
  __syncthreads();
  if (mp == 0) {
#pragma unroll
    for (int d = 0; d < 4; ++d)
#pragma unroll
      for (int r = 0; r < 16; ++r) { const int ix = (wq * 64 + d * 16 + r) * 64 + lane; X[ix] = o[d][r] * rli[r] - X[ix]; }
  }
  __syncthreads();
  {
    const int row = tid >> 2, dq = tid & 3, rl = row & 31, w = row >> 5, hh = (rl >> 2) & 1, r = (rl & 3) + 4 * (rl >> 3);
    const float* xb = X + (w * 64 + dq * 16 + r) * 64 + hh * 32;
    f32x4 a[8]; float ss = 0.f;
#pragma unroll
    for (int i = 0; i < 8; ++i) { a[i] = *(const f32x4*)(xb + i * 4); ss += a[i][0] * a[i][0] + a[i][1] * a[i][1] + a[i][2] * a[i][2] + a[i][3] * a[i][3]; }
    ss += __shfl_xor(ss, 1); ss += __shfl_xor(ss, 2);
    const float rn = __builtin_amdgcn_rsqf(ss * (1.f / 128.f) + 1e-5f) * oscale;
    bf16_t* zp = proj + (size_t)(tok0 + row) * NPROJ + C_ZA + h * 128 + dq * 32;
    const float* gg = subg + dq * 32;
#pragma unroll
    for (int i = 0; i < 4; ++i) {
      const u32x4 z = *(const u32x4*)(zp + i * 8);
      const f32x4 a0 = a[2 * i], a1 = a[2 * i + 1]; const f32x4 g0 = *(const f32x4*)(gg + i * 8), g1 = *(const f32x4*)(gg + i * 8 + 4);
      u32x4 wv;
      wv.x = cvtpk(a0[0] * rn * g0[0] * silu(bflo(z.x)), a0[1] * rn * g0[1] * silu(bfhi(z.x)));
      wv.y = cvtpk(a0[2] * rn * g0[2] * silu(bflo(z.y)), a0[3] * rn * g0[3] * silu(bfhi(z.y)));
      wv.z = cvtpk(a1[0] * rn * g1[0] * silu(bflo(z.z)), a1[1] * rn * g1[1] * silu(bfhi(z.z)));
      wv.w = cvtpk(a1[2] * rn * g1[2] * silu(bflo(z.w)), a1[3] * rn * g1[3] * silu(bfhi(z.w)));
      if (!dry) *(u32x4*)(zp + i * 8) = wv;
    }
  }
  __syncthreads();
#undef DMA
#undef GLDS16
#undef KBUF
#undef VBUF
#undef LANDED
#undef RESC
}

__device__ void attn_phase(const Params& p, int l, char* lds, bool dry = false) {
  const float lam = p.lam[l];
  const float oscale = 1.f - (0.8f - 0.6f * expf(-0.3f * (float)l));
  const float* subg = p.subln_g + l * 128;
  for (int u = blockIdx.x; u < 2048; u += gridDim.x) {
    int tok0, kv0, seq, h;
    if (u < 1024) { const int x = u & 7, j = u >> 3; const int b = x >> 2; h = x & 3; seq = S_P; kv0 = b * S_P; tok0 = kv0 + j * 128; }
    else { const int v = u - 1024, x = v & 7, j = v >> 3; const int pr = x * 4 + (j >> 5), b = pr >> 2; h = pr & 3; seq = S_S; kv0 = TP + b * S_S; tok0 = kv0 + (j & 31) * 128; }
    bool need;
    { const int tid = opaque_tid(), wid = tid >> 6, lane = tid & 63, r32 = lane & 31, hi = lane >> 5, wq = wid & 3, mp = wid >> 2;
      const int sq = tok0 < TP ? (tok0 >> 14) : 2 + ((tok0 - TP) >> 12);
      const float* km = p.kmax2 + ((l * 10 + sq) * 4 + h) * 4 + mp * 2;
      const float kmx = sqrtf(km[0] + km[1]) * 1.01f;
      const bf16_t* Qw = p.proj + (size_t)(tok0 + wq * 32 + r32) * NPROJ + C_Q + h * 128 + mp * 64 + hi * 8;
      float ss = 0.f;
#pragma unroll
      for (int d0 = 0; d0 < 4; ++d0) { const u32x4 w = *(const u32x4*)(Qw + d0 * 16);
        ss += bflo(w.x) * bflo(w.x) + bfhi(w.x) * bfhi(w.x) + bflo(w.y) * bflo(w.y) + bfhi(w.y) * bfhi(w.y) + bflo(w.z) * bflo(w.z) + bfhi(w.z) * bfhi(w.z) + bflo(w.w) * bflo(w.w) + bfhi(w.w) * bfhi(w.w); }
      ss += __shfl_xor(ss, 32);
      need = __any(!(sqrtf(ss) * kmx < 100.f)) != 0; }
    if (need) attn_unit<true>(p.proj, tok0, kv0, seq, h, lam, oscale, subg, lds, dry);
    else attn_unit<false>(p.proj, tok0, kv0, seq, h, lam, oscale, subg, lds, dry);
  }
}
}

__device__ void post_phase(const Params& p, int l) {
  const int tid = opaque_tid(), wid = tid >> 6, lane = tid & 63, nw = blockDim.x >> 6;
  const float* pg = p.post_g + l * DM;
  constexpr int R = 2;
  for (int row0 = (blockIdx.x * nw + wid) * R; row0 < T_TOK; row0 += gridDim.x * nw * R) {
    f32x4 y[R][4], x[R][4]; u32x2 xh[R][4], xl[R][4], yb[R][4];
#pragma unroll
    for (int q = 0; q < R; ++q) {
      const int row = row0 + q;
      const bf16_t* yr = p.proj + (size_t)row * NPROJ + C_U;
#pragma unroll
      for (int i = 0; i < 4; ++i) yb[q][i] = *(const u32x2*)(yr + i * 256 + lane * 4);
      if (l == 0) {
        const float* xr = row < TP ? p.xp + (size_t)row * DM : p.xs + (size_t)(row - TP) * DM;
#pragma unroll
        for (int i = 0; i < 4; ++i) x[q][i] = *(const f32x4*)(xr + i * 256 + lane * 4);
      } else {
        const bf16_t* xo = (const bf16_t*)p.out + (size_t)row * LDX;
#pragma unroll
        for (int i = 0; i < 4; ++i) { xh[q][i] = *(const u32x2*)(xo + i * 256 + lane * 4); xl[q][i] = *(const u32x2*)(xo + DM + i * 256 + lane * 4); }
      }
    }
#pragma unroll
    for (int q = 0; q < R; ++q) {
      const int row = row0 + q;
      bf16_t* xo = (bf16_t*)p.out + (size_t)row * LDX;
      float ss = 0.f;
#pragma unroll
      for (int i = 0; i < 4; ++i) { y[q][i] = (f32x4){bflo(yb[q][i].x), bfhi(yb[q][i].x), bflo(yb[q][i].y), bfhi(yb[q][i].y)};
        ss += y[q][i][0] * y[q][i][0] + y[q][i][1] * y[q][i][1] + y[q][i][2] * y[q][i][2] + y[q][i][3] * y[q][i][3]; }
      if (l != 0) {
#pragma unroll
        for (int i = 0; i < 4; ++i) {
          const u32x2 h = xh[q][i], lo = xl[q][i];
          x[q][i][0] = bflo(h.x) + bflo(lo.x); x[q][i][1] = bfhi(h.x) + bfhi(lo.x); x[q][i][2] = bflo(h.y) + bflo(lo.y); x[q][i][3] = bfhi(h.y) + bfhi(lo.y);
        }
      }
      ss = wave_sum(ss);
      const float ry = __builtin_amdgcn_rsqf(ss * (1.f / DM) + 1e-6f);
      float s2 = 0.f;
#pragma unroll
      for (int i = 0; i < 4; ++i) {
        const f32x4 g = *(const f32x4*)(pg + i * 256 + lane * 4);
#pragma unroll
        for (int e = 0; e < 4; ++e) { x[q][i][e] = x[q][i][e] + y[q][i][e] * ry * g[e]; s2 += x[q][i][e] * x[q][i][e]; }
      }
      if (l == DEPTH - 1) {
        float* orow = p.out + (size_t)row * DM;
#pragma unroll
        for (int i = 0; i < 4; ++i) *(f32x4*)(orow + i * 256 + lane * 4) = x[q][i];
      } else {
        s2 = wave_sum(s2);
        if (lane == 0) p.rinv[row] = __builtin_amdgcn_rsqf(s2 * (1.f / DM) + 1e-6f);
#pragma unroll
        for (int i = 0; i < 4; ++i) {
          const unsigned h0 = cvtpk(x[q][i][0], x[q][i][1]), h1 = cvtpk(x[q][i][2], x[q][i][3]);
          const unsigned l0 = cvtpk(x[q][i][0] - bflo(h0), x[q][i][1] - bfhi(h0)), l1 = cvtpk(x[q][i][2] - bflo(h1), x[q][i][3] - bfhi(h1));
          *(u32x2*)(xo + i * 256 + lane * 4) = (u32x2){h0, h1}; *(u32x2*)(xo + DM + i * 256 + lane * 4) = (u32x2){l0, l1};
        }
      }
    }
  }
}

#define XB_TMO      128
#define XB_XCNT(j)  (256  + 64 * (j))
#define XB_XSUB(j)  (1280 + 64 * (j))
#define XB_XGEN(j)  (2304 + 64 * (j))
#define XB_TOP      3328
#define XB_TOPGEN   3392
#define XB_SPIN_CAP (1u << 22)
#define XLAS __attribute__((address_space(3)))
__device__ __forceinline__ unsigned xb_ld(unsigned* p)              { return __hip_atomic_load(p, __ATOMIC_RELAXED, __HIP_MEMORY_SCOPE_AGENT); }
__device__ __forceinline__ unsigned xb_add(unsigned* p, unsigned v) { return __hip_atomic_fetch_add(p, v, __ATOMIC_RELAXED, __HIP_MEMORY_SCOPE_AGENT); }
__device__ __forceinline__ unsigned xb_xcc_id() { return (unsigned)__builtin_amdgcn_s_getreg((3 << 11) | 20) & 0xFu; }
#define XB_SPIN(cond, bar) do { unsigned _sp = 0; while (cond) { __builtin_amdgcn_s_sleep(1); \
    if ((++_sp & 255u) == 0u) { if (xb_ld(&(bar)[XB_TMO])) break; if (_sp > XB_SPIN_CAP) { atomicAdd(&(bar)[XB_TMO], 1u); break; } } } } while (0)
struct XcdBarrier { unsigned* bar; unsigned x; volatile XLAS unsigned* st; };
__device__ __forceinline__ XcdBarrier xcd_barrier_post(unsigned* bar, volatile XLAS unsigned* st) {
  XcdBarrier b; b.bar = bar; b.x = xb_xcc_id(); b.st = st;
  if (threadIdx.x == 0) (void)xb_add(&bar[XB_XCNT(b.x)], 1u);
  return b;
}
__device__ __forceinline__ void xcd_barrier_complete(unsigned* bar, unsigned x, unsigned& nloc, unsigned& nx) {
  const unsigned G = gridDim.x * gridDim.y * gridDim.z;
  unsigned sum, cnt, mine, sp = 0u;
  for (;;) {
    sum = 0u; cnt = 0u; mine = 0u;
#pragma unroll
    for (unsigned j = 0; j < 16; ++j) { const unsigned c = xb_ld(&bar[XB_XCNT(j)]); sum += c; cnt += (c > 0u) ? 1u : 0u; mine = (j == x) ? c : mine; }
    if (sum == G) break;
    __builtin_amdgcn_s_sleep(1);
    if ((++sp & 255u) == 0u) { if (xb_ld(&bar[XB_TMO])) break; if (sp > XB_SPIN_CAP) { atomicAdd(&bar[XB_TMO], 1u); break; } }
  }
  nloc = mine > 0u ? mine : 1u; nx = cnt > 0u ? cnt : 1u;
}
__device__ __forceinline__ void xcd_barrier(const XcdBarrier& b) {
  asm volatile("s_waitcnt vmcnt(0)" ::: "memory");
  __syncthreads();
  if (threadIdx.x == 0) {
    unsigned* bar = b.bar;
    __builtin_amdgcn_s_waitcnt(0);
    unsigned nloc = b.st[0], nx = b.st[1];
    if (nloc == 0u) { xcd_barrier_complete(bar, b.x, nloc, nx); b.st[0] = nloc; b.st[1] = nx; }
    const unsigned old = xb_add(&bar[XB_XSUB(b.x)], 1u);
    const unsigned gen = old / nloc;
    if (old + 1u == (gen + 1u) * nloc) {
      __builtin_amdgcn_fence(__ATOMIC_RELEASE, "agent");
      asm volatile("s_waitcnt vmcnt(0)" ::: "memory");
      const unsigned og = xb_add(&bar[XB_TOP], 1u);
      const unsigned tg = og / nx;
      if (og + 1u == (tg + 1u) * nx) xb_add(&bar[XB_TOPGEN], 1u);
      else XB_SPIN(xb_ld(&bar[XB_TOPGEN]) == tg, bar);
      __builtin_amdgcn_fence(__ATOMIC_ACQUIRE, "agent");
      xb_add(&bar[XB_XGEN(b.x)], 1u);
      asm volatile("s_waitcnt vmcnt(0)" ::: "memory");
    } else {
      XB_SPIN(xb_ld(&bar[XB_XGEN(b.x)]) == gen, bar);
      __builtin_amdgcn_fence(__ATOMIC_ACQUIRE, "agent");
      asm volatile("s_waitcnt vmcnt(0)" ::: "memory");
    }
  }
  __syncthreads();
}

__device__ __forceinline__ void run_phase(const Params& p, int ph, char* shm) {
  if (ph == 0) { phase0(p, shm); return; }
  const int l = (ph - 1) >> 2, s = (ph - 1) & 3;
  if (s == 0) { gm::EpiIn e{p.rinv, p.rope, p.proj, p.kmax2 + l * 160}; gm::gemm_phase(( const bf16_t*)p.out, LDX, p.WinT + (size_t)l * NPROJ * DM, NPROJ, e, shm); }
  else if (s == 1) { pool_phase(p, l); at::attn_phase(p, l, shm); }
  else if (s == 2) { gm::EpiOut e{p.proj}; gm::gemm_phase(p.proj, NPROJ, p.WoutT + (size_t)l * DM * DM, DM, e, shm); }
  else post_phase(p, l);
}

#if MK_MULTI
template <int S> __global__ void __launch_bounds__(NT_THREADS, 1) k_phase(Params p, int l) {
  extern __shared__ __attribute__((aligned(16))) char shm[];
  if (S == 0) phase0(p, shm); else run_phase(p, 1 + 4 * l + (S - 1), shm);
}
#else
__global__ void __launch_bounds__(NT_THREADS, 1) k_mega(Params p) {
  extern __shared__ __attribute__((aligned(16))) char shm[];
  cg::grid_group grid = cg::this_grid();
  volatile XLAS unsigned* xst = (volatile XLAS unsigned*)(XLAS char*)(shm + 131072 + 3072);
  if (threadIdx.x == 0) { xst[0] = 0u; xst[1] = 0u; xst[2] = 0u; xst[3] = 0u; }
  phase0(p, shm);
  grid.sync();
  const XcdBarrier xb = xcd_barrier_post(p.bar, xst);
#define GSYNC() xcd_barrier(xb)
  for (int l = 0; l < DEPTH; ++l) {
#if REP_GEMM
    { gm::EpiIn e{p.rinv, p.rope, p.proj, p.kmax2 + l * 160}; gm::gemm_phase((const bf16_t*)p.out, LDX, p.WinT + (size_t)l * NPROJ * DM, NPROJ, e, shm); }
    GSYNC();
#endif
    { gm::EpiIn e{p.rinv, p.rope, p.proj, p.kmax2 + l * 160}; gm::gemm_phase((const bf16_t*)p.out, LDX, p.WinT + (size_t)l * NPROJ * DM, NPROJ, e, shm); }
    GSYNC();
    pool_phase(p, l);
#if REP_ATT
    at::attn_phase(p, l, shm, true); GSYNC();
#endif
    at::attn_phase(p, l, shm);
    GSYNC();
#if REP_GEMM
    { gm::EpiOut e{p.proj}; gm::gemm_phase(p.proj, NPROJ, p.WoutT + (size_t)l * DM * DM, DM, e, shm); }
    GSYNC();
#endif
    { gm::EpiOut e{p.proj}; gm::gemm_phase(p.proj, NPROJ, p.WoutT + (size_t)l * DM * DM, DM, e, shm); }
    GSYNC();
#if REP_POST
    if (l == 0) { post_phase(p, l); GSYNC(); }
#endif
    post_phase(p, l);
    if (l + 1 < DEPTH) GSYNC();
  }
}
#endif

extern "C" void kernel_launch(void* const* d_in, const int* in_sizes, int n_in, void* d_out, int out_size, void* d_ws, size_t ws_size, hipStream_t stream) {
  Params p{};
  p.xp = (const float*)d_in[0]; p.xs = (const float*)d_in[1]; p.pre_g = (const float*)d_in[2]; p.w_in = (const float*)d_in[3];
  p.pool_w = (const float*)d_in[4]; p.pool_scale = (const float*)d_in[5]; p.lq1 = (const float*)d_in[6]; p.lk1 = (const float*)d_in[7];
  p.lq2 = (const float*)d_in[8]; p.lk2 = (const float*)d_in[9]; p.subln_g = (const float*)d_in[10]; p.w_out = (const float*)d_in[11]; p.post_g = (const float*)d_in[12];
  p.out = (float*)d_out;
  char* w = (char*)d_ws; size_t off = 0;
  p.proj = (bf16_t*)(w + off); off += (size_t)T_TOK * NPROJ * 2;
  p.WinT = (bf16_t*)(w + off); off += (size_t)DEPTH * NPROJ * DM * 2;
  p.WoutT = (bf16_t*)(w + off); off += (size_t)DEPTH * DM * DM * 2;
  p.rinv = (float*)(w + off); off += (size_t)T_TOK * 4;
  p.rope = (float*)(w + off); off += 256;
  p.lam = (float*)(w + off); off += 256;
  p.kmax2 = (float*)(w + off); off += 2048;
  p.bar = (unsigned*)(w + off); off += 16384;
  if (off > ws_size) { fprintf(stderr, "kernel_launch: workspace too small (%zu > %zu)\n", off, ws_size); return; }
#if MK_MULTI
  static int ok = 0;
  if (!ok) {
    (void)hipFuncSetAttribute((const void*)k_phase<0>, hipFuncAttributeMaxDynamicSharedMemorySize, (int)SHM_BYTES);
    (void)hipFuncSetAttribute((const void*)k_phase<1>, hipFuncAttributeMaxDynamicSharedMemorySize, (int)SHM_BYTES);
    (void)hipFuncSetAttribute((const void*)k_phase<2>, hipFuncAttributeMaxDynamicSharedMemorySize, (int)SHM_BYTES);
    (void)hipFuncSetAttribute((const void*)k_phase<3>, hipFuncAttributeMaxDynamicSharedMemorySize, (int)SHM_BYTES);
    (void)hipFuncSetAttribute((const void*)k_phase<4>, hipFuncAttributeMaxDynamicSharedMemorySize, (int)SHM_BYTES);
    ok = 1; }
  hipLaunchKernelGGL(k_phase<0>, dim3(256), dim3(NT_THREADS), SHM_BYTES, stream, p, 0);
  for (int l = 0; l < DEPTH; ++l) {
    hipLaunchKernelGGL(k_phase<1>, dim3(256), dim3(NT_THREADS), SHM_BYTES, stream, p, l);
    hipLaunchKernelGGL(k_phase<2>, dim3(256), dim3(NT_THREADS), SHM_BYTES, stream, p, l);
    hipLaunchKernelGGL(k_phase<3>, dim3(256), dim3(NT_THREADS), SHM_BYTES, stream, p, l);
    hipLaunchKernelGGL(k_phase<4>, dim3(256), dim3(NT_THREADS), SHM_BYTES, stream, p, l);
  }
#else
  static int grid_blocks = 0;
  if (!grid_blocks) {
    (void)hipFuncSetAttribute((const void*)k_mega, hipFuncAttributeMaxDynamicSharedMemorySize, (int)SHM_BYTES);
    int dev = 0, cus = 0, per_cu = 0;
    (void)hipGetDevice(&dev);
    (void)hipDeviceGetAttribute(&cus, hipDeviceAttributeMultiprocessorCount, dev);
    (void)hipOccupancyMaxActiveBlocksPerMultiprocessor(&per_cu, k_mega, NT_THREADS, SHM_BYTES);
    if (per_cu > 1) per_cu = 1;
    grid_blocks = cus * per_cu;
  }
  void* args[] = {&p};
  hipError_t e = hipLaunchCooperativeKernel((void*)k_mega, dim3(grid_blocks), dim3(NT_THREADS), args, SHM_BYTES, stream);
  if (e != hipSuccess) fprintf(stderr, "cooperative launch failed: %s (grid %d)\n", hipGetErrorString(e), grid_blocks);
#endif
}
```

```cpp
#include <hip/hip_runtime.h>
#include <hip/hip_cooperative_groups.h>
#include <cstdio>
#include <cstdint>
namespace cg = cooperative_groups;

#ifndef REP_ATT
#define REP_ATT 0
#endif
#ifndef STAGGER_MAP
#define STAGGER_MAP 1
#endif
#ifndef REP_POST
#define REP_POST 0
#endif
#ifndef REP_GEMM
#define REP_GEMM 0
#endif
#ifndef MK_MULTI
#define MK_MULTI 0
#endif

typedef unsigned short bf16_t;
using bf16x8 = __attribute__((ext_vector_type(8))) short;
using s16x4  = __attribute__((ext_vector_type(4))) short;
using f32x16 = __attribute__((ext_vector_type(16))) float;
using f32x4  = __attribute__((ext_vector_type(4))) float;
using u32x4  = __attribute__((ext_vector_type(4))) unsigned;
using u32x2  = __attribute__((ext_vector_type(2))) unsigned;

#define XCD_BAR_WORDS 3456
constexpr int NT_THREADS = 512;
constexpr int T_TOK = 65536, TP = 32768, DM = 1024, NPROJ = 3072, DEPTH = 2;
constexpr int S_P = 16384, S_S = 4096;
constexpr int C_ZP = 0, C_ZA = 512, C_U = 1024, C_Q = 1536, C_K = 2048, C_V = 2560;
constexpr int LDX = 2048;
constexpr float QSCALE = 0.125f * 1.4426950408889634f;
constexpr size_t SHM_BYTES = 131072 + 4096;

struct Params {
  const float* xp; const float* xs; const float* pre_g; const float* w_in; const float* pool_w; const float* pool_scale;
  const float* lq1; const float* lk1; const float* lq2; const float* lk2; const float* subln_g; const float* w_out; const float* post_g;
  float* out; bf16_t* WinT; bf16_t* WoutT; bf16_t* proj; float* rinv; float* rope; float* lam; float* kmax2; unsigned* bar;
};

#define SBAR() __builtin_amdgcn_sched_barrier(0)
__device__ __forceinline__ unsigned cvtpk(float lo, float hi) {
  unsigned r; asm volatile("v_cvt_pk_bf16_f32 %0, %1, %2" : "=v"(r) : "v"(lo), "v"(hi)); return r;
}
__device__ __forceinline__ float bf2f(unsigned short b) { return __uint_as_float(((unsigned)b) << 16); }
__device__ __forceinline__ float bflo(unsigned w) { return __uint_as_float(w << 16); }
__device__ __forceinline__ float bfhi(unsigned w) { return __uint_as_float(w & 0xffff0000u); }
__device__ __forceinline__ bf16_t f2bf(float f) { return (bf16_t)(cvtpk(f, 0.f) & 0xffffu); }
__host__ __device__ __forceinline__ int perm32(int rho) { const int n = rho >> 4, i = rho & 15; return 8 * (i >> 2) + 4 * n + (i & 3); }
__device__ __forceinline__ float silu(float z) { return z * __builtin_amdgcn_rcpf(1.f + __builtin_amdgcn_exp2f(-1.4426950408889634f * z)); }
__device__ __forceinline__ int opaque_tid() { int t = threadIdx.x; asm volatile("" : "+v"(t)); return t; }
__device__ __forceinline__ float wave_sum(float v) {
#pragma unroll
  for (int o = 32; o >= 1; o >>= 1) v += __shfl_xor(v, o);
  return v;
}

__device__ __forceinline__ int src_col_in(int s) {
  const int type = s >> 9, within = s & 511;
  if (type == 0) return 512 + within;
  if (type == 1) return 2560 + within;
  if (type == 5) return 2048 + within;
  const int p = within & 63, wcl = p >> 5, fq = (p >> 3) & 3, n = (p >> 2) & 1, jj = p & 3;
  const int d = wcl * 16 + fq * 4 + jj + 32 * n;
  return (type == 3 ? 1024 : 1536) + (within & ~63) + d;
}

__device__ void phase0(const Params& p, char* shm) {
  const int tid = opaque_tid(), nth = blockDim.x;
  float* tile = (float*)shm;
  float* Wt = tile + 64 * 65 + 32;
  float* Pw = Wt + 64 * 128;
  constexpr int NT_U = DEPTH * 8 * 16, NT_IN = DEPTH * 40 * 16, NT_OUT = DEPTH * 16 * 16;
  for (int it = blockIdx.x; it < NT_U + NT_IN + NT_OUT; it += gridDim.x) {
    __syncthreads();
    if (it < NT_U + NT_IN) {
      int l, n0, k0; const bool isu = it < NT_U;
      if (isu) { l = it / 128; const int r = it % 128; n0 = C_U + (r / 16) * 64; k0 = (r % 16) * 64; }
      else { const int i2 = it - NT_U; l = i2 / 640; const int r = i2 % 640; int nt = r / 16; if (nt >= 16) nt += 8; n0 = nt * 64; k0 = (r % 16) * 64; }
      const float* W = p.w_in + (size_t)l * DM * NPROJ; const float* g = p.pre_g + l * DM;
      if (isu) {
        const int gi = (n0 - C_U) >> 7, d0 = (n0 - C_U) & 127;
        for (int e = tid; e < 64 * 128; e += nth) { const int c = e & 127, kk = e >> 7; Wt[e] = W[(size_t)(k0 + kk) * NPROJ + gi * 128 + c]; }
        for (int e = tid; e < 128 * 64; e += nth) { const int d = e & 63, c = e >> 6; Pw[e] = p.pool_w[((size_t)(l * 4 + gi) * 128 + c) * 128 + d0 + d]; }
        __syncthreads();
        for (int e = tid; e < 4096; e += nth) {
          const int nn = e & 63, kk = e >> 6, nrow = n0 + nn; const int s = (nrow & ~31) + perm32(nrow & 31), dl = s - n0;
          float a = 0.f;
#pragma unroll 8
          for (int c = 0; c < 128; ++c) a = fmaf(Wt[kk * 128 + c], Pw[c * 64 + dl], a);
          tile[kk * 65 + nn] = a * g[k0 + kk];
        }
      } else {
        for (int e = tid; e < 4096; e += nth) {
          const int nn = e & 63, kk = e >> 6, k = k0 + kk, nrow = n0 + nn;
          const int s = (nrow & ~31) + perm32(nrow & 31);
          tile[kk * 65 + nn] = W[(size_t)k * NPROJ + src_col_in(s)] * g[k];
        }
      }
      __syncthreads();
      bf16_t* O = p.WinT + (size_t)l * NPROJ * DM;
      for (int e = tid; e < 4096; e += nth) { const int kk = e & 63, nn = e >> 6; O[(size_t)(n0 + nn) * DM + k0 + kk] = f2bf(tile[kk * 65 + nn]); }
    } else {
      const int it2 = it - NT_U - NT_IN, l = it2 / 256, r = it2 % 256, n0 = (r / 16) * 64, k0 = (r % 16) * 64;
      const float* W = p.w_out + (size_t)l * DM * DM;
      for (int e = tid; e < 4096; e += nth) {
        const int nn = e & 63, kk = e >> 6, nrow = n0 + nn; const int s = (nrow & ~31) + perm32(nrow & 31);
        tile[kk * 65 + nn] = W[(size_t)(k0 + kk) * DM + s];
      }
      __syncthreads();
      bf16_t* O = p.WoutT + (size_t)l * DM * DM;
      for (int e = tid; e < 4096; e += nth) { const int kk = e & 63, nn = e >> 6; O[(size_t)(n0 + nn) * DM + k0 + kk] = f2bf(tile[kk * 65 + nn]); }
    }
  }
  if (blockIdx.x == 0) {
    for (int i = tid; i < XCD_BAR_WORDS; i += nth) p.bar[i] = 0u;
    if (tid < DEPTH * 160) p.kmax2[tid] = 0.f;
    if (tid < 32) { const double c = exp(-(double)tid * (9.210340371976184 / 32.0)) * 0.15915494309189535; const float h = (float)c; p.rope[2 * tid] = h; p.rope[2 * tid + 1] = (float)(c - (double)h); }
    if (tid >= 64 && tid < 64 + 64 * DEPTH) {
      const int l = (tid >> 6) - 1, i = tid & 63;
      float a = p.lq1[l * 64 + i] * p.lk1[l * 64 + i], b = p.lq2[l * 64 + i] * p.lk2[l * 64 + i];
      a = wave_sum(a); b = wave_sum(b);
      const float li = 0.8f - 0.6f * expf(-0.3f * (float)l);
      if (i == 0) p.lam[l] = expf(a) - expf(b) + li;
    }
  }
  const int wid = tid >> 6, lane = tid & 63, nw = nth >> 6;
  for (int row0 = (blockIdx.x * nw + wid) * 2; row0 < T_TOK; row0 += gridDim.x * nw * 2) {
    f32x4 v[2][4];
#pragma unroll
    for (int q = 0; q < 2; ++q) {
      const int row = row0 + q;
      const float* xr = row < TP ? p.xp + (size_t)row * DM : p.xs + (size_t)(row - TP) * DM;
#pragma unroll
      for (int i = 0; i < 4; ++i) v[q][i] = *(const f32x4*)(xr + i * 256 + lane * 4);
    }
#pragma unroll
    for (int q = 0; q < 2; ++q) {
      const int row = row0 + q;
      bf16_t* xo = (bf16_t*)p.out + (size_t)row * LDX;
      float ss = 0.f;
#pragma unroll
      for (int i = 0; i < 4; ++i) {
        ss += v[q][i][0] * v[q][i][0] + v[q][i][1] * v[q][i][1] + v[q][i][2] * v[q][i][2] + v[q][i][3] * v[q][i][3];
        u32x2 w = {cvtpk(v[q][i][0], v[q][i][1]), cvtpk(v[q][i][2], v[q][i][3])};
        *(u32x2*)(xo + i * 256 + lane * 4) = w;
      }
      ss = wave_sum(ss);
      if (lane == 0) p.rinv[row] = __builtin_amdgcn_rsqf(ss * (1.f / DM) + 1e-6f);
    }
  }
}

namespace gm {
constexpr int BM = 256, BK = 64, HALF = 128, NXCD = 8, WGM = 8, HT = HALF * BK;
__device__ __forceinline__ int lds_byte(int r, int c) { int st = (r >> 4) * 2 + (c >> 5), rr = r & 15, cc = c & 31, ob = rr * 64 + cc * 2; return st * 1024 + (ob ^ (((ob >> 9) & 1) << 5)); }
__device__ __forceinline__ void stage_rc(int b, int& R, int& C) { int st = b / 1024, sb = b % 1024, swz = sb ^ (((sb >> 9) & 1) << 5); R = (st >> 1) * 16 + swz / 64; C = (st & 1) * 32 + (swz % 64) / 2; }

#define LAS __attribute__((address_space(3)))
template <class Epi>
__device__ __forceinline__ void gemm_phase(const bf16_t* __restrict__ A, const int lda, const bf16_t* __restrict__ Bt, const int N, const Epi& E, char* shmc) {
  constexpr int K = 1024, nt = K / BK, HTB = HALF * BK * 2;
  LAS unsigned char* lds = (LAS unsigned char*)shmc;
  const int tid = opaque_tid(), wid = __builtin_amdgcn_readfirstlane(tid >> 6), lane = tid & 63, wr = wid >> 2, wc = wid & 3, fr = lane & 15, fq = lane >> 4;
  unsigned voffA[2], voffB[2];
#pragma unroll
  for (int i = 0; i < 2; ++i) { int R, C; stage_rc(tid * 16 + i * 8192, R, C); voffA[i] = (unsigned)(R * lda + C) * 2u; voffB[i] = (unsigned)(R * K + C) * 2u; }
  const size_t kstep = (size_t)(BK * 2);
  const size_t hstepA = (size_t)HALF * lda * 2, hstepB = (size_t)HALF * K * 2;
  const size_t tstepA = 2 * hstepA, tstepB = 2 * hstepB;
  const unsigned ldsw = (unsigned)wid * 1024u;
  const int aoff = lds_byte(wr * 64 + fr, fq * 8), boff = lds_byte(wc * 32 + fr, fq * 8);
#define PG8_SA(b, h) (((b) * 2 + (h)) * HTB)
#define PG8_SB(b, h) ((4 + (b) * 2 + (h)) * HTB)
#define PG8_STAGE(bufoff, gbase, voff) do { _Pragma("unroll") for (int _i = 0; _i < 2; ++_i) \
        __builtin_amdgcn_global_load_lds((const unsigned*)((const char*)(gbase) + (voff)[_i]), (LAS unsigned*)(lds + (bufoff) + ldsw + _i * 8192), 16, 0, 0); } while (0)
#define PG8_LDA(dst, b, h) do { _Pragma("unroll") for (int m = 0; m < 4; ++m) _Pragma("unroll") for (int k = 0; k < 2; ++k) dst[m][k] = *(const LAS bf16x8*)(lds + PG8_SA(b, h) + aoff + m * 2048 + k * 1024); } while (0)
#define PG8_LDB(dst, b, h) do { _Pragma("unroll") for (int n = 0; n < 2; ++n) _Pragma("unroll") for (int k = 0; k < 2; ++k) dst[n][k] = *(const LAS bf16x8*)(lds + PG8_SB(b, h) + boff + n * 2048 + k * 1024); } while (0)
#define PG8_MMA(ai, bj, At, Bx) do { __builtin_amdgcn_s_setprio(1); _Pragma("unroll") for (int m = 0; m < 4; ++m) _Pragma("unroll") for (int n = 0; n < 2; ++n) _Pragma("unroll") for (int k = 0; k < 2; ++k) \
        acc[ai][bj][m][n] = __builtin_amdgcn_mfma_f32_16x16x32_bf16(Bx[n][k], At[m][k], acc[ai][bj][m][n], 0, 0, 0); __builtin_amdgcn_s_setprio(0); } while (0)
#define PG8_WAIT_V(n) asm volatile("s_waitcnt vmcnt(" #n ")" ::: "memory")
#define PG8_WAIT_L(n) asm volatile("s_waitcnt lgkmcnt(" #n ")" ::: "memory")
#define PG8_BAR __builtin_amdgcn_s_barrier()
#define PG8_SCHED __builtin_amdgcn_sched_barrier(0)
  const int nM = T_TOK / BM, nN = N / BM, nwg = nM * nN, G = gridDim.x, cblk = blockIdx.x;
  auto next_unit = [&](int i, int& pm, int& pn) -> bool {
    const long L = (long)i * G + cblk; if (L >= nwg) return false;
    int wgid = (int)L; { const int q = nwg / NXCD, r = nwg % NXCD, xcd = wgid % NXCD, off = wgid / NXCD; wgid = (xcd < r ? xcd * (q + 1) : r * (q + 1) + (xcd - r) * q) + off; }
    const int nig = WGM * nN, gid = wgid / nig, fm = gid * WGM, gsz = (nM - fm) < WGM ? (nM - fm) : WGM;
    pm = fm + ((wgid % nig) % gsz); pn = (wgid % nig) / gsz; return true;
  };
  int cpm, cpn, npm = 0, npn = 0, ui = 0;
  if (!next_unit(0, cpm, cpn)) return;
  f32x4 acc[2][2][4][2];
#pragma unroll
  for (int a = 0; a < 2; ++a)
#pragma unroll
    for (int b = 0; b < 2; ++b)
#pragma unroll
      for (int m = 0; m < 4; ++m)
#pragma unroll
        for (int n = 0; n < 2; ++n) acc[a][b][m][n] = (f32x4){0.f, 0.f, 0.f, 0.f};
  bf16x8 At[4][2], B0[2][2], B1[2][2];
  const char* cA = (const char*)A + (size_t)cpm * tstepA; const char* cB = (const char*)Bt + (size_t)cpn * tstepB;
  PG8_STAGE(PG8_SB(0, 0), cB, voffB); PG8_STAGE(PG8_SB(0, 1), cB + hstepB, voffB); PG8_STAGE(PG8_SA(0, 0), cA, voffA); PG8_STAGE(PG8_SA(0, 1), cA + hstepA, voffA);
  if (wr == 1) PG8_BAR;
  PG8_WAIT_V(2); PG8_BAR;
  PG8_STAGE(PG8_SB(1, 0), cB + kstep, voffB); PG8_STAGE(PG8_SA(1, 0), cA + kstep, voffA); PG8_STAGE(PG8_SB(1, 1), cB + hstepB + kstep, voffB);
  PG8_WAIT_V(6); PG8_BAR;
  for (;;) {
    const bool has_next = next_unit(ui + 1, npm, npn);
    const char* nA = has_next ? (const char*)A + (size_t)npm * tstepA : cA; const char* nB = has_next ? (const char*)Bt + (size_t)npn * tstepB : cB;
    for (int t = 0; t < nt; t += 2) {
      const bool last = (t == nt - 2);
      const char* a1 = cA + (size_t)(t + 1) * kstep;
      const char* a2 = last ? nA : cA + (size_t)(t + 2) * kstep; const char* b2 = last ? nB : cB + (size_t)(t + 2) * kstep;
      const char* a3 = a2 + kstep; const char* b3 = b2 + kstep;
      PG8_LDB(B0, 0, 0); PG8_LDB(B1, 0, 1); PG8_SCHED; PG8_LDA(At, 0, 0); PG8_STAGE(PG8_SA(1, 1), a1 + hstepA, voffA);
      PG8_WAIT_V(8); PG8_WAIT_L(0); PG8_BAR; PG8_MMA(0, 0, At, B0); PG8_MMA(0, 1, At, B1); PG8_BAR; PG8_SCHED;
      PG8_LDA(At, 0, 1); PG8_STAGE(PG8_SB(0, 0), b2, voffB); PG8_STAGE(PG8_SB(0, 1), b2 + hstepB, voffB); PG8_STAGE(PG8_SA(0, 0), a2, voffA);
      PG8_WAIT_V(8); PG8_WAIT_L(0); PG8_BAR; PG8_MMA(1, 0, At, B0); PG8_MMA(1, 1, At, B1); PG8_BAR; PG8_SCHED;
      PG8_LDB(B0, 1, 0); PG8_LDB(B1, 1, 1); PG8_SCHED; PG8_LDA(At, 1, 0); PG8_STAGE(PG8_SA(0, 1), a2 + hstepA, voffA);
      PG8_WAIT_V(8); PG8_WAIT_L(0); PG8_BAR; PG8_MMA(0, 0, At, B0); PG8_MMA(0, 1, At, B1); PG8_BAR; PG8_SCHED;
      PG8_LDA(At, 1, 1); PG8_STAGE(PG8_SB(1, 0), b3, voffB); PG8_STAGE(PG8_SB(1, 1), b3 + hstepB, voffB); PG8_STAGE(PG8_SA(1, 0), a3, voffA);
      PG8_WAIT_V(8); PG8_WAIT_L(0); PG8_BAR; PG8_MMA(1, 0, At, B0); PG8_MMA(1, 1, At, B1); PG8_BAR; PG8_SCHED;
    }
    if (wr == 0) PG8_BAR;
    E(acc, cpm, cpn, wr, wc, fr, fq);
    if (!has_next) break;
#pragma unroll
    for (int a = 0; a < 2; ++a)
#pragma unroll
      for (int b = 0; b < 2; ++b)
#pragma unroll
        for (int m = 0; m < 4; ++m)
#pragma unroll
          for (int n = 0; n < 2; ++n) acc[a][b][m][n] = (f32x4){0.f, 0.f, 0.f, 0.f};
    cpm = npm; cpn = npn; cA = nA; cB = nB; ++ui;
    if (wr == 1) PG8_BAR;
  }
  PG8_WAIT_V(0);
  PG8_BAR;
#undef PG8_SA
#undef PG8_SB
#undef PG8_STAGE
#undef PG8_LDA
#undef PG8_LDB
#undef PG8_MMA
}

struct EpiIn {
  const float* rinv; const float* rope; bf16_t* proj; float* kmax2;
  __device__ __forceinline__ void operator()(const f32x4 (&acc)[2][2][4][2], int pm, int pn, int wr, int wc, int fr, int fq) const {
    const bool isrope = (pn >= 6 && pn <= 9); const float qs = (pn == 6 || pn == 7) ? QSCALE : 1.f;
    const bool isk = (pn == 8 || pn == 9);
    float kmx[2] = {0.f, 0.f};
    float ch[4], cl[4];
    if (isrope) {
#pragma unroll
      for (int jj = 0; jj < 4; ++jj) { const int i = (wc & 1) * 16 + fq * 4 + jj; ch[jj] = rope[2 * i]; cl[jj] = rope[2 * i + 1]; }
    }
#pragma unroll
    for (int ai = 0; ai < 2; ++ai)
#pragma unroll
      for (int m = 0; m < 4; ++m) {
        const int row = pm * BM + ai * HALF + wr * 64 + m * 16 + fr;
        const float ri = rinv[row];
        float cs[4], sn[4];
        if (isrope) {
          const float pos = (float)(row < TP ? (row & (S_P - 1)) : (row & (S_S - 1)));
#pragma unroll
          for (int jj = 0; jj < 4; ++jj) {
            const float h = pos * ch[jj], e = fmaf(pos, ch[jj], -h) + pos * cl[jj];
            const float rev = (h - floorf(h)) + e;
            sn[jj] = __builtin_amdgcn_sinf(rev); cs[jj] = __builtin_amdgcn_cosf(rev);
          }
        }
        bf16_t* rowp = proj + (size_t)row * NPROJ + pn * BM + wc * 32 + 8 * fq;
#pragma unroll
        for (int bj = 0; bj < 2; ++bj) {
          f32x4 v0 = acc[ai][bj][m][0] * ri, v1 = acc[ai][bj][m][1] * ri;
          if (isrope) {
#pragma unroll
            for (int jj = 0; jj < 4; ++jj) { const float a = v0[jj], b = v1[jj]; v0[jj] = (a * cs[jj] - b * sn[jj]) * qs; v1[jj] = (b * cs[jj] + a * sn[jj]) * qs; }
          }
          u32x4 w; w.x = cvtpk(v0[0], v0[1]); w.y = cvtpk(v0[2], v0[3]); w.z = cvtpk(v1[0], v1[1]); w.w = cvtpk(v1[2], v1[3]);
          *(u32x4*)(rowp + bj * HALF) = w;
          if (isk) { float ss = v0[0] * v0[0] + v0[1] * v0[1] + v0[2] * v0[2] + v0[3] * v0[3] + v1[0] * v1[0] + v1[1] * v1[1] + v1[2] * v1[2] + v1[3] * v1[3];
            ss += __shfl_xor(ss, 16); ss += __shfl_xor(ss, 32); kmx[bj] = fmaxf(kmx[bj], ss); }
        }
      }
    if (isk) {
      const int row0 = pm * BM, sq = row0 < TP ? (row0 >> 14) : 2 + ((row0 - TP) >> 12);
#pragma unroll
      for (int bj = 0; bj < 2; ++bj) { float v = kmx[bj];
        v = fmaxf(v, __shfl_xor(v, 1)); v = fmaxf(v, __shfl_xor(v, 2)); v = fmaxf(v, __shfl_xor(v, 4)); v = fmaxf(v, __shfl_xor(v, 8));
        if ((fr | fq) == 0) atomicMax((unsigned*)(kmax2 + (sq * 4 + (pn - 8) * 2 + bj) * 4 + wc), __float_as_uint(v)); }
    }
  }
};
struct EpiOut {
  bf16_t* proj;
  __device__ __forceinline__ void operator()(const f32x4 (&acc)[2][2][4][2], int pm, int pn, int wr, int wc, int fr, int fq) const {
#pragma unroll
    for (int ai = 0; ai < 2; ++ai)
#pragma unroll
      for (int m = 0; m < 4; ++m) {
        const int row = pm * BM + ai * HALF + wr * 64 + m * 16 + fr;
        bf16_t* rowp = proj + (size_t)row * NPROJ + C_U + pn * BM + wc * 32 + 8 * fq;
#pragma unroll
        for (int bj = 0; bj < 2; ++bj) { const f32x4 v0 = acc[ai][bj][m][0], v1 = acc[ai][bj][m][1];
          u32x4 w; w.x = cvtpk(v0[0], v0[1]); w.y = cvtpk(v0[2], v0[3]); w.z = cvtpk(v1[0], v1[1]); w.w = cvtpk(v1[2], v1[3]);
          *(u32x4*)(rowp + bj * HALF) = w; }
      }
  }
};
}

__device__ __forceinline__ void bf8_to_f(const u32x4 w, float* v) {
  v[0] = bflo(w.x); v[1] = bfhi(w.x); v[2] = bflo(w.y); v[3] = bfhi(w.y); v[4] = bflo(w.z); v[5] = bfhi(w.z); v[6] = bflo(w.w); v[7] = bfhi(w.w);
}
__device__ void pool_phase(const Params& p, int l, bool dry = false) {
  const int tid = opaque_tid(), c8 = tid & 63, tq = tid >> 6;
  const int g = c8 >> 4, hw = 1 << g;
  const float* sc = p.pool_scale + l * 512 + c8 * 8;
  float scl[8];
#pragma unroll
  for (int e = 0; e < 8; ++e) scl[e] = sc[e];
  for (int ch = blockIdx.x; ch < T_TOK / 128; ch += gridDim.x) {
    const int t0 = ch * 128 + tq * 16;
    const int S = t0 < TP ? S_P : S_S, pos0 = t0 & (S - 1), s0 = t0 - pos0;
    const bf16_t* ub = p.proj + (size_t)s0 * NPROJ + C_U + c8 * 8;
    float sum[8] = {0, 0, 0, 0, 0, 0, 0, 0};
#pragma unroll
    for (int j = 0; j < 16; ++j) {
      const int r = pos0 - hw + j; const bool ok = (j < 2 * hw) && r >= 0 && r < S; const int rc = min(max(r, 0), S - 1);
      float v[8]; bf8_to_f(*(const u32x4*)(ub + (size_t)rc * NPROJ), v); const float m = ok ? 1.f : 0.f;
#pragma unroll
      for (int e = 0; e < 8; ++e) sum[e] = fmaf(m, v[e], sum[e]);
    }
#pragma unroll
    for (int i4 = 0; i4 < 16; i4 += 4) {
      u32x4 wu[4], wz[4], wa[4], wsb[4];
#pragma unroll
      for (int q = 0; q < 4; ++q) {
        const int pos = pos0 + i4 + q, ra = pos + hw, rs = pos - hw;
        wu[q] = *(const u32x4*)(ub + (size_t)pos * NPROJ);
        wz[q] = *(const u32x4*)(p.proj + (size_t)(t0 + i4 + q) * NPROJ + C_ZP + c8 * 8);
        wa[q] = *(const u32x4*)(ub + (size_t)min(ra, S - 1) * NPROJ); wsb[q] = *(const u32x4*)(ub + (size_t)max(rs, 0) * NPROJ);
      }
#pragma unroll
      for (int q = 0; q < 4; ++q) {
        const int pos = pos0 + i4 + q, t = t0 + i4 + q;
        const int lo = max(pos - hw, 0), hi = min(pos + hw, S);
        const float inv = 1.f / (float)(hi - lo);
        float uc[8], z[8], va[8], vs[8], o[8];
        bf8_to_f(wu[q], uc); bf8_to_f(wz[q], z);
#pragma unroll
        for (int e = 0; e < 8; ++e) o[e] = (sum[e] * inv - uc[e]) * scl[e] * silu(z[e]);
        const u32x4 w = {cvtpk(o[0], o[1]), cvtpk(o[2], o[3]), cvtpk(o[4], o[5]), cvtpk(o[6], o[7])};
        if (!dry) *(u32x4*)(p.proj + (size_t)t * NPROJ + C_ZP + c8 * 8) = w;
        const int ra = pos + hw, rs = pos - hw; const float ma = ra < S ? 1.f : 0.f, ms = rs >= 0 ? 1.f : 0.f;
        bf8_to_f(wa[q], va); bf8_to_f(wsb[q], vs);
#pragma unroll
        for (int e = 0; e < 8; ++e) sum[e] = fmaf(ma, va[e], fmaf(-ms, vs[e], sum[e]));
      }
    }
  }
}

namespace at {
constexpr int KVBLK = 64, LDK = NPROJ;
constexpr size_t SHM_V = KVBLK * 128 * 2, SHM_K = KVBLK * 128 * 2;
constexpr float THRL = 11.5f;
#define KSWZ(row, colB) ((row) * 256 + ((colB) ^ (((row) & 7) << 4)))
__device__ __forceinline__ int crow(int r, int hi) { return (r & 3) + 8 * (r >> 2) + 4 * hi; }
template <bool SH> __device__ __forceinline__ void partialSM(f32x16& p0, f32x16& p1, float& m_reg, float& mn, float& alpha) {
  if constexpr (!SH) {
    alpha = 1.f;
    return;
  }
  float pmax = p0[0];
#pragma unroll
  for (int r = 1; r < 16; ++r) pmax = fmaxf(pmax, p0[r]);
#pragma unroll
  for (int r = 0; r < 16; ++r) pmax = fmaxf(pmax, p1[r]);
  { auto rr = __builtin_amdgcn_permlane32_swap(__float_as_uint(pmax), __float_as_uint(pmax), false, false);
    pmax = fmaxf(__uint_as_float(rr[0]), __uint_as_float(rr[1])); }
  if (__builtin_expect(__all(pmax - m_reg <= THRL), 1)) { mn = m_reg; alpha = 1.f; }
  else { mn = fmaxf(m_reg, pmax); alpha = __builtin_amdgcn_exp2f(m_reg - mn); m_reg = mn; }
#pragma unroll
  for (int r = 0; r < 16; ++r) p0[r] = p0[r] - mn;
#pragma unroll
  for (int r = 0; r < 16; ++r) p1[r] = p1[r] - mn;
#pragma unroll
  for (int r = 0; r < 16; ++r) { p0[r] = __builtin_amdgcn_exp2f(p0[r]); p1[r] = __builtin_amdgcn_exp2f(p1[r]); }
}
template <bool SH> __device__ __forceinline__ void finishSM(f32x16& p0, f32x16& p1, float alpha, float& l_reg, bf16x8& pa0, bf16x8& pa1, bf16x8& pa2, bf16x8& pa3) {
  if constexpr (!SH) {
#pragma unroll
    for (int r = 0; r < 16; ++r) { p0[r] = __builtin_amdgcn_exp2f(p0[r]); p1[r] = __builtin_amdgcn_exp2f(p1[r]); }
  }
  float ps = 0;
#pragma unroll
  for (int r = 0; r < 16; ++r) ps += p0[r];
#pragma unroll
  for (int r = 0; r < 16; ++r) ps += p1[r];
  { auto rr = __builtin_amdgcn_permlane32_swap(__float_as_uint(ps), __float_as_uint(ps), false, false);
    ps = __uint_as_float(rr[0]) + __uint_as_float(rr[1]); }
  if constexpr (SH) l_reg = l_reg * alpha + ps; else l_reg += ps;
#define PK4(P, BASE, OUT) do { unsigned a0 = cvtpk(P[BASE + 0], P[BASE + 1]), a1 = cvtpk(P[BASE + 2], P[BASE + 3]);   \
    unsigned b0 = cvtpk(P[BASE + 4], P[BASE + 5]), b1 = cvtpk(P[BASE + 6], P[BASE + 7]);                              \
    auto r0 = __builtin_amdgcn_permlane32_swap(a0, b0, false, false); auto r1 = __builtin_amdgcn_permlane32_swap(a1, b1, false, false); \
    u32x4 w = {r0[0], r1[0], r0[1], r1[1]}; OUT = *reinterpret_cast<bf16x8*>(&w); } while (0)
  PK4(p0, 0, pa0); PK4(p0, 8, pa1); PK4(p1, 0, pa2); PK4(p1, 8, pa3);
#undef PK4
}
__device__ __forceinline__ void qkt(f32x16& p0, f32x16& p1, const char* Ks, const bf16x8* qr, int r32, int hi, int mapB) {
  p0 = f32x16{}; p1 = f32x16{};
#pragma unroll
  for (int d0 = 0; d0 < 4; ++d0) { const int cb = (d0 * 16 + hi * 8) * 2 + mapB;
    bf16x8 b0 = *reinterpret_cast<const bf16x8*>(Ks + KSWZ(r32, cb));
    bf16x8 b1 = *reinterpret_cast<const bf16x8*>(Ks + KSWZ(32 + r32, cb));
    p0 = __builtin_amdgcn_mfma_f32_32x32x16_bf16(b0, qr[d0], p0, 0, 0, 0);
    p1 = __builtin_amdgcn_mfma_f32_32x32x16_bf16(b1, qr[d0], p1, 0, 0, 0); }
}
__device__ __forceinline__ int v_st(int k, int c) { const int kk = (k & ~0xC) | ((k & 4) << 1) | ((k & 8) >> 1); return ((kk >> 3) * 4 + (c >> 5)) * 512 + ((kk & 7) * 32 + (c & 31)) * 2; }
__device__ __forceinline__ int v_rd_base(int lane) { return ((lane & 3) << 3) | (((lane >> 2) & 3) << 6) | (((lane >> 4) & 1) << 5) | (((lane >> 5) & 1) << 8); }
constexpr int v_rd_off(int d0, int ks, int half) { return d0 * 512 + ks * 4096 + half * 2048; }
template <int OFF> __device__ __forceinline__ s16x4 tr_read(int vb) {
  s16x4 r; asm volatile("ds_read_b64_tr_b16 %0, %1 offset:%2" : "=&v"(r) : "v"(vb), "i"(OFF) : "memory"); return r;
}
template <int D0> __device__ __forceinline__ void pv_one(f32x16& od, int vb, bf16x8 pa0, bf16x8 pa1, bf16x8 pa2, bf16x8 pa3) {
  const s16x4 l0 = tr_read<v_rd_off(D0, 0, 0)>(vb), h0 = tr_read<v_rd_off(D0, 0, 1)>(vb), l1 = tr_read<v_rd_off(D0, 1, 0)>(vb), h1 = tr_read<v_rd_off(D0, 1, 1)>(vb);
  const s16x4 l2 = tr_read<v_rd_off(D0, 2, 0)>(vb), h2 = tr_read<v_rd_off(D0, 2, 1)>(vb), l3 = tr_read<v_rd_off(D0, 3, 0)>(vb), h3 = tr_read<v_rd_off(D0, 3, 1)>(vb);
  asm volatile("s_waitcnt lgkmcnt(0)" ::: "memory"); SBAR();
#define PK(L, H) (bf16x8){L[0], L[1], L[2], L[3], H[0], H[1], H[2], H[3]}
  od = __builtin_amdgcn_mfma_f32_32x32x16_bf16(pa0, PK(l0, h0), od, 0, 0, 0);
  od = __builtin_amdgcn_mfma_f32_32x32x16_bf16(pa1, PK(l1, h1), od, 0, 0, 0);
  od = __builtin_amdgcn_mfma_f32_32x32x16_bf16(pa2, PK(l2, h2), od, 0, 0, 0);
  od = __builtin_amdgcn_mfma_f32_32x32x16_bf16(pa3, PK(l3, h3), od, 0, 0, 0);
#undef PK
}
__device__ __forceinline__ void pv_d0(f32x16* o, int vb, bf16x8 pa0, bf16x8 pa1, bf16x8 pa2, bf16x8 pa3) {
  pv_one<0>(o[0], vb, pa0, pa1, pa2, pa3); pv_one<1>(o[1], vb, pa0, pa1, pa2, pa3); pv_one<2>(o[2], vb, pa0, pa1, pa2, pa3); pv_one<3>(o[3], vb, pa0, pa1, pa2, pa3);
}

struct VFrag { s16x4 l0, h0, l1, h1, l2, h2, l3, h3; };
template <int D0> __device__ __forceinline__ void v_frag_read(VFrag& f, int vb) {
  f.l0 = tr_read<v_rd_off(D0, 0, 0)>(vb); f.h0 = tr_read<v_rd_off(D0, 0, 1)>(vb); f.l1 = tr_read<v_rd_off(D0, 1, 0)>(vb); f.h1 = tr_read<v_rd_off(D0, 1, 1)>(vb);
  f.l2 = tr_read<v_rd_off(D0, 2, 0)>(vb); f.h2 = tr_read<v_rd_off(D0, 2, 1)>(vb); f.l3 = tr_read<v_rd_off(D0, 3, 0)>(vb); f.h3 = tr_read<v_rd_off(D0, 3, 1)>(vb);
}
__device__ __forceinline__ void v_frag_mma(f32x16& od, const VFrag& f, bf16x8 pa0, bf16x8 pa1, bf16x8 pa2, bf16x8 pa3) {
#define PK(L, H) (bf16x8){L[0], L[1], L[2], L[3], H[0], H[1], H[2], H[3]}
  od = __builtin_amdgcn_mfma_f32_32x32x16_bf16(pa0, PK(f.l0, f.h0), od, 0, 0, 0);
  od = __builtin_amdgcn_mfma_f32_32x32x16_bf16(pa1, PK(f.l1, f.h1), od, 0, 0, 0);
  od = __builtin_amdgcn_mfma_f32_32x32x16_bf16(pa2, PK(f.l2, f.h2), od, 0, 0, 0);
  od = __builtin_amdgcn_mfma_f32_32x32x16_bf16(pa3, PK(f.l3, f.h3), od, 0, 0, 0);
#undef PK
}
template <bool PRE> __device__ __forceinline__ void pv_d0_pipe(f32x16* o, int vb, bf16x8 pa0, bf16x8 pa1, bf16x8 pa2, bf16x8 pa3, VFrag& fa) {
  VFrag fb;
  if constexpr (!PRE) v_frag_read<0>(fa, vb);
  asm volatile("s_waitcnt lgkmcnt(0)" ::: "memory"); SBAR();
  v_frag_read<1>(fb, vb); SBAR(); v_frag_mma(o[0], fa, pa0, pa1, pa2, pa3); SBAR(); asm volatile("s_waitcnt lgkmcnt(0)" ::: "memory"); SBAR();
  v_frag_read<2>(fa, vb); SBAR(); v_frag_mma(o[1], fb, pa0, pa1, pa2, pa3); SBAR(); asm volatile("s_waitcnt lgkmcnt(0)" ::: "memory"); SBAR();
  v_frag_read<3>(fb, vb); SBAR(); v_frag_mma(o[2], fa, pa0, pa1, pa2, pa3); SBAR(); asm volatile("s_waitcnt lgkmcnt(0)" ::: "memory"); SBAR();
  v_frag_mma(o[3], fb, pa0, pa1, pa2, pa3);
}

template <bool SH> __device__ __forceinline__ void attn_unit(bf16_t* __restrict__ proj, int tok0, int kv0, int seq, int h, float lam, float oscale, const float* __restrict__ subg, char* lds, bool dry) {
  const int tid = opaque_tid(), wid = __builtin_amdgcn_readfirstlane(tid >> 6), lane = tid & 63, r32 = lane & 31, hi = lane >> 5;
  const int wq = wid & 3, mp = wid >> 2, mapB = mp * 128;
  constexpr int RING = 32768, NRING = 4;
  LAS char* ldsl = (LAS char*)lds;
  float* ws = (float*)(lds + NRING * RING) + wid * 64; float* li_l = ws; float* al_l = ws + 32;
  const bf16_t* Kh = proj + (size_t)kv0 * NPROJ + C_K + h * 128;
  const bf16_t* Vh = proj + (size_t)kv0 * NPROJ + C_V + h * 128;
  float m_reg = -1e30f, l_reg = 0; f32x16 o[4] = {}; bf16x8 qr[4];
  const bf16_t* Qw = proj + (size_t)(tok0 + wq * 32 + r32) * NPROJ + C_Q + h * 128 + mp * 64 + hi * 8;
#pragma unroll
  for (int d0 = 0; d0 < 4; ++d0) qr[d0] = *reinterpret_cast<const bf16x8*>(Qw + d0 * 16);
  int offK[2], offV[2];
#pragma unroll
  for (int i = 0; i < 2; ++i) {
    const int c = i * 512 + tid;
    { const int row = c >> 4, pc = c & 15, scn = pc ^ (row & 7); offK[i] = row * LDK + scn * 8; }
    { const int sub = c >> 5, kk = (sub >> 2) * 8 + ((c >> 2) & 7), col = (sub & 3) * 32 + (c & 3) * 8;
      const int k = (kk & ~0xC) | ((kk & 4) << 1) | ((kk & 8) >> 1); offV[i] = k * LDK + col; }
  }
  const int vbb = (int)(uintptr_t)ldsl + 16384 + v_rd_base(lane);
#define GLDS16(src, dst) __builtin_amdgcn_global_load_lds((const unsigned*)(src), (LAS unsigned*)(dst), 16, 0, 0)
#define DMA(t, b) do { const bf16_t* kg_ = Kh + (size_t)(t) * (KVBLK * LDK); const bf16_t* vg_ = Vh + (size_t)(t) * (KVBLK * LDK); LAS char* d_ = ldsl + (b) * RING + wid * 1024; \
    GLDS16(kg_ + offK[0], d_); GLDS16(kg_ + offK[1], d_ + 8192); GLDS16(vg_ + offV[0], d_ + 16384); GLDS16(vg_ + offV[1], d_ + 16384 + 8192); } while (0)
#define KBUF(b) ((const char*)lds + (b) * RING)
#define VBUF(b) (vbb + (b) * RING)
#define LANDED() do { asm volatile("s_waitcnt vmcnt(0)" ::: "memory"); __syncthreads(); } while (0)
#define RESC(a) do { if (SH && __any((a) < 1.f)) { if (hi == 0) al_l[r32] = (a); asm volatile("s_waitcnt lgkmcnt(0)" ::: "memory"); \
    _Pragma("unroll") for (int d = 0; d < 4; ++d) _Pragma("unroll") for (int r = 0; r < 16; ++r) o[d][r] *= al_l[crow(r, hi)]; } } while (0)
  f32x16 pA0, pA1, pB0, pB1; float mnA, mnB, alA, alB; bf16x8 pa0, pa1, pa2, pa3; const int NT = seq / KVBLK;
#define BLK_X(N0, N1, P0, P1, alP, t) do { SBAR(); __builtin_amdgcn_s_setprio(1); qkt(N0, N1, KBUF((t) & 3), qr, r32, hi, mapB); \
    if constexpr (!SH) v_frag_read<0>(vfa, VBUF(((t) - 1) & 3)); \
    finishSM<SH>(P0, P1, alP, l_reg, pa0, pa1, pa2, pa3); __builtin_amdgcn_s_setprio(0); SBAR(); } while (0)
#define BLK_Y(C0, C1, mnC, alC, t) do { if constexpr (SH) pv_d0(o, VBUF((t) & 3), pa0, pa1, pa2, pa3); else pv_d0_pipe<true>(o, VBUF((t) & 3), pa0, pa1, pa2, pa3, vfa); partialSM<SH>(C0, C1, m_reg, mnC, alC); RESC(alC); } while (0)
  const int ty = STAGGER_MAP ? mp : (wid & 1);
  VFrag vfa;
  DMA(0, 0); LANDED();
  DMA(1, 1);
  if (ty == 0) {
    qkt(pA0, pA1, KBUF(0), qr, r32, hi, mapB); partialSM<SH>(pA0, pA1, m_reg, mnA, alA);
    LANDED();
    for (int j = 1; j + 1 < NT; j += 2) {
      BLK_X(pB0, pB1, pA0, pA1, alA, j); DMA(j + 1, (j + 1) & 3); BLK_Y(pB0, pB1, mnB, alB, j - 1); LANDED();
      BLK_X(pA0, pA1, pB0, pB1, alB, j + 1); DMA(j + 2, (j + 2) & 3); BLK_Y(pA0, pA1, mnA, alA, j); LANDED();
    }
    BLK_X(pB0, pB1, pA0, pA1, alA, NT - 1); BLK_Y(pB0, pB1, mnB, alB, NT - 2);
    finishSM<SH>(pB0, pB1, alB, l_reg, pa0, pa1, pa2, pa3); SBAR();
    if constexpr (SH) pv_d0(o, VBUF((NT - 1) & 3), pa0, pa1, pa2, pa3); else pv_d0_pipe<false>(o, VBUF((NT - 1) & 3), pa0, pa1, pa2, pa3, vfa);
  } else {
    qkt(pA0, pA1, KBUF(0), qr, r32, hi, mapB);
    LANDED();
    DMA(2, 2); partialSM<SH>(pA0, pA1, m_reg, mnA, alA); BLK_X(pB0, pB1, pA0, pA1, alA, 1); LANDED();
    for (int j = 2; j + 2 < NT; j += 2) {
      DMA(j + 1, (j + 1) & 3); BLK_Y(pB0, pB1, mnB, alB, j - 2); BLK_X(pA0, pA1, pB0, pB1, alB, j); LANDED();
      DMA(j + 2, (j + 2) & 3); BLK_Y(pA0, pA1, mnA, alA, j - 1); BLK_X(pB0, pB1, pA0, pA1, alA, j + 1); LANDED();
    }
    DMA(NT - 1, (NT - 1) & 3); BLK_Y(pB0, pB1, mnB, alB, NT - 4); BLK_X(pA0, pA1, pB0, pB1, alB, NT - 2); LANDED();
    BLK_Y(pA0, pA1, mnA, alA, NT - 3); BLK_X(pB0, pB1, pA0, pA1, alA, NT - 1);
    BLK_Y(pB0, pB1, mnB, alB, NT - 2);
    finishSM<SH>(pB0, pB1, alB, l_reg, pa0, pa1, pa2, pa3); SBAR();
    if constexpr (SH) pv_d0(o, VBUF((NT - 1) & 3), pa0, pa1, pa2, pa3); else pv_d0_pipe<false>(o, VBUF((NT - 1) & 3), pa0, pa1, pa2, pa3, vfa);
  }
#undef BLK_X
#undef BLK_Y
  if (hi == 0) li_l[r32] = l_reg; asm volatile("s_waitcnt lgkmcnt(0)" ::: "memory");
  float rli[16];
#pragma unroll
  for (int r = 0; r < 16; ++r) rli[r] = __builtin_amdgcn_rcpf(li_l[crow(r, hi)]);
  __syncthreads();
  float* X = (float*)lds;
  if (mp == 1) {
#pragma unroll
    for (int d = 0; d < 4; ++d)
#pragma unroll
      for (int r = 0; r < 16; ++r) X[(wq * 64 + d * 16 + r) * 64 + lane] = o[d][r] * rli[r] * lam;
  }
  __syncthreads();
  if (mp == 0) {
#pragma unroll
    for (int d = 0; d < 4; ++d)
#pragma unroll
      for (int r = 0; r < 16; ++r) { const int ix = (wq * 64 + d * 16 + r) * 64 + lane; X[ix] = o[d][r] * rli[r] - X[ix]; }
  }
  __syncthreads();
  {
    const int row = tid >> 2, dq = tid & 3, rl = row & 31, w = row >> 5, hh = (rl >> 2) & 1, r = (rl & 3) + 4 * (rl >> 3);
    const float* xb = X + (w * 64 + dq * 16 + r) * 64 + hh * 32;
    f32x4 a[8]; float ss = 0.f;
#pragma unroll
    for (int i = 0; i < 8; ++i) { a[i] = *(const f32x4*)(xb + i * 4); ss += a[i][0] * a[i][0] + a[i][1] * a[i][1] + a[i][2] * a[i][2] + a[i][3] * a[i][3]; }
    ss += __shfl_xor(ss, 1); ss += __shfl_xor(ss, 2);
    const float rn = __builtin_amdgcn_rsqf(ss * (1.f / 128.f) + 1e-5f) * oscale;
    bf16_t* zp = proj + (size_t)(tok0 + row) * NPROJ + C_ZA + h * 128 + dq * 32;
    const float* gg = subg + dq * 32;
#pragma unroll
    for (int i = 0; i < 4; ++i) {
      const u32x4 z = *(const u32x4*)(zp + i * 8);
      const f32x4 a0 = a[2 * i], a1 = a[2 * i + 1]; const f32x4 g0 = *(const f32x4*)(gg + i * 8), g1 = *(const f32x4*)(gg + i * 8 + 4);
      u32x4 wv;
      wv.x = cvtpk(a0[0] * rn * g0[0] * silu(bflo(z.x)), a0[1] * rn * g0[1] * silu(bfhi(z.x)));
      wv.y = cvtpk(a0[2] * rn * g0[2] * silu(bflo(z.y)), a0[3] * rn * g0[3] * silu(bfhi(z.y)));
      wv.z = cvtpk(a1[0] * rn * g1[0] * silu(bflo(z.z)), a1[1] * rn * g1[1] * silu(bfhi(z.z)));
      wv.w = cvtpk(a1[2] * rn * g1[2] * silu(bflo(z.w)), a1[3] * rn * g1[3] * silu(bfhi(z.w)));
      if (!dry) *(u32x4*)(zp + i * 8) = wv;
    }
  }
  __syncthreads();
#undef DMA
#undef GLDS16
#undef KBUF
#undef VBUF
#undef LANDED
#undef RESC
}

__device__ void attn_phase(const Params& p, int l, char* lds, bool dry = false) {
  const float lam = p.lam[l];
  const float oscale = 1.f - (0.8f - 0.6f * expf(-0.3f * (float)l));
  const float* subg = p.subln_g + l * 128;
  for (int u = blockIdx.x; u < 2048; u += gridDim.x) {
    int tok0, kv0, seq, h;
    if (u < 1024) { const int x = u & 7, j = u >> 3; const int b = x >> 2; h = x & 3; seq = S_P; kv0 = b * S_P; tok0 = kv0 + j * 128; }
    else { const int v = u - 1024, x = v & 7, j = v >> 3; const int pr = x * 4 + (j >> 5), b = pr >> 2; h = pr & 3; seq = S_S; kv0 = TP + b * S_S; tok0 = kv0 + (j & 31) * 128; }
    bool need;
    { const int tid = opaque_tid(), wid = tid >> 6, lane = tid & 63, r32 = lane & 31, hi = lane >> 5, wq = wid & 3, mp = wid >> 2;
      const int sq = tok0 < TP ? (tok0 >> 14) : 2 + ((tok0 - TP) >> 12);
      const float* km = p.kmax2 + ((l * 10 + sq) * 4 + h) * 4 + mp * 2;
      const float kmx = sqrtf(km[0] + km[1]) * 1.01f;
      const bf16_t* Qw = p.proj + (size_t)(tok0 + wq * 32 + r32) * NPROJ + C_Q + h * 128 + mp * 64 + hi * 8;
      float ss = 0.f;
#pragma unroll
      for (int d0 = 0; d0 < 4; ++d0) { const u32x4 w = *(const u32x4*)(Qw + d0 * 16);
        ss += bflo(w.x) * bflo(w.x) + bfhi(w.x) * bfhi(w.x) + bflo(w.y) * bflo(w.y) + bfhi(w.y) * bfhi(w.y) + bflo(w.z) * bflo(w.z) + bfhi(w.z) * bfhi(w.z) + bflo(w.w) * bflo(w.w) + bfhi(w.w) * bfhi(w.w); }
      ss += __shfl_xor(ss, 32);
      need = __any(!(sqrtf(ss) * kmx < 100.f)) != 0; }
    if (need) attn_unit<true>(p.proj, tok0, kv0, seq, h, lam, oscale, subg, lds, dry);
    else attn_unit<false>(p.proj, tok0, kv0, seq, h, lam, oscale, subg, lds, dry);
  }
}
}

__device__ void post_phase(const Params& p, int l) {
  const int tid = opaque_tid(), wid = tid >> 6, lane = tid & 63, nw = blockDim.x >> 6;
  const float* pg = p.post_g + l * DM;
  constexpr int R = 2;
  for (int row0 = (blockIdx.x * nw + wid) * R; row0 < T_TOK; row0 += gridDim.x * nw * R) {
    f32x4 y[R][4], x[R][4]; u32x2 xh[R][4], xl[R][4], yb[R][4];
#pragma unroll
    for (int q = 0; q < R; ++q) {
      const int row = row0 + q;
      const bf16_t* yr = p.proj + (size_t)row * NPROJ + C_U;
#pragma unroll
      for (int i = 0; i < 4; ++i) yb[q][i] = *(const u32x2*)(yr + i * 256 + lane * 4);
      if (l == 0) {
        const float* xr = row < TP ? p.xp + (size_t)row * DM : p.xs + (size_t)(row - TP) * DM;
#pragma unroll
        for (int i = 0; i < 4; ++i) x[q][i] = *(const f32x4*)(xr + i * 256 + lane * 4);
      } else {
        const bf16_t* xo = (const bf16_t*)p.out + (size_t)row * LDX;
#pragma unroll
        for (int i = 0; i < 4; ++i) { xh[q][i] = *(const u32x2*)(xo + i * 256 + lane * 4); xl[q][i] = *(const u32x2*)(xo + DM + i * 256 + lane * 4); }
      }
    }
#pragma unroll
    for (int q = 0; q < R; ++q) {
      const int row = row0 + q;
      bf16_t* xo = (bf16_t*)p.out + (size_t)row * LDX;
      float ss = 0.f;
#pragma unroll
      for (int i = 0; i < 4; ++i) { y[q][i] = (f32x4){bflo(yb[q][i].x), bfhi(yb[q][i].x), bflo(yb[q][i].y), bfhi(yb[q][i].y)};
        ss += y[q][i][0] * y[q][i][0] + y[q][i][1] * y[q][i][1] + y[q][i][2] * y[q][i][2] + y[q][i][3] * y[q][i][3]; }
      if (l != 0) {
#pragma unroll
        for (int i = 0; i < 4; ++i) {
          const u32x2 h = xh[q][i], lo = xl[q][i];
          x[q][i][0] = bflo(h.x) + bflo(lo.x); x[q][i][1] = bfhi(h.x) + bfhi(lo.x); x[q][i][2] = bflo(h.y) + bflo(lo.y); x[q][i][3] = bfhi(h.y) + bfhi(lo.y);
        }
      }
      ss = wave_sum(ss);
      const float ry = __builtin_amdgcn_rsqf(ss * (1.f / DM) + 1e-6f);
      float s2 = 0.f;
#pragma unroll
      for (int i = 0; i < 4; ++i) {
        const f32x4 g = *(const f32x4*)(pg + i * 256 + lane * 4);
#pragma unroll
        for (int e = 0; e < 4; ++e) { x[q][i][e] = x[q][i][e] + y[q][i][e] * ry * g[e]; s2 += x[q][i][e] * x[q][i][e]; }
      }
      if (l == DEPTH - 1) {
        float* orow = p.out + (size_t)row * DM;
#pragma unroll
        for (int i = 0; i < 4; ++i) *(f32x4*)(orow + i * 256 + lane * 4) = x[q][i];
      } else {
        s2 = wave_sum(s2);
        if (lane == 0) p.rinv[row] = __builtin_amdgcn_rsqf(s2 * (1.f / DM) + 1e-6f);
#pragma unroll
        for (int i = 0; i < 4; ++i) {
          const unsigned h0 = cvtpk(x[q][i][0], x[q][i][1]), h1 = cvtpk(x[q][i][2], x[q][i][3]);
          const unsigned l0 = cvtpk(x[q][i][0] - bflo(h0), x[q][i][1] - bfhi(h0)), l1 = cvtpk(x[q][i][2] - bflo(h1), x[q][i][3] - bfhi(h1));
          *(u32x2*)(xo + i * 256 + lane * 4) = (u32x2){h0, h1}; *(u32x2*)(xo + DM + i * 256 + lane * 4) = (u32x2){l0, l1};
        }
      }
    }
  }
}

#define XB_TMO      128
#define XB_XCNT(j)  (256  + 64 * (j))
#define XB_XSUB(j)  (1280 + 64 * (j))
#define XB_XGEN(j)  (2304 + 64 * (j))
#define XB_TOP      3328
#define XB_TOPGEN   3392
#define XB_SPIN_CAP (1u << 22)
#define XLAS __attribute__((address_space(3)))
__device__ __forceinline__ unsigned xb_ld(unsigned* p)              { return __hip_atomic_load(p, __ATOMIC_RELAXED, __HIP_MEMORY_SCOPE_AGENT); }
__device__ __forceinline__ unsigned xb_add(unsigned* p, unsigned v) { return __hip_atomic_fetch_add(p, v, __ATOMIC_RELAXED, __HIP_MEMORY_SCOPE_AGENT); }
__device__ __forceinline__ unsigned xb_xcc_id() { return (unsigned)__builtin_amdgcn_s_getreg((3 << 11) | 20) & 0xFu; }
#define XB_SPIN(cond, bar) do { unsigned _sp = 0; while (cond) { __builtin_amdgcn_s_sleep(1); \
    if ((++_sp & 255u) == 0u) { if (xb_ld(&(bar)[XB_TMO])) break; if (_sp > XB_SPIN_CAP) { atomicAdd(&(bar)[XB_TMO], 1u); break; } } } } while (0)
struct XcdBarrier { unsigned* bar; unsigned x; volatile XLAS unsigned* st; };
__device__ __forceinline__ XcdBarrier xcd_barrier_post(unsigned* bar, volatile XLAS unsigned* st) {
  XcdBarrier b; b.bar = bar; b.x = xb_xcc_id(); b.st = st;
  if (threadIdx.x == 0) (void)xb_add(&bar[XB_XCNT(b.x)], 1u);
  return b;
}
__device__ __forceinline__ void xcd_barrier_complete(unsigned* bar, unsigned x, unsigned& nloc, unsigned& nx) {
  const unsigned G = gridDim.x * gridDim.y * gridDim.z;
  unsigned sum, cnt, mine, sp = 0u;
  for (;;) {
    sum = 0u; cnt = 0u; mine = 0u;
#pragma unroll
    for (unsigned j = 0; j < 16; ++j) { const unsigned c = xb_ld(&bar[XB_XCNT(j)]); sum += c; cnt += (c > 0u) ? 1u : 0u; mine = (j == x) ? c : mine; }
    if (sum == G) break;
    __builtin_amdgcn_s_sleep(1);
    if ((++sp & 255u) == 0u) { if (xb_ld(&bar[XB_TMO])) break; if (sp > XB_SPIN_CAP) { atomicAdd(&bar[XB_TMO], 1u); break; } }
  }
  nloc = mine > 0u ? mine : 1u; nx = cnt > 0u ? cnt : 1u;
}
__device__ __forceinline__ void xcd_barrier(const XcdBarrier& b) {
  asm volatile("s_waitcnt vmcnt(0)" ::: "memory");
  __syncthreads();
  if (threadIdx.x == 0) {
    unsigned* bar = b.bar;
    __builtin_amdgcn_s_waitcnt(0);
    unsigned nloc = b.st[0], nx = b.st[1];
    if (nloc == 0u) { xcd_barrier_complete(bar, b.x, nloc, nx); b.st[0] = nloc; b.st[1] = nx; }
    const unsigned old = xb_add(&bar[XB_XSUB(b.x)], 1u);
    const unsigned gen = old / nloc;
    if (old + 1u == (gen + 1u) * nloc) {
      __builtin_amdgcn_fence(__ATOMIC_RELEASE, "agent");
      asm volatile("s_waitcnt vmcnt(0)" ::: "memory");
      const unsigned og = xb_add(&bar[XB_TOP], 1u);
      const unsigned tg = og / nx;
      if (og + 1u == (tg + 1u) * nx) xb_add(&bar[XB_TOPGEN], 1u);
      else XB_SPIN(xb_ld(&bar[XB_TOPGEN]) == tg, bar);
      __builtin_amdgcn_fence(__ATOMIC_ACQUIRE, "agent");
      xb_add(&bar[XB_XGEN(b.x)], 1u);
      asm volatile("s_waitcnt vmcnt(0)" ::: "memory");
    } else {
      XB_SPIN(xb_ld(&bar[XB_XGEN(b.x)]) == gen, bar);
      __builtin_amdgcn_fence(__ATOMIC_ACQUIRE, "agent");
      asm volatile("s_waitcnt vmcnt(0)" ::: "memory");
    }
  }
  __syncthreads();
}

__device__ __forceinline__ void run_phase(const Params& p, int ph, char* shm) {
  if (ph == 0) { phase0(p, shm); return; }
  const int l = (ph - 1) >> 2, s = (ph - 1) & 3;
  if (s == 0) { gm::EpiIn e{p.rinv, p.rope, p.proj, p.kmax2 + l * 160}; gm::gemm_phase(( const bf16_t*)p.out, LDX, p.WinT + (size_t)l * NPROJ * DM, NPROJ, e, shm); }
  else if (s == 1) { pool_phase(p, l); at::attn_phase(p, l, shm); }
  else if (s == 2) { gm::EpiOut e{p.proj}; gm::gemm_phase(p.proj, NPROJ, p.WoutT + (size_t)l * DM * DM, DM, e, shm); }
  else post_phase(p, l);
}

#if MK_MULTI
template <int S> __global__ void __launch_bounds__(NT_THREADS, 1) k_phase(Params p, int l) {
  extern __shared__ __attribute__((aligned(16))) char shm[];
  if (S == 0) phase0(p, shm); else run_phase(p, 1 + 4 * l + (S - 1), shm);
}
#else
__global__ void __launch_bounds__(NT_THREADS, 1) k_mega(Params p) {
  extern __shared__ __attribute__((aligned(16))) char shm[];
  cg::grid_group grid = cg::this_grid();
  volatile XLAS unsigned* xst = (volatile XLAS unsigned*)(XLAS char*)(shm + 131072 + 3072);
  if (threadIdx.x == 0) { xst[0] = 0u; xst[1] = 0u; xst[2] = 0u; xst[3] = 0u; }
  phase0(p, shm);
  grid.sync();
  const XcdBarrier xb = xcd_barrier_post(p.bar, xst);
#define GSYNC() xcd_barrier(xb)
  for (int l = 0; l < DEPTH; ++l) {
#if REP_GEMM
    { gm::EpiIn e{p.rinv, p.rope, p.proj, p.kmax2 + l * 160}; gm::gemm_phase((const bf16_t*)p.out, LDX, p.WinT + (size_t)l * NPROJ * DM, NPROJ, e, shm); }
    GSYNC();
#endif
    { gm::EpiIn e{p.rinv, p.rope, p.proj, p.kmax2 + l * 160}; gm::gemm_phase((const bf16_t*)p.out, LDX, p.WinT + (size_t)l * NPROJ * DM, NPROJ, e, shm); }
    GSYNC();
    pool_phase(p, l);
#if REP_ATT
    at::attn_phase(p, l, shm, true); GSYNC();
#endif
    at::attn_phase(p, l, shm);
    GSYNC();
#if REP_GEMM
    { gm::EpiOut e{p.proj}; gm::gemm_phase(p.proj, NPROJ, p.WoutT + (size_t)l * DM * DM, DM, e, shm); }
    GSYNC();
#endif
    { gm::EpiOut e{p.proj}; gm::gemm_phase(p.proj, NPROJ, p.WoutT + (size_t)l * DM * DM, DM, e, shm); }
    GSYNC();
#if REP_POST
    if (l == 0) { post_phase(p, l); GSYNC(); }
#endif
    post_phase(p, l);
    if (l + 1 < DEPTH) GSYNC();
  }
}
#endif

extern "C" void kernel_launch(void* const* d_in, const int* in_sizes, int n_in, void* d_out, int out_size, void* d_ws, size_t ws_size, hipStream_t stream) {
  Params p{};
  p.xp = (const float*)d_in[0]; p.xs = (const float*)d_in[1]; p.pre_g = (const float*)d_in[2]; p.w_in = (const float*)d_in[3];
  p.pool_w = (const float*)d_in[4]; p.pool_scale = (const float*)d_in[5]; p.lq1 = (const float*)d_in[6]; p.lk1 = (const float*)d_in[7];
  p.lq2 = (const float*)d_in[8]; p.lk2 = (const float*)d_in[9]; p.subln_g = (const float*)d_in[10]; p.w_out = (const float*)d_in[11]; p.post_g = (const float*)d_in[12];
  p.out = (float*)d_out;
  char* w = (char*)d_ws; size_t off = 0;
  p.proj = (bf16_t*)(w + off); off += (size_t)T_TOK * NPROJ * 2;
  p.WinT = (bf16_t*)(w + off); off += (size_t)DEPTH * NPROJ * DM * 2;
  p.WoutT = (bf16_t*)(w + off); off += (size_t)DEPTH * DM * DM * 2;
  p.rinv = (float*)(w + off); off += (size_t)T_TOK * 4;
  p.rope = (float*)(w + off); off += 256;
  p.lam = (float*)(w + off); off += 256;
  p.kmax2 = (float*)(w + off); off += 2048;
  p.bar = (unsigned*)(w + off); off += 16384;
  if (off > ws_size) { fprintf(stderr, "kernel_launch: workspace too small (%zu > %zu)\n", off, ws_size); return; }
#if MK_MULTI
  static int ok = 0;
  if (!ok) {
    (void)hipFuncSetAttribute((const void*)k_phase<0>, hipFuncAttributeMaxDynamicSharedMemorySize, (int)SHM_BYTES);
    (void)hipFuncSetAttribute((const void*)k_phase<1>, hipFuncAttributeMaxDynamicSharedMemorySize, (int)SHM_BYTES);
    (void)hipFuncSetAttribute((const void*)k_phase<2>, hipFuncAttributeMaxDynamicSharedMemorySize, (int)SHM_BYTES);
    (void)hipFuncSetAttribute((const void*)k_phase<3>, hipFuncAttributeMaxDynamicSharedMemorySize, (int)SHM_BYTES);
    (void)hipFuncSetAttribute((const void*)k_phase<4>, hipFuncAttributeMaxDynamicSharedMemorySize, (int)SHM_BYTES);
    ok = 1; }
  hipLaunchKernelGGL(k_phase<0>, dim3(256), dim3(NT_THREADS), SHM_BYTES, stream, p, 0);
  for (int l = 0; l < DEPTH; ++l) {
    hipLaunchKernelGGL(k_phase<1>, dim3(256), dim3(NT_THREADS), SHM_BYTES, stream, p, l);
    hipLaunchKernelGGL(k_phase<2>, dim3(256), dim3(NT_THREADS), SHM_BYTES, stream, p, l);
    hipLaunchKernelGGL(k_phase<3>, dim3(256), dim3(NT_THREADS), SHM_BYTES, stream, p, l);
    hipLaunchKernelGGL(k_phase<4>, dim3(256), dim3(NT_THREADS), SHM_BYTES, stream, p, l);
  }
#else
  static int grid_blocks = 0;
  if (!grid_blocks) {
    (void)hipFuncSetAttribute((const void*)k_mega, hipFuncAttributeMaxDynamicSharedMemorySize, (int)SHM_BYTES);
    int dev = 0, cus = 0, per_cu = 0;
    (void)hipGetDevice(&dev);
    (void)hipDeviceGetAttribute(&cus, hipDeviceAttributeMultiprocessorCount, dev);
    (void)hipOccupancyMaxActiveBlocksPerMultiprocessor(&per_cu, k_mega, NT_THREADS, SHM_BYTES);
    if (per_cu > 1) per_cu = 1;
    grid_blocks = cus * per_cu;
  }
  void* args[] = {&p};
  hipError_t e = hipLaunchCooperativeKernel((void*)k_mega, dim3(grid_blocks), dim3(NT_THREADS), args, SHM_BYTES, stream);
  if (e != hipSuccess) fprintf(stderr, "cooperative launch failed: %s (grid %d)\n", hipGetErrorString(e), grid_blocks);
#endif
}
```

```cpp
#include <hip/hip_runtime.h>
#include <hip/hip_cooperative_groups.h>
#include <cstdio>
#include <cstdint>
namespace cg = cooperative_groups;

#ifndef REP_ATT
#define REP_ATT 0
#endif
#ifndef STAGGER_MAP
#define STAGGER_MAP 1
#endif
#ifndef REP_POST
#define REP_POST 0
#endif
#ifndef REP_GEMM
#define REP_GEMM 0
#endif
#ifndef MK_MULTI
#define MK_MULTI 0
#endif

typedef unsigned short bf16_t;
using bf16x8 = __attribute__((ext_vector_type(8))) short;
using s16x4  = __attribute__((ext_vector_type(4))) short;
using f32x16 = __attribute__((ext_vector_type(16))) float;
using f32x4  = __attribute__((ext_vector_type(4))) float;
using u32x4  = __attribute__((ext_vector_type(4))) unsigned;
using u32x2  = __attribute__((ext_vector_type(2))) unsigned;

#define XCD_BAR_WORDS 3456
constexpr int NT_THREADS = 512;
constexpr int T_TOK = 65536, TP = 32768, DM = 1024, NPROJ = 3072, DEPTH = 2;
constexpr int S_P = 16384, S_S = 4096;
constexpr int C_ZP = 0, C_ZA = 512, C_U = 1024, C_Q = 1536, C_K = 2048, C_V = 2560;
constexpr int LDX = 2048;
constexpr float QSCALE = 0.125f * 1.4426950408889634f;
constexpr size_t SHM_BYTES = 131072 + 4096;

struct Params {
  const float* xp; const float* xs; const float* pre_g; const float* w_in; const float* pool_w; const float* pool_scale;
  const float* lq1; const float* lk1; const float* lq2; const float* lk2; const float* subln_g; const float* w_out; const float* post_g;
  float* out; bf16_t* WinT; bf16_t* WoutT; bf16_t* proj; float* rinv; float* rope; float* lam; float* kmax2; unsigned* bar;
};

#define SBAR() __builtin_amdgcn_sched_barrier(0)
__device__ __forceinline__ unsigned cvtpk(float lo, float hi) {
  unsigned r; asm volatile("v_cvt_pk_bf16_f32 %0, %1, %2" : "=v"(r) : "v"(lo), "v"(hi)); return r;
}
__device__ __forceinline__ float bf2f(unsigned short b) { return __uint_as_float(((unsigned)b) << 16); }
__device__ __forceinline__ float bflo(unsigned w) { return __uint_as_float(w << 16); }
__device__ __forceinline__ float bfhi(unsigned w) { return __uint_as_float(w & 0xffff0000u); }
__device__ __forceinline__ bf16_t f2bf(float f) { return (bf16_t)(cvtpk(f, 0.f) & 0xffffu); }
__host__ __device__ __forceinline__ int perm32(int rho) { const int n = rho >> 4, i = rho & 15; return 8 * (i >> 2) + 4 * n + (i & 3); }
__device__ __forceinline__ float silu(float z) { return z * __builtin_amdgcn_rcpf(1.f + __builtin_amdgcn_exp2f(-1.4426950408889634f * z)); }
__device__ __forceinline__ int opaque_tid() { int t = threadIdx.x; asm volatile("" : "+v"(t)); return t; }
__device__ __forceinline__ float wave_sum(float v) {
#pragma unroll
  for (int o = 32; o >= 1; o >>= 1) v += __shfl_xor(v, o);
  return v;
}

__device__ __forceinline__ int src_col_in(int s) {
  const int type = s >> 9, within = s & 511;
  if (type == 0) return 512 + within;
  if (type == 1) return 2560 + within;
  if (type == 5) return 2048 + within;
  const int p = within & 63, wcl = p >> 5, fq = (p >> 3) & 3, n = (p >> 2) & 1, jj = p & 3;
  const int d = wcl * 16 + fq * 4 + jj + 32 * n;
  return (type == 3 ? 1024 : 1536) + (within & ~63) + d;
}

__device__ void phase0(const Params& p, char* shm) {
  const int tid = opaque_tid(), nth = blockDim.x;
  float* tile = (float*)shm;
  float* Wt = tile + 64 * 65 + 32;
  float* Pw = Wt + 64 * 128;
  constexpr int NT_U = DEPTH * 8 * 16, NT_IN = DEPTH * 40 * 16, NT_OUT = DEPTH * 16 * 16;
  for (int it = blockIdx.x; it < NT_U + NT_IN + NT_OUT; it += gridDim.x) {
    __syncthreads();
    if (it < NT_U + NT_IN) {
      int l, n0, k0; const bool isu = it < NT_U;
      if (isu) { l = it / 128; const int r = it % 128; n0 = C_U + (r / 16) * 64; k0 = (r % 16) * 64; }
      else { const int i2 = it - NT_U; l = i2 / 640; const int r = i2 % 640; int nt = r / 16; if (nt >= 16) nt += 8; n0 = nt * 64; k0 = (r % 16) * 64; }
      const float* W = p.w_in + (size_t)l * DM * NPROJ; const float* g = p.pre_g + l * DM;
      if (isu) {
        const int gi = (n0 - C_U) >> 7, d0 = (n0 - C_U) & 127;
        for (int e = tid; e < 64 * 128; e += nth) { const int c = e & 127, kk = e >> 7; Wt[e] = W[(size_t)(k0 + kk) * NPROJ + gi * 128 + c]; }
        for (int e = tid; e < 128 * 64; e += nth) { const int d = e & 63, c = e >> 6; Pw[e] = p.pool_w[((size_t)(l * 4 + gi) * 128 + c) * 128 + d0 + d]; }
        __syncthreads();
        for (int e = tid; e < 4096; e += nth) {
          const int nn = e & 63, kk = e >> 6, nrow = n0 + nn; const int s = (nrow & ~31) + perm32(nrow & 31), dl = s - n0;
          float a = 0.f;
#pragma unroll 8
          for (int c = 0; c < 128; ++c) a = fmaf(Wt[kk * 128 + c], Pw[c * 64 + dl], a);
          tile[kk * 65 + nn] = a * g[k0 + kk];
        }
      } else {
        for (int e = tid; e < 4096; e += nth) {
          const int nn = e & 63, kk = e >> 6, k = k0 + kk, nrow = n0 + nn;
          const int s = (nrow & ~31) + perm32(nrow & 31);
          tile[kk * 65 + nn] = W[(size_t)k * NPROJ + src_col_in(s)] * g[k];
        }
      }
      __syncthreads();
      bf16_t* O = p.WinT + (size_t)l * NPROJ * DM;
      for (int e = tid; e < 4096; e += nth) { const int kk = e & 63, nn = e >> 6; O[(size_t)(n0 + nn) * DM + k0 + kk] = f2bf(tile[kk * 65 + nn]); }
    } else {
      const int it2 = it - NT_U - NT_IN, l = it2 / 256, r = it2 % 256, n0 = (r / 16) * 64, k0 = (r % 16) * 64;
      const float* W = p.w_out + (size_t)l * DM * DM;
      for (int e = tid; e < 4096; e += nth) {
        const int nn = e & 63, kk = e >> 6, nrow = n0 + nn; const int s = (nrow & ~31) + perm32(nrow & 31);
        tile[kk * 65 + nn] = W[(size_t)(k0 + kk) * DM + s];
      }
      __syncthreads();
      bf16_t* O = p.WoutT + (size_t)l * DM * DM;
      for (int e = tid; e < 4096; e += nth) { const int kk = e & 63, nn = e >> 6; O[(size_t)(n0 + nn) * DM + k0 + kk] = f2bf(tile[kk * 65 + nn]); }
    }
  }
  if (blockIdx.x == 0) {
    for (int i = tid; i < XCD_BAR_WORDS; i += nth) p.bar[i] = 0u;
    if (tid < DEPTH * 160) p.kmax2[tid] = 0.f;
    if (tid < 32) { const double c = exp(-(double)tid * (9.210340371976184 / 32.0)) * 0.15915494309189535; const float h = (float)c; p.rope[2 * tid] = h; p.rope[2 * tid + 1] = (float)(c - (double)h); }
    if (tid >= 64 && tid < 64 + 64 * DEPTH) {
      const int l = (tid >> 6) - 1, i = tid & 63;
      float a = p.lq1[l * 64 + i] * p.lk1[l * 64 + i], b = p.lq2[l * 64 + i] * p.lk2[l * 64 + i];
      a = wave_sum(a); b = wave_sum(b);
      const float li = 0.8f - 0.6f * expf(-0.3f * (float)l);
      if (i == 0) p.lam[l] = expf(a) - expf(b) + li;
    }
  }
  const int wid = tid >> 6, lane = tid & 63, nw = nth >> 6;
  for (int row0 = (blockIdx.x * nw + wid) * 2; row0 < T_TOK; row0 += gridDim.x * nw * 2) {
    f32x4 v[2][4];
#pragma unroll
    for (int q = 0; q < 2; ++q) {
      const int row = row0 + q;
      const float* xr = row < TP ? p.xp + (size_t)row * DM : p.xs + (size_t)(row - TP) * DM;
#pragma unroll
      for (int i = 0; i < 4; ++i) v[q][i] = *(const f32x4*)(xr + i * 256 + lane * 4);
    }
#pragma unroll
    for (int q = 0; q < 2; ++q) {
      const int row = row0 + q;
      bf16_t* xo = (bf16_t*)p.out + (size_t)row * LDX;
      float ss = 0.f;
#pragma unroll
      for (int i = 0; i < 4; ++i) {
        ss += v[q][i][0] * v[q][i][0] + v[q][i][1] * v[q][i][1] + v[q][i][2] * v[q][i][2] + v[q][i][3] * v[q][i][3];
        u32x2 w = {cvtpk(v[q][i][0], v[q][i][1]), cvtpk(v[q][i][2], v[q][i][3])};
        *(u32x2*)(xo + i * 256 + lane * 4) = w;
      }
      ss = wave_sum(ss);
      if (lane == 0) p.rinv[row] = __builtin_amdgcn_rsqf(ss * (1.f / DM) + 1e-6f);
    }
  }
}

namespace gm {
constexpr int BM = 256, BK = 64, HALF = 128, NXCD = 8, WGM = 8, HT = HALF * BK;
__device__ __forceinline__ int lds_byte(int r, int c) { int st = (r >> 4) * 2 + (c >> 5), rr = r & 15, cc = c & 31, ob = rr * 64 + cc * 2; return st * 1024 + (ob ^ (((ob >> 9) & 1) << 5)); }
__device__ __forceinline__ void stage_rc(int b, int& R, int& C) { int st = b / 1024, sb = b % 1024, swz = sb ^ (((sb >> 9) & 1) << 5); R = (st >> 1) * 16 + swz / 64; C = (st & 1) * 32 + (swz % 64) / 2; }

#define LAS __attribute__((address_space(3)))
template <class Epi>
__device__ __forceinline__ void gemm_phase(const bf16_t* __restrict__ A, const int lda, const bf16_t* __restrict__ Bt, const int N, const Epi& E, char* shmc) {
  constexpr int K = 1024, nt = K / BK, HTB = HALF * BK * 2;
  LAS unsigned char* lds = (LAS unsigned char*)shmc;
  const int tid = opaque_tid(), wid = __builtin_amdgcn_readfirstlane(tid >> 6), lane = tid & 63, wr = wid >> 2, wc = wid & 3, fr = lane & 15, fq = lane >> 4;
  unsigned voffA[2], voffB[2];
#pragma unroll
  for (int i = 0; i < 2; ++i) { int R, C; stage_rc(tid * 16 + i * 8192, R, C); voffA[i] = (unsigned)(R * lda + C) * 2u; voffB[i] = (unsigned)(R * K + C) * 2u; }
  const size_t kstep = (size_t)(BK * 2);
  const size_t hstepA = (size_t)HALF * lda * 2, hstepB = (size_t)HALF * K * 2;
  const size_t tstepA = 2 * hstepA, tstepB = 2 * hstepB;
  const unsigned ldsw = (unsigned)wid * 1024u;
  const int aoff = lds_byte(wr * 64 + fr, fq * 8), boff = lds_byte(wc * 32 + fr, fq * 8);
#define PG8_SA(b, h) (((b) * 2 + (h)) * HTB)
#define PG8_SB(b, h) ((4 + (b) * 2 + (h)) * HTB)
#define PG8_STAGE(bufoff, gbase, voff) do { _Pragma("unroll") for (int _i = 0; _i < 2; ++_i) \
        __builtin_amdgcn_global_load_lds((const unsigned*)((const char*)(gbase) + (voff)[_i]), (LAS unsigned*)(lds + (bufoff) + ldsw + _i * 8192), 16, 0, 0); } while (0)
#define PG8_LDA(dst, b, h) do { _Pragma("unroll") for (int m = 0; m < 4; ++m) _Pragma("unroll") for (int k = 0; k < 2; ++k) dst[m][k] = *(const LAS bf16x8*)(lds + PG8_SA(b, h) + aoff + m * 2048 + k * 1024); } while (0)
#define PG8_LDB(dst, b, h) do { _Pragma("unroll") for (int n = 0; n < 2; ++n) _Pragma("unroll") for (int k = 0; k < 2; ++k) dst[n][k] = *(const LAS bf16x8*)(lds + PG8_SB(b, h) + boff + n * 2048 + k * 1024); } while (0)
#define PG8_MMA(ai, bj, At, Bx) do { __builtin_amdgcn_s_setprio(1); _Pragma("unroll") for (int m = 0; m < 4; ++m) _Pragma("unroll") for (int n = 0; n < 2; ++n) _Pragma("unroll") for (int k = 0; k < 2; ++k) \
        acc[ai][bj][m][n] = __builtin_amdgcn_mfma_f32_16x16x32_bf16(Bx[n][k], At[m][k], acc[ai][bj][m][n], 0, 0, 0); __builtin_amdgcn_s_setprio(0); } while (0)
#define PG8_WAIT_V(n) asm volatile("s_waitcnt vmcnt(" #n ")" ::: "memory")
#define PG8_WAIT_L(n) asm volatile("s_waitcnt lgkmcnt(" #n ")" ::: "memory")
#define PG8_BAR __builtin_amdgcn_s_barrier()
#define PG8_SCHED __builtin_amdgcn_sched_barrier(0)
  const int nM = T_TOK / BM, nN = N / BM, nwg = nM * nN, G = gridDim.x, cblk = blockIdx.x;
  auto next_unit = [&](int i, int& pm, int& pn) -> bool {
    const long L = (long)i * G + cblk; if (L >= nwg) return false;
    int wgid = (int)L; { const int q = nwg / NXCD, r = nwg % NXCD, xcd = wgid % NXCD, off = wgid / NXCD; wgid = (xcd < r ? xcd * (q + 1) : r * (q + 1) + (xcd - r) * q) + off; }
    const int nig = WGM * nN, gid = wgid / nig, fm = gid * WGM, gsz = (nM - fm) < WGM ? (nM - fm) : WGM;
    pm = fm + ((wgid % nig) % gsz); pn = (wgid % nig) / gsz; return true;
  };
  int cpm, cpn, npm = 0, npn = 0, ui = 0;
  if (!next_unit(0, cpm, cpn)) return;
  f32x4 acc[2][2][4][2];
#pragma unroll
  for (int a = 0; a < 2; ++a)
#pragma unroll
    for (int b = 0; b < 2; ++b)
#pragma unroll
      for (int m = 0; m < 4; ++m)
#pragma unroll
        for (int n = 0; n < 2; ++n) acc[a][b][m][n] = (f32x4){0.f, 0.f, 0.f, 0.f};
  bf16x8 At[4][2], B0[2][2], B1[2][2];
  const char* cA = (const char*)A + (size_t)cpm * tstepA; const char* cB = (const char*)Bt + (size_t)cpn * tstepB;
  PG8_STAGE(PG8_SB(0, 0), cB, voffB); PG8_STAGE(PG8_SB(0, 1), cB + hstepB, voffB); PG8_STAGE(PG8_SA(0, 0), cA, voffA); PG8_STAGE(PG8_SA(0, 1), cA + hstepA, voffA);
  if (wr == 1) PG8_BAR;
  PG8_WAIT_V(2); PG8_BAR;
  PG8_STAGE(PG8_SB(1, 0), cB + kstep, voffB); PG8_STAGE(PG8_SA(1, 0), cA + kstep, voffA); PG8_STAGE(PG8_SB(1, 1), cB + hstepB + kstep, voffB);
  PG8_WAIT_V(6); PG8_BAR;
  for (;;) {
    const bool has_next = next_unit(ui + 1, npm, npn);
    const char* nA = has_next ? (const char*)A + (size_t)npm * tstepA : cA; const char* nB = has_next ? (const char*)Bt + (size_t)npn * tstepB : cB;
    for (int t = 0; t < nt; t += 2) {
      const bool last = (t == nt - 2);
      const char* a1 = cA + (size_t)(t + 1) * kstep;
      const char* a2 = last ? nA : cA + (size_t)(t + 2) * kstep; const char* b2 = last ? nB : cB + (size_t)(t + 2) * kstep;
      const char* a3 = a2 + kstep; const char* b3 = b2 + kstep;
      PG8_LDB(B0, 0, 0); PG8_LDB(B1, 0, 1); PG8_SCHED; PG8_LDA(At, 0, 0); PG8_STAGE(PG8_SA(1, 1), a1 + hstepA, voffA);
      PG8_WAIT_V(8); PG8_WAIT_L(0); PG8_BAR; PG8_MMA(0, 0, At, B0); PG8_MMA(0, 1, At, B1); PG8_BAR; PG8_SCHED;
      PG8_LDA(At, 0, 1); PG8_STAGE(PG8_SB(0, 0), b2, voffB); PG8_STAGE(PG8_SB(0, 1), b2 + hstepB, voffB); PG8_STAGE(PG8_SA(0, 0), a2, voffA);
      PG8_WAIT_V(8); PG8_WAIT_L(0); PG8_BAR; PG8_MMA(1, 0, At, B0); PG8_MMA(1, 1, At, B1); PG8_BAR; PG8_SCHED;
      PG8_LDB(B0, 1, 0); PG8_LDB(B1, 1, 1); PG8_SCHED; PG8_LDA(At, 1, 0); PG8_STAGE(PG8_SA(0, 1), a2 + hstepA, voffA);
      PG8_WAIT_V(8); PG8_WAIT_L(0); PG8_BAR; PG8_MMA(0, 0, At, B0); PG8_MMA(0, 1, At, B1); PG8_BAR; PG8_SCHED;
      PG8_LDA(At, 1, 1); PG8_STAGE(PG8_SB(1, 0), b3, voffB); PG8_STAGE(PG8_SB(1, 1), b3 + hstepB, voffB); PG8_STAGE(PG8_SA(1, 0), a3, voffA);
      PG8_WAIT_V(8); PG8_WAIT_L(0); PG8_BAR; PG8_MMA(1, 0, At, B0); PG8_MMA(1, 1, At, B1); PG8_BAR; PG8_SCHED;
    }
    if (wr == 0) PG8_BAR;
    E(acc, cpm, cpn, wr, wc, fr, fq);
    if (!has_next) break;
#pragma unroll
    for (int a = 0; a < 2; ++a)
#pragma unroll
      for (int b = 0; b < 2; ++b)
#pragma unroll
        for (int m = 0; m < 4; ++m)
#pragma unroll
          for (int n = 0; n < 2; ++n) acc[a][b][m][n] = (f32x4){0.f, 0.f, 0.f, 0.f};
    cpm = npm; cpn = npn; cA = nA; cB = nB; ++ui;
    if (wr == 1) PG8_BAR;
  }
  PG8_WAIT_V(0);
  PG8_BAR;
#undef PG8_SA
#undef PG8_SB
#undef PG8_STAGE
#undef PG8_LDA
#undef PG8_LDB
#undef PG8_MMA
}

struct EpiIn {
  const float* rinv; const float* rope; bf16_t* proj; float* kmax2;
  __device__ __forceinline__ void operator()(const f32x4 (&acc)[2][2][4][2], int pm, int pn, int wr, int wc, int fr, int fq) const {
    const bool isrope = (pn >= 6 && pn <= 9); const float qs = (pn == 6 || pn == 7) ? QSCALE : 1.f;
    const bool isk = (pn == 8 || pn == 9);
    float kmx[2] = {0.f, 0.f};
    float ch[4], cl[4];
    if (isrope) {
#pragma unroll
      for (int jj = 0; jj < 4; ++jj) { const int i = (wc & 1) * 16 + fq * 4 + jj; ch[jj] = rope[2 * i]; cl[jj] = rope[2 * i + 1]; }
    }
    float riv[2][4];
#pragma unroll
    for (int ai = 0; ai < 2; ++ai)
#pragma unroll
      for (int m = 0; m < 4; ++m) riv[ai][m] = rinv[pm * BM + ai * HALF + wr * 64 + m * 16 + fr];
#pragma unroll
    for (int ai = 0; ai < 2; ++ai)
#pragma unroll
      for (int m = 0; m < 4; ++m) {
        const int row = pm * BM + ai * HALF + wr * 64 + m * 16 + fr;
        const float ri = riv[ai][m];
        float cs[4], sn[4];
        if (isrope) {
          const float pos = (float)(row < TP ? (row & (S_P - 1)) : (row & (S_S - 1)));
#pragma unroll
          for (int jj = 0; jj < 4; ++jj) {
            const float h = pos * ch[jj], e = fmaf(pos, ch[jj], -h) + pos * cl[jj];
            const float rev = (h - floorf(h)) + e;
            sn[jj] = __builtin_amdgcn_sinf(rev); cs[jj] = __builtin_amdgcn_cosf(rev);
          }
        }
        bf16_t* rowp = proj + (size_t)row * NPROJ + pn * BM + wc * 32 + 8 * fq;
#pragma unroll
        for (int bj = 0; bj < 2; ++bj) {
          f32x4 v0 = acc[ai][bj][m][0] * ri, v1 = acc[ai][bj][m][1] * ri;
          if (isrope) {
#pragma unroll
            for (int jj = 0; jj < 4; ++jj) { const float a = v0[jj], b = v1[jj]; v0[jj] = (a * cs[jj] - b * sn[jj]) * qs; v1[jj] = (b * cs[jj] + a * sn[jj]) * qs; }
          }
          u32x4 w; w.x = cvtpk(v0[0], v0[1]); w.y = cvtpk(v0[2], v0[3]); w.z = cvtpk(v1[0], v1[1]); w.w = cvtpk(v1[2], v1[3]);
          *(u32x4*)(rowp + bj * HALF) = w;
          if (isk) { float ss = v0[0] * v0[0] + v0[1] * v0[1] + v0[2] * v0[2] + v0[3] * v0[3] + v1[0] * v1[0] + v1[1] * v1[1] + v1[2] * v1[2] + v1[3] * v1[3];
            ss += __shfl_xor(ss, 16); ss += __shfl_xor(ss, 32); kmx[bj] = fmaxf(kmx[bj], ss); }
        }
      }
    if (isk) {
      const int row0 = pm * BM, sq = row0 < TP ? (row0 >> 14) : 2 + ((row0 - TP) >> 12);
#pragma unroll
      for (int bj = 0; bj < 2; ++bj) { float v = kmx[bj];
        v = fmaxf(v, __shfl_xor(v, 1)); v = fmaxf(v, __shfl_xor(v, 2)); v = fmaxf(v, __shfl_xor(v, 4)); v = fmaxf(v, __shfl_xor(v, 8));
        if ((fr | fq) == 0) atomicMax((unsigned*)(kmax2 + (sq * 4 + (pn - 8) * 2 + bj) * 4 + wc), __float_as_uint(v)); }
    }
  }
};
struct EpiOut {
  bf16_t* proj;
  __device__ __forceinline__ void operator()(const f32x4 (&acc)[2][2][4][2], int pm, int pn, int wr, int wc, int fr, int fq) const {
#pragma unroll
    for (int ai = 0; ai < 2; ++ai)
#pragma unroll
      for (int m = 0; m < 4; ++m) {
        const int row = pm * BM + ai * HALF + wr * 64 + m * 16 + fr;
        bf16_t* rowp = proj + (size_t)row * NPROJ + C_U + pn * BM + wc * 32 + 8 * fq;
#pragma unroll
        for (int bj = 0; bj < 2; ++bj) { const f32x4 v0 = acc[ai][bj][m][0], v1 = acc[ai][bj][m][1];
          u32x4 w; w.x = cvtpk(v0[0], v0[1]); w.y = cvtpk(v0[2], v0[3]); w.z = cvtpk(v1[0], v1[1]); w.w = cvtpk(v1[2], v1[3]);
          *(u32x4*)(rowp + bj * HALF) = w; }
      }
  }
};
}

__device__ __forceinline__ void bf8_to_f(const u32x4 w, float* v) {
  v[0] = bflo(w.x); v[1] = bfhi(w.x); v[2] = bflo(w.y); v[3] = bfhi(w.y); v[4] = bflo(w.z); v[5] = bfhi(w.z); v[6] = bflo(w.w); v[7] = bfhi(w.w);
}
__device__ void pool_phase(const Params& p, int l, bool dry = false) {
  const int tid = opaque_tid(), c8 = tid & 63, tq = tid >> 6;
  const int g = c8 >> 4, hw = 1 << g;
  const float* sc = p.pool_scale + l * 512 + c8 * 8;
  float scl[8];
#pragma unroll
  for (int e = 0; e < 8; ++e) scl[e] = sc[e];
  for (int ch = blockIdx.x; ch < T_TOK / 128; ch += gridDim.x) {
    const int t0 = ch * 128 + tq * 16;
    const int S = t0 < TP ? S_P : S_S, pos0 = t0 & (S - 1), s0 = t0 - pos0;
    const bf16_t* ub = p.proj + (size_t)s0 * NPROJ + C_U + c8 * 8;
    float sum[8] = {0, 0, 0, 0, 0, 0, 0, 0};
#pragma unroll
    for (int j = 0; j < 16; ++j) {
      const int r = pos0 - hw + j; const bool ok = (j < 2 * hw) && r >= 0 && r < S; const int rc = min(max(r, 0), S - 1);
      float v[8]; bf8_to_f(*(const u32x4*)(ub + (size_t)rc * NPROJ), v); const float m = ok ? 1.f : 0.f;
#pragma unroll
      for (int e = 0; e < 8; ++e) sum[e] = fmaf(m, v[e], sum[e]);
    }
#pragma unroll
    for (int i4 = 0; i4 < 16; i4 += 4) {
      u32x4 wu[4], wz[4], wa[4], wsb[4];
#pragma unroll
      for (int q = 0; q < 4; ++q) {
        const int pos = pos0 + i4 + q, ra = pos + hw, rs = pos - hw;
        wu[q] = *(const u32x4*)(ub + (size_t)pos * NPROJ);
        wz[q] = *(const u32x4*)(p.proj + (size_t)(t0 + i4 + q) * NPROJ + C_ZP + c8 * 8);
        wa[q] = *(const u32x4*)(ub + (size_t)min(ra, S - 1) * NPROJ); wsb[q] = *(const u32x4*)(ub + (size_t)max(rs, 0) * NPROJ);
      }
#pragma unroll
      for (int q = 0; q < 4; ++q) {
        const int pos = pos0 + i4 + q, t = t0 + i4 + q;
        const int lo = max(pos - hw, 0), hi = min(pos + hw, S);
        const float inv = 1.f / (float)(hi - lo);
        float uc[8], z[8], va[8], vs[8], o[8];
        bf8_to_f(wu[q], uc); bf8_to_f(wz[q], z);
#pragma unroll
        for (int e = 0; e < 8; ++e) o[e] = (sum[e] * inv - uc[e]) * scl[e] * silu(z[e]);
        const u32x4 w = {cvtpk(o[0], o[1]), cvtpk(o[2], o[3]), cvtpk(o[4], o[5]), cvtpk(o[6], o[7])};
        if (!dry) *(u32x4*)(p.proj + (size_t)t * NPROJ + C_ZP + c8 * 8) = w;
        const int ra = pos + hw, rs = pos - hw; const float ma = ra < S ? 1.f : 0.f, ms = rs >= 0 ? 1.f : 0.f;
        bf8_to_f(wa[q], va); bf8_to_f(wsb[q], vs);
#pragma unroll
        for (int e = 0; e < 8; ++e) sum[e] = fmaf(ma, va[e], fmaf(-ms, vs[e], sum[e]));
      }
    }
  }
}

namespace at {
constexpr int KVBLK = 64, LDK = NPROJ;
constexpr size_t SHM_V = KVBLK * 128 * 2, SHM_K = KVBLK * 128 * 2;
constexpr float THRL = 11.5f;
#define KSWZ(row, colB) ((row) * 256 + ((colB) ^ (((row) & 7) << 4)))
__device__ __forceinline__ int crow(int r, int hi) { return (r & 3) + 8 * (r >> 2) + 4 * hi; }
template <bool SH> __device__ __forceinline__ void partialSM(f32x16& p0, f32x16& p1, float& m_reg, float& mn, float& alpha) {
  if constexpr (!SH) {
    alpha = 1.f;
    return;
  }
  float pmax = p0[0];
#pragma unroll
  for (int r = 1; r < 16; ++r) pmax = fmaxf(pmax, p0[r]);
#pragma unroll
  for (int r = 0; r < 16; ++r) pmax = fmaxf(pmax, p1[r]);
  { auto rr = __builtin_amdgcn_permlane32_swap(__float_as_uint(pmax), __float_as_uint(pmax), false, false);
    pmax = fmaxf(__uint_as_float(rr[0]), __uint_as_float(rr[1])); }
  if (__builtin_expect(__all(pmax - m_reg <= THRL), 1)) { mn = m_reg; alpha = 1.f; }
  else { mn = fmaxf(m_reg, pmax); alpha = __builtin_amdgcn_exp2f(m_reg - mn); m_reg = mn; }
#pragma unroll
  for (int r = 0; r < 16; ++r) p0[r] = p0[r] - mn;
#pragma unroll
  for (int r = 0; r < 16; ++r) p1[r] = p1[r] - mn;
#pragma unroll
  for (int r = 0; r < 16; ++r) { p0[r] = __builtin_amdgcn_exp2f(p0[r]); p1[r] = __builtin_amdgcn_exp2f(p1[r]); }
}
template <bool SH> __device__ __forceinline__ void finishSM(f32x16& p0, f32x16& p1, float alpha, float& l_reg, bf16x8& pa0, bf16x8& pa1, bf16x8& pa2, bf16x8& pa3) {
  if constexpr (!SH) {
#pragma unroll
    for (int r = 0; r < 16; ++r) { p0[r] = __builtin_amdgcn_exp2f(p0[r]); p1[r] = __builtin_amdgcn_exp2f(p1[r]); }
  }
  float ps = 0;
#pragma unroll
  for (int r = 0; r < 16; ++r) ps += p0[r];
#pragma unroll
  for (int r = 0; r < 16; ++r) ps += p1[r];
  { auto rr = __builtin_amdgcn_permlane32_swap(__float_as_uint(ps), __float_as_uint(ps), false, false);
    ps = __uint_as_float(rr[0]) + __uint_as_float(rr[1]); }
  if constexpr (SH) l_reg = l_reg * alpha + ps; else l_reg += ps;
#define PK4(P, BASE, OUT) do { unsigned a0 = cvtpk(P[BASE + 0], P[BASE + 1]), a1 = cvtpk(P[BASE + 2], P[BASE + 3]);   \
    unsigned b0 = cvtpk(P[BASE + 4], P[BASE + 5]), b1 = cvtpk(P[BASE + 6], P[BASE + 7]);                              \
    auto r0 = __builtin_amdgcn_permlane32_swap(a0, b0, false, false); auto r1 = __builtin_amdgcn_permlane32_swap(a1, b1, false, false); \
    u32x4 w = {r0[0], r1[0], r0[1], r1[1]}; OUT = *reinterpret_cast<bf16x8*>(&w); } while (0)
  PK4(p0, 0, pa0); PK4(p0, 8, pa1); PK4(p1, 0, pa2); PK4(p1, 8, pa3);
#undef PK4
}
__device__ __forceinline__ void qkt(f32x16& p0, f32x16& p1, const char* Ks, const bf16x8* qr, int r32, int hi, int mapB) {
  p0 = f32x16{}; p1 = f32x16{};
#pragma unroll
  for (int d0 = 0; d0 < 4; ++d0) { const int cb = (d0 * 16 + hi * 8) * 2 + mapB;
    bf16x8 b0 = *reinterpret_cast<const bf16x8*>(Ks + KSWZ(r32, cb));
    bf16x8 b1 = *reinterpret_cast<const bf16x8*>(Ks + KSWZ(32 + r32, cb));
    p0 = __builtin_amdgcn_mfma_f32_32x32x16_bf16(b0, qr[d0], p0, 0, 0, 0);
    p1 = __builtin_amdgcn_mfma_f32_32x32x16_bf16(b1, qr[d0], p1, 0, 0, 0); }
}
__device__ __forceinline__ int v_st(int k, int c) { const int kk = (k & ~0xC) | ((k & 4) << 1) | ((k & 8) >> 1); return ((kk >> 3) * 4 + (c >> 5)) * 512 + ((kk & 7) * 32 + (c & 31)) * 2; }
__device__ __forceinline__ int v_rd_base(int lane) { return ((lane & 3) << 3) | (((lane >> 2) & 3) << 6) | (((lane >> 4) & 1) << 5) | (((lane >> 5) & 1) << 8); }
constexpr int v_rd_off(int d0, int ks, int half) { return d0 * 512 + ks * 4096 + half * 2048; }
template <int OFF> __device__ __forceinline__ s16x4 tr_read(int vb) {
  s16x4 r; asm volatile("ds_read_b64_tr_b16 %0, %1 offset:%2" : "=&v"(r) : "v"(vb), "i"(OFF) : "memory"); return r;
}
template <int D0> __device__ __forceinline__ void pv_one(f32x16& od, int vb, bf16x8 pa0, bf16x8 pa1, bf16x8 pa2, bf16x8 pa3) {
  const s16x4 l0 = tr_read<v_rd_off(D0, 0, 0)>(vb), h0 = tr_read<v_rd_off(D0, 0, 1)>(vb), l1 = tr_read<v_rd_off(D0, 1, 0)>(vb), h1 = tr_read<v_rd_off(D0, 1, 1)>(vb);
  const s16x4 l2 = tr_read<v_rd_off(D0, 2, 0)>(vb), h2 = tr_read<v_rd_off(D0, 2, 1)>(vb), l3 = tr_read<v_rd_off(D0, 3, 0)>(vb), h3 = tr_read<v_rd_off(D0, 3, 1)>(vb);
  asm volatile("s_waitcnt lgkmcnt(0)" ::: "memory"); SBAR();
#define PK(L, H) (bf16x8){L[0], L[1], L[2], L[3], H[0], H[1], H[2], H[3]}
  od = __builtin_amdgcn_mfma_f32_32x32x16_bf16(pa0, PK(l0, h0), od, 0, 0, 0);
  od = __builtin_amdgcn_mfma_f32_32x32x16_bf16(pa1, PK(l1, h1), od, 0, 0, 0);
  od = __builtin_amdgcn_mfma_f32_32x32x16_bf16(pa2, PK(l2, h2), od, 0, 0, 0);
  od = __builtin_amdgcn_mfma_f32_32x32x16_bf16(pa3, PK(l3, h3), od, 0, 0, 0);
#undef PK
}
__device__ __forceinline__ void pv_d0(f32x16* o, int vb, bf16x8 pa0, bf16x8 pa1, bf16x8 pa2, bf16x8 pa3) {
  pv_one<0>(o[0], vb, pa0, pa1, pa2, pa3); pv_one<1>(o[1], vb, pa0, pa1, pa2, pa3); pv_one<2>(o[2], vb, pa0, pa1, pa2, pa3); pv_one<3>(o[3], vb, pa0, pa1, pa2, pa3);
}

struct VFrag { s16x4 l0, h0, l1, h1, l2, h2, l3, h3; };
template <int D0> __device__ __forceinline__ void v_frag_read(VFrag& f, int vb) {
  f.l0 = tr_read<v_rd_off(D0, 0, 0)>(vb); f.h0 = tr_read<v_rd_off(D0, 0, 1)>(vb); f.l1 = tr_read<v_rd_off(D0, 1, 0)>(vb); f.h1 = tr_read<v_rd_off(D0, 1, 1)>(vb);
  f.l2 = tr_read<v_rd_off(D0, 2, 0)>(vb); f.h2 = tr_read<v_rd_off(D0, 2, 1)>(vb); f.l3 = tr_read<v_rd_off(D0, 3, 0)>(vb); f.h3 = tr_read<v_rd_off(D0, 3, 1)>(vb);
}
__device__ __forceinline__ void v_frag_mma(f32x16& od, const VFrag& f, bf16x8 pa0, bf16x8 pa1, bf16x8 pa2, bf16x8 pa3) {
#define PK(L, H) (bf16x8){L[0], L[1], L[2], L[3], H[0], H[1], H[2], H[3]}
  od = __builtin_amdgcn_mfma_f32_32x32x16_bf16(pa0, PK(f.l0, f.h0), od, 0, 0, 0);
  od = __builtin_amdgcn_mfma_f32_32x32x16_bf16(pa1, PK(f.l1, f.h1), od, 0, 0, 0);
  od = __builtin_amdgcn_mfma_f32_32x32x16_bf16(pa2, PK(f.l2, f.h2), od, 0, 0, 0);
  od = __builtin_amdgcn_mfma_f32_32x32x16_bf16(pa3, PK(f.l3, f.h3), od, 0, 0, 0);
#undef PK
}
template <bool PRE> __device__ __forceinline__ void pv_d0_pipe(f32x16* o, int vb, bf16x8 pa0, bf16x8 pa1, bf16x8 pa2, bf16x8 pa3, VFrag& fa) {
  VFrag fb;
  if constexpr (!PRE) v_frag_read<0>(fa, vb);
  asm volatile("s_waitcnt lgkmcnt(0)" ::: "memory"); SBAR();
  v_frag_read<1>(fb, vb); SBAR(); v_frag_mma(o[0], fa, pa0, pa1, pa2, pa3); SBAR(); asm volatile("s_waitcnt lgkmcnt(0)" ::: "memory"); SBAR();
  v_frag_read<2>(fa, vb); SBAR(); v_frag_mma(o[1], fb, pa0, pa1, pa2, pa3); SBAR(); asm volatile("s_waitcnt lgkmcnt(0)" ::: "memory"); SBAR();
  v_frag_read<3>(fb, vb); SBAR(); v_frag_mma(o[2], fa, pa0, pa1, pa2, pa3); SBAR(); asm volatile("s_waitcnt lgkmcnt(0)" ::: "memory"); SBAR();
  v_frag_mma(o[3], fb, pa0, pa1, pa2, pa3);
}

template <bool SH> __device__ __forceinline__ void attn_unit(bf16_t* __restrict__ proj, int tok0, int kv0, int seq, int h, float lam, float oscale, const float* __restrict__ subg, char* lds, bool dry) {
  const int tid = opaque_tid(), wid = __builtin_amdgcn_readfirstlane(tid >> 6), lane = tid & 63, r32 = lane & 31, hi = lane >> 5;
  const int wq = wid & 3, mp = wid >> 2, mapB = mp * 128;
  constexpr int RING = 32768, NRING = 4;
  LAS char* ldsl = (LAS char*)lds;
  float* ws = (float*)(lds + NRING * RING) + wid * 64; float* li_l = ws; float* al_l = ws + 32;
  const bf16_t* Kh = proj + (size_t)kv0 * NPROJ + C_K + h * 128;
  const bf16_t* Vh = proj + (size_t)kv0 * NPROJ + C_V + h * 128;
  float m_reg = -1e30f, l_reg = 0; f32x16 o[4] = {}; bf16x8 qr[4];
  const bf16_t* Qw = proj + (size_t)(tok0 + wq * 32 + r32) * NPROJ + C_Q + h * 128 + mp * 64 + hi * 8;
#pragma unroll
  for (int d0 = 0; d0 < 4; ++d0) qr[d0] = *reinterpret_cast<const bf16x8*>(Qw + d0 * 16);
  int offK[2], offV[2];
#pragma unroll
  for (int i = 0; i < 2; ++i) {
    const int c = i * 512 + tid;
    { const int row = c >> 4, pc = c & 15, scn = pc ^ (row & 7); offK[i] = row * LDK + scn * 8; }
    { const int sub = c >> 5, kk = (sub >> 2) * 8 + ((c >> 2) & 7), col = (sub & 3) * 32 + (c & 3) * 8;
      const int k = (kk & ~0xC) | ((kk & 4) << 1) | ((kk & 8) >> 1); offV[i] = k * LDK + col; }
  }
  const int vbb = (int)(uintptr_t)ldsl + 16384 + v_rd_base(lane);
#define GLDS16(src, dst) __builtin_amdgcn_global_load_lds((const unsigned*)(src), (LAS unsigned*)(dst), 16, 0, 0)
#define DMA(t, b) do { const bf16_t* kg_ = Kh + (size_t)(t) * (KVBLK * LDK); const bf16_t* vg_ = Vh + (size_t)(t) * (KVBLK * LDK); LAS char* d_ = ldsl + (b) * RING + wid * 1024; \
    GLDS16(kg_ + offK[0], d_); GLDS16(kg_ + offK[1], d_ + 8192); GLDS16(vg_ + offV[0], d_ + 16384); GLDS16(vg_ + offV[1], d_ + 16384 + 8192); } while (0)
#define KBUF(b) ((const char*)lds + (b) * RING)
#define VBUF(b) (vbb + (b) * RING)
#define LANDED() do { asm volatile("s_waitcnt vmcnt(0)" ::: "memory"); __syncthreads(); } while (0)
#define RESC(a) do { if (SH && __any((a) < 1.f)) { if (hi == 0) al_l[r32] = (a); asm volatile("s_waitcnt lgkmcnt(0)" ::: "memory"); \
    _Pragma("unroll") for (int d = 0; d < 4; ++d) _Pragma("unroll") for (int r = 0; r < 16; ++r) o[d][r] *= al_l[crow(r, hi)]; } } while (0)
  f32x16 pA0, pA1, pB0, pB1; float mnA, mnB, alA, alB; bf16x8 pa0, pa1, pa2, pa3; const int NT = seq / KVBLK;
#define BLK_X(N0, N1, P0, P1, alP, t) do { SBAR(); __builtin_amdgcn_s_setprio(1); qkt(N0, N1, KBUF((t) & 3), qr, r32, hi, mapB); \
    if constexpr (!SH) v_frag_read<0>(vfa, VBUF(((t) - 1) & 3)); \
    finishSM<SH>(P0, P1, alP, l_reg, pa0, pa1, pa2, pa3); __builtin_amdgcn_s_setprio(0); SBAR(); } while (0)
#define BLK_Y(C0, C1, mnC, alC, t) do { if constexpr (SH) pv_d0(o, VBUF((t) & 3), pa0, pa1, pa2, pa3); else pv_d0_pipe<true>(o, VBUF((t) & 3), pa0, pa1, pa2, pa3, vfa); partialSM<SH>(C0, C1, m_reg, mnC, alC); RESC(alC); } while (0)
  const int ty = STAGGER_MAP ? mp : (wid & 1);
  VFrag vfa;
  DMA(0, 0); LANDED();
  DMA(1, 1);
  if (ty == 0) {
    qkt(pA0, pA1, KBUF(0), qr, r32, hi, mapB); partialSM<SH>(pA0, pA1, m_reg, mnA, alA);
    LANDED();
    for (int j = 1; j + 1 < NT; j += 2) {
      BLK_X(pB0, pB1, pA0, pA1, alA, j); DMA(j + 1, (j + 1) & 3); BLK_Y(pB0, pB1, mnB, alB, j - 1); LANDED();
      BLK_X(pA0, pA1, pB0, pB1, alB, j + 1); DMA(j + 2, (j + 2) & 3); BLK_Y(pA0, pA1, mnA, alA, j); LANDED();
    }
    BLK_X(pB0, pB1, pA0, pA1, alA, NT - 1); BLK_Y(pB0, pB1, mnB, alB, NT - 2);
    finishSM<SH>(pB0, pB1, alB, l_reg, pa0, pa1, pa2, pa3); SBAR();
    if constexpr (SH) pv_d0(o, VBUF((NT - 1) & 3), pa0, pa1, pa2, pa3); else pv_d0_pipe<false>(o, VBUF((NT - 1) & 3), pa0, pa1, pa2, pa3, vfa);
  } else {
    qkt(pA0, pA1, KBUF(0), qr, r32, hi, mapB);
    LANDED();
    DMA(2, 2); partialSM<SH>(pA0, pA1, m_reg, mnA, alA); BLK_X(pB0, pB1, pA0, pA1, alA, 1); LANDED();
    for (int j = 2; j + 2 < NT; j += 2) {
      DMA(j + 1, (j + 1) & 3); BLK_Y(pB0, pB1, mnB, alB, j - 2); BLK_X(pA0, pA1, pB0, pB1, alB, j); LANDED();
      DMA(j + 2, (j + 2) & 3); BLK_Y(pA0, pA1, mnA, alA, j - 1); BLK_X(pB0, pB1, pA0, pA1, alA, j + 1); LANDED();
    }
    DMA(NT - 1, (NT - 1) & 3); BLK_Y(pB0, pB1, mnB, alB, NT - 4); BLK_X(pA0, pA1, pB0, pB1, alB, NT - 2); LANDED();
    BLK_Y(pA0, pA1, mnA, alA, NT - 3); BLK_X(pB0, pB1, pA0, pA1, alA, NT - 1);
    BLK_Y(pB0, pB1, mnB, alB, NT - 2);
    finishSM<SH>(pB0, pB1, alB, l_reg, pa0, pa1, pa2, pa3); SBAR();
    if constexpr (SH) pv_d0(o, VBUF((NT - 1) & 3), pa0, pa1, pa2, pa3); else pv_d0_pipe<false>(o, VBUF((NT - 1) & 3), pa0, pa1, pa2, pa3, vfa);
  }
#undef BLK_X
#undef BLK_Y
  u32x4 zg[4];
  bf16_t* zp = proj + (size_t)(tok0 + (tid >> 2)) * NPROJ + C_ZA + h * 128 + (tid & 3) * 32;
#pragma unroll
  for (int i = 0; i < 4; ++i) zg[i] = *(const u32x4*)(zp + i * 8);
  if (hi == 0) li_l[r32] = l_reg; asm volatile("s_waitcnt lgkmcnt(0)" ::: "memory");
  float rli[16];
#pragma unroll
  for (int r = 0; r < 16; ++r) rli[r] = __builtin_amdgcn_rcpf(li_l[crow(r, hi)]);
  __syncthreads();
  float* X = (float*)lds;
  if (mp == 1) {
#pragma unroll
    for (int d = 0; d < 4; ++d)
#pragma unroll
      for (int r = 0; r < 16; ++r) X[(wq * 64 + d * 16 + r) * 64 + lane] = o[d][r] * rli[r] * lam;
  }
  __syncthreads();
  if (mp == 0) {
#pragma unroll
    for (int d = 0; d < 4; ++d)
#pragma unroll
      for (int r = 0; r < 16; ++r) { const int ix = (wq * 64 + d * 16 + r) * 64 + lane; X[ix] = o[d][r] * rli[r] - X[ix]; }
  }
  __syncthreads();
  {
    const int row = tid >> 2, dq = tid & 3, rl = row & 31, w = row >> 5, hh = (rl >> 2) & 1, r = (rl & 3) + 4 * (rl >> 3);
    const float* xb = X + (w * 64 + dq * 16 + r) * 64 + hh * 32;
    f32x4 a[8]; float ss = 0.f;
#pragma unroll
    for (int i = 0; i < 8; ++i) { a[i] = *(const f32x4*)(xb + i * 4); ss += a[i][0] * a[i][0] + a[i][1] * a[i][1] + a[i][2] * a[i][2] + a[i][3] * a[i][3]; }
    ss += __shfl_xor(ss, 1); ss += __shfl_xor(ss, 2);
    const float rn = __builtin_amdgcn_rsqf(ss * (1.f / 128.f) + 1e-5f) * oscale;
    const float* gg = subg + dq * 32;
#pragma unroll
    for (int i = 0; i < 4; ++i) {
      const u32x4 z = zg[i];
      const f32x4 a0 = a[2 * i], a1 = a[2 * i + 1]; const f32x4 g0 = *(const f32x4*)(gg + i * 8), g1 = *(const f32x4*)(gg + i * 8 + 4);
      u32x4 wv;
      wv.x = cvtpk(a0[0] * rn * g0[0] * silu(bflo(z.x)), a0[1] * rn * g0[1] * silu(bfhi(z.x)));
      wv.y = cvtpk(a0[2] * rn * g0[2] * silu(bflo(z.y)), a0[3] * rn * g0[3] * silu(bfhi(z.y)));
      wv.z = cvtpk(a1[0] * rn * g1[0] * silu(bflo(z.z)), a1[1] * rn * g1[1] * silu(bfhi(z.z)));
      wv.w = cvtpk(a1[2] * rn * g1[2] * silu(bflo(z.w)), a1[3] * rn * g1[3] * silu(bfhi(z.w)));
      if (!dry) *(u32x4*)(zp + i * 8) = wv;
    }
  }
  __syncthreads();
#undef DMA
#undef GLDS16
#undef KBUF
#undef VBUF
#undef LANDED
#undef RESC
}

__device__ void attn_phase(const Params& p, int l, char* lds, bool dry = false) {
  const float lam = p.lam[l];
  const float oscale = 1.f - (0.8f - 0.6f * expf(-0.3f * (float)l));
  const float* subg = p.subln_g + l * 128;
  for (int u = blockIdx.x; u < 2048; u += gridDim.x) {
    int tok0, kv0, seq, h;
    if (u < 1024) { const int x = u & 7, j = u >> 3; const int b = x >> 2; h = x & 3; seq = S_P; kv0 = b * S_P; tok0 = kv0 + j * 128; }
    else { const int v = u - 1024, x = v & 7, j = v >> 3; const int pr = x * 4 + (j >> 5), b = pr >> 2; h = pr & 3; seq = S_S; kv0 = TP + b * S_S; tok0 = kv0 + (j & 31) * 128; }
    bool need;
    { const int tid = opaque_tid(), wid = tid >> 6, lane = tid & 63, r32 = lane & 31, hi = lane >> 5, wq = wid & 3, mp = wid >> 2;
      const int sq = tok0 < TP ? (tok0 >> 14) : 2 + ((tok0 - TP) >> 12);
      const float* km = p.kmax2 + ((l * 10 + sq) * 4 + h) * 4 + mp * 2;
      const float kmx = sqrtf(km[0] + km[1]) * 1.01f;
      const bf16_t* Qw = p.proj + (size_t)(tok0 + wq * 32 + r32) * NPROJ + C_Q + h * 128 + mp * 64 + hi * 8;
      float ss = 0.f;
#pragma unroll
      for (int d0 = 0; d0 < 4; ++d0) { const u32x4 w = *(const u32x4*)(Qw + d0 * 16);
        ss += bflo(w.x) * bflo(w.x) + bfhi(w.x) * bfhi(w.x) + bflo(w.y) * bflo(w.y) + bfhi(w.y) * bfhi(w.y) + bflo(w.z) * bflo(w.z) + bfhi(w.z) * bfhi(w.z) + bflo(w.w) * bflo(w.w) + bfhi(w.w) * bfhi(w.w); }
      ss += __shfl_xor(ss, 32);
      need = __any(!(sqrtf(ss) * kmx < 100.f)) != 0; }
    if (need) attn_unit<true>(p.proj, tok0, kv0, seq, h, lam, oscale, subg, lds, dry);
    else attn_unit<false>(p.proj, tok0, kv0, seq, h, lam, oscale, subg, lds, dry);
  }
}
}

__device__ void post_phase(const Params& p, int l) {
  const int tid = opaque_tid(), wid = tid >> 6, lane = tid & 63, nw = blockDim.x >> 6;
  const float* pg = p.post_g + l * DM;
  constexpr int R = 2;
  for (int row0 = (blockIdx.x * nw + wid) * R; row0 < T_TOK; row0 += gridDim.x * nw * R) {
    f32x4 y[R][4], x[R][4]; u32x2 xh[R][4], xl[R][4], yb[R][4];
#pragma unroll
    for (int q = 0; q < R; ++q) {
      const int row = row0 + q;
      const bf16_t* yr = p.proj + (size_t)row * NPROJ + C_U;
#pragma unroll
      for (int i = 0; i < 4; ++i) yb[q][i] = *(const u32x2*)(yr + i * 256 + lane * 4);
      if (l == 0) {
        const float* xr = row < TP ? p.xp + (size_t)row * DM : p.xs + (size_t)(row - TP) * DM;
#pragma unroll
        for (int i = 0; i < 4; ++i) x[q][i] = *(const f32x4*)(xr + i * 256 + lane * 4);
      } else {
        const bf16_t* xo = (const bf16_t*)p.out + (size_t)row * LDX;
#pragma unroll
        for (int i = 0; i < 4; ++i) { xh[q][i] = *(const u32x2*)(xo + i * 256 + lane * 4); xl[q][i] = *(const u32x2*)(xo + DM + i * 256 + lane * 4); }
      }
    }
#pragma unroll
    for (int q = 0; q < R; ++q) {
      const int row = row0 + q;
      bf16_t* xo = (bf16_t*)p.out + (size_t)row * LDX;
      float ss = 0.f;
#pragma unroll
      for (int i = 0; i < 4; ++i) { y[q][i] = (f32x4){bflo(yb[q][i].x), bfhi(yb[q][i].x), bflo(yb[q][i].y), bfhi(yb[q][i].y)};
        ss += y[q][i][0] * y[q][i][0] + y[q][i][1] * y[q][i][1] + y[q][i][2] * y[q][i][2] + y[q][i][3] * y[q][i][3]; }
      if (l != 0) {
#pragma unroll
        for (int i = 0; i < 4; ++i) {
          const u32x2 h = xh[q][i], lo = xl[q][i];
          x[q][i][0] = bflo(h.x) + bflo(lo.x); x[q][i][1] = bfhi(h.x) + bfhi(lo.x); x[q][i][2] = bflo(h.y) + bflo(lo.y); x[q][i][3] = bfhi(h.y) + bfhi(lo.y);
        }
      }
      ss = wave_sum(ss);
      const float ry = __builtin_amdgcn_rsqf(ss * (1.f / DM) + 1e-6f);
      float s2 = 0.f;
#pragma unroll
      for (int i = 0; i < 4; ++i) {
        const f32x4 g = *(const f32x4*)(pg + i * 256 + lane * 4);
#pragma unroll
        for (int e = 0; e < 4; ++e) { x[q][i][e] = x[q][i][e] + y[q][i][e] * ry * g[e]; s2 += x[q][i][e] * x[q][i][e]; }
      }
      if (l == DEPTH - 1) {
        float* orow = p.out + (size_t)row * DM;
#pragma unroll
        for (int i = 0; i < 4; ++i) *(f32x4*)(orow + i * 256 + lane * 4) = x[q][i];
      } else {
        s2 = wave_sum(s2);
        if (lane == 0) p.rinv[row] = __builtin_amdgcn_rsqf(s2 * (1.f / DM) + 1e-6f);
#pragma unroll
        for (int i = 0; i < 4; ++i) {
          const unsigned h0 = cvtpk(x[q][i][0], x[q][i][1]), h1 = cvtpk(x[q][i][2], x[q][i][3]);
          const unsigned l0 = cvtpk(x[q][i][0] - bflo(h0), x[q][i][1] - bfhi(h0)), l1 = cvtpk(x[q][i][2] - bflo(h1), x[q][i][3] - bfhi(h1));
          *(u32x2*)(xo + i * 256 + lane * 4) = (u32x2){h0, h1}; *(u32x2*)(xo + DM + i * 256 + lane * 4) = (u32x2){l0, l1};
        }
      }
    }
  }
}

#define XB_TMO      128
#define XB_XCNT(j)  (256  + 64 * (j))
#define XB_XSUB(j)  (1280 + 64 * (j))
#define XB_XGEN(j)  (2304 + 64 * (j))
#define XB_TOP      3328
#define XB_TOPGEN   3392
#define XB_SPIN_CAP (1u << 22)
#define XLAS __attribute__((address_space(3)))
__device__ __forceinline__ unsigned xb_ld(unsigned* p)              { return __hip_atomic_load(p, __ATOMIC_RELAXED, __HIP_MEMORY_SCOPE_AGENT); }
__device__ __forceinline__ unsigned xb_add(unsigned* p, unsigned v) { return __hip_atomic_fetch_add(p, v, __ATOMIC_RELAXED, __HIP_MEMORY_SCOPE_AGENT); }
__device__ __forceinline__ unsigned xb_xcc_id() { return (unsigned)__builtin_amdgcn_s_getreg((3 << 11) | 20) & 0xFu; }
#define XB_SPIN(cond, bar) do { unsigned _sp = 0; while (cond) { __builtin_amdgcn_s_sleep(1); \
    if ((++_sp & 255u) == 0u) { if (xb_ld(&(bar)[XB_TMO])) break; if (_sp > XB_SPIN_CAP) { atomicAdd(&(bar)[XB_TMO], 1u); break; } } } } while (0)
struct XcdBarrier { unsigned* bar; unsigned x; volatile XLAS unsigned* st; };
__device__ __forceinline__ XcdBarrier xcd_barrier_post(unsigned* bar, volatile XLAS unsigned* st) {
  XcdBarrier b; b.bar = bar; b.x = xb_xcc_id(); b.st = st;
  if (threadIdx.x == 0) (void)xb_add(&bar[XB_XCNT(b.x)], 1u);
  return b;
}
__device__ __forceinline__ void xcd_barrier_complete(unsigned* bar, unsigned x, unsigned& nloc, unsigned& nx) {
  const unsigned G = gridDim.x * gridDim.y * gridDim.z;
  unsigned sum, cnt, mine, sp = 0u;
  for (;;) {
    sum = 0u; cnt = 0u; mine = 0u;
#pragma unroll
    for (unsigned j = 0; j < 16; ++j) { const unsigned c = xb_ld(&bar[XB_XCNT(j)]); sum += c; cnt += (c > 0u) ? 1u : 0u; mine = (j == x) ? c : mine; }
    if (sum == G) break;
    __builtin_amdgcn_s_sleep(1);
    if ((++sp & 255u) == 0u) { if (xb_ld(&bar[XB_TMO])) break; if (sp > XB_SPIN_CAP) { atomicAdd(&bar[XB_TMO], 1u); break; } }
  }
  nloc = mine > 0u ? mine : 1u; nx = cnt > 0u ? cnt : 1u;
}
__device__ __forceinline__ void xcd_barrier(const XcdBarrier& b) {
  asm volatile("s_waitcnt vmcnt(0)" ::: "memory");
  __syncthreads();
  if (threadIdx.x == 0) {
    unsigned* bar = b.bar;
    __builtin_amdgcn_s_waitcnt(0);
    unsigned nloc = b.st[0], nx = b.st[1];
    if (nloc == 0u) { xcd_barrier_complete(bar, b.x, nloc, nx); b.st[0] = nloc; b.st[1] = nx; }
    const unsigned old = xb_add(&bar[XB_XSUB(b.x)], 1u);
    const unsigned gen = old / nloc;
    if (old + 1u == (gen + 1u) * nloc) {
      __builtin_amdgcn_fence(__ATOMIC_RELEASE, "agent");
      asm volatile("s_waitcnt vmcnt(0)" ::: "memory");
      const unsigned og = xb_add(&bar[XB_TOP], 1u);
      const unsigned tg = og / nx;
      if (og + 1u == (tg + 1u) * nx) xb_add(&bar[XB_TOPGEN], 1u);
      else XB_SPIN(xb_ld(&bar[XB_TOPGEN]) == tg, bar);
      __builtin_amdgcn_fence(__ATOMIC_ACQUIRE, "agent");
      xb_add(&bar[XB_XGEN(b.x)], 1u);
      asm volatile("s_waitcnt vmcnt(0)" ::: "memory");
    } else {
      XB_SPIN(xb_ld(&bar[XB_XGEN(b.x)]) == gen, bar);
      __builtin_amdgcn_fence(__ATOMIC_ACQUIRE, "agent");
      asm volatile("s_waitcnt vmcnt(0)" ::: "memory");
    }
  }
  __syncthreads();
}

__device__ __forceinline__ void run_phase(const Params& p, int ph, char* shm) {
  if (ph == 0) { phase0(p, shm); return; }
  const int l = (ph - 1) >> 2, s = (ph - 1) & 3;
  if (s == 0) { gm::EpiIn e{p.rinv, p.rope, p.proj, p.kmax2 + l * 160}; gm::gemm_phase(( const bf16_t*)p.out, LDX, p.WinT + (size_t)l * NPROJ * DM, NPROJ, e, shm); }
  else if (s == 1) { pool_phase(p, l); at::attn_phase(p, l, shm); }
  else if (s == 2) { gm::EpiOut e{p.proj}; gm::gemm_phase(p.proj, NPROJ, p.WoutT + (size_t)l * DM * DM, DM, e, shm); }
  else post_phase(p, l);
}

#if MK_MULTI
template <int S> __global__ void __launch_bounds__(NT_THREADS, 1) k_phase(Params p, int l) {
  extern __shared__ __attribute__((aligned(16))) char shm[];
  if (S == 0) phase0(p, shm); else run_phase(p, 1 + 4 * l + (S - 1), shm);
}
#else
__global__ void __launch_bounds__(NT_THREADS, 1) k_mega(Params p) {
  extern __shared__ __attribute__((aligned(16))) char shm[];
  cg::grid_group grid = cg::this_grid();
  volatile XLAS unsigned* xst = (volatile XLAS unsigned*)(XLAS char*)(shm + 131072 + 3072);
  if (threadIdx.x == 0) { xst[0] = 0u; xst[1] = 0u; xst[2] = 0u; xst[3] = 0u; }
  phase0(p, shm);
  grid.sync();
  const XcdBarrier xb = xcd_barrier_post(p.bar, xst);
#define GSYNC() xcd_barrier(xb)
  for (int l = 0; l < DEPTH; ++l) {
#if REP_GEMM
    { gm::EpiIn e{p.rinv, p.rope, p.proj, p.kmax2 + l * 160}; gm::gemm_phase((const bf16_t*)p.out, LDX, p.WinT + (size_t)l * NPROJ * DM, NPROJ, e, shm); }
    GSYNC();
#endif
    { gm::EpiIn e{p.rinv, p.rope, p.proj, p.kmax2 + l * 160}; gm::gemm_phase((const bf16_t*)p.out, LDX, p.WinT + (size_t)l * NPROJ * DM, NPROJ, e, shm); }
    GSYNC();
    pool_phase(p, l);
#if REP_ATT
    at::attn_phase(p, l, shm, true); GSYNC();
#endif
    at::attn_phase(p, l, shm);
    GSYNC();
#if REP_GEMM
    { gm::EpiOut e{p.proj}; gm::gemm_phase(p.proj, NPROJ, p.WoutT + (size_t)l * DM * DM, DM, e, shm); }
    GSYNC();
#endif
    { gm::EpiOut e{p.proj}; gm::gemm_phase(p.proj, NPROJ, p.WoutT + (size_t)l * DM * DM, DM, e, shm); }
    GSYNC();
#if REP_POST
    if (l == 0) { post_phase(p, l); GSYNC(); }
#endif
    post_phase(p, l);
    if (l + 1 < DEPTH) GSYNC();
  }
}
#endif

extern "C" void kernel_launch(void* const* d_in, const int* in_sizes, int n_in, void* d_out, int out_size, void* d_ws, size_t ws_size, hipStream_t stream) {
  Params p{};
  p.xp = (const float*)d_in[0]; p.xs = (const float*)d_in[1]; p.pre_g = (const float*)d_in[2]; p.w_in = (const float*)d_in[3];
  p.pool_w = (const float*)d_in[4]; p.pool_scale = (const float*)d_in[5]; p.lq1 = (const float*)d_in[6]; p.lk1 = (const float*)d_in[7];
  p.lq2 = (const float*)d_in[8]; p.lk2 = (const float*)d_in[9]; p.subln_g = (const float*)d_in[10]; p.w_out = (const float*)d_in[11]; p.post_g = (const float*)d_in[12];
  p.out = (float*)d_out;
  char* w = (char*)d_ws; size_t off = 0;
  p.proj = (bf16_t*)(w + off); off += (size_t)T_TOK * NPROJ * 2;
  p.WinT = (bf16_t*)(w + off); off += (size_t)DEPTH * NPROJ * DM * 2;
  p.WoutT = (bf16_t*)(w + off); off += (size_t)DEPTH * DM * DM * 2;
  p.rinv = (float*)(w + off); off += (size_t)T_TOK * 4;
  p.rope = (float*)(w + off); off += 256;
  p.lam = (float*)(w + off); off += 256;
  p.kmax2 = (float*)(w + off); off += 2048;
  p.bar = (unsigned*)(w + off); off += 16384;
  if (off > ws_size) { fprintf(stderr, "kernel_launch: workspace too small (%zu > %zu)\n", off, ws_size); return; }
#if MK_MULTI
  static int ok = 0;
  if (!ok) {
    (void)hipFuncSetAttribute((const void*)k_phase<0>, hipFuncAttributeMaxDynamicSharedMemorySize, (int)SHM_BYTES);
    (void)hipFuncSetAttribute((const void*)k_phase<1>, hipFuncAttributeMaxDynamicSharedMemorySize, (int)SHM_BYTES);
    (void)hipFuncSetAttribute((const void*)k_phase<2>, hipFuncAttributeMaxDynamicSharedMemorySize, (int)SHM_BYTES);
    (void)hipFuncSetAttribute((const void*)k_phase<3>, hipFuncAttributeMaxDynamicSharedMemorySize, (int)SHM_BYTES);
    (void)hipFuncSetAttribute((const void*)k_phase<4>, hipFuncAttributeMaxDynamicSharedMemorySize, (int)SHM_BYTES);
    ok = 1; }
  hipLaunchKernelGGL(k_phase<0>, dim3(256), dim3(NT_THREADS), SHM_BYTES, stream, p, 0);
  for (int l = 0; l < DEPTH; ++l) {
    hipLaunchKernelGGL(k_phase<1>, dim3(256), dim3(NT_THREADS), SHM_BYTES, stream, p, l);
    hipLaunchKernelGGL(k_phase<2>, dim3(256), dim3(NT_THREADS), SHM_BYTES, stream, p, l);
    hipLaunchKernelGGL(k_phase<3>, dim3(256), dim3(NT_THREADS), SHM_BYTES, stream, p, l);
    hipLaunchKernelGGL(k_phase<4>, dim3(256), dim3(NT_THREADS), SHM_BYTES, stream, p, l);
  }
#else
  static int grid_blocks = 0;
  if (!grid_blocks) {
    (void)hipFuncSetAttribute((const void*)k_mega, hipFuncAttributeMaxDynamicSharedMemorySize, (int)SHM_BYTES);
    int dev = 0, cus = 0, per_cu = 0;
    (void)hipGetDevice(&dev);
    (void)hipDeviceGetAttribute(&cus, hipDeviceAttributeMultiprocessorCount, dev);
    (void)hipOccupancyMaxActiveBlocksPerMultiprocessor(&per_cu, k_mega, NT_THREADS, SHM_BYTES);
    if (per_cu > 1) per_cu = 1;
    grid_blocks = cus * per_cu;
  }
  void* args[] = {&p};
  hipError_t e = hipLaunchCooperativeKernel((void*)k_mega, dim3(grid_blocks), dim3(NT_THREADS), args, SHM_BYTES, stream);
  if (e != hipSuccess) fprintf(stderr, "cooperative launch failed: %s (grid %d)\n", hipGetErrorString(e), grid_blocks);
#endif
}
```

```cpp
#include <hip/hip_runtime.h>
#include <hip/hip_cooperative_groups.h>
#include <cstdio>
#include <cstdint>
namespace cg = cooperative_groups;

#ifndef REP_ATT
#define REP_ATT 0
#endif
#ifndef STAGGER_MAP
#define STAGGER_MAP 1
#endif
#ifndef REP_POST
#define REP_POST 0
#endif
#ifndef REP_GEMM
#define REP_GEMM 0
#endif
#ifndef MK_MULTI
#define MK_MULTI 0
#endif

typedef unsigned short bf16_t;
using bf16x8 = __attribute__((ext_vector_type(8))) short;
using s16x4  = __attribute__((ext_vector_type(4))) short;
using f32x16 = __attribute__((ext_vector_type(16))) float;
using f32x4  = __attribute__((ext_vector_type(4))) float;
using u32x4  = __attribute__((ext_vector_type(4))) unsigned;
using u32x2  = __attribute__((ext_vector_type(2))) unsigned;

#define XCD_BAR_WORDS 3456
constexpr int NT_THREADS = 512;
constexpr int T_TOK = 65536, TP = 32768, DM = 1024, NPROJ = 3072, DEPTH = 2;
constexpr int S_P = 16384, S_S = 4096;
constexpr int C_ZP = 0, C_ZA = 512, C_U = 1024, C_Q = 1536, C_K = 2048, C_V = 2560;
constexpr int LDX = 2048;
constexpr float QSCALE = 0.125f * 1.4426950408889634f;
constexpr size_t SHM_BYTES = 131072 + 4096;

struct Params {
  const float* xp; const float* xs; const float* pre_g; const float* w_in; const float* pool_w; const float* pool_scale;
  const float* lq1; const float* lk1; const float* lq2; const float* lk2; const float* subln_g; const float* w_out; const float* post_g;
  float* out; bf16_t* WinT; bf16_t* WoutT; bf16_t* proj; float* rinv; float* rope; float* lam; float* kmax2; unsigned* bar;
};

#define SBAR() __builtin_amdgcn_sched_barrier(0)
__device__ __forceinline__ unsigned cvtpk(float lo, float hi) {
  unsigned r; asm volatile("v_cvt_pk_bf16_f32 %0, %1, %2" : "=v"(r) : "v"(lo), "v"(hi)); return r;
}
typedef __bf16 bf16x2_t __attribute__((ext_vector_type(2)));
typedef float f32x2_t __attribute__((ext_vector_type(2)));
__device__ __forceinline__ unsigned cvtpk_b(float lo, float hi) { const f32x2_t v = {lo, hi}; const bf16x2_t b = __builtin_convertvector(v, bf16x2_t); return *reinterpret_cast<const unsigned*>(&b); }
__device__ __forceinline__ float bf2f(unsigned short b) { return __uint_as_float(((unsigned)b) << 16); }
__device__ __forceinline__ float bflo(unsigned w) { return __uint_as_float(w << 16); }
__device__ __forceinline__ float bfhi(unsigned w) { return __uint_as_float(w & 0xffff0000u); }
__device__ __forceinline__ bf16_t f2bf(float f) { return (bf16_t)(cvtpk(f, 0.f) & 0xffffu); }
__host__ __device__ __forceinline__ int perm32(int rho) { const int n = rho >> 4, i = rho & 15; return 8 * (i >> 2) + 4 * n + (i & 3); }
__device__ __forceinline__ float silu(float z) { return z * __builtin_amdgcn_rcpf(1.f + __builtin_amdgcn_exp2f(-1.4426950408889634f * z)); }
__device__ __forceinline__ int opaque_tid() { int t = threadIdx.x; asm volatile("" : "+v"(t)); return t; }
__device__ __forceinline__ float wave_sum(float v) {
#pragma unroll
  for (int o = 32; o >= 1; o >>= 1) v += __shfl_xor(v, o);
  return v;
}

__device__ __forceinline__ int src_col_in(int s) {
  const int type = s >> 9, within = s & 511;
  if (type == 0) return 512 + within;
  if (type == 1) return 2560 + within;
  if (type == 5) return 2048 + within;
  const int p = within & 63, wcl = p >> 5, fq = (p >> 3) & 3, n = (p >> 2) & 1, jj = p & 3;
  const int d = wcl * 16 + fq * 4 + jj + 32 * n;
  return (type == 3 ? 1024 : 1536) + (within & ~63) + d;
}

__device__ void phase0(const Params& p, char* shm) {
  const int tid = opaque_tid(), nth = blockDim.x;
  float* tile = (float*)shm;
  float* Wt = tile + 64 * 65 + 32;
  float* Pw = Wt + 64 * 128;
  constexpr int NT_U = DEPTH * 8 * 16, NT_IN = DEPTH * 40 * 16, NT_OUT = DEPTH * 16 * 16;
  for (int it = blockIdx.x; it < NT_U + NT_IN + NT_OUT; it += gridDim.x) {
    __syncthreads();
    if (it < NT_U + NT_IN) {
      int l, n0, k0; const bool isu = it < NT_U;
      if (isu) { l = it / 128; const int r = it % 128; n0 = C_U + (r / 16) * 64; k0 = (r % 16) * 64; }
      else { const int i2 = it - NT_U; l = i2 / 640; const int r = i2 % 640; int nt = r / 16; if (nt >= 16) nt += 8; n0 = nt * 64; k0 = (r % 16) * 64; }
      const float* W = p.w_in + (size_t)l * DM * NPROJ; const float* g = p.pre_g + l * DM;
      if (isu) {
        const int gi = (n0 - C_U) >> 7, d0 = (n0 - C_U) & 127;
        for (int e = tid; e < 64 * 128; e += nth) { const int c = e & 127, kk = e >> 7; Wt[e] = W[(size_t)(k0 + kk) * NPROJ + gi * 128 + c]; }
        for (int e = tid; e < 128 * 64; e += nth) { const int d = e & 63, c = e >> 6; Pw[e] = p.pool_w[((size_t)(l * 4 + gi) * 128 + c) * 128 + d0 + d]; }
        __syncthreads();
        for (int e = tid; e < 4096; e += nth) {
          const int nn = e & 63, kk = e >> 6, nrow = n0 + nn; const int s = (nrow & ~31) + perm32(nrow & 31), dl = s - n0;
          float a = 0.f;
#pragma unroll 8
          for (int c = 0; c < 128; ++c) a = fmaf(Wt[kk * 128 + c], Pw[c * 64 + dl], a);
          tile[kk * 65 + nn] = a * g[k0 + kk];
        }
      } else {
        for (int e = tid; e < 4096; e += nth) {
          const int nn = e & 63, kk = e >> 6, k = k0 + kk, nrow = n0 + nn;
          const int s = (nrow & ~31) + perm32(nrow & 31);
          tile[kk * 65 + nn] = W[(size_t)k * NPROJ + src_col_in(s)] * g[k];
        }
      }
      __syncthreads();
      bf16_t* O = p.WinT + (size_t)l * NPROJ * DM;
      for (int e = tid; e < 4096; e += nth) { const int kk = e & 63, nn = e >> 6; O[(size_t)(n0 + nn) * DM + k0 + kk] = f2bf(tile[kk * 65 + nn]); }
    } else {
      const int it2 = it - NT_U - NT_IN, l = it2 / 256, r = it2 % 256, n0 = (r / 16) * 64, k0 = (r % 16) * 64;
      const float* W = p.w_out + (size_t)l * DM * DM;
      for (int e = tid; e < 4096; e += nth) {
        const int nn = e & 63, kk = e >> 6, nrow = n0 + nn; const int s = (nrow & ~31) + perm32(nrow & 31);
        tile[kk * 65 + nn] = W[(size_t)(k0 + kk) * DM + s];
      }
      __syncthreads();
      bf16_t* O = p.WoutT + (size_t)l * DM * DM;
      for (int e = tid; e < 4096; e += nth) { const int kk = e & 63, nn = e >> 6; O[(size_t)(n0 + nn) * DM + k0 + kk] = f2bf(tile[kk * 65 + nn]); }
    }
  }
  if (blockIdx.x == 0) {
    for (int i = tid; i < XCD_BAR_WORDS; i += nth) p.bar[i] = 0u;
    if (tid < DEPTH * 160) p.kmax2[tid] = 0.f;
    if (tid < 32) { const double c = exp(-(double)tid * (9.210340371976184 / 32.0)) * 0.15915494309189535; const float h = (float)c; p.rope[2 * tid] = h; p.rope[2 * tid + 1] = (float)(c - (double)h); }
    if (tid >= 64 && tid < 64 + 64 * DEPTH) {
      const int l = (tid >> 6) - 1, i = tid & 63;
      float a = p.lq1[l * 64 + i] * p.lk1[l * 64 + i], b = p.lq2[l * 64 + i] * p.lk2[l * 64 + i];
      a = wave_sum(a); b = wave_sum(b);
      const float li = 0.8f - 0.6f * expf(-0.3f * (float)l);
      if (i == 0) p.lam[l] = expf(a) - expf(b) + li;
    }
  }
  const int wid = tid >> 6, lane = tid & 63, nw = nth >> 6;
  for (int row0 = (blockIdx.x * nw + wid) * 2; row0 < T_TOK; row0 += gridDim.x * nw * 2) {
    f32x4 v[2][4];
#pragma unroll
    for (int q = 0; q < 2; ++q) {
      const int row = row0 + q;
      const float* xr = row < TP ? p.xp + (size_t)row * DM : p.xs + (size_t)(row - TP) * DM;
#pragma unroll
      for (int i = 0; i < 4; ++i) v[q][i] = *(const f32x4*)(xr + i * 256 + lane * 4);
    }
#pragma unroll
    for (int q = 0; q < 2; ++q) {
      const int row = row0 + q;
      bf16_t* xo = (bf16_t*)p.out + (size_t)row * LDX;
      float ss = 0.f;
#pragma unroll
      for (int i = 0; i < 4; ++i) {
        ss += v[q][i][0] * v[q][i][0] + v[q][i][1] * v[q][i][1] + v[q][i][2] * v[q][i][2] + v[q][i][3] * v[q][i][3];
        u32x2 w = {cvtpk(v[q][i][0], v[q][i][1]), cvtpk(v[q][i][2], v[q][i][3])};
        *(u32x2*)(xo + i * 256 + lane * 4) = w;
      }
      ss = wave_sum(ss);
      if (lane == 0) p.rinv[row] = __builtin_amdgcn_rsqf(ss * (1.f / DM) + 1e-6f);
    }
  }
}

namespace gm {
constexpr int BM = 256, BK = 64, HALF = 128, NXCD = 8, WGM = 8, HT = HALF * BK;
__device__ __forceinline__ int lds_byte(int r, int c) { int st = (r >> 4) * 2 + (c >> 5), rr = r & 15, cc = c & 31, ob = rr * 64 + cc * 2; return st * 1024 + (ob ^ (((ob >> 9) & 1) << 5)); }
__device__ __forceinline__ void stage_rc(int b, int& R, int& C) { int st = b / 1024, sb = b % 1024, swz = sb ^ (((sb >> 9) & 1) << 5); R = (st >> 1) * 16 + swz / 64; C = (st & 1) * 32 + (swz % 64) / 2; }

#define LAS __attribute__((address_space(3)))
template <class Epi>
__device__ __forceinline__ void gemm_phase(const bf16_t* __restrict__ A, const int lda, const bf16_t* __restrict__ Bt, const int N, const Epi& E, char* shmc) {
  constexpr int K = 1024, nt = K / BK, HTB = HALF * BK * 2;
  LAS unsigned char* lds = (LAS unsigned char*)shmc;
  const int tid = opaque_tid(), wid = __builtin_amdgcn_readfirstlane(tid >> 6), lane = tid & 63, wr = wid >> 2, wc = wid & 3, fr = lane & 15, fq = lane >> 4;
  unsigned voffA[2], voffB[2];
#pragma unroll
  for (int i = 0; i < 2; ++i) { int R, C; stage_rc(tid * 16 + i * 8192, R, C); voffA[i] = (unsigned)(R * lda + C) * 2u; voffB[i] = (unsigned)(R * K + C) * 2u; }
  const size_t kstep = (size_t)(BK * 2);
  const size_t hstepA = (size_t)HALF * lda * 2, hstepB = (size_t)HALF * K * 2;
  const size_t tstepA = 2 * hstepA, tstepB = 2 * hstepB;
  const unsigned ldsw = (unsigned)wid * 1024u;
  const int aoff = lds_byte(wr * 64 + fr, fq * 8), boff = lds_byte(wc * 32 + fr, fq * 8);
#define PG8_SA(b, h) (((b) * 2 + (h)) * HTB)
#define PG8_SB(b, h) ((4 + (b) * 2 + (h)) * HTB)
#define PG8_STAGE(bufoff, gbase, voff) do { _Pragma("unroll") for (int _i = 0; _i < 2; ++_i) \
        __builtin_amdgcn_global_load_lds((const unsigned*)((const char*)(gbase) + (voff)[_i]), (LAS unsigned*)(lds + (bufoff) + ldsw + _i * 8192), 16, 0, 0); } while (0)
#define PG8_LDA(dst, b, h) do { _Pragma("unroll") for (int m = 0; m < 4; ++m) _Pragma("unroll") for (int k = 0; k < 2; ++k) dst[m][k] = *(const LAS bf16x8*)(lds + PG8_SA(b, h) + aoff + m * 2048 + k * 1024); } while (0)
#define PG8_LDB(dst, b, h) do { _Pragma("unroll") for (int n = 0; n < 2; ++n) _Pragma("unroll") for (int k = 0; k < 2; ++k) dst[n][k] = *(const LAS bf16x8*)(lds + PG8_SB(b, h) + boff + n * 2048 + k * 1024); } while (0)
#define PG8_MMA(ai, bj, At, Bx) do { __builtin_amdgcn_s_setprio(1); _Pragma("unroll") for (int m = 0; m < 4; ++m) _Pragma("unroll") for (int n = 0; n < 2; ++n) _Pragma("unroll") for (int k = 0; k < 2; ++k) \
        acc[ai][bj][m][n] = __builtin_amdgcn_mfma_f32_16x16x32_bf16(Bx[n][k], At[m][k], acc[ai][bj][m][n], 0, 0, 0); __builtin_amdgcn_s_setprio(0); } while (0)
#define PG8_WAIT_V(n) asm volatile("s_waitcnt vmcnt(" #n ")" ::: "memory")
#define PG8_WAIT_L(n) asm volatile("s_waitcnt lgkmcnt(" #n ")" ::: "memory")
#define PG8_BAR __builtin_amdgcn_s_barrier()
#define PG8_SCHED __builtin_amdgcn_sched_barrier(0)
  const int nM = T_TOK / BM, nN = N / BM, nwg = nM * nN, G = gridDim.x, cblk = blockIdx.x;
  auto next_unit = [&](int i, int& pm, int& pn) -> bool {
    const long L = (long)i * G + cblk; if (L >= nwg) return false;
    int wgid = (int)L; { const int q = nwg / NXCD, r = nwg % NXCD, xcd = wgid % NXCD, off = wgid / NXCD; wgid = (xcd < r ? xcd * (q + 1) : r * (q + 1) + (xcd - r) * q) + off; }
    const int nig = WGM * nN, gid = wgid / nig, fm = gid * WGM, gsz = (nM - fm) < WGM ? (nM - fm) : WGM;
    pm = fm + ((wgid % nig) % gsz); pn = (wgid % nig) / gsz; return true;
  };
  int cpm, cpn, npm = 0, npn = 0, ui = 0;
  if (!next_unit(0, cpm, cpn)) return;
  f32x4 acc[2][2][4][2];
#pragma unroll
  for (int a = 0; a < 2; ++a)
#pragma unroll
    for (int b = 0; b < 2; ++b)
#pragma unroll
      for (int m = 0; m < 4; ++m)
#pragma unroll
        for (int n = 0; n < 2; ++n) acc[a][b][m][n] = (f32x4){0.f, 0.f, 0.f, 0.f};
  bf16x8 At[4][2], B0[2][2], B1[2][2];
  const char* cA = (const char*)A + (size_t)cpm * tstepA; const char* cB = (const char*)Bt + (size_t)cpn * tstepB;
  PG8_STAGE(PG8_SB(0, 0), cB, voffB); PG8_STAGE(PG8_SB(0, 1), cB + hstepB, voffB); PG8_STAGE(PG8_SA(0, 0), cA, voffA); PG8_STAGE(PG8_SA(0, 1), cA + hstepA, voffA);
  if (wr == 1) PG8_BAR;
  PG8_WAIT_V(2); PG8_BAR;
  PG8_STAGE(PG8_SB(1, 0), cB + kstep, voffB); PG8_STAGE(PG8_SA(1, 0), cA + kstep, voffA); PG8_STAGE(PG8_SB(1, 1), cB + hstepB + kstep, voffB);
  PG8_WAIT_V(6); PG8_BAR;
  for (;;) {
    const bool has_next = next_unit(ui + 1, npm, npn);
    const char* nA = has_next ? (const char*)A + (size_t)npm * tstepA : cA; const char* nB = has_next ? (const char*)Bt + (size_t)npn * tstepB : cB;
    for (int t = 0; t < nt; t += 2) {
      const bool last = (t == nt - 2);
      const char* a1 = cA + (size_t)(t + 1) * kstep;
      const char* a2 = last ? nA : cA + (size_t)(t + 2) * kstep; const char* b2 = last ? nB : cB + (size_t)(t + 2) * kstep;
      const char* a3 = a2 + kstep; const char* b3 = b2 + kstep;
      PG8_LDB(B0, 0, 0); PG8_LDB(B1, 0, 1); PG8_SCHED; PG8_LDA(At, 0, 0); PG8_STAGE(PG8_SA(1, 1), a1 + hstepA, voffA);
      PG8_WAIT_V(8); PG8_WAIT_L(0); PG8_BAR; PG8_MMA(0, 0, At, B0); PG8_MMA(0, 1, At, B1); PG8_BAR; PG8_SCHED;
      PG8_LDA(At, 0, 1); PG8_STAGE(PG8_SB(0, 0), b2, voffB); PG8_STAGE(PG8_SB(0, 1), b2 + hstepB, voffB); PG8_STAGE(PG8_SA(0, 0), a2, voffA);
      PG8_WAIT_V(8); PG8_WAIT_L(0); PG8_BAR; PG8_MMA(1, 0, At, B0); PG8_MMA(1, 1, At, B1); PG8_BAR; PG8_SCHED;
      PG8_LDB(B0, 1, 0); PG8_LDB(B1, 1, 1); PG8_SCHED; PG8_LDA(At, 1, 0); PG8_STAGE(PG8_SA(0, 1), a2 + hstepA, voffA);
      PG8_WAIT_V(8); PG8_WAIT_L(0); PG8_BAR; PG8_MMA(0, 0, At, B0); PG8_MMA(0, 1, At, B1); PG8_BAR; PG8_SCHED;
      PG8_LDA(At, 1, 1); PG8_STAGE(PG8_SB(1, 0), b3, voffB); PG8_STAGE(PG8_SB(1, 1), b3 + hstepB, voffB); PG8_STAGE(PG8_SA(1, 0), a3, voffA);
      PG8_WAIT_V(8); PG8_WAIT_L(0); PG8_BAR; PG8_MMA(1, 0, At, B0); PG8_MMA(1, 1, At, B1); PG8_BAR; PG8_SCHED;
    }
    if (wr == 0) PG8_BAR;
    E(acc, cpm, cpn, wr, wc, fr, fq);
    if (!has_next) break;
#pragma unroll
    for (int a = 0; a < 2; ++a)
#pragma unroll
      for (int b = 0; b < 2; ++b)
#pragma unroll
        for (int m = 0; m < 4; ++m)
#pragma unroll
          for (int n = 0; n < 2; ++n) acc[a][b][m][n] = (f32x4){0.f, 0.f, 0.f, 0.f};
    cpm = npm; cpn = npn; cA = nA; cB = nB; ++ui;
    if (wr == 1) PG8_BAR;
  }
  PG8_WAIT_V(0);
  PG8_BAR;
#undef PG8_SA
#undef PG8_SB
#undef PG8_STAGE
#undef PG8_LDA
#undef PG8_LDB
#undef PG8_MMA
}

struct EpiIn {
  const float* rinv; const float* rope; bf16_t* proj; float* kmax2;
  __device__ __forceinline__ void operator()(const f32x4 (&acc)[2][2][4][2], int pm, int pn, int wr, int wc, int fr, int fq) const {
    const bool isrope = (pn >= 6 && pn <= 9); const float qs = (pn == 6 || pn == 7) ? QSCALE : 1.f;
    const bool isk = (pn == 8 || pn == 9);
    float kmx[2] = {0.f, 0.f};
    float ch[4], cl[4];
    if (isrope) {
#pragma unroll
      for (int jj = 0; jj < 4; ++jj) { const int i = (wc & 1) * 16 + fq * 4 + jj; ch[jj] = rope[2 * i]; cl[jj] = rope[2 * i + 1]; }
    }
    float riv[2][4];
#pragma unroll
    for (int ai = 0; ai < 2; ++ai)
#pragma unroll
      for (int m = 0; m < 4; ++m) riv[ai][m] = rinv[pm * BM + ai * HALF + wr * 64 + m * 16 + fr];
#pragma unroll
    for (int ai = 0; ai < 2; ++ai)
#pragma unroll
      for (int m = 0; m < 4; ++m) {
        const int row = pm * BM + ai * HALF + wr * 64 + m * 16 + fr;
        const float ri = riv[ai][m];
        float cs[4], sn[4];
        if (isrope) {
          const float pos = (float)(row < TP ? (row & (S_P - 1)) : (row & (S_S - 1)));
#pragma unroll
          for (int jj = 0; jj < 4; ++jj) {
            const float h = pos * ch[jj], e = fmaf(pos, ch[jj], -h) + pos * cl[jj];
            const float rev = (h - floorf(h)) + e;
            sn[jj] = __builtin_amdgcn_sinf(rev); cs[jj] = __builtin_amdgcn_cosf(rev);
          }
        }
        bf16_t* rowp = proj + (size_t)row * NPROJ + pn * BM + wc * 32 + 8 * fq;
#pragma unroll
        for (int bj = 0; bj < 2; ++bj) {
          f32x4 v0 = acc[ai][bj][m][0] * ri, v1 = acc[ai][bj][m][1] * ri;
          if (isrope) {
#pragma unroll
            for (int jj = 0; jj < 4; ++jj) { const float a = v0[jj], b = v1[jj]; v0[jj] = (a * cs[jj] - b * sn[jj]) * qs; v1[jj] = (b * cs[jj] + a * sn[jj]) * qs; }
          }
          u32x4 w; w.x = cvtpk(v0[0], v0[1]); w.y = cvtpk(v0[2], v0[3]); w.z = cvtpk(v1[0], v1[1]); w.w = cvtpk(v1[2], v1[3]);
          *(u32x4*)(rowp + bj * HALF) = w;
          if (isk) { float ss = v0[0] * v0[0] + v0[1] * v0[1] + v0[2] * v0[2] + v0[3] * v0[3] + v1[0] * v1[0] + v1[1] * v1[1] + v1[2] * v1[2] + v1[3] * v1[3];
            ss += __shfl_xor(ss, 16); ss += __shfl_xor(ss, 32); kmx[bj] = fmaxf(kmx[bj], ss); }
        }
      }
    if (isk) {
      const int row0 = pm * BM, sq = row0 < TP ? (row0 >> 14) : 2 + ((row0 - TP) >> 12);
#pragma unroll
      for (int bj = 0; bj < 2; ++bj) { float v = kmx[bj];
        v = fmaxf(v, __shfl_xor(v, 1)); v = fmaxf(v, __shfl_xor(v, 2)); v = fmaxf(v, __shfl_xor(v, 4)); v = fmaxf(v, __shfl_xor(v, 8));
        if ((fr | fq) == 0) atomicMax((unsigned*)(kmax2 + (sq * 4 + (pn - 8) * 2 + bj) * 4 + wc), __float_as_uint(v)); }
    }
  }
};
struct EpiOut {
  bf16_t* proj;
  __device__ __forceinline__ void operator()(const f32x4 (&acc)[2][2][4][2], int pm, int pn, int wr, int wc, int fr, int fq) const {
#pragma unroll
    for (int ai = 0; ai < 2; ++ai)
#pragma unroll
      for (int m = 0; m < 4; ++m) {
        const int row = pm * BM + ai * HALF + wr * 64 + m * 16 + fr;
        bf16_t* rowp = proj + (size_t)row * NPROJ + C_U + pn * BM + wc * 32 + 8 * fq;
#pragma unroll
        for (int bj = 0; bj < 2; ++bj) { const f32x4 v0 = acc[ai][bj][m][0], v1 = acc[ai][bj][m][1];
          u32x4 w; w.x = cvtpk(v0[0], v0[1]); w.y = cvtpk(v0[2], v0[3]); w.z = cvtpk(v1[0], v1[1]); w.w = cvtpk(v1[2], v1[3]);
          *(u32x4*)(rowp + bj * HALF) = w; }
      }
  }
};
}

__device__ __forceinline__ void bf8_to_f(const u32x4 w, float* v) {
  v[0] = bflo(w.x); v[1] = bfhi(w.x); v[2] = bflo(w.y); v[3] = bfhi(w.y); v[4] = bflo(w.z); v[5] = bfhi(w.z); v[6] = bflo(w.w); v[7] = bfhi(w.w);
}
__device__ void pool_phase(const Params& p, int l, bool dry = false) {
  const int tid = opaque_tid(), c8 = tid & 63, tq = tid >> 6;
  const int g = c8 >> 4, hw = 1 << g;
  const float* sc = p.pool_scale + l * 512 + c8 * 8;
  float scl[8];
#pragma unroll
  for (int e = 0; e < 8; ++e) scl[e] = sc[e];
  for (int ch = blockIdx.x; ch < T_TOK / 128; ch += gridDim.x) {
    const int t0 = ch * 128 + tq * 16;
    const int S = t0 < TP ? S_P : S_S, pos0 = t0 & (S - 1), s0 = t0 - pos0;
    const bf16_t* ub = p.proj + (size_t)s0 * NPROJ + C_U + c8 * 8;
    float sum[8] = {0, 0, 0, 0, 0, 0, 0, 0};
#pragma unroll
    for (int j = 0; j < 16; ++j) {
      const int r = pos0 - hw + j; const bool ok = (j < 2 * hw) && r >= 0 && r < S; const int rc = min(max(r, 0), S - 1);
      float v[8]; bf8_to_f(*(const u32x4*)(ub + (size_t)rc * NPROJ), v); const float m = ok ? 1.f : 0.f;
#pragma unroll
      for (int e = 0; e < 8; ++e) sum[e] = fmaf(m, v[e], sum[e]);
    }
#pragma unroll
    for (int i4 = 0; i4 < 16; i4 += 4) {
      u32x4 wu[4], wz[4], wa[4], wsb[4];
#pragma unroll
      for (int q = 0; q < 4; ++q) {
        const int pos = pos0 + i4 + q, ra = pos + hw, rs = pos - hw;
        wu[q] = *(const u32x4*)(ub + (size_t)pos * NPROJ);
        wz[q] = *(const u32x4*)(p.proj + (size_t)(t0 + i4 + q) * NPROJ + C_ZP + c8 * 8);
        wa[q] = *(const u32x4*)(ub + (size_t)min(ra, S - 1) * NPROJ); wsb[q] = *(const u32x4*)(ub + (size_t)max(rs, 0) * NPROJ);
      }
#pragma unroll
      for (int q = 0; q < 4; ++q) {
        const int pos = pos0 + i4 + q, t = t0 + i4 + q;
        const int lo = max(pos - hw, 0), hi = min(pos + hw, S);
        const float inv = 1.f / (float)(hi - lo);
        float uc[8], z[8], va[8], vs[8], o[8];
        bf8_to_f(wu[q], uc); bf8_to_f(wz[q], z);
#pragma unroll
        for (int e = 0; e < 8; ++e) o[e] = (sum[e] * inv - uc[e]) * scl[e] * silu(z[e]);
        const u32x4 w = {cvtpk(o[0], o[1]), cvtpk(o[2], o[3]), cvtpk(o[4], o[5]), cvtpk(o[6], o[7])};
        if (!dry) *(u32x4*)(p.proj + (size_t)t * NPROJ + C_ZP + c8 * 8) = w;
        const int ra = pos + hw, rs = pos - hw; const float ma = ra < S ? 1.f : 0.f, ms = rs >= 0 ? 1.f : 0.f;
        bf8_to_f(wa[q], va); bf8_to_f(wsb[q], vs);
#pragma unroll
        for (int e = 0; e < 8; ++e) sum[e] = fmaf(ma, va[e], fmaf(-ms, vs[e], sum[e]));
      }
    }
  }
}

namespace at {
constexpr int KVBLK = 64, LDK = NPROJ;
constexpr size_t SHM_V = KVBLK * 128 * 2, SHM_K = KVBLK * 128 * 2;
constexpr float THRL = 11.5f;
#define KSWZ(row, colB) ((row) * 256 + ((colB) ^ (((row) & 7) << 4)))
__device__ __forceinline__ int crow(int r, int hi) { return (r & 3) + 8 * (r >> 2) + 4 * hi; }
template <bool SH> __device__ __forceinline__ void partialSM(f32x16& p0, f32x16& p1, float& m_reg, float& mn, float& alpha) {
  if constexpr (!SH) {
    alpha = 1.f;
    return;
  }
  float pmax = p0[0];
#pragma unroll
  for (int r = 1; r < 16; ++r) pmax = fmaxf(pmax, p0[r]);
#pragma unroll
  for (int r = 0; r < 16; ++r) pmax = fmaxf(pmax, p1[r]);
  { auto rr = __builtin_amdgcn_permlane32_swap(__float_as_uint(pmax), __float_as_uint(pmax), false, false);
    pmax = fmaxf(__uint_as_float(rr[0]), __uint_as_float(rr[1])); }
  if (__builtin_expect(__all(pmax - m_reg <= THRL), 1)) { mn = m_reg; alpha = 1.f; }
  else { mn = fmaxf(m_reg, pmax); alpha = __builtin_amdgcn_exp2f(m_reg - mn); m_reg = mn; }
#pragma unroll
  for (int r = 0; r < 16; ++r) p0[r] = p0[r] - mn;
#pragma unroll
  for (int r = 0; r < 16; ++r) p1[r] = p1[r] - mn;
#pragma unroll
  for (int r = 0; r < 16; ++r) { p0[r] = __builtin_amdgcn_exp2f(p0[r]); p1[r] = __builtin_amdgcn_exp2f(p1[r]); }
}
template <bool SH> __device__ __forceinline__ void finishSM(f32x16& p0, f32x16& p1, float alpha, float& l_reg, bf16x8& pa0, bf16x8& pa1, bf16x8& pa2, bf16x8& pa3) {
  if constexpr (!SH) {
#pragma unroll
    for (int r = 0; r < 16; ++r) { p0[r] = __builtin_amdgcn_exp2f(p0[r]); p1[r] = __builtin_amdgcn_exp2f(p1[r]); }
  }
  float ps = 0;
#pragma unroll
  for (int r = 0; r < 16; ++r) ps += p0[r];
#pragma unroll
  for (int r = 0; r < 16; ++r) ps += p1[r];
  if constexpr (SH) l_reg = l_reg * alpha + ps; else l_reg += ps;
#define PK4(P, BASE, OUT) do { u32x4 w = {cvtpk_b(P[BASE + 0], P[BASE + 1]), cvtpk_b(P[BASE + 2], P[BASE + 3]), cvtpk_b(P[BASE + 4], P[BASE + 5]), cvtpk_b(P[BASE + 6], P[BASE + 7])}; \
    OUT = *reinterpret_cast<bf16x8*>(&w); } while (0)
  PK4(p0, 0, pa0); PK4(p0, 8, pa1); PK4(p1, 0, pa2); PK4(p1, 8, pa3);
#undef PK4
}
__device__ __forceinline__ void qkt(f32x16& p0, f32x16& p1, const char* Ks, const bf16x8* qr, int r32, int hi, int mapB) {
  p0 = f32x16{}; p1 = f32x16{};
#pragma unroll
  for (int d0 = 0; d0 < 4; ++d0) { const int cb = (d0 * 16 + hi * 8) * 2 + mapB;
    bf16x8 b0 = *reinterpret_cast<const bf16x8*>(Ks + KSWZ(r32, cb));
    bf16x8 b1 = *reinterpret_cast<const bf16x8*>(Ks + KSWZ(32 + r32, cb));
    p0 = __builtin_amdgcn_mfma_f32_32x32x16_bf16(b0, qr[d0], p0, 0, 0, 0);
    p1 = __builtin_amdgcn_mfma_f32_32x32x16_bf16(b1, qr[d0], p1, 0, 0, 0); }
}
__device__ __forceinline__ int v_st(int k, int c) { const int kk = (k & ~0xC) | ((k & 4) << 1) | ((k & 8) >> 1); return ((kk >> 3) * 4 + (c >> 5)) * 512 + ((kk & 7) * 32 + (c & 31)) * 2; }
__device__ __forceinline__ int v_rd_base(int lane) { return ((lane & 3) << 3) | (((lane >> 2) & 3) << 6) | (((lane >> 4) & 1) << 5) | (((lane >> 5) & 1) << 8); }
constexpr int v_rd_off(int d0, int ks, int half) { return d0 * 512 + ks * 4096 + half * 2048; }
template <int OFF> __device__ __forceinline__ s16x4 tr_read(int vb) {
  s16x4 r; asm volatile("ds_read_b64_tr_b16 %0, %1 offset:%2" : "=&v"(r) : "v"(vb), "i"(OFF) : "memory"); return r;
}
template <int D0> __device__ __forceinline__ void pv_one(f32x16& od, int vb, bf16x8 pa0, bf16x8 pa1, bf16x8 pa2, bf16x8 pa3) {
  const s16x4 l0 = tr_read<v_rd_off(D0, 0, 0)>(vb), h0 = tr_read<v_rd_off(D0, 0, 1)>(vb), l1 = tr_read<v_rd_off(D0, 1, 0)>(vb), h1 = tr_read<v_rd_off(D0, 1, 1)>(vb);
  const s16x4 l2 = tr_read<v_rd_off(D0, 2, 0)>(vb), h2 = tr_read<v_rd_off(D0, 2, 1)>(vb), l3 = tr_read<v_rd_off(D0, 3, 0)>(vb), h3 = tr_read<v_rd_off(D0, 3, 1)>(vb);
  asm volatile("s_waitcnt lgkmcnt(0)" ::: "memory"); SBAR();
#define PK(L, H) (bf16x8){L[0], L[1], L[2], L[3], H[0], H[1], H[2], H[3]}
  od = __builtin_amdgcn_mfma_f32_32x32x16_bf16(pa0, PK(l0, h0), od, 0, 0, 0);
  od = __builtin_amdgcn_mfma_f32_32x32x16_bf16(pa1, PK(l1, h1), od, 0, 0, 0);
  od = __builtin_amdgcn_mfma_f32_32x32x16_bf16(pa2, PK(l2, h2), od, 0, 0, 0);
  od = __builtin_amdgcn_mfma_f32_32x32x16_bf16(pa3, PK(l3, h3), od, 0, 0, 0);
#undef PK
}
__device__ __forceinline__ void pv_d0(f32x16* o, int vb, bf16x8 pa0, bf16x8 pa1, bf16x8 pa2, bf16x8 pa3) {
  pv_one<0>(o[0], vb, pa0, pa1, pa2, pa3); pv_one<1>(o[1], vb, pa0, pa1, pa2, pa3); pv_one<2>(o[2], vb, pa0, pa1, pa2, pa3); pv_one<3>(o[3], vb, pa0, pa1, pa2, pa3);
}

struct VFrag { s16x4 l0, h0, l1, h1, l2, h2, l3, h3; };
template <int D0> __device__ __forceinline__ void v_frag_read(VFrag& f, int vb) {
  f.l0 = tr_read<v_rd_off(D0, 0, 0)>(vb); f.h0 = tr_read<v_rd_off(D0, 0, 1)>(vb); f.l1 = tr_read<v_rd_off(D0, 1, 0)>(vb); f.h1 = tr_read<v_rd_off(D0, 1, 1)>(vb);
  f.l2 = tr_read<v_rd_off(D0, 2, 0)>(vb); f.h2 = tr_read<v_rd_off(D0, 2, 1)>(vb); f.l3 = tr_read<v_rd_off(D0, 3, 0)>(vb); f.h3 = tr_read<v_rd_off(D0, 3, 1)>(vb);
}
__device__ __forceinline__ void v_frag_mma(f32x16& od, const VFrag& f, bf16x8 pa0, bf16x8 pa1, bf16x8 pa2, bf16x8 pa3) {
#define PK(L, H) (bf16x8){L[0], L[1], L[2], L[3], H[0], H[1], H[2], H[3]}
  od = __builtin_amdgcn_mfma_f32_32x32x16_bf16(pa0, PK(f.l0, f.h0), od, 0, 0, 0);
  od = __builtin_amdgcn_mfma_f32_32x32x16_bf16(pa1, PK(f.l1, f.h1), od, 0, 0, 0);
  od = __builtin_amdgcn_mfma_f32_32x32x16_bf16(pa2, PK(f.l2, f.h2), od, 0, 0, 0);
  od = __builtin_amdgcn_mfma_f32_32x32x16_bf16(pa3, PK(f.l3, f.h3), od, 0, 0, 0);
#undef PK
}
template <bool PRE> __device__ __forceinline__ void pv_d0_pipe(f32x16* o, int vb, bf16x8 pa0, bf16x8 pa1, bf16x8 pa2, bf16x8 pa3, VFrag& fa) {
  VFrag fb;
  if constexpr (!PRE) v_frag_read<0>(fa, vb);
  asm volatile("s_waitcnt lgkmcnt(0)" ::: "memory"); SBAR();
  v_frag_read<1>(fb, vb); SBAR(); v_frag_mma(o[0], fa, pa0, pa1, pa2, pa3); SBAR(); asm volatile("s_waitcnt lgkmcnt(0)" ::: "memory"); SBAR();
  v_frag_read<2>(fa, vb); SBAR(); v_frag_mma(o[1], fb, pa0, pa1, pa2, pa3); SBAR(); asm volatile("s_waitcnt lgkmcnt(0)" ::: "memory"); SBAR();
  v_frag_read<3>(fb, vb); SBAR(); v_frag_mma(o[2], fa, pa0, pa1, pa2, pa3); SBAR(); asm volatile("s_waitcnt lgkmcnt(0)" ::: "memory"); SBAR();
  v_frag_mma(o[3], fb, pa0, pa1, pa2, pa3);
}

template <bool SH> __device__ __forceinline__ void attn_unit(bf16_t* __restrict__ proj, int tok0, int kv0, int seq, int h, float lam, float oscale, const float* __restrict__ subg, char* lds, bool dry) {
  const int tid = opaque_tid(), wid = __builtin_amdgcn_readfirstlane(tid >> 6), lane = tid & 63, r32 = lane & 31, hi = lane >> 5;
  const int wq = wid & 3, mp = wid >> 2, mapB = mp * 128;
  constexpr int RING = 32768, NRING = 4;
  LAS char* ldsl = (LAS char*)lds;
  float* ws = (float*)(lds + NRING * RING) + wid * 64; float* li_l = ws; float* al_l = ws + 32;
  const bf16_t* Kh = proj + (size_t)kv0 * NPROJ + C_K + h * 128;
  const bf16_t* Vh = proj + (size_t)kv0 * NPROJ + C_V + h * 128;
  float m_reg = -1e30f, l_reg = 0; f32x16 o[4] = {}; bf16x8 qr[4];
  const bf16_t* Qw = proj + (size_t)(tok0 + wq * 32 + r32) * NPROJ + C_Q + h * 128 + mp * 64 + hi * 8;
#pragma unroll
  for (int d0 = 0; d0 < 4; ++d0) qr[d0] = *reinterpret_cast<const bf16x8*>(Qw + d0 * 16);
  int offK[2], offV[2];
#pragma unroll
  for (int i = 0; i < 2; ++i) {
    const int c = i * 512 + tid;
    { const int row = c >> 4, pc = c & 15, scn = pc ^ (row & 7); offK[i] = row * LDK + scn * 8; }
    { const int sub = c >> 5, kk = (sub >> 2) * 8 + ((c >> 2) & 7), col = (sub & 3) * 32 + (c & 3) * 8;
      const int k = kk; offV[i] = k * LDK + col; }
  }
  const int vbb = (int)(uintptr_t)ldsl + 16384 + v_rd_base(lane);
#define GLDS16(src, dst) __builtin_amdgcn_global_load_lds((const unsigned*)(src), (LAS unsigned*)(dst), 16, 0, 0)
#define DMA(t, b) do { const bf16_t* kg_ = Kh + (size_t)(t) * (KVBLK * LDK); const bf16_t* vg_ = Vh + (size_t)(t) * (KVBLK * LDK); LAS char* d_ = ldsl + (b) * RING + wid * 1024; \
    GLDS16(kg_ + offK[0], d_); GLDS16(kg_ + offK[1], d_ + 8192); GLDS16(vg_ + offV[0], d_ + 16384); GLDS16(vg_ + offV[1], d_ + 16384 + 8192); } while (0)
#define KBUF(b) ((const char*)lds + (b) * RING)
#define VBUF(b) (vbb + (b) * RING)
#define LANDED() do { asm volatile("s_waitcnt vmcnt(0)" ::: "memory"); __syncthreads(); } while (0)
#define RESC(a) do { if (SH && __any((a) < 1.f)) { if (hi == 0) al_l[r32] = (a); asm volatile("s_waitcnt lgkmcnt(0)" ::: "memory"); \
    _Pragma("unroll") for (int d = 0; d < 4; ++d) _Pragma("unroll") for (int r = 0; r < 16; ++r) o[d][r] *= al_l[crow(r, hi)]; } } while (0)
  f32x16 pA0, pA1, pB0, pB1; float mnA, mnB, alA, alB; bf16x8 pa0, pa1, pa2, pa3; const int NT = seq / KVBLK;
#define BLK_X(N0, N1, P0, P1, alP, t) do { SBAR(); __builtin_amdgcn_s_setprio(1); qkt(N0, N1, KBUF((t) & 3), qr, r32, hi, mapB); \
    if constexpr (!SH) v_frag_read<0>(vfa, VBUF(((t) - 1) & 3)); \
    finishSM<SH>(P0, P1, alP, l_reg, pa0, pa1, pa2, pa3); __builtin_amdgcn_s_setprio(0); SBAR(); } while (0)
#define BLK_Y(C0, C1, mnC, alC, t) do { if constexpr (SH) pv_d0(o, VBUF((t) & 3), pa0, pa1, pa2, pa3); else pv_d0_pipe<true>(o, VBUF((t) & 3), pa0, pa1, pa2, pa3, vfa); partialSM<SH>(C0, C1, m_reg, mnC, alC); RESC(alC); } while (0)
  const int ty = STAGGER_MAP ? mp : (wid & 1);
  VFrag vfa;
  DMA(0, 0); LANDED();
  DMA(1, 1);
  if (ty == 0) {
    qkt(pA0, pA1, KBUF(0), qr, r32, hi, mapB); partialSM<SH>(pA0, pA1, m_reg, mnA, alA);
    LANDED();
    for (int j = 1; j + 1 < NT; j += 2) {
      BLK_X(pB0, pB1, pA0, pA1, alA, j); DMA(j + 1, (j + 1) & 3); BLK_Y(pB0, pB1, mnB, alB, j - 1); LANDED();
      BLK_X(pA0, pA1, pB0, pB1, alB, j + 1); DMA(j + 2, (j + 2) & 3); BLK_Y(pA0, pA1, mnA, alA, j); LANDED();
    }
    BLK_X(pB0, pB1, pA0, pA1, alA, NT - 1); BLK_Y(pB0, pB1, mnB, alB, NT - 2);
    finishSM<SH>(pB0, pB1, alB, l_reg, pa0, pa1, pa2, pa3); SBAR();
    if constexpr (SH) pv_d0(o, VBUF((NT - 1) & 3), pa0, pa1, pa2, pa3); else pv_d0_pipe<false>(o, VBUF((NT - 1) & 3), pa0, pa1, pa2, pa3, vfa);
  } else {
    qkt(pA0, pA1, KBUF(0), qr, r32, hi, mapB);
    LANDED();
    DMA(2, 2); partialSM<SH>(pA0, pA1, m_reg, mnA, alA); BLK_X(pB0, pB1, pA0, pA1, alA, 1); LANDED();
    for (int j = 2; j + 2 < NT; j += 2) {
      DMA(j + 1, (j + 1) & 3); BLK_Y(pB0, pB1, mnB, alB, j - 2); BLK_X(pA0, pA1, pB0, pB1, alB, j); LANDED();
      DMA(j + 2, (j + 2) & 3); BLK_Y(pA0, pA1, mnA, alA, j - 1); BLK_X(pB0, pB1, pA0, pA1, alA, j + 1); LANDED();
    }
    DMA(NT - 1, (NT - 1) & 3); BLK_Y(pB0, pB1, mnB, alB, NT - 4); BLK_X(pA0, pA1, pB0, pB1, alB, NT - 2); LANDED();
    BLK_Y(pA0, pA1, mnA, alA, NT - 3); BLK_X(pB0, pB1, pA0, pA1, alA, NT - 1);
    BLK_Y(pB0, pB1, mnB, alB, NT - 2);
    finishSM<SH>(pB0, pB1, alB, l_reg, pa0, pa1, pa2, pa3); SBAR();
    if constexpr (SH) pv_d0(o, VBUF((NT - 1) & 3), pa0, pa1, pa2, pa3); else pv_d0_pipe<false>(o, VBUF((NT - 1) & 3), pa0, pa1, pa2, pa3, vfa);
  }
#undef BLK_X
#undef BLK_Y
  u32x4 zg[4];
  bf16_t* zp = proj + (size_t)(tok0 + (tid >> 2)) * NPROJ + C_ZA + h * 128 + (tid & 3) * 32;
#pragma unroll
  for (int i = 0; i < 4; ++i) zg[i] = *(const u32x4*)(zp + i * 8);
  l_reg += __shfl_xor(l_reg, 32);
  if (hi == 0) li_l[r32] = l_reg; asm volatile("s_waitcnt lgkmcnt(0)" ::: "memory");
  float rli[16];
#pragma unroll
  for (int r = 0; r < 16; ++r) rli[r] = __builtin_amdgcn_rcpf(li_l[crow(r, hi)]);
  __syncthreads();
  float* X = (float*)lds;
  if (mp == 1) {
#pragma unroll
    for (int d = 0; d < 4; ++d)
#pragma unroll
      for (int r = 0; r < 16; ++r) X[(wq * 64 + d * 16 + r) * 64 + lane] = o[d][r] * rli[r] * lam;
  }
  __syncthreads();
  if (mp == 0) {
#pragma unroll
    for (int d = 0; d < 4; ++d)
#pragma unroll
      for (int r = 0; r < 16; ++r) { const int ix = (wq * 64 + d * 16 + r) * 64 + lane; X[ix] = o[d][r] * rli[r] - X[ix]; }
  }
  __syncthreads();
  {
    const int row = tid >> 2, dq = tid & 3, rl = row & 31, w = row >> 5, hh = (rl >> 2) & 1, r = (rl & 3) + 4 * (rl >> 3);
    const float* xb = X + (w * 64 + dq * 16 + r) * 64 + hh * 32;
    f32x4 a[8]; float ss = 0.f;
#pragma unroll
    for (int i = 0; i < 8; ++i) { a[i] = *(const f32x4*)(xb + i * 4); ss += a[i][0] * a[i][0] + a[i][1] * a[i][1] + a[i][2] * a[i][2] + a[i][3] * a[i][3]; }
    ss += __shfl_xor(ss, 1); ss += __shfl_xor(ss, 2);
    const float rn = __builtin_amdgcn_rsqf(ss * (1.f / 128.f) + 1e-5f) * oscale;
    const float* gg = subg + dq * 32;
#pragma unroll
    for (int i = 0; i < 4; ++i) {
      const u32x4 z = zg[i];
      const f32x4 a0 = a[2 * i], a1 = a[2 * i + 1]; const f32x4 g0 = *(const f32x4*)(gg + i * 8), g1 = *(const f32x4*)(gg + i * 8 + 4);
      u32x4 wv;
      wv.x = cvtpk(a0[0] * rn * g0[0] * silu(bflo(z.x)), a0[1] * rn * g0[1] * silu(bfhi(z.x)));
      wv.y = cvtpk(a0[2] * rn * g0[2] * silu(bflo(z.y)), a0[3] * rn * g0[3] * silu(bfhi(z.y)));
      wv.z = cvtpk(a1[0] * rn * g1[0] * silu(bflo(z.z)), a1[1] * rn * g1[1] * silu(bfhi(z.z)));
      wv.w = cvtpk(a1[2] * rn * g1[2] * silu(bflo(z.w)), a1[3] * rn * g1[3] * silu(bfhi(z.w)));
      if (!dry) *(u32x4*)(zp + i * 8) = wv;
    }
  }
  __syncthreads();
#undef DMA
#undef GLDS16
#undef KBUF
#undef VBUF
#undef LANDED
#undef RESC
}

__device__ void attn_phase(const Params& p, int l, char* lds, bool dry = false) {
  const float lam = p.lam[l];
  const float oscale = 1.f - (0.8f - 0.6f * expf(-0.3f * (float)l));
  const float* subg = p.subln_g + l * 128;
  for (int u = blockIdx.x; u < 2048; u += gridDim.x) {
    int tok0, kv0, seq, h;
    if (u < 1024) { const int x = u & 7, j = u >> 3; const int b = x >> 2; h = x & 3; seq = S_P; kv0 = b * S_P; tok0 = kv0 + j * 128; }
    else { const int v = u - 1024, x = v & 7, j = v >> 3; const int pr = x * 4 + (j >> 5), b = pr >> 2; h = pr & 3; seq = S_S; kv0 = TP + b * S_S; tok0 = kv0 + (j & 31) * 128; }
    bool need;
    { const int tid = opaque_tid(), wid = tid >> 6, lane = tid & 63, r32 = lane & 31, hi = lane >> 5, wq = wid & 3, mp = wid >> 2;
      const int sq = tok0 < TP ? (tok0 >> 14) : 2 + ((tok0 - TP) >> 12);
      const float* km = p.kmax2 + ((l * 10 + sq) * 4 + h) * 4 + mp * 2;
      const float kmx = sqrtf(km[0] + km[1]) * 1.01f;
      const bf16_t* Qw = p.proj + (size_t)(tok0 + wq * 32 + r32) * NPROJ + C_Q + h * 128 + mp * 64 + hi * 8;
      float ss = 0.f;
#pragma unroll
      for (int d0 = 0; d0 < 4; ++d0) { const u32x4 w = *(const u32x4*)(Qw + d0 * 16);
        ss += bflo(w.x) * bflo(w.x) + bfhi(w.x) * bfhi(w.x) + bflo(w.y) * bflo(w.y) + bfhi(w.y) * bfhi(w.y) + bflo(w.z) * bflo(w.z) + bfhi(w.z) * bfhi(w.z) + bflo(w.w) * bflo(w.w) + bfhi(w.w) * bfhi(w.w); }
      ss += __shfl_xor(ss, 32);
      need = __any(!(sqrtf(ss) * kmx < 100.f)) != 0; }
    if (need) attn_unit<true>(p.proj, tok0, kv0, seq, h, lam, oscale, subg, lds, dry);
    else attn_unit<false>(p.proj, tok0, kv0, seq, h, lam, oscale, subg, lds, dry);
  }
}
}

__device__ void post_phase(const Params& p, int l) {
  const int tid = opaque_tid(), wid = tid >> 6, lane = tid & 63, nw = blockDim.x >> 6;
  const float* pg = p.post_g + l * DM;
  constexpr int R = 2;
  for (int row0 = (blockIdx.x * nw + wid) * R; row0 < T_TOK; row0 += gridDim.x * nw * R) {
    f32x4 y[R][4], x[R][4]; u32x2 xh[R][4], xl[R][4], yb[R][4];
#pragma unroll
    for (int q = 0; q < R; ++q) {
      const int row = row0 + q;
      const bf16_t* yr = p.proj + (size_t)row * NPROJ + C_U;
#pragma unroll
      for (int i = 0; i < 4; ++i) yb[q][i] = *(const u32x2*)(yr + i * 256 + lane * 4);
      if (l == 0) {
        const float* xr = row < TP ? p.xp + (size_t)row * DM : p.xs + (size_t)(row - TP) * DM;
#pragma unroll
        for (int i = 0; i < 4; ++i) x[q][i] = *(const f32x4*)(xr + i * 256 + lane * 4);
      } else {
        const bf16_t* xo = (const bf16_t*)p.out + (size_t)row * LDX;
#pragma unroll
        for (int i = 0; i < 4; ++i) { xh[q][i] = *(const u32x2*)(xo + i * 256 + lane * 4); xl[q][i] = *(const u32x2*)(xo + DM + i * 256 + lane * 4); }
      }
    }
#pragma unroll
    for (int q = 0; q < R; ++q) {
      const int row = row0 + q;
      bf16_t* xo = (bf16_t*)p.out + (size_t)row * LDX;
      float ss = 0.f;
#pragma unroll
      for (int i = 0; i < 4; ++i) { y[q][i] = (f32x4){bflo(yb[q][i].x), bfhi(yb[q][i].x), bflo(yb[q][i].y), bfhi(yb[q][i].y)};
        ss += y[q][i][0] * y[q][i][0] + y[q][i][1] * y[q][i][1] + y[q][i][2] * y[q][i][2] + y[q][i][3] * y[q][i][3]; }
      if (l != 0) {
#pragma unroll
        for (int i = 0; i < 4; ++i) {
          const u32x2 h = xh[q][i], lo = xl[q][i];
          x[q][i][0] = bflo(h.x) + bflo(lo.x); x[q][i][1] = bfhi(h.x) + bfhi(lo.x); x[q][i][2] = bflo(h.y) + bflo(lo.y); x[q][i][3] = bfhi(h.y) + bfhi(lo.y);
        }
      }
      ss = wave_sum(ss);
      const float ry = __builtin_amdgcn_rsqf(ss * (1.f / DM) + 1e-6f);
      float s2 = 0.f;
#pragma unroll
      for (int i = 0; i < 4; ++i) {
        const f32x4 g = *(const f32x4*)(pg + i * 256 + lane * 4);
#pragma unroll
        for (int e = 0; e < 4; ++e) { x[q][i][e] = x[q][i][e] + y[q][i][e] * ry * g[e]; s2 += x[q][i][e] * x[q][i][e]; }
      }
      if (l == DEPTH - 1) {
        float* orow = p.out + (size_t)row * DM;
#pragma unroll
        for (int i = 0; i < 4; ++i) *(f32x4*)(orow + i * 256 + lane * 4) = x[q][i];
      } else {
        s2 = wave_sum(s2);
        if (lane == 0) p.rinv[row] = __builtin_amdgcn_rsqf(s2 * (1.f / DM) + 1e-6f);
#pragma unroll
        for (int i = 0; i < 4; ++i) {
          const unsigned h0 = cvtpk(x[q][i][0], x[q][i][1]), h1 = cvtpk(x[q][i][2], x[q][i][3]);
          const unsigned l0 = cvtpk(x[q][i][0] - bflo(h0), x[q][i][1] - bfhi(h0)), l1 = cvtpk(x[q][i][2] - bflo(h1), x[q][i][3] - bfhi(h1));
          *(u32x2*)(xo + i * 256 + lane * 4) = (u32x2){h0, h1}; *(u32x2*)(xo + DM + i * 256 + lane * 4) = (u32x2){l0, l1};
        }
      }
    }
  }
}

#define XB_TMO      128
#define XB_XCNT(j)  (256  + 64 * (j))
#define XB_XSUB(j)  (1280 + 64 * (j))
#define XB_XGEN(j)  (2304 + 64 * (j))
#define XB_TOP      3328
#define XB_TOPGEN   3392
#define XB_SPIN_CAP (1u << 22)
#define XLAS __attribute__((address_space(3)))
__device__ __forceinline__ unsigned xb_ld(unsigned* p)              { return __hip_atomic_load(p, __ATOMIC_RELAXED, __HIP_MEMORY_SCOPE_AGENT); }
__device__ __forceinline__ unsigned xb_add(unsigned* p, unsigned v) { return __hip_atomic_fetch_add(p, v, __ATOMIC_RELAXED, __HIP_MEMORY_SCOPE_AGENT); }
__device__ __forceinline__ unsigned xb_xcc_id() { return (unsigned)__builtin_amdgcn_s_getreg((3 << 11) | 20) & 0xFu; }
#define XB_SPIN(cond, bar) do { unsigned _sp = 0; while (cond) { __builtin_amdgcn_s_sleep(1); \
    if ((++_sp & 255u) == 0u) { if (xb_ld(&(bar)[XB_TMO])) break; if (_sp > XB_SPIN_CAP) { atomicAdd(&(bar)[XB_TMO], 1u); break; } } } } while (0)
struct XcdBarrier { unsigned* bar; unsigned x; volatile XLAS unsigned* st; };
__device__ __forceinline__ XcdBarrier xcd_barrier_post(unsigned* bar, volatile XLAS unsigned* st) {
  XcdBarrier b; b.bar = bar; b.x = xb_xcc_id(); b.st = st;
  if (threadIdx.x == 0) (void)xb_add(&bar[XB_XCNT(b.x)], 1u);
  return b;
}
__device__ __forceinline__ void xcd_barrier_complete(unsigned* bar, unsigned x, unsigned& nloc, unsigned& nx) {
  const unsigned G = gridDim.x * gridDim.y * gridDim.z;
  unsigned sum, cnt, mine, sp = 0u;
  for (;;) {
    sum = 0u; cnt = 0u; mine = 0u;
#pragma unroll
    for (unsigned j = 0; j < 16; ++j) { const unsigned c = xb_ld(&bar[XB_XCNT(j)]); sum += c; cnt += (c > 0u) ? 1u : 0u; mine = (j == x) ? c : mine; }
    if (sum == G) break;
    __builtin_amdgcn_s_sleep(1);
    if ((++sp & 255u) == 0u) { if (xb_ld(&bar[XB_TMO])) break; if (sp > XB_SPIN_CAP) { atomicAdd(&bar[XB_TMO], 1u); break; } }
  }
  nloc = mine > 0u ? mine : 1u; nx = cnt > 0u ? cnt : 1u;
}
__device__ __forceinline__ void xcd_barrier(const XcdBarrier& b) {
  asm volatile("s_waitcnt vmcnt(0)" ::: "memory");
  __syncthreads();
  if (threadIdx.x == 0) {
    unsigned* bar = b.bar;
    __builtin_amdgcn_s_waitcnt(0);
    unsigned nloc = b.st[0], nx = b.st[1];
    if (nloc == 0u) { xcd_barrier_complete(bar, b.x, nloc, nx); b.st[0] = nloc; b.st[1] = nx; }
    const unsigned old = xb_add(&bar[XB_XSUB(b.x)], 1u);
    const unsigned gen = old / nloc;
    if (old + 1u == (gen + 1u) * nloc) {
      __builtin_amdgcn_fence(__ATOMIC_RELEASE, "agent");
      asm volatile("s_waitcnt vmcnt(0)" ::: "memory");
      const unsigned og = xb_add(&bar[XB_TOP], 1u);
      const unsigned tg = og / nx;
      if (og + 1u == (tg + 1u) * nx) xb_add(&bar[XB_TOPGEN], 1u);
      else XB_SPIN(xb_ld(&bar[XB_TOPGEN]) == tg, bar);
      __builtin_amdgcn_fence(__ATOMIC_ACQUIRE, "agent");
      xb_add(&bar[XB_XGEN(b.x)], 1u);
      asm volatile("s_waitcnt vmcnt(0)" ::: "memory");
    } else {
      XB_SPIN(xb_ld(&bar[XB_XGEN(b.x)]) == gen, bar);
      __builtin_amdgcn_fence(__ATOMIC_ACQUIRE, "agent");
      asm volatile("s_waitcnt vmcnt(0)" ::: "memory");
    }
  }
  __syncthreads();
}

__device__ __forceinline__ void run_phase(const Params& p, int ph, char* shm) {
  if (ph == 0) { phase0(p, shm); return; }
  const int l = (ph - 1) >> 2, s = (ph - 1) & 3;
  if (s == 0) { gm::EpiIn e{p.rinv, p.rope, p.proj, p.kmax2 + l * 160}; gm::gemm_phase(( const bf16_t*)p.out, LDX, p.WinT + (size_t)l * NPROJ * DM, NPROJ, e, shm); }
  else if (s == 1) { pool_phase(p, l); at::attn_phase(p, l, shm); }
  else if (s == 2) { gm::EpiOut e{p.proj}; gm::gemm_phase(p.proj, NPROJ, p.WoutT + (size_t)l * DM * DM, DM, e, shm); }
  else post_phase(p, l);
}

#if MK_MULTI
template <int S> __global__ void __launch_bounds__(NT_THREADS, 1) k_phase(Params p, int l) {
  extern __shared__ __attribute__((aligned(16))) char shm[];
  if (S == 0) phase0(p, shm); else run_phase(p, 1 + 4 * l + (S - 1), shm);
}
#else
__global__ void __launch_bounds__(NT_THREADS, 1) k_mega(Params p) {
  extern __shared__ __attribute__((aligned(16))) char shm[];
  cg::grid_group grid = cg::this_grid();
  volatile XLAS unsigned* xst = (volatile XLAS unsigned*)(XLAS char*)(shm + 131072 + 3072);
  if (threadIdx.x == 0) { xst[0] = 0u; xst[1] = 0u; xst[2] = 0u; xst[3] = 0u; }
  phase0(p, shm);
  grid.sync();
  (void)xcd_barrier_post(p.bar, xst);
#define GSYNC() do { XcdBarrier xb_; xb_.bar = p.bar; xb_.x = xb_xcc_id(); xb_.st = xst; xcd_barrier(xb_); } while (0)
  for (int l = 0; l < DEPTH; ++l) {
#if REP_GEMM
    { gm::EpiIn e{p.rinv, p.rope, p.proj, p.kmax2 + l * 160}; gm::gemm_phase((const bf16_t*)p.out, LDX, p.WinT + (size_t)l * NPROJ * DM, NPROJ, e, shm); }
    GSYNC();
#endif
    { gm::EpiIn e{p.rinv, p.rope, p.proj, p.kmax2 + l * 160}; gm::gemm_phase((const bf16_t*)p.out, LDX, p.WinT + (size_t)l * NPROJ * DM, NPROJ, e, shm); }
    GSYNC();
    pool_phase(p, l);
#if REP_ATT
    at::attn_phase(p, l, shm, true); GSYNC();
#endif
    at::attn_phase(p, l, shm);
    GSYNC();
#if REP_GEMM
    { gm::EpiOut e{p.proj}; gm::gemm_phase(p.proj, NPROJ, p.WoutT + (size_t)l * DM * DM, DM, e, shm); }
    GSYNC();
#endif
    { gm::EpiOut e{p.proj}; gm::gemm_phase(p.proj, NPROJ, p.WoutT + (size_t)l * DM * DM, DM, e, shm); }
    GSYNC();
#if REP_POST
    if (l == 0) { post_phase(p, l); GSYNC(); }
#endif
    post_phase(p, l);
    if (l + 1 < DEPTH) GSYNC();
  }
}
#endif

extern "C" void kernel_launch(void* const* d_in, const int* in_sizes, int n_in, void* d_out, int out_size, void* d_ws, size_t ws_size, hipStream_t stream) {
  Params p{};
  p.xp = (const float*)d_in[0]; p.xs = (const float*)d_in[1]; p.pre_g = (const float*)d_in[2]; p.w_in = (const float*)d_in[3];
  p.pool_w = (const float*)d_in[4]; p.pool_scale = (const float*)d_in[5]; p.lq1 = (const float*)d_in[6]; p.lk1 = (const float*)d_in[7];
  p.lq2 = (const float*)d_in[8]; p.lk2 = (const float*)d_in[9]; p.subln_g = (const float*)d_in[10]; p.w_out = (const float*)d_in[11]; p.post_g = (const float*)d_in[12];
  p.out = (float*)d_out;
  char* w = (char*)d_ws; size_t off = 0;
  p.proj = (bf16_t*)(w + off); off += (size_t)T_TOK * NPROJ * 2;
  p.WinT = (bf16_t*)(w + off); off += (size_t)DEPTH * NPROJ * DM * 2;
  p.WoutT = (bf16_t*)(w + off); off += (size_t)DEPTH * DM * DM * 2;
  p.rinv = (float*)(w + off); off += (size_t)T_TOK * 4;
  p.rope = (float*)(w + off); off += 256;
  p.lam = (float*)(w + off); off += 256;
  p.kmax2 = (float*)(w + off); off += 2048;
  p.bar = (unsigned*)(w + off); off += 16384;
  if (off > ws_size) { fprintf(stderr, "kernel_launch: workspace too small (%zu > %zu)\n", off, ws_size); return; }
#if MK_MULTI
  static int ok = 0;
  if (!ok) {
    (void)hipFuncSetAttribute((const void*)k_phase<0>, hipFuncAttributeMaxDynamicSharedMemorySize, (int)SHM_BYTES);
    (void)hipFuncSetAttribute((const void*)k_phase<1>, hipFuncAttributeMaxDynamicSharedMemorySize, (int)SHM_BYTES);
    (void)hipFuncSetAttribute((const void*)k_phase<2>, hipFuncAttributeMaxDynamicSharedMemorySize, (int)SHM_BYTES);
    (void)hipFuncSetAttribute((const void*)k_phase<3>, hipFuncAttributeMaxDynamicSharedMemorySize, (int)SHM_BYTES);
    (void)hipFuncSetAttribute((const void*)k_phase<4>, hipFuncAttributeMaxDynamicSharedMemorySize, (int)SHM_BYTES);
    ok = 1; }
  hipLaunchKernelGGL(k_phase<0>, dim3(256), dim3(NT_THREADS), SHM_BYTES, stream, p, 0);
  for (int l = 0; l < DEPTH; ++l) {
    hipLaunchKernelGGL(k_phase<1>, dim3(256), dim3(NT_THREADS), SHM_BYTES, stream, p, l);
    hipLaunchKernelGGL(k_phase<2>, dim3(256), dim3(NT_THREADS), SHM_BYTES, stream, p, l);
    hipLaunchKernelGGL(k_phase<3>, dim3(256), dim3(NT_THREADS), SHM_BYTES, stream, p, l);
    hipLaunchKernelGGL(k_phase<4>, dim3(256), dim3(NT_THREADS), SHM_BYTES, stream, p, l);
  }
#else
  static int grid_blocks = 0;
  if (!grid_blocks) {
    (void)hipFuncSetAttribute((const void*)k_mega, hipFuncAttributeMaxDynamicSharedMemorySize, (int)SHM_BYTES);
    int dev = 0, cus = 0, per_cu = 0;
    (void)hipGetDevice(&dev);
    (void)hipDeviceGetAttribute(&cus, hipDeviceAttributeMultiprocessorCount, dev);
    (void)hipOccupancyMaxActiveBlocksPerMultiprocessor(&per_cu, k_mega, NT_THREADS, SHM_BYTES);
    if (per_cu > 1) per_cu = 1;
    grid_blocks = cus * per_cu;
  }
  void* args[] = {&p};
  hipError_t e = hipLaunchCooperativeKernel((void*)k_mega, dim3(grid_blocks), dim3(NT_THREADS), args, SHM_BYTES, stream);
  if (e != hipSuccess) fprintf(stderr, "cooperative launch failed: %s (grid %d)\n", hipGetErrorString(e), grid_blocks);
#endif
}
```

```cpp
#include <hip/hip_runtime.h>
#include <hip/hip_cooperative_groups.h>
#include <cstdio>
#include <cstdint>
namespace cg = cooperative_groups;

#ifndef REP_ATT
#define REP_ATT 0
#endif
#ifndef STAGGER_MAP
#define STAGGER_MAP 1
#endif
#ifndef REP_POST
#define REP_POST 0
#endif
#ifndef REP_GEMM
#define REP_GEMM 0
#endif
#ifndef MK_MULTI
#define MK_MULTI 0
#endif

typedef unsigned short bf16_t;
using bf16x8 = __attribute__((ext_vector_type(8))) short;
using s16x4  = __attribute__((ext_vector_type(4))) short;
using f32x16 = __attribute__((ext_vector_type(16))) float;
using f32x4  = __attribute__((ext_vector_type(4))) float;
using u32x4  = __attribute__((ext_vector_type(4))) unsigned;
using u32x2  = __attribute__((ext_vector_type(2))) unsigned;

#define XCD_BAR_WORDS 3456
constexpr int NT_THREADS = 512;
constexpr int T_TOK = 65536, TP = 32768, DM = 1024, NPROJ = 3072, DEPTH = 2;
constexpr int S_P = 16384, S_S = 4096;
constexpr int C_ZP = 0, C_ZA = 512, C_U = 1024, C_Q = 1536, C_K = 2048, C_V = 2560;
constexpr int LDX = 2048;
constexpr float QSCALE = 0.125f * 1.4426950408889634f;
constexpr size_t SHM_BYTES = 131072 + 4096;

struct Params {
  const float* xp; const float* xs; const float* pre_g; const float* w_in; const float* pool_w; const float* pool_scale;
  const float* lq1; const float* lk1; const float* lq2; const float* lk2; const float* subln_g; const float* w_out; const float* post_g;
  float* out; bf16_t* WinT; bf16_t* WoutT; bf16_t* proj; float* rinv; float* rope; float* lam; float* kmax2; unsigned* bar;
};

#define SBAR() __builtin_amdgcn_sched_barrier(0)
__device__ __forceinline__ unsigned cvtpk(float lo, float hi) {
  unsigned r; asm volatile("v_cvt_pk_bf16_f32 %0, %1, %2" : "=v"(r) : "v"(lo), "v"(hi)); return r;
}
typedef __bf16 bf16x2_t __attribute__((ext_vector_type(2)));
typedef float f32x2_t __attribute__((ext_vector_type(2)));
__device__ __forceinline__ unsigned cvtpk_b(float lo, float hi) { const f32x2_t v = {lo, hi}; const bf16x2_t b = __builtin_convertvector(v, bf16x2_t); return *reinterpret_cast<const unsigned*>(&b); }
__device__ __forceinline__ float bf2f(unsigned short b) { return __uint_as_float(((unsigned)b) << 16); }
__device__ __forceinline__ float bflo(unsigned w) { return __uint_as_float(w << 16); }
__device__ __forceinline__ float bfhi(unsigned w) { return __uint_as_float(w & 0xffff0000u); }
__device__ __forceinline__ bf16_t f2bf(float f) { return (bf16_t)(cvtpk(f, 0.f) & 0xffffu); }
__host__ __device__ __forceinline__ int perm32(int rho) { const int n = rho >> 4, i = rho & 15; return 8 * (i >> 2) + 4 * n + (i & 3); }
__device__ __forceinline__ float silu(float z) { return z * __builtin_amdgcn_rcpf(1.f + __builtin_amdgcn_exp2f(-1.4426950408889634f * z)); }
__device__ __forceinline__ int opaque_tid() { int t = threadIdx.x; asm volatile("" : "+v"(t)); return t; }
__device__ __forceinline__ float wave_sum(float v) {
#pragma unroll
  for (int o = 32; o >= 1; o >>= 1) v += __shfl_xor(v, o);
  return v;
}

__device__ __forceinline__ int src_col_in(int s) {
  const int type = s >> 9, within = s & 511;
  if (type == 0) return 512 + within;
  if (type == 1) return 2560 + within;
  if (type == 5) return 2048 + within;
  const int p = within & 63, wcl = p >> 5, fq = (p >> 3) & 3, n = (p >> 2) & 1, jj = p & 3;
  const int d = wcl * 16 + fq * 4 + jj + 32 * n;
  return (type == 3 ? 1024 : 1536) + (within & ~63) + d;
}

__device__ void phase0(const Params& p, char* shm) {
  const int tid = opaque_tid(), nth = blockDim.x;
  float* tile = (float*)shm;
  float* Wt = tile + 64 * 65 + 32;
  float* Pw = Wt + 64 * 128;
  constexpr int NT_U = DEPTH * 8 * 16, NT_IN = DEPTH * 40 * 16, NT_OUT = DEPTH * 16 * 16;
  for (int it = blockIdx.x; it < NT_U + NT_IN + NT_OUT; it += gridDim.x) {
    __syncthreads();
    if (it < NT_U + NT_IN) {
      int l, n0, k0; const bool isu = it < NT_U;
      if (isu) { l = it / 128; const int r = it % 128; n0 = C_U + (r / 16) * 64; k0 = (r % 16) * 64; }
      else { const int i2 = it - NT_U; l = i2 / 640; const int r = i2 % 640; int nt = r / 16; if (nt >= 16) nt += 8; n0 = nt * 64; k0 = (r % 16) * 64; }
      const float* W = p.w_in + (size_t)l * DM * NPROJ; const float* g = p.pre_g + l * DM;
      if (isu) {
        const int gi = (n0 - C_U) >> 7, d0 = (n0 - C_U) & 127;
        for (int e = tid; e < 64 * 128; e += nth) { const int c = e & 127, kk = e >> 7; Wt[e] = W[(size_t)(k0 + kk) * NPROJ + gi * 128 + c]; }
        for (int e = tid; e < 128 * 64; e += nth) { const int d = e & 63, c = e >> 6; Pw[e] = p.pool_w[((size_t)(l * 4 + gi) * 128 + c) * 128 + d0 + d]; }
        __syncthreads();
        for (int e = tid; e < 4096; e += nth) {
          const int nn = e & 63, kk = e >> 6, nrow = n0 + nn; const int s = (nrow & ~31) + perm32(nrow & 31), dl = s - n0;
          float a = 0.f;
#pragma unroll 8
          for (int c = 0; c < 128; ++c) a = fmaf(Wt[kk * 128 + c], Pw[c * 64 + dl], a);
          tile[kk * 65 + nn] = a * g[k0 + kk];
        }
      } else {
        for (int e = tid; e < 4096; e += nth) {
          const int nn = e & 63, kk = e >> 6, k = k0 + kk, nrow = n0 + nn;
          const int s = (nrow & ~31) + perm32(nrow & 31);
          tile[kk * 65 + nn] = W[(size_t)k * NPROJ + src_col_in(s)] * g[k];
        }
      }
      __syncthreads();
      bf16_t* O = p.WinT + (size_t)l * NPROJ * DM;
      for (int e = tid; e < 4096; e += nth) { const int kk = e & 63, nn = e >> 6; O[(size_t)(n0 + nn) * DM + k0 + kk] = f2bf(tile[kk * 65 + nn]); }
    } else {
      const int it2 = it - NT_U - NT_IN, l = it2 / 256, r = it2 % 256, n0 = (r / 16) * 64, k0 = (r % 16) * 64;
      const float* W = p.w_out + (size_t)l * DM * DM;
      for (int e = tid; e < 4096; e += nth) {
        const int nn = e & 63, kk = e >> 6, nrow = n0 + nn; const int s = (nrow & ~31) + perm32(nrow & 31);
        tile[kk * 65 + nn] = W[(size_t)(k0 + kk) * DM + s];
      }
      __syncthreads();
      bf16_t* O = p.WoutT + (size_t)l * DM * DM;
      for (int e = tid; e < 4096; e += nth) { const int kk = e & 63, nn = e >> 6; O[(size_t)(n0 + nn) * DM + k0 + kk] = f2bf(tile[kk * 65 + nn]); }
    }
  }
  if (blockIdx.x == 0) {
    for (int i = tid; i < XCD_BAR_WORDS; i += nth) p.bar[i] = 0u;
    if (tid < DEPTH * 160) p.kmax2[tid] = 0.f;
    if (tid < 32) { const double c = exp(-(double)tid * (9.210340371976184 / 32.0)) * 0.15915494309189535; const float h = (float)c; p.rope[2 * tid] = h; p.rope[2 * tid + 1] = (float)(c - (double)h); }
    if (tid >= 64 && tid < 64 + 64 * DEPTH) {
      const int l = (tid >> 6) - 1, i = tid & 63;
      float a = p.lq1[l * 64 + i] * p.lk1[l * 64 + i], b = p.lq2[l * 64 + i] * p.lk2[l * 64 + i];
      a = wave_sum(a); b = wave_sum(b);
      const float li = 0.8f - 0.6f * expf(-0.3f * (float)l);
      if (i == 0) p.lam[l] = expf(a) - expf(b) + li;
    }
  }
  const int wid = tid >> 6, lane = tid & 63, nw = nth >> 6;
  for (int row0 = (blockIdx.x * nw + wid) * 2; row0 < T_TOK; row0 += gridDim.x * nw * 2) {
    f32x4 v[2][4];
#pragma unroll
    for (int q = 0; q < 2; ++q) {
      const int row = row0 + q;
      const float* xr = row < TP ? p.xp + (size_t)row * DM : p.xs + (size_t)(row - TP) * DM;
#pragma unroll
      for (int i = 0; i < 4; ++i) v[q][i] = __builtin_nontemporal_load((const f32x4*)(xr + i * 256 + lane * 4));
    }
#pragma unroll
    for (int q = 0; q < 2; ++q) {
      const int row = row0 + q;
      bf16_t* xo = (bf16_t*)p.out + (size_t)row * LDX;
      float ss = 0.f;
#pragma unroll
      for (int i = 0; i < 4; ++i) {
        ss += v[q][i][0] * v[q][i][0] + v[q][i][1] * v[q][i][1] + v[q][i][2] * v[q][i][2] + v[q][i][3] * v[q][i][3];
        u32x2 w = {cvtpk(v[q][i][0], v[q][i][1]), cvtpk(v[q][i][2], v[q][i][3])};
        *(u32x2*)(xo + i * 256 + lane * 4) = w;
      }
      ss = wave_sum(ss);
      if (lane == 0) p.rinv[row] = __builtin_amdgcn_rsqf(ss * (1.f / DM) + 1e-6f);
    }
  }
}

namespace gm {
constexpr int BM = 256, BK = 64, HALF = 128, NXCD = 8, WGM = 8, HT = HALF * BK;
__device__ __forceinline__ int lds_byte(int r, int c) { int st = (r >> 4) * 2 + (c >> 5), rr = r & 15, cc = c & 31, ob = rr * 64 + cc * 2; return st * 1024 + (ob ^ (((ob >> 9) & 1) << 5)); }
__device__ __forceinline__ void stage_rc(int b, int& R, int& C) { int st = b / 1024, sb = b % 1024, swz = sb ^ (((sb >> 9) & 1) << 5); R = (st >> 1) * 16 + swz / 64; C = (st & 1) * 32 + (swz % 64) / 2; }

#define LAS __attribute__((address_space(3)))
template <class Epi>
__device__ __forceinline__ void gemm_phase(const bf16_t* __restrict__ A, const int lda, const bf16_t* __restrict__ Bt, const int N, const Epi& E, char* shmc) {
  constexpr int K = 1024, nt = K / BK, HTB = HALF * BK * 2;
  LAS unsigned char* lds = (LAS unsigned char*)shmc;
  const int tid = opaque_tid(), wid = __builtin_amdgcn_readfirstlane(tid >> 6), lane = tid & 63, wr = wid >> 2, wc = wid & 3, fr = lane & 15, fq = lane >> 4;
  unsigned voffA[2], voffB[2];
#pragma unroll
  for (int i = 0; i < 2; ++i) { int R, C; stage_rc(tid * 16 + i * 8192, R, C); voffA[i] = (unsigned)(R * lda + C) * 2u; voffB[i] = (unsigned)(R * K + C) * 2u; }
  const size_t kstep = (size_t)(BK * 2);
  const size_t hstepA = (size_t)HALF * lda * 2, hstepB = (size_t)HALF * K * 2;
  const size_t tstepA = 2 * hstepA, tstepB = 2 * hstepB;
  const unsigned ldsw = (unsigned)wid * 1024u;
  const int aoff = lds_byte(wr * 64 + fr, fq * 8), boff = lds_byte(wc * 32 + fr, fq * 8);
#define PG8_SA(b, h) (((b) * 2 + (h)) * HTB)
#define PG8_SB(b, h) ((4 + (b) * 2 + (h)) * HTB)
#define PG8_STAGE(bufoff, gbase, voff) do { _Pragma("unroll") for (int _i = 0; _i < 2; ++_i) \
        __builtin_amdgcn_global_load_lds((const unsigned*)((const char*)(gbase) + (voff)[_i]), (LAS unsigned*)(lds + (bufoff) + ldsw + _i * 8192), 16, 0, 0); } while (0)
#define PG8_LDA(dst, b, h) do { _Pragma("unroll") for (int m = 0; m < 4; ++m) _Pragma("unroll") for (int k = 0; k < 2; ++k) dst[m][k] = *(const LAS bf16x8*)(lds + PG8_SA(b, h) + aoff + m * 2048 + k * 1024); } while (0)
#define PG8_LDB(dst, b, h) do { _Pragma("unroll") for (int n = 0; n < 2; ++n) _Pragma("unroll") for (int k = 0; k < 2; ++k) dst[n][k] = *(const LAS bf16x8*)(lds + PG8_SB(b, h) + boff + n * 2048 + k * 1024); } while (0)
#define PG8_MMA(ai, bj, At, Bx) do { __builtin_amdgcn_s_setprio(1); _Pragma("unroll") for (int m = 0; m < 4; ++m) _Pragma("unroll") for (int n = 0; n < 2; ++n) _Pragma("unroll") for (int k = 0; k < 2; ++k) \
        acc[ai][bj][m][n] = __builtin_amdgcn_mfma_f32_16x16x32_bf16(Bx[n][k], At[m][k], acc[ai][bj][m][n], 0, 0, 0); __builtin_amdgcn_s_setprio(0); } while (0)
#define PG8_WAIT_V(n) asm volatile("s_waitcnt vmcnt(" #n ")" ::: "memory")
#define PG8_WAIT_L(n) asm volatile("s_waitcnt lgkmcnt(" #n ")" ::: "memory")
#define PG8_BAR __builtin_amdgcn_s_barrier()
#define PG8_SCHED __builtin_amdgcn_sched_barrier(0)
  const int nM = T_TOK / BM, nN = N / BM, nwg = nM * nN, G = gridDim.x, cblk = blockIdx.x;
  auto next_unit = [&](int i, int& pm, int& pn) -> bool {
    const long L = (long)i * G + cblk; if (L >= nwg) return false;
    int wgid = (int)L; { const int q = nwg / NXCD, r = nwg % NXCD, xcd = wgid % NXCD, off = wgid / NXCD; wgid = (xcd < r ? xcd * (q + 1) : r * (q + 1) + (xcd - r) * q) + off; }
    const int nig = WGM * nN, gid = wgid / nig, fm = gid * WGM, gsz = (nM - fm) < WGM ? (nM - fm) : WGM;
    pm = fm + ((wgid % nig) % gsz); pn = (wgid % nig) / gsz; return true;
  };
  int cpm, cpn, npm = 0, npn = 0, ui = 0;
  if (!next_unit(0, cpm, cpn)) return;
  f32x4 acc[2][2][4][2];
#pragma unroll
  for (int a = 0; a < 2; ++a)
#pragma unroll
    for (int b = 0; b < 2; ++b)
#pragma unroll
      for (int m = 0; m < 4; ++m)
#pragma unroll
        for (int n = 0; n < 2; ++n) acc[a][b][m][n] = (f32x4){0.f, 0.f, 0.f, 0.f};
  bf16x8 At[4][2], B0[2][2], B1[2][2];
  const char* cA = (const char*)A + (size_t)cpm * tstepA; const char* cB = (const char*)Bt + (size_t)cpn * tstepB;
  PG8_STAGE(PG8_SB(0, 0), cB, voffB); PG8_STAGE(PG8_SB(0, 1), cB + hstepB, voffB); PG8_STAGE(PG8_SA(0, 0), cA, voffA); PG8_STAGE(PG8_SA(0, 1), cA + hstepA, voffA);
  if (wr == 1) PG8_BAR;
  PG8_WAIT_V(2); PG8_BAR;
  PG8_STAGE(PG8_SB(1, 0), cB + kstep, voffB); PG8_STAGE(PG8_SA(1, 0), cA + kstep, voffA); PG8_STAGE(PG8_SB(1, 1), cB + hstepB + kstep, voffB);
  PG8_WAIT_V(6); PG8_BAR;
  for (;;) {
    const bool has_next = next_unit(ui + 1, npm, npn);
    const char* nA = has_next ? (const char*)A + (size_t)npm * tstepA : cA; const char* nB = has_next ? (const char*)Bt + (size_t)npn * tstepB : cB;
    for (int t = 0; t < nt; t += 2) {
      const bool last = (t == nt - 2);
      const char* a1 = cA + (size_t)(t + 1) * kstep;
      const char* a2 = last ? nA : cA + (size_t)(t + 2) * kstep; const char* b2 = last ? nB : cB + (size_t)(t + 2) * kstep;
      const char* a3 = a2 + kstep; const char* b3 = b2 + kstep;
      PG8_LDB(B0, 0, 0); PG8_LDB(B1, 0, 1); PG8_SCHED; PG8_LDA(At, 0, 0); PG8_STAGE(PG8_SA(1, 1), a1 + hstepA, voffA);
      PG8_WAIT_V(8); PG8_WAIT_L(0); PG8_BAR; PG8_MMA(0, 0, At, B0); PG8_MMA(0, 1, At, B1); PG8_BAR; PG8_SCHED;
      PG8_LDA(At, 0, 1); PG8_STAGE(PG8_SB(0, 0), b2, voffB); PG8_STAGE(PG8_SB(0, 1), b2 + hstepB, voffB); PG8_STAGE(PG8_SA(0, 0), a2, voffA);
      PG8_WAIT_V(8); PG8_WAIT_L(0); PG8_BAR; PG8_MMA(1, 0, At, B0); PG8_MMA(1, 1, At, B1); PG8_BAR; PG8_SCHED;
      PG8_LDB(B0, 1, 0); PG8_LDB(B1, 1, 1); PG8_SCHED; PG8_LDA(At, 1, 0); PG8_STAGE(PG8_SA(0, 1), a2 + hstepA, voffA);
      PG8_WAIT_V(8); PG8_WAIT_L(0); PG8_BAR; PG8_MMA(0, 0, At, B0); PG8_MMA(0, 1, At, B1); PG8_BAR; PG8_SCHED;
      PG8_LDA(At, 1, 1); PG8_STAGE(PG8_SB(1, 0), b3, voffB); PG8_STAGE(PG8_SB(1, 1), b3 + hstepB, voffB); PG8_STAGE(PG8_SA(1, 0), a3, voffA);
      PG8_WAIT_V(8); PG8_WAIT_L(0); PG8_BAR; PG8_MMA(1, 0, At, B0); PG8_MMA(1, 1, At, B1); PG8_BAR; PG8_SCHED;
    }
    if (wr == 0) PG8_BAR;
    E(acc, cpm, cpn, wr, wc, fr, fq);
    if (!has_next) break;
#pragma unroll
    for (int a = 0; a < 2; ++a)
#pragma unroll
      for (int b = 0; b < 2; ++b)
#pragma unroll
        for (int m = 0; m < 4; ++m)
#pragma unroll
          for (int n = 0; n < 2; ++n) acc[a][b][m][n] = (f32x4){0.f, 0.f, 0.f, 0.f};
    cpm = npm; cpn = npn; cA = nA; cB = nB; ++ui;
    if (wr == 1) PG8_BAR;
  }
  PG8_WAIT_V(0);
  PG8_BAR;
#undef PG8_SA
#undef PG8_SB
#undef PG8_STAGE
#undef PG8_LDA
#undef PG8_LDB
#undef PG8_MMA
}

struct EpiIn {
  const float* rinv; const float* rope; bf16_t* proj; float* kmax2;
  __device__ __forceinline__ void operator()(const f32x4 (&acc)[2][2][4][2], int pm, int pn, int wr, int wc, int fr, int fq) const {
    const bool isrope = (pn >= 6 && pn <= 9); const float qs = (pn == 6 || pn == 7) ? QSCALE : 1.f;
    const bool isk = (pn == 8 || pn == 9);
    float kmx[2] = {0.f, 0.f};
    float ch[4], cl[4];
    if (isrope) {
#pragma unroll
      for (int jj = 0; jj < 4; ++jj) { const int i = (wc & 1) * 16 + fq * 4 + jj; ch[jj] = rope[2 * i]; cl[jj] = rope[2 * i + 1]; }
    }
    float riv[2][4];
#pragma unroll
    for (int ai = 0; ai < 2; ++ai)
#pragma unroll
      for (int m = 0; m < 4; ++m) riv[ai][m] = rinv[pm * BM + ai * HALF + wr * 64 + m * 16 + fr];
#pragma unroll
    for (int ai = 0; ai < 2; ++ai)
#pragma unroll
      for (int m = 0; m < 4; ++m) {
        const int row = pm * BM + ai * HALF + wr * 64 + m * 16 + fr;
        const float ri = riv[ai][m];
        float cs[4], sn[4];
        if (isrope) {
          const float pos = (float)(row < TP ? (row & (S_P - 1)) : (row & (S_S - 1)));
#pragma unroll
          for (int jj = 0; jj < 4; ++jj) {
            const float h = pos * ch[jj], e = fmaf(pos, ch[jj], -h) + pos * cl[jj];
            const float rev = (h - floorf(h)) + e;
            sn[jj] = __builtin_amdgcn_sinf(rev); cs[jj] = __builtin_amdgcn_cosf(rev);
          }
        }
        bf16_t* rowp = proj + (size_t)row * NPROJ + pn * BM + wc * 32 + 8 * fq;
#pragma unroll
        for (int bj = 0; bj < 2; ++bj) {
          f32x4 v0 = acc[ai][bj][m][0] * ri, v1 = acc[ai][bj][m][1] * ri;
          if (isrope) {
#pragma unroll
            for (int jj = 0; jj < 4; ++jj) { const float a = v0[jj], b = v1[jj]; v0[jj] = (a * cs[jj] - b * sn[jj]) * qs; v1[jj] = (b * cs[jj] + a * sn[jj]) * qs; }
          }
          u32x4 w; w.x = cvtpk(v0[0], v0[1]); w.y = cvtpk(v0[2], v0[3]); w.z = cvtpk(v1[0], v1[1]); w.w = cvtpk(v1[2], v1[3]);
          *(u32x4*)(rowp + bj * HALF) = w;
          if (isk) { float ss = v0[0] * v0[0] + v0[1] * v0[1] + v0[2] * v0[2] + v0[3] * v0[3] + v1[0] * v1[0] + v1[1] * v1[1] + v1[2] * v1[2] + v1[3] * v1[3];
            ss += __shfl_xor(ss, 16); ss += __shfl_xor(ss, 32); kmx[bj] = fmaxf(kmx[bj], ss); }
        }
      }
    if (isk) {
      const int row0 = pm * BM, sq = row0 < TP ? (row0 >> 14) : 2 + ((row0 - TP) >> 12);
#pragma unroll
      for (int bj = 0; bj < 2; ++bj) { float v = kmx[bj];
        v = fmaxf(v, __shfl_xor(v, 1)); v = fmaxf(v, __shfl_xor(v, 2)); v = fmaxf(v, __shfl_xor(v, 4)); v = fmaxf(v, __shfl_xor(v, 8));
        if ((fr | fq) == 0) atomicMax((unsigned*)(kmax2 + (sq * 4 + (pn - 8) * 2 + bj) * 4 + wc), __float_as_uint(v)); }
    }
  }
};
struct EpiOut {
  bf16_t* proj;
  __device__ __forceinline__ void operator()(const f32x4 (&acc)[2][2][4][2], int pm, int pn, int wr, int wc, int fr, int fq) const {
#pragma unroll
    for (int ai = 0; ai < 2; ++ai)
#pragma unroll
      for (int m = 0; m < 4; ++m) {
        const int row = pm * BM + ai * HALF + wr * 64 + m * 16 + fr;
        bf16_t* rowp = proj + (size_t)row * NPROJ + C_U + pn * BM + wc * 32 + 8 * fq;
#pragma unroll
        for (int bj = 0; bj < 2; ++bj) { const f32x4 v0 = acc[ai][bj][m][0], v1 = acc[ai][bj][m][1];
          u32x4 w; w.x = cvtpk(v0[0], v0[1]); w.y = cvtpk(v0[2], v0[3]); w.z = cvtpk(v1[0], v1[1]); w.w = cvtpk(v1[2], v1[3]);
          *(u32x4*)(rowp + bj * HALF) = w; }
      }
  }
};
}

__device__ __forceinline__ void bf8_to_f(const u32x4 w, float* v) {
  v[0] = bflo(w.x); v[1] = bfhi(w.x); v[2] = bflo(w.y); v[3] = bfhi(w.y); v[4] = bflo(w.z); v[5] = bfhi(w.z); v[6] = bflo(w.w); v[7] = bfhi(w.w);
}
__device__ void pool_phase(const Params& p, int l, bool dry = false) {
  const int tid = opaque_tid(), c8 = tid & 63, tq = tid >> 6;
  const int g = c8 >> 4, hw = 1 << g;
  const float* sc = p.pool_scale + l * 512 + c8 * 8;
  float scl[8];
#pragma unroll
  for (int e = 0; e < 8; ++e) scl[e] = sc[e];
  for (int ch = blockIdx.x; ch < T_TOK / 128; ch += gridDim.x) {
    const int t0 = ch * 128 + tq * 16;
    const int S = t0 < TP ? S_P : S_S, pos0 = t0 & (S - 1), s0 = t0 - pos0;
    const bf16_t* ub = p.proj + (size_t)s0 * NPROJ + C_U + c8 * 8;
    float sum[8] = {0, 0, 0, 0, 0, 0, 0, 0};
#pragma unroll
    for (int j = 0; j < 16; ++j) {
      const int r = pos0 - hw + j; const bool ok = (j < 2 * hw) && r >= 0 && r < S; const int rc = min(max(r, 0), S - 1);
      float v[8]; bf8_to_f(*(const u32x4*)(ub + (size_t)rc * NPROJ), v); const float m = ok ? 1.f : 0.f;
#pragma unroll
      for (int e = 0; e < 8; ++e) sum[e] = fmaf(m, v[e], sum[e]);
    }
#pragma unroll
    for (int i4 = 0; i4 < 16; i4 += 4) {
      u32x4 wu[4], wz[4], wa[4], wsb[4];
#pragma unroll
      for (int q = 0; q < 4; ++q) {
        const int pos = pos0 + i4 + q, ra = pos + hw, rs = pos - hw;
        wu[q] = *(const u32x4*)(ub + (size_t)pos * NPROJ);
        wz[q] = *(const u32x4*)(p.proj + (size_t)(t0 + i4 + q) * NPROJ + C_ZP + c8 * 8);
        wa[q] = *(const u32x4*)(ub + (size_t)min(ra, S - 1) * NPROJ); wsb[q] = *(const u32x4*)(ub + (size_t)max(rs, 0) * NPROJ);
      }
#pragma unroll
      for (int q = 0; q < 4; ++q) {
        const int pos = pos0 + i4 + q, t = t0 + i4 + q;
        const int lo = max(pos - hw, 0), hi = min(pos + hw, S);
        const float inv = 1.f / (float)(hi - lo);
        float uc[8], z[8], va[8], vs[8], o[8];
        bf8_to_f(wu[q], uc); bf8_to_f(wz[q], z);
#pragma unroll
        for (int e = 0; e < 8; ++e) o[e] = (sum[e] * inv - uc[e]) * scl[e] * silu(z[e]);
        const u32x4 w = {cvtpk(o[0], o[1]), cvtpk(o[2], o[3]), cvtpk(o[4], o[5]), cvtpk(o[6], o[7])};
        if (!dry) *(u32x4*)(p.proj + (size_t)t * NPROJ + C_ZP + c8 * 8) = w;
        const int ra = pos + hw, rs = pos - hw; const float ma = ra < S ? 1.f : 0.f, ms = rs >= 0 ? 1.f : 0.f;
        bf8_to_f(wa[q], va); bf8_to_f(wsb[q], vs);
#pragma unroll
        for (int e = 0; e < 8; ++e) sum[e] = fmaf(ma, va[e], fmaf(-ms, vs[e], sum[e]));
      }
    }
  }
}

namespace at {
constexpr int KVBLK = 64, LDK = NPROJ;
constexpr size_t SHM_V = KVBLK * 128 * 2, SHM_K = KVBLK * 128 * 2;
constexpr float THRL = 11.5f;
#define KSWZ(row, colB) ((row) * 256 + ((colB) ^ (((row) & 7) << 4)))
__device__ __forceinline__ int crow(int r, int hi) { return (r & 3) + 8 * (r >> 2) + 4 * hi; }
template <bool SH> __device__ __forceinline__ void partialSM(f32x16& p0, f32x16& p1, float& m_reg, float& mn, float& alpha) {
  if constexpr (!SH) {
    alpha = 1.f;
    return;
  }
  float pmax = p0[0];
#pragma unroll
  for (int r = 1; r < 16; ++r) pmax = fmaxf(pmax, p0[r]);
#pragma unroll
  for (int r = 0; r < 16; ++r) pmax = fmaxf(pmax, p1[r]);
  { auto rr = __builtin_amdgcn_permlane32_swap(__float_as_uint(pmax), __float_as_uint(pmax), false, false);
    pmax = fmaxf(__uint_as_float(rr[0]), __uint_as_float(rr[1])); }
  if (__builtin_expect(__all(pmax - m_reg <= THRL), 1)) { mn = m_reg; alpha = 1.f; }
  else { mn = fmaxf(m_reg, pmax); alpha = __builtin_amdgcn_exp2f(m_reg - mn); m_reg = mn; }
#pragma unroll
  for (int r = 0; r < 16; ++r) p0[r] = p0[r] - mn;
#pragma unroll
  for (int r = 0; r < 16; ++r) p1[r] = p1[r] - mn;
#pragma unroll
  for (int r = 0; r < 16; ++r) { p0[r] = __builtin_amdgcn_exp2f(p0[r]); p1[r] = __builtin_amdgcn_exp2f(p1[r]); }
}
template <bool SH> __device__ __forceinline__ void finishSM(f32x16& p0, f32x16& p1, float alpha, float& l_reg, bf16x8& pa0, bf16x8& pa1, bf16x8& pa2, bf16x8& pa3) {
  if constexpr (!SH) {
#pragma unroll
    for (int r = 0; r < 16; ++r) { p0[r] = __builtin_amdgcn_exp2f(p0[r]); p1[r] = __builtin_amdgcn_exp2f(p1[r]); }
  }
  float ps = 0;
#pragma unroll
  for (int r = 0; r < 16; ++r) ps += p0[r];
#pragma unroll
  for (int r = 0; r < 16; ++r) ps += p1[r];
  if constexpr (SH) l_reg = l_reg * alpha + ps; else l_reg += ps;
#define PK4(P, BASE, OUT) do { u32x4 w = {cvtpk_b(P[BASE + 0], P[BASE + 1]), cvtpk_b(P[BASE + 2], P[BASE + 3]), cvtpk_b(P[BASE + 4], P[BASE + 5]), cvtpk_b(P[BASE + 6], P[BASE + 7])}; \
    OUT = *reinterpret_cast<bf16x8*>(&w); } while (0)
  PK4(p0, 0, pa0); PK4(p0, 8, pa1); PK4(p1, 0, pa2); PK4(p1, 8, pa3);
#undef PK4
}
__device__ __forceinline__ void qkt(f32x16& p0, f32x16& p1, const char* Ks, const bf16x8* qr, int r32, int hi, int mapB) {
  p0 = f32x16{}; p1 = f32x16{};
#pragma unroll
  for (int d0 = 0; d0 < 4; ++d0) { const int cb = (d0 * 16 + hi * 8) * 2 + mapB;
    bf16x8 b0 = *reinterpret_cast<const bf16x8*>(Ks + KSWZ(r32, cb));
    bf16x8 b1 = *reinterpret_cast<const bf16x8*>(Ks + KSWZ(32 + r32, cb));
    p0 = __builtin_amdgcn_mfma_f32_32x32x16_bf16(b0, qr[d0], p0, 0, 0, 0);
    p1 = __builtin_amdgcn_mfma_f32_32x32x16_bf16(b1, qr[d0], p1, 0, 0, 0); }
}
__device__ __forceinline__ int v_st(int k, int c) { const int kk = (k & ~0xC) | ((k & 4) << 1) | ((k & 8) >> 1); return ((kk >> 3) * 4 + (c >> 5)) * 512 + ((kk & 7) * 32 + (c & 31)) * 2; }
__device__ __forceinline__ int v_rd_base(int lane) { return ((lane & 3) << 3) | (((lane >> 2) & 3) << 6) | (((lane >> 4) & 1) << 5) | (((lane >> 5) & 1) << 8); }
constexpr int v_rd_off(int d0, int ks, int half) { return d0 * 512 + ks * 4096 + half * 2048; }
template <int OFF> __device__ __forceinline__ s16x4 tr_read(int vb) {
  s16x4 r; asm volatile("ds_read_b64_tr_b16 %0, %1 offset:%2" : "=&v"(r) : "v"(vb), "i"(OFF) : "memory"); return r;
}
template <int D0> __device__ __forceinline__ void pv_one(f32x16& od, int vb, bf16x8 pa0, bf16x8 pa1, bf16x8 pa2, bf16x8 pa3) {
  const s16x4 l0 = tr_read<v_rd_off(D0, 0, 0)>(vb), h0 = tr_read<v_rd_off(D0, 0, 1)>(vb), l1 = tr_read<v_rd_off(D0, 1, 0)>(vb), h1 = tr_read<v_rd_off(D0, 1, 1)>(vb);
  const s16x4 l2 = tr_read<v_rd_off(D0, 2, 0)>(vb), h2 = tr_read<v_rd_off(D0, 2, 1)>(vb), l3 = tr_read<v_rd_off(D0, 3, 0)>(vb), h3 = tr_read<v_rd_off(D0, 3, 1)>(vb);
  asm volatile("s_waitcnt lgkmcnt(0)" ::: "memory"); SBAR();
#define PK(L, H) (bf16x8){L[0], L[1], L[2], L[3], H[0], H[1], H[2], H[3]}
  od = __builtin_amdgcn_mfma_f32_32x32x16_bf16(pa0, PK(l0, h0), od, 0, 0, 0);
  od = __builtin_amdgcn_mfma_f32_32x32x16_bf16(pa1, PK(l1, h1), od, 0, 0, 0);
  od = __builtin_amdgcn_mfma_f32_32x32x16_bf16(pa2, PK(l2, h2), od, 0, 0, 0);
  od = __builtin_amdgcn_mfma_f32_32x32x16_bf16(pa3, PK(l3, h3), od, 0, 0, 0);
#undef PK
}
__device__ __forceinline__ void pv_d0(f32x16* o, int vb, bf16x8 pa0, bf16x8 pa1, bf16x8 pa2, bf16x8 pa3) {
  pv_one<0>(o[0], vb, pa0, pa1, pa2, pa3); pv_one<1>(o[1], vb, pa0, pa1, pa2, pa3); pv_one<2>(o[2], vb, pa0, pa1, pa2, pa3); pv_one<3>(o[3], vb, pa0, pa1, pa2, pa3);
}

struct VFrag { s16x4 l0, h0, l1, h1, l2, h2, l3, h3; };
template <int D0> __device__ __forceinline__ void v_frag_read(VFrag& f, int vb) {
  f.l0 = tr_read<v_rd_off(D0, 0, 0)>(vb); f.h0 = tr_read<v_rd_off(D0, 0, 1)>(vb); f.l1 = tr_read<v_rd_off(D0, 1, 0)>(vb); f.h1 = tr_read<v_rd_off(D0, 1, 1)>(vb);
  f.l2 = tr_read<v_rd_off(D0, 2, 0)>(vb); f.h2 = tr_read<v_rd_off(D0, 2, 1)>(vb); f.l3 = tr_read<v_rd_off(D0, 3, 0)>(vb); f.h3 = tr_read<v_rd_off(D0, 3, 1)>(vb);
}
__device__ __forceinline__ void v_frag_mma(f32x16& od, const VFrag& f, bf16x8 pa0, bf16x8 pa1, bf16x8 pa2, bf16x8 pa3) {
#define PK(L, H) (bf16x8){L[0], L[1], L[2], L[3], H[0], H[1], H[2], H[3]}
  od = __builtin_amdgcn_mfma_f32_32x32x16_bf16(pa0, PK(f.l0, f.h0), od, 0, 0, 0);
  od = __builtin_amdgcn_mfma_f32_32x32x16_bf16(pa1, PK(f.l1, f.h1), od, 0, 0, 0);
  od = __builtin_amdgcn_mfma_f32_32x32x16_bf16(pa2, PK(f.l2, f.h2), od, 0, 0, 0);
  od = __builtin_amdgcn_mfma_f32_32x32x16_bf16(pa3, PK(f.l3, f.h3), od, 0, 0, 0);
#undef PK
}
template <bool PRE> __device__ __forceinline__ void pv_d0_pipe(f32x16* o, int vb, bf16x8 pa0, bf16x8 pa1, bf16x8 pa2, bf16x8 pa3, VFrag& fa) {
  VFrag fb;
  if constexpr (!PRE) v_frag_read<0>(fa, vb);
  asm volatile("s_waitcnt lgkmcnt(0)" ::: "memory"); SBAR();
  v_frag_read<1>(fb, vb); SBAR(); v_frag_mma(o[0], fa, pa0, pa1, pa2, pa3); SBAR(); asm volatile("s_waitcnt lgkmcnt(0)" ::: "memory"); SBAR();
  v_frag_read<2>(fa, vb); SBAR(); v_frag_mma(o[1], fb, pa0, pa1, pa2, pa3); SBAR(); asm volatile("s_waitcnt lgkmcnt(0)" ::: "memory"); SBAR();
  v_frag_read<3>(fb, vb); SBAR(); v_frag_mma(o[2], fa, pa0, pa1, pa2, pa3); SBAR(); asm volatile("s_waitcnt lgkmcnt(0)" ::: "memory"); SBAR();
  v_frag_mma(o[3], fb, pa0, pa1, pa2, pa3);
}

template <bool SH> __device__ __forceinline__ void attn_unit(bf16_t* __restrict__ proj, int tok0, int kv0, int seq, int h, float lam, float oscale, const float* __restrict__ subg, char* lds, bool dry) {
  const int tid = opaque_tid(), wid = __builtin_amdgcn_readfirstlane(tid >> 6), lane = tid & 63, r32 = lane & 31, hi = lane >> 5;
  const int wq = wid & 3, mp = wid >> 2, mapB = mp * 128;
  constexpr int RING = 32768, NRING = 4;
  LAS char* ldsl = (LAS char*)lds;
  float* ws = (float*)(lds + NRING * RING) + wid * 64; float* li_l = ws; float* al_l = ws + 32;
  const bf16_t* Kh = proj + (size_t)kv0 * NPROJ + C_K + h * 128;
  const bf16_t* Vh = proj + (size_t)kv0 * NPROJ + C_V + h * 128;
  float m_reg = -1e30f, l_reg = 0; f32x16 o[4] = {}; bf16x8 qr[4];
  const bf16_t* Qw = proj + (size_t)(tok0 + wq * 32 + r32) * NPROJ + C_Q + h * 128 + mp * 64 + hi * 8;
#pragma unroll
  for (int d0 = 0; d0 < 4; ++d0) qr[d0] = *reinterpret_cast<const bf16x8*>(Qw + d0 * 16);
  int offK[2], offV[2];
#pragma unroll
  for (int i = 0; i < 2; ++i) {
    const int c = i * 512 + tid;
    { const int row = c >> 4, pc = c & 15, scn = pc ^ (row & 7); offK[i] = row * LDK + scn * 8; }
    { const int sub = c >> 5, kk = (sub >> 2) * 8 + ((c >> 2) & 7), col = (sub & 3) * 32 + (c & 3) * 8;
      const int k = kk; offV[i] = k * LDK + col; }
  }
  const int vbb = (int)(uintptr_t)ldsl + 16384 + v_rd_base(lane);
#define GLDS16(src, dst) __builtin_amdgcn_global_load_lds((const unsigned*)(src), (LAS unsigned*)(dst), 16, 0, 0)
#define DMA(t, b) do { const bf16_t* kg_ = Kh + (size_t)(t) * (KVBLK * LDK); const bf16_t* vg_ = Vh + (size_t)(t) * (KVBLK * LDK); LAS char* d_ = ldsl + (b) * RING + wid * 1024; \
    GLDS16(kg_ + offK[0], d_); GLDS16(kg_ + offK[1], d_ + 8192); GLDS16(vg_ + offV[0], d_ + 16384); GLDS16(vg_ + offV[1], d_ + 16384 + 8192); } while (0)
#define KBUF(b) ((const char*)lds + (b) * RING)
#define VBUF(b) (vbb + (b) * RING)
#define LANDED() do { asm volatile("s_waitcnt vmcnt(0)" ::: "memory"); __syncthreads(); } while (0)
#define RESC(a) do { if (SH && __any((a) < 1.f)) { if (hi == 0) al_l[r32] = (a); asm volatile("s_waitcnt lgkmcnt(0)" ::: "memory"); \
    _Pragma("unroll") for (int d = 0; d < 4; ++d) _Pragma("unroll") for (int r = 0; r < 16; ++r) o[d][r] *= al_l[crow(r, hi)]; } } while (0)
  f32x16 pA0, pA1, pB0, pB1; float mnA, mnB, alA, alB; bf16x8 pa0, pa1, pa2, pa3; const int NT = seq / KVBLK;
#define BLK_X(N0, N1, P0, P1, alP, t) do { SBAR(); __builtin_amdgcn_s_setprio(1); qkt(N0, N1, KBUF((t) & 3), qr, r32, hi, mapB); \
    if constexpr (!SH) v_frag_read<0>(vfa, VBUF(((t) - 1) & 3)); \
    finishSM<SH>(P0, P1, alP, l_reg, pa0, pa1, pa2, pa3); __builtin_amdgcn_s_setprio(0); SBAR(); } while (0)
#define BLK_Y(C0, C1, mnC, alC, t) do { if constexpr (SH) pv_d0(o, VBUF((t) & 3), pa0, pa1, pa2, pa3); else pv_d0_pipe<true>(o, VBUF((t) & 3), pa0, pa1, pa2, pa3, vfa); partialSM<SH>(C0, C1, m_reg, mnC, alC); RESC(alC); } while (0)
  const int ty = STAGGER_MAP ? mp : (wid & 1);
  VFrag vfa;
  DMA(0, 0); LANDED();
  DMA(1, 1);
  if (ty == 0) {
    qkt(pA0, pA1, KBUF(0), qr, r32, hi, mapB); partialSM<SH>(pA0, pA1, m_reg, mnA, alA);
    LANDED();
    for (int j = 1; j + 1 < NT; j += 2) {
      BLK_X(pB0, pB1, pA0, pA1, alA, j); DMA(j + 1, (j + 1) & 3); BLK_Y(pB0, pB1, mnB, alB, j - 1); LANDED();
      BLK_X(pA0, pA1, pB0, pB1, alB, j + 1); DMA(j + 2, (j + 2) & 3); BLK_Y(pA0, pA1, mnA, alA, j); LANDED();
    }
    BLK_X(pB0, pB1, pA0, pA1, alA, NT - 1); BLK_Y(pB0, pB1, mnB, alB, NT - 2);
    finishSM<SH>(pB0, pB1, alB, l_reg, pa0, pa1, pa2, pa3); SBAR();
    if constexpr (SH) pv_d0(o, VBUF((NT - 1) & 3), pa0, pa1, pa2, pa3); else pv_d0_pipe<false>(o, VBUF((NT - 1) & 3), pa0, pa1, pa2, pa3, vfa);
  } else {
    qkt(pA0, pA1, KBUF(0), qr, r32, hi, mapB);
    LANDED();
    DMA(2, 2); partialSM<SH>(pA0, pA1, m_reg, mnA, alA); BLK_X(pB0, pB1, pA0, pA1, alA, 1); LANDED();
    for (int j = 2; j + 2 < NT; j += 2) {
      DMA(j + 1, (j + 1) & 3); BLK_Y(pB0, pB1, mnB, alB, j - 2); BLK_X(pA0, pA1, pB0, pB1, alB, j); LANDED();
      DMA(j + 2, (j + 2) & 3); BLK_Y(pA0, pA1, mnA, alA, j - 1); BLK_X(pB0, pB1, pA0, pA1, alA, j + 1); LANDED();
    }
    DMA(NT - 1, (NT - 1) & 3); BLK_Y(pB0, pB1, mnB, alB, NT - 4); BLK_X(pA0, pA1, pB0, pB1, alB, NT - 2); LANDED();
    BLK_Y(pA0, pA1, mnA, alA, NT - 3); BLK_X(pB0, pB1, pA0, pA1, alA, NT - 1);
    BLK_Y(pB0, pB1, mnB, alB, NT - 2);
    finishSM<SH>(pB0, pB1, alB, l_reg, pa0, pa1, pa2, pa3); SBAR();
    if constexpr (SH) pv_d0(o, VBUF((NT - 1) & 3), pa0, pa1, pa2, pa3); else pv_d0_pipe<false>(o, VBUF((NT - 1) & 3), pa0, pa1, pa2, pa3, vfa);
  }
#undef BLK_X
#undef BLK_Y
  u32x4 zg[4];
  bf16_t* zp = proj + (size_t)(tok0 + (tid >> 2)) * NPROJ + C_ZA + h * 128 + (tid & 3) * 32;
#pragma unroll
  for (int i = 0; i < 4; ++i) zg[i] = *(const u32x4*)(zp + i * 8);
  l_reg += __shfl_xor(l_reg, 32);
  if (hi == 0) li_l[r32] = l_reg; asm volatile("s_waitcnt lgkmcnt(0)" ::: "memory");
  float rli[16];
#pragma unroll
  for (int r = 0; r < 16; ++r) rli[r] = __builtin_amdgcn_rcpf(li_l[crow(r, hi)]);
  __syncthreads();
  float* X = (float*)lds;
  if (mp == 1) {
#pragma unroll
    for (int d = 0; d < 4; ++d)
#pragma unroll
      for (int r = 0; r < 16; ++r) X[(wq * 64 + d * 16 + r) * 64 + lane] = o[d][r] * rli[r] * lam;
  }
  __syncthreads();
  if (mp == 0) {
#pragma unroll
    for (int d = 0; d < 4; ++d)
#pragma unroll
      for (int r = 0; r < 16; ++r) { const int ix = (wq * 64 + d * 16 + r) * 64 + lane; X[ix] = o[d][r] * rli[r] - X[ix]; }
  }
  __syncthreads();
  {
    const int row = tid >> 2, dq = tid & 3, rl = row & 31, w = row >> 5, hh = (rl >> 2) & 1, r = (rl & 3) + 4 * (rl >> 3);
    const float* xb = X + (w * 64 + dq * 16 + r) * 64 + hh * 32;
    f32x4 a[8]; float ss = 0.f;
#pragma unroll
    for (int i = 0; i < 8; ++i) { a[i] = *(const f32x4*)(xb + i * 4); ss += a[i][0] * a[i][0] + a[i][1] * a[i][1] + a[i][2] * a[i][2] + a[i][3] * a[i][3]; }
    ss += __shfl_xor(ss, 1); ss += __shfl_xor(ss, 2);
    const float rn = __builtin_amdgcn_rsqf(ss * (1.f / 128.f) + 1e-5f) * oscale;
    const float* gg = subg + dq * 32;
#pragma unroll
    for (int i = 0; i < 4; ++i) {
      const u32x4 z = zg[i];
      const f32x4 a0 = a[2 * i], a1 = a[2 * i + 1]; const f32x4 g0 = *(const f32x4*)(gg + i * 8), g1 = *(const f32x4*)(gg + i * 8 + 4);
      u32x4 wv;
      wv.x = cvtpk(a0[0] * rn * g0[0] * silu(bflo(z.x)), a0[1] * rn * g0[1] * silu(bfhi(z.x)));
      wv.y = cvtpk(a0[2] * rn * g0[2] * silu(bflo(z.y)), a0[3] * rn * g0[3] * silu(bfhi(z.y)));
      wv.z = cvtpk(a1[0] * rn * g1[0] * silu(bflo(z.z)), a1[1] * rn * g1[1] * silu(bfhi(z.z)));
      wv.w = cvtpk(a1[2] * rn * g1[2] * silu(bflo(z.w)), a1[3] * rn * g1[3] * silu(bfhi(z.w)));
      if (!dry) *(u32x4*)(zp + i * 8) = wv;
    }
  }
  __syncthreads();
#undef DMA
#undef GLDS16
#undef KBUF
#undef VBUF
#undef LANDED
#undef RESC
}

__device__ void attn_phase(const Params& p, int l, char* lds, bool dry = false) {
  const float lam = p.lam[l];
  const float oscale = 1.f - (0.8f - 0.6f * expf(-0.3f * (float)l));
  const float* subg = p.subln_g + l * 128;
  for (int u = blockIdx.x; u < 2048; u += gridDim.x) {
    int tok0, kv0, seq, h;
    if (u < 1024) { const int x = u & 7, j = u >> 3; const int b = x >> 2; h = x & 3; seq = S_P; kv0 = b * S_P; tok0 = kv0 + j * 128; }
    else { const int v = u - 1024, x = v & 7, j = v >> 3; const int pr = x * 4 + (j >> 5), b = pr >> 2; h = pr & 3; seq = S_S; kv0 = TP + b * S_S; tok0 = kv0 + (j & 31) * 128; }
    bool need;
    { const int tid = opaque_tid(), wid = tid >> 6, lane = tid & 63, r32 = lane & 31, hi = lane >> 5, wq = wid & 3, mp = wid >> 2;
      const int sq = tok0 < TP ? (tok0 >> 14) : 2 + ((tok0 - TP) >> 12);
      const float* km = p.kmax2 + ((l * 10 + sq) * 4 + h) * 4 + mp * 2;
      const float kmx = sqrtf(km[0] + km[1]) * 1.01f;
      const bf16_t* Qw = p.proj + (size_t)(tok0 + wq * 32 + r32) * NPROJ + C_Q + h * 128 + mp * 64 + hi * 8;
      float ss = 0.f;
#pragma unroll
      for (int d0 = 0; d0 < 4; ++d0) { const u32x4 w = *(const u32x4*)(Qw + d0 * 16);
        ss += bflo(w.x) * bflo(w.x) + bfhi(w.x) * bfhi(w.x) + bflo(w.y) * bflo(w.y) + bfhi(w.y) * bfhi(w.y) + bflo(w.z) * bflo(w.z) + bfhi(w.z) * bfhi(w.z) + bflo(w.w) * bflo(w.w) + bfhi(w.w) * bfhi(w.w); }
      ss += __shfl_xor(ss, 32);
      need = __any(!(sqrtf(ss) * kmx < 100.f)) != 0; }
    if (need) attn_unit<true>(p.proj, tok0, kv0, seq, h, lam, oscale, subg, lds, dry);
    else attn_unit<false>(p.proj, tok0, kv0, seq, h, lam, oscale, subg, lds, dry);
  }
}
}

__device__ void post_phase(const Params& p, int l) {
  const int tid = opaque_tid(), wid = tid >> 6, lane = tid & 63, nw = blockDim.x >> 6;
  const float* pg = p.post_g + l * DM;
  constexpr int R = 2;
  for (int row0 = (blockIdx.x * nw + wid) * R; row0 < T_TOK; row0 += gridDim.x * nw * R) {
    f32x4 y[R][4], x[R][4]; u32x2 xh[R][4], xl[R][4], yb[R][4];
#pragma unroll
    for (int q = 0; q < R; ++q) {
      const int row = row0 + q;
      const bf16_t* yr = p.proj + (size_t)row * NPROJ + C_U;
#pragma unroll
      for (int i = 0; i < 4; ++i) yb[q][i] = __builtin_nontemporal_load((const u32x2*)(yr + i * 256 + lane * 4));
      if (l == 0) {
        const float* xr = row < TP ? p.xp + (size_t)row * DM : p.xs + (size_t)(row - TP) * DM;
#pragma unroll
        for (int i = 0; i < 4; ++i) x[q][i] = __builtin_nontemporal_load((const f32x4*)(xr + i * 256 + lane * 4));
      } else {
        const bf16_t* xo = (const bf16_t*)p.out + (size_t)row * LDX;
#pragma unroll
        for (int i = 0; i < 4; ++i) { xh[q][i] = __builtin_nontemporal_load((const u32x2*)(xo + i * 256 + lane * 4)); xl[q][i] = __builtin_nontemporal_load((const u32x2*)(xo + DM + i * 256 + lane * 4)); }
      }
    }
#pragma unroll
    for (int q = 0; q < R; ++q) {
      const int row = row0 + q;
      bf16_t* xo = (bf16_t*)p.out + (size_t)row * LDX;
      float ss = 0.f;
#pragma unroll
      for (int i = 0; i < 4; ++i) { y[q][i] = (f32x4){bflo(yb[q][i].x), bfhi(yb[q][i].x), bflo(yb[q][i].y), bfhi(yb[q][i].y)};
        ss += y[q][i][0] * y[q][i][0] + y[q][i][1] * y[q][i][1] + y[q][i][2] * y[q][i][2] + y[q][i][3] * y[q][i][3]; }
      if (l != 0) {
#pragma unroll
        for (int i = 0; i < 4; ++i) {
          const u32x2 h = xh[q][i], lo = xl[q][i];
          x[q][i][0] = bflo(h.x) + bflo(lo.x); x[q][i][1] = bfhi(h.x) + bfhi(lo.x); x[q][i][2] = bflo(h.y) + bflo(lo.y); x[q][i][3] = bfhi(h.y) + bfhi(lo.y);
        }
      }
      ss = wave_sum(ss);
      const float ry = __builtin_amdgcn_rsqf(ss * (1.f / DM) + 1e-6f);
      float s2 = 0.f;
#pragma unroll
      for (int i = 0; i < 4; ++i) {
        const f32x4 g = *(const f32x4*)(pg + i * 256 + lane * 4);
#pragma unroll
        for (int e = 0; e < 4; ++e) { x[q][i][e] = x[q][i][e] + y[q][i][e] * ry * g[e]; s2 += x[q][i][e] * x[q][i][e]; }
      }
      if (l == DEPTH - 1) {
        float* orow = p.out + (size_t)row * DM;
#pragma unroll
        for (int i = 0; i < 4; ++i) __builtin_nontemporal_store(x[q][i], (f32x4*)(orow + i * 256 + lane * 4));
      } else {
        s2 = wave_sum(s2);
        if (lane == 0) p.rinv[row] = __builtin_amdgcn_rsqf(s2 * (1.f / DM) + 1e-6f);
#pragma unroll
        for (int i = 0; i < 4; ++i) {
          const unsigned h0 = cvtpk(x[q][i][0], x[q][i][1]), h1 = cvtpk(x[q][i][2], x[q][i][3]);
          const unsigned l0 = cvtpk(x[q][i][0] - bflo(h0), x[q][i][1] - bfhi(h0)), l1 = cvtpk(x[q][i][2] - bflo(h1), x[q][i][3] - bfhi(h1));
          *(u32x2*)(xo + i * 256 + lane * 4) = (u32x2){h0, h1}; *(u32x2*)(xo + DM + i * 256 + lane * 4) = (u32x2){l0, l1};
        }
      }
    }
  }
}

#define XB_TMO      128
#define XB_XCNT(j)  (256  + 64 * (j))
#define XB_XSUB(j)  (1280 + 64 * (j))
#define XB_XGEN(j)  (2304 + 64 * (j))
#define XB_TOP      3328
#define XB_TOPGEN   3392
#define XB_SPIN_CAP (1u << 22)
#define XLAS __attribute__((address_space(3)))
__device__ __forceinline__ unsigned xb_ld(unsigned* p)              { return __hip_atomic_load(p, __ATOMIC_RELAXED, __HIP_MEMORY_SCOPE_AGENT); }
__device__ __forceinline__ unsigned xb_add(unsigned* p, unsigned v) { return __hip_atomic_fetch_add(p, v, __ATOMIC_RELAXED, __HIP_MEMORY_SCOPE_AGENT); }
__device__ __forceinline__ unsigned xb_xcc_id() { return (unsigned)__builtin_amdgcn_s_getreg((3 << 11) | 20) & 0xFu; }
#define XB_SPIN(cond, bar) do { unsigned _sp = 0; while (cond) { __builtin_amdgcn_s_sleep(1); \
    if ((++_sp & 255u) == 0u) { if (xb_ld(&(bar)[XB_TMO])) break; if (_sp > XB_SPIN_CAP) { atomicAdd(&(bar)[XB_TMO], 1u); break; } } } } while (0)
struct XcdBarrier { unsigned* bar; unsigned x; volatile XLAS unsigned* st; };
__device__ __forceinline__ XcdBarrier xcd_barrier_post(unsigned* bar, volatile XLAS unsigned* st) {
  XcdBarrier b; b.bar = bar; b.x = xb_xcc_id(); b.st = st;
  if (threadIdx.x == 0) (void)xb_add(&bar[XB_XCNT(b.x)], 1u);
  return b;
}
__device__ __forceinline__ void xcd_barrier_complete(unsigned* bar, unsigned x, unsigned& nloc, unsigned& nx) {
  const unsigned G = gridDim.x * gridDim.y * gridDim.z;
  unsigned sum, cnt, mine, sp = 0u;
  for (;;) {
    sum = 0u; cnt = 0u; mine = 0u;
#pragma unroll
    for (unsigned j = 0; j < 16; ++j) { const unsigned c = xb_ld(&bar[XB_XCNT(j)]); sum += c; cnt += (c > 0u) ? 1u : 0u; mine = (j == x) ? c : mine; }
    if (sum == G) break;
    __builtin_amdgcn_s_sleep(1);
    if ((++sp & 255u) == 0u) { if (xb_ld(&bar[XB_TMO])) break; if (sp > XB_SPIN_CAP) { atomicAdd(&bar[XB_TMO], 1u); break; } }
  }
  nloc = mine > 0u ? mine : 1u; nx = cnt > 0u ? cnt : 1u;
}
__device__ __forceinline__ void xcd_barrier(const XcdBarrier& b) {
  asm volatile("s_waitcnt vmcnt(0)" ::: "memory");
  __syncthreads();
  if (threadIdx.x == 0) {
    unsigned* bar = b.bar;
    __builtin_amdgcn_s_waitcnt(0);
    unsigned nloc = b.st[0], nx = b.st[1];
    if (nloc == 0u) { xcd_barrier_complete(bar, b.x, nloc, nx); b.st[0] = nloc; b.st[1] = nx; }
    const unsigned old = xb_add(&bar[XB_XSUB(b.x)], 1u);
    const unsigned gen = old / nloc;
    if (old + 1u == (gen + 1u) * nloc) {
      __builtin_amdgcn_fence(__ATOMIC_RELEASE, "agent");
      asm volatile("s_waitcnt vmcnt(0)" ::: "memory");
      const unsigned og = xb_add(&bar[XB_TOP], 1u);
      const unsigned tg = og / nx;
      if (og + 1u == (tg + 1u) * nx) xb_add(&bar[XB_TOPGEN], 1u);
      else XB_SPIN(xb_ld(&bar[XB_TOPGEN]) == tg, bar);
      __builtin_amdgcn_fence(__ATOMIC_ACQUIRE, "agent");
      xb_add(&bar[XB_XGEN(b.x)], 1u);
      asm volatile("s_waitcnt vmcnt(0)" ::: "memory");
    } else {
      XB_SPIN(xb_ld(&bar[XB_XGEN(b.x)]) == gen, bar);
      __builtin_amdgcn_fence(__ATOMIC_ACQUIRE, "agent");
      asm volatile("s_waitcnt vmcnt(0)" ::: "memory");
    }
  }
  __syncthreads();
}

__device__ __forceinline__ void run_phase(const Params& p, int ph, char* shm) {
  if (ph == 0) { phase0(p, shm); return; }
  const int l = (ph - 1) >> 2, s = (ph - 1) & 3;
  if (s == 0) { gm::EpiIn e{p.rinv, p.rope, p.proj, p.kmax2 + l * 160}; gm::gemm_phase(( const bf16_t*)p.out, LDX, p.WinT + (size_t)l * NPROJ * DM, NPROJ, e, shm); }
  else if (s == 1) { pool_phase(p, l); at::attn_phase(p, l, shm); }
  else if (s == 2) { gm::EpiOut e{p.proj}; gm::gemm_phase(p.proj, NPROJ, p.WoutT + (size_t)l * DM * DM, DM, e, shm); }
  else post_phase(p, l);
}

#if MK_MULTI
template <int S> __global__ void __launch_bounds__(NT_THREADS, 1) k_phase(Params p, int l) {
  extern __shared__ __attribute__((aligned(16))) char shm[];
  if (S == 0) phase0(p, shm); else run_phase(p, 1 + 4 * l + (S - 1), shm);
}
#else
__global__ void __launch_bounds__(NT_THREADS, 1) k_mega(Params p) {
  extern __shared__ __attribute__((aligned(16))) char shm[];
  cg::grid_group grid = cg::this_grid();
  volatile XLAS unsigned* xst = (volatile XLAS unsigned*)(XLAS char*)(shm + 131072 + 3072);
  if (threadIdx.x == 0) { xst[0] = 0u; xst[1] = 0u; xst[2] = 0u; xst[3] = 0u; }
  phase0(p, shm);
  grid.sync();
  (void)xcd_barrier_post(p.bar, xst);
#define GSYNC() do { XcdBarrier xb_; xb_.bar = p.bar; xb_.x = xb_xcc_id(); xb_.st = xst; xcd_barrier(xb_); } while (0)
  for (int l = 0; l < DEPTH; ++l) {
#if REP_GEMM
    { gm::EpiIn e{p.rinv, p.rope, p.proj, p.kmax2 + l * 160}; gm::gemm_phase((const bf16_t*)p.out, LDX, p.WinT + (size_t)l * NPROJ * DM, NPROJ, e, shm); }
    GSYNC();
#endif
    { gm::EpiIn e{p.rinv, p.rope, p.proj, p.kmax2 + l * 160}; gm::gemm_phase((const bf16_t*)p.out, LDX, p.WinT + (size_t)l * NPROJ * DM, NPROJ, e, shm); }
    GSYNC();
    pool_phase(p, l);
#if REP_ATT
    at::attn_phase(p, l, shm, true); GSYNC();
#endif
    at::attn_phase(p, l, shm);
    GSYNC();
#if REP_GEMM
    { gm::EpiOut e{p.proj}; gm::gemm_phase(p.proj, NPROJ, p.WoutT + (size_t)l * DM * DM, DM, e, shm); }
    GSYNC();
#endif
    { gm::EpiOut e{p.proj}; gm::gemm_phase(p.proj, NPROJ, p.WoutT + (size_t)l * DM * DM, DM, e, shm); }
    GSYNC();
#if REP_POST
    if (l == 0) { post_phase(p, l); GSYNC(); }
#endif
    post_phase(p, l);
    if (l + 1 < DEPTH) GSYNC();
  }
}
#endif

extern "C" void kernel_launch(void* const* d_in, const int* in_sizes, int n_in, void* d_out, int out_size, void* d_ws, size_t ws_size, hipStream_t stream) {
  Params p{};
  p.xp = (const float*)d_in[0]; p.xs = (const float*)d_in[1]; p.pre_g = (const float*)d_in[2]; p.w_in = (const float*)d_in[3];
  p.pool_w = (const float*)d_in[4]; p.pool_scale = (const float*)d_in[5]; p.lq1 = (const float*)d_in[6]; p.lk1 = (const float*)d_in[7];
  p.lq2 = (const float*)d_in[8]; p.lk2 = (const float*)d_in[9]; p.subln_g = (const float*)d_in[10]; p.w_out = (const float*)d_in[11]; p.post_g = (const float*)d_in[12];
  p.out = (float*)d_out;
  char* w = (char*)d_ws; size_t off = 0;
  p.proj = (bf16_t*)(w + off); off += (size_t)T_TOK * NPROJ * 2;
  p.WinT = (bf16_t*)(w + off); off += (size_t)DEPTH * NPROJ * DM * 2;
  p.WoutT = (bf16_t*)(w + off); off += (size_t)DEPTH * DM * DM * 2;
  p.rinv = (float*)(w + off); off += (size_t)T_TOK * 4;
  p.rope = (float*)(w + off); off += 256;
  p.lam = (float*)(w + off); off += 256;
  p.kmax2 = (float*)(w + off); off += 2048;
  p.bar = (unsigned*)(w + off); off += 16384;
  if (off > ws_size) { fprintf(stderr, "kernel_launch: workspace too small (%zu > %zu)\n", off, ws_size); return; }
#if MK_MULTI
  static int ok = 0;
  if (!ok) {
    (void)hipFuncSetAttribute((const void*)k_phase<0>, hipFuncAttributeMaxDynamicSharedMemorySize, (int)SHM_BYTES);
    (void)hipFuncSetAttribute((const void*)k_phase<1>, hipFuncAttributeMaxDynamicSharedMemorySize, (int)SHM_BYTES);
    (void)hipFuncSetAttribute((const void*)k_phase<2>, hipFuncAttributeMaxDynamicSharedMemorySize, (int)SHM_BYTES);
    (void)hipFuncSetAttribute((const void*)k_phase<3>, hipFuncAttributeMaxDynamicSharedMemorySize, (int)SHM_BYTES);
    (void)hipFuncSetAttribute((const void*)k_phase<4>, hipFuncAttributeMaxDynamicSharedMemorySize, (int)SHM_BYTES);
    ok = 1; }
  hipLaunchKernelGGL(k_phase<0>, dim3(256), dim3(NT_THREADS), SHM_BYTES, stream, p, 0);
  for (int l = 0; l < DEPTH; ++l) {
    hipLaunchKernelGGL(k_phase<1>, dim3(256), dim3(NT_THREADS), SHM_BYTES, stream, p, l);
    hipLaunchKernelGGL(k_phase<2>, dim3(256), dim3(NT_THREADS), SHM_BYTES, stream, p, l);
    hipLaunchKernelGGL(k_phase<3>, dim3(256), dim3(NT_THREADS), SHM_BYTES, stream, p, l);
    hipLaunchKernelGGL(k_phase<4>, dim3(256), dim3(NT_THREADS), SHM_BYTES, stream, p, l);
  }
#else
  static int grid_blocks = 0;
  if (!grid_blocks) {
    (void)hipFuncSetAttribute((const void*)k_mega, hipFuncAttributeMaxDynamicSharedMemorySize, (int)SHM_BYTES);
    int dev = 0, cus = 0, per_cu = 0;
    (void)hipGetDevice(&dev);
    (void)hipDeviceGetAttribute(&cus, hipDeviceAttributeMultiprocessorCount, dev);
    (void)hipOccupancyMaxActiveBlocksPerMultiprocessor(&per_cu, k_mega, NT_THREADS, SHM_BYTES);
    if (per_cu > 1) per_cu = 1;
    grid_blocks = cus * per_cu;
  }
  void* args[] = {&p};
  hipError_t e = hipLaunchCooperativeKernel((void*)k_mega, dim3(grid_blocks), dim3(NT_THREADS), args, SHM_BYTES, stream);
  if (e != hipSuccess) fprintf(stderr, "cooperative launch failed: %s (grid %d)\n", hipGetErrorString(e), grid_blocks);
#endif
}
```

```cpp
#include <hip/hip_runtime.h>
#include <hip/hip_cooperative_groups.h>
#include <cstdio>
#include <cstdint>
namespace cg = cooperative_groups;

#ifndef REP_ATT
#define REP_ATT 0
#endif
#ifndef STAGGER_MAP
#define STAGGER_MAP 1
#endif
#ifndef REP_POST
#define REP_POST 0
#endif
#ifndef REP_GEMM
#define REP_GEMM 0
#endif
#ifndef MK_MULTI
#define MK_MULTI 0
#endif

typedef unsigned short bf16_t;
using bf16x8 = __attribute__((ext_vector_type(8))) short;
using s16x4  = __attribute__((ext_vector_type(4))) short;
using f32x16 = __attribute__((ext_vector_type(16))) float;
using f32x4  = __attribute__((ext_vector_type(4))) float;
using u32x4  = __attribute__((ext_vector_type(4))) unsigned;
using u32x2  = __attribute__((ext_vector_type(2))) unsigned;

#define XCD_BAR_WORDS 3456
constexpr int NT_THREADS = 512;
constexpr int T_TOK = 65536, TP = 32768, DM = 1024, NPROJ = 3072, DEPTH = 2;
constexpr int S_P = 16384, S_S = 4096;
constexpr int C_ZP = 0, C_ZA = 512, C_U = 1024, C_Q = 1536, C_K = 2048, C_V = 2560;
constexpr int LDX = 2048;
constexpr float QSCALE = 0.125f * 1.4426950408889634f;
constexpr size_t SHM_BYTES = 131072 + 4096;

struct Params {
  const float* xp; const float* xs; const float* pre_g; const float* w_in; const float* pool_w; const float* pool_scale;
  const float* lq1; const float* lk1; const float* lq2; const float* lk2; const float* subln_g; const float* w_out; const float* post_g;
  float* out; bf16_t* WinT; bf16_t* WoutT; bf16_t* proj; float* rinv; float* rope; float* lam; float* kmax2; unsigned* bar;
};

#define SBAR() __builtin_amdgcn_sched_barrier(0)
__device__ __forceinline__ unsigned cvtpk(float lo, float hi) {
  unsigned r; asm volatile("v_cvt_pk_bf16_f32 %0, %1, %2" : "=v"(r) : "v"(lo), "v"(hi)); return r;
}
typedef __bf16 bf16x2_t __attribute__((ext_vector_type(2)));
typedef float f32x2_t __attribute__((ext_vector_type(2)));
__device__ __forceinline__ unsigned cvtpk_b(float lo, float hi) { const f32x2_t v = {lo, hi}; const bf16x2_t b = __builtin_convertvector(v, bf16x2_t); return *reinterpret_cast<const unsigned*>(&b); }
__device__ __forceinline__ float bf2f(unsigned short b) { return __uint_as_float(((unsigned)b) << 16); }
__device__ __forceinline__ float bflo(unsigned w) { return __uint_as_float(w << 16); }
__device__ __forceinline__ float bfhi(unsigned w) { return __uint_as_float(w & 0xffff0000u); }
__device__ __forceinline__ bf16_t f2bf(float f) { return (bf16_t)(cvtpk(f, 0.f) & 0xffffu); }
__host__ __device__ __forceinline__ int perm32(int rho) { const int n = rho >> 4, i = rho & 15; return 8 * (i >> 2) + 4 * n + (i & 3); }
__device__ __forceinline__ float silu(float z) { return z * __builtin_amdgcn_rcpf(1.f + __builtin_amdgcn_exp2f(-1.4426950408889634f * z)); }
__device__ __forceinline__ int opaque_tid() { int t = threadIdx.x; asm volatile("" : "+v"(t)); return t; }
__device__ __forceinline__ float wave_sum(float v) {
#pragma unroll
  for (int o = 32; o >= 1; o >>= 1) v += __shfl_xor(v, o);
  return v;
}

__device__ __forceinline__ int src_col_in(int s) {
  const int type = s >> 9, within = s & 511;
  if (type == 0) return 512 + within;
  if (type == 1) return 2560 + within;
  if (type == 5) return 2048 + within;
  const int p = within & 63, wcl = p >> 5, fq = (p >> 3) & 3, n = (p >> 2) & 1, jj = p & 3;
  const int d = wcl * 16 + fq * 4 + jj + 32 * n;
  return (type == 3 ? 1024 : 1536) + (within & ~63) + d;
}

__device__ void phase0(const Params& p, char* shm) {
  const int tid = opaque_tid(), nth = blockDim.x;
  float* tile = (float*)shm;
  float* Wt = tile + 64 * 65 + 32;
  float* Pw = Wt + 64 * 128;
  constexpr int NT_U = DEPTH * 8 * 16, NT_IN = DEPTH * 40 * 16, NT_OUT = DEPTH * 16 * 16;
  for (int it = blockIdx.x; it < NT_U + NT_IN + NT_OUT; it += gridDim.x) {
    __syncthreads();
    if (it < NT_U + NT_IN) {
      int l, n0, k0; const bool isu = it < NT_U;
      if (isu) { l = it / 128; const int r = it % 128; n0 = C_U + (r / 16) * 64; k0 = (r % 16) * 64; }
      else { const int i2 = it - NT_U; l = i2 / 640; const int r = i2 % 640; int nt = r / 16; if (nt >= 16) nt += 8; n0 = nt * 64; k0 = (r % 16) * 64; }
      const float* W = p.w_in + (size_t)l * DM * NPROJ; const float* g = p.pre_g + l * DM;
      if (isu) {
        const int gi = (n0 - C_U) >> 7, d0 = (n0 - C_U) & 127;
        for (int e = tid; e < 64 * 128; e += nth) { const int c = e & 127, kk = e >> 7; Wt[e] = W[(size_t)(k0 + kk) * NPROJ + gi * 128 + c]; }
        for (int e = tid; e < 128 * 64; e += nth) { const int d = e & 63, c = e >> 6; Pw[e] = p.pool_w[((size_t)(l * 4 + gi) * 128 + c) * 128 + d0 + d]; }
        __syncthreads();
        for (int e = tid; e < 4096; e += nth) {
          const int nn = e & 63, kk = e >> 6, nrow = n0 + nn; const int s = (nrow & ~31) + perm32(nrow & 31), dl = s - n0;
          float a = 0.f;
#pragma unroll 8
          for (int c = 0; c < 128; ++c) a = fmaf(Wt[kk * 128 + c], Pw[c * 64 + dl], a);
          tile[kk * 65 + nn] = a * g[k0 + kk];
        }
      } else {
        for (int e = tid; e < 4096; e += nth) {
          const int nn = e & 63, kk = e >> 6, k = k0 + kk, nrow = n0 + nn;
          const int s = (nrow & ~31) + perm32(nrow & 31);
          tile[kk * 65 + nn] = W[(size_t)k * NPROJ + src_col_in(s)] * g[k];
        }
      }
      __syncthreads();
      bf16_t* O = p.WinT + (size_t)l * NPROJ * DM;
      for (int e = tid; e < 4096; e += nth) { const int kk = e & 63, nn = e >> 6; O[(size_t)(n0 + nn) * DM + k0 + kk] = f2bf(tile[kk * 65 + nn]); }
    } else {
      const int it2 = it - NT_U - NT_IN, l = it2 / 256, r = it2 % 256, n0 = (r / 16) * 64, k0 = (r % 16) * 64;
      const float* W = p.w_out + (size_t)l * DM * DM;
      for (int e = tid; e < 4096; e += nth) {
        const int nn = e & 63, kk = e >> 6, nrow = n0 + nn; const int s = (nrow & ~31) + perm32(nrow & 31);
        tile[kk * 65 + nn] = W[(size_t)(k0 + kk) * DM + s];
      }
      __syncthreads();
      bf16_t* O = p.WoutT + (size_t)l * DM * DM;
      for (int e = tid; e < 4096; e += nth) { const int kk = e & 63, nn = e >> 6; O[(size_t)(n0 + nn) * DM + k0 + kk] = f2bf(tile[kk * 65 + nn]); }
    }
  }
  if (blockIdx.x == 0) {
    for (int i = tid; i < XCD_BAR_WORDS; i += nth) p.bar[i] = 0u;
    if (tid < DEPTH * 160) p.kmax2[tid] = 0.f;
    if (tid < 32) { const double c = exp(-(double)tid * (9.210340371976184 / 32.0)) * 0.15915494309189535; const float h = (float)c; p.rope[2 * tid] = h; p.rope[2 * tid + 1] = (float)(c - (double)h); }
    if (tid >= 64 && tid < 64 + 64 * DEPTH) {
      const int l = (tid >> 6) - 1, i = tid & 63;
      float a = p.lq1[l * 64 + i] * p.lk1[l * 64 + i], b = p.lq2[l * 64 + i] * p.lk2[l * 64 + i];
      a = wave_sum(a); b = wave_sum(b);
      const float li = 0.8f - 0.6f * expf(-0.3f * (float)l);
      if (i == 0) p.lam[l] = expf(a) - expf(b) + li;
    }
  }
  const int wid = tid >> 6, lane = tid & 63, nw = nth >> 6;
  for (int row0 = (blockIdx.x * nw + wid) * 2; row0 < T_TOK; row0 += gridDim.x * nw * 2) {
    f32x4 v[2][4];
#pragma unroll
    for (int q = 0; q < 2; ++q) {
      const int row = row0 + q;
      const float* xr = row < TP ? p.xp + (size_t)row * DM : p.xs + (size_t)(row - TP) * DM;
#pragma unroll
      for (int i = 0; i < 4; ++i) v[q][i] = __builtin_nontemporal_load((const f32x4*)(xr + i * 256 + lane * 4));
    }
#pragma unroll
    for (int q = 0; q < 2; ++q) {
      const int row = row0 + q;
      bf16_t* xo = (bf16_t*)p.out + (size_t)row * LDX;
      float ss = 0.f;
#pragma unroll
      for (int i = 0; i < 4; ++i) {
        ss += v[q][i][0] * v[q][i][0] + v[q][i][1] * v[q][i][1] + v[q][i][2] * v[q][i][2] + v[q][i][3] * v[q][i][3];
        u32x2 w = {cvtpk(v[q][i][0], v[q][i][1]), cvtpk(v[q][i][2], v[q][i][3])};
        *(u32x2*)(xo + i * 256 + lane * 4) = w;
      }
      ss = wave_sum(ss);
      if (lane == 0) p.rinv[row] = __builtin_amdgcn_rsqf(ss * (1.f / DM) + 1e-6f);
    }
  }
}

namespace gm {
constexpr int BM = 256, BK = 64, HALF = 128, NXCD = 8, WGM = 8, HT = HALF * BK;
__device__ __forceinline__ int lds_byte(int r, int c) { int st = (r >> 4) * 2 + (c >> 5), rr = r & 15, cc = c & 31, ob = rr * 64 + cc * 2; return st * 1024 + (ob ^ (((ob >> 9) & 1) << 5)); }
__device__ __forceinline__ void stage_rc(int b, int& R, int& C) { int st = b / 1024, sb = b % 1024, swz = sb ^ (((sb >> 9) & 1) << 5); R = (st >> 1) * 16 + swz / 64; C = (st & 1) * 32 + (swz % 64) / 2; }

#define LAS __attribute__((address_space(3)))
template <class Epi>
__device__ __forceinline__ void gemm_phase(const bf16_t* __restrict__ A, const int lda, const bf16_t* __restrict__ Bt, const int N, const Epi& E, char* shmc) {
  constexpr int K = 1024, nt = K / BK, HTB = HALF * BK * 2;
  LAS unsigned char* lds = (LAS unsigned char*)shmc;
  const int tid = opaque_tid(), wid = __builtin_amdgcn_readfirstlane(tid >> 6), lane = tid & 63, wr = wid >> 2, wc = wid & 3, fr = lane & 15, fq = lane >> 4;
  unsigned voffA[2], voffB[2];
#pragma unroll
  for (int i = 0; i < 2; ++i) { int R, C; stage_rc(tid * 16 + i * 8192, R, C); voffA[i] = (unsigned)(R * lda + C) * 2u; voffB[i] = (unsigned)(R * K + C) * 2u; }
  const size_t kstep = (size_t)(BK * 2);
  const size_t hstepA = (size_t)HALF * lda * 2, hstepB = (size_t)HALF * K * 2;
  const size_t tstepA = 2 * hstepA, tstepB = 2 * hstepB;
  const unsigned ldsw = (unsigned)wid * 1024u;
  const int aoff = lds_byte(wr * 64 + fr, fq * 8), boff = lds_byte(wc * 32 + fr, fq * 8);
#define PG8_SA(b, h) (((b) * 2 + (h)) * HTB)
#define PG8_SB(b, h) ((4 + (b) * 2 + (h)) * HTB)
#define PG8_STAGE(bufoff, gbase, voff) do { _Pragma("unroll") for (int _i = 0; _i < 2; ++_i) \
        __builtin_amdgcn_global_load_lds((const unsigned*)((const char*)(gbase) + (voff)[_i]), (LAS unsigned*)(lds + (bufoff) + ldsw + _i * 8192), 16, 0, 0); } while (0)
#define PG8_LDA(dst, b, h) do { _Pragma("unroll") for (int m = 0; m < 4; ++m) _Pragma("unroll") for (int k = 0; k < 2; ++k) dst[m][k] = *(const LAS bf16x8*)(lds + PG8_SA(b, h) + aoff + m * 2048 + k * 1024); } while (0)
#define PG8_LDB(dst, b, h) do { _Pragma("unroll") for (int n = 0; n < 2; ++n) _Pragma("unroll") for (int k = 0; k < 2; ++k) dst[n][k] = *(const LAS bf16x8*)(lds + PG8_SB(b, h) + boff + n * 2048 + k * 1024); } while (0)
#define PG8_MMA(ai, bj, At, Bx) do { __builtin_amdgcn_s_setprio(1); _Pragma("unroll") for (int m = 0; m < 4; ++m) _Pragma("unroll") for (int n = 0; n < 2; ++n) _Pragma("unroll") for (int k = 0; k < 2; ++k) \
        acc[ai][bj][m][n] = __builtin_amdgcn_mfma_f32_16x16x32_bf16(Bx[n][k], At[m][k], acc[ai][bj][m][n], 0, 0, 0); __builtin_amdgcn_s_setprio(0); } while (0)
#define PG8_WAIT_V(n) asm volatile("s_waitcnt vmcnt(" #n ")" ::: "memory")
#define PG8_WAIT_L(n) asm volatile("s_waitcnt lgkmcnt(" #n ")" ::: "memory")
#define PG8_BAR __builtin_amdgcn_s_barrier()
#define PG8_SCHED __builtin_amdgcn_sched_barrier(0)
  const int nM = T_TOK / BM, nN = N / BM, nwg = nM * nN, G = gridDim.x, cblk = blockIdx.x;
  auto next_unit = [&](int i, int& pm, int& pn) -> bool {
    const long L = (long)i * G + cblk; if (L >= nwg) return false;
    int wgid = (int)L; { const int q = nwg / NXCD, r = nwg % NXCD, xcd = wgid % NXCD, off = wgid / NXCD; wgid = (xcd < r ? xcd * (q + 1) : r * (q + 1) + (xcd - r) * q) + off; }
    const int nig = WGM * nN, gid = wgid / nig, fm = gid * WGM, gsz = (nM - fm) < WGM ? (nM - fm) : WGM;
    pm = fm + ((wgid % nig) % gsz); pn = (wgid % nig) / gsz; return true;
  };
  int cpm, cpn, npm = 0, npn = 0, ui = 0;
  if (!next_unit(0, cpm, cpn)) return;
  f32x4 acc[2][2][4][2];
#pragma unroll
  for (int a = 0; a < 2; ++a)
#pragma unroll
    for (int b = 0; b < 2; ++b)
#pragma unroll
      for (int m = 0; m < 4; ++m)
#pragma unroll
        for (int n = 0; n < 2; ++n) acc[a][b][m][n] = (f32x4){0.f, 0.f, 0.f, 0.f};
  bf16x8 At[4][2], B0[2][2], B1[2][2];
  const char* cA = (const char*)A + (size_t)cpm * tstepA; const char* cB = (const char*)Bt + (size_t)cpn * tstepB;
  PG8_STAGE(PG8_SB(0, 0), cB, voffB); PG8_STAGE(PG8_SB(0, 1), cB + hstepB, voffB); PG8_STAGE(PG8_SA(0, 0), cA, voffA); PG8_STAGE(PG8_SA(0, 1), cA + hstepA, voffA);
  if (wr == 1) PG8_BAR;
  PG8_WAIT_V(2); PG8_BAR;
  PG8_STAGE(PG8_SB(1, 0), cB + kstep, voffB); PG8_STAGE(PG8_SA(1, 0), cA + kstep, voffA); PG8_STAGE(PG8_SB(1, 1), cB + hstepB + kstep, voffB);
  PG8_WAIT_V(6); PG8_BAR;
  for (;;) {
    const bool has_next = next_unit(ui + 1, npm, npn);
    const char* nA = has_next ? (const char*)A + (size_t)npm * tstepA : cA; const char* nB = has_next ? (const char*)Bt + (size_t)npn * tstepB : cB;
    for (int t = 0; t < nt; t += 2) {
      const bool last = (t == nt - 2);
      const char* a1 = cA + (size_t)(t + 1) * kstep;
      const char* a2 = last ? nA : cA + (size_t)(t + 2) * kstep; const char* b2 = last ? nB : cB + (size_t)(t + 2) * kstep;
      const char* a3 = a2 + kstep; const char* b3 = b2 + kstep;
      PG8_LDB(B0, 0, 0); PG8_LDB(B1, 0, 1); PG8_SCHED; PG8_LDA(At, 0, 0); PG8_STAGE(PG8_SA(1, 1), a1 + hstepA, voffA);
      PG8_WAIT_V(8); PG8_WAIT_L(0); PG8_BAR; PG8_MMA(0, 0, At, B0); PG8_MMA(0, 1, At, B1); PG8_BAR; PG8_SCHED;
      PG8_LDA(At, 0, 1); PG8_STAGE(PG8_SB(0, 0), b2, voffB); PG8_STAGE(PG8_SB(0, 1), b2 + hstepB, voffB); PG8_STAGE(PG8_SA(0, 0), a2, voffA);
      PG8_WAIT_V(8); PG8_WAIT_L(0); PG8_BAR; PG8_MMA(1, 0, At, B0); PG8_MMA(1, 1, At, B1); PG8_BAR; PG8_SCHED;
      PG8_LDB(B0, 1, 0); PG8_LDB(B1, 1, 1); PG8_SCHED; PG8_LDA(At, 1, 0); PG8_STAGE(PG8_SA(0, 1), a2 + hstepA, voffA);
      PG8_WAIT_V(8); PG8_WAIT_L(0); PG8_BAR; PG8_MMA(0, 0, At, B0); PG8_MMA(0, 1, At, B1); PG8_BAR; PG8_SCHED;
      PG8_LDA(At, 1, 1); PG8_STAGE(PG8_SB(1, 0), b3, voffB); PG8_STAGE(PG8_SB(1, 1), b3 + hstepB, voffB); PG8_STAGE(PG8_SA(1, 0), a3, voffA);
      PG8_WAIT_V(8); PG8_WAIT_L(0); PG8_BAR; PG8_MMA(1, 0, At, B0); PG8_MMA(1, 1, At, B1); PG8_BAR; PG8_SCHED;
    }
    if (wr == 0) PG8_BAR;
    E(acc, cpm, cpn, wr, wc, fr, fq);
    if (!has_next) break;
#pragma unroll
    for (int a = 0; a < 2; ++a)
#pragma unroll
      for (int b = 0; b < 2; ++b)
#pragma unroll
        for (int m = 0; m < 4; ++m)
#pragma unroll
          for (int n = 0; n < 2; ++n) acc[a][b][m][n] = (f32x4){0.f, 0.f, 0.f, 0.f};
    cpm = npm; cpn = npn; cA = nA; cB = nB; ++ui;
    if (wr == 1) PG8_BAR;
  }
  PG8_WAIT_V(0);
  PG8_BAR;
#undef PG8_SA
#undef PG8_SB
#undef PG8_STAGE
#undef PG8_LDA
#undef PG8_LDB
#undef PG8_MMA
}

struct EpiIn {
  const float* rinv; const float* rope; bf16_t* proj; float* kmax2;
  __device__ __forceinline__ void operator()(const f32x4 (&acc)[2][2][4][2], int pm, int pn, int wr, int wc, int fr, int fq) const {
    const bool isrope = (pn >= 6 && pn <= 9); const float qs = (pn == 6 || pn == 7) ? QSCALE : 1.f;
    const bool isk = (pn == 8 || pn == 9);
    float kmx[2] = {0.f, 0.f};
    float ch[4], cl[4];
    if (isrope) {
#pragma unroll
      for (int jj = 0; jj < 4; ++jj) { const int i = (wc & 1) * 16 + fq * 4 + jj; ch[jj] = rope[2 * i]; cl[jj] = rope[2 * i + 1]; }
    }
    float riv[2][4];
#pragma unroll
    for (int ai = 0; ai < 2; ++ai)
#pragma unroll
      for (int m = 0; m < 4; ++m) riv[ai][m] = rinv[pm * BM + ai * HALF + wr * 64 + m * 16 + fr];
#pragma unroll
    for (int ai = 0; ai < 2; ++ai)
#pragma unroll
      for (int m = 0; m < 4; ++m) {
        const int row = pm * BM + ai * HALF + wr * 64 + m * 16 + fr;
        const float ri = riv[ai][m];
        float cs[4], sn[4];
        if (isrope) {
          const float pos = (float)(row < TP ? (row & (S_P - 1)) : (row & (S_S - 1)));
#pragma unroll
          for (int jj = 0; jj < 4; ++jj) {
            const float h = pos * ch[jj], e = fmaf(pos, ch[jj], -h) + pos * cl[jj];
            const float rev = (h - floorf(h)) + e;
            sn[jj] = __builtin_amdgcn_sinf(rev); cs[jj] = __builtin_amdgcn_cosf(rev);
          }
        }
        bf16_t* rowp = proj + (size_t)row * NPROJ + pn * BM + wc * 32 + 8 * fq;
#pragma unroll
        for (int bj = 0; bj < 2; ++bj) {
          f32x4 v0 = acc[ai][bj][m][0] * ri, v1 = acc[ai][bj][m][1] * ri;
          if (isrope) {
#pragma unroll
            for (int jj = 0; jj < 4; ++jj) { const float a = v0[jj], b = v1[jj]; v0[jj] = (a * cs[jj] - b * sn[jj]) * qs; v1[jj] = (b * cs[jj] + a * sn[jj]) * qs; }
          }
          u32x4 w; w.x = cvtpk(v0[0], v0[1]); w.y = cvtpk(v0[2], v0[3]); w.z = cvtpk(v1[0], v1[1]); w.w = cvtpk(v1[2], v1[3]);
          *(u32x4*)(rowp + bj * HALF) = w;
          if (isk) { float ss = v0[0] * v0[0] + v0[1] * v0[1] + v0[2] * v0[2] + v0[3] * v0[3] + v1[0] * v1[0] + v1[1] * v1[1] + v1[2] * v1[2] + v1[3] * v1[3];
            ss += __shfl_xor(ss, 16); ss += __shfl_xor(ss, 32); kmx[bj] = fmaxf(kmx[bj], ss); }
        }
      }
    if (isk) {
      const int row0 = pm * BM, sq = row0 < TP ? (row0 >> 14) : 2 + ((row0 - TP) >> 12);
#pragma unroll
      for (int bj = 0; bj < 2; ++bj) { float v = kmx[bj];
        v = fmaxf(v, __shfl_xor(v, 1)); v = fmaxf(v, __shfl_xor(v, 2)); v = fmaxf(v, __shfl_xor(v, 4)); v = fmaxf(v, __shfl_xor(v, 8));
        if ((fr | fq) == 0) atomicMax((unsigned*)(kmax2 + (sq * 4 + (pn - 8) * 2 + bj) * 4 + wc), __float_as_uint(v)); }
    }
  }
};
struct EpiOut {
  bf16_t* proj;
  __device__ __forceinline__ void operator()(const f32x4 (&acc)[2][2][4][2], int pm, int pn, int wr, int wc, int fr, int fq) const {
#pragma unroll
    for (int ai = 0; ai < 2; ++ai)
#pragma unroll
      for (int m = 0; m < 4; ++m) {
        const int row = pm * BM + ai * HALF + wr * 64 + m * 16 + fr;
        bf16_t* rowp = proj + (size_t)row * NPROJ + C_U + pn * BM + wc * 32 + 8 * fq;
#pragma unroll
        for (int bj = 0; bj < 2; ++bj) { const f32x4 v0 = acc[ai][bj][m][0], v1 = acc[ai][bj][m][1];
          u32x4 w; w.x = cvtpk(v0[0], v0[1]); w.y = cvtpk(v0[2], v0[3]); w.z = cvtpk(v1[0], v1[1]); w.w = cvtpk(v1[2], v1[3]);
          *(u32x4*)(rowp + bj * HALF) = w; }
      }
  }
};
}

__device__ __forceinline__ void bf8_to_f(const u32x4 w, float* v) {
  v[0] = bflo(w.x); v[1] = bfhi(w.x); v[2] = bflo(w.y); v[3] = bfhi(w.y); v[4] = bflo(w.z); v[5] = bfhi(w.z); v[6] = bflo(w.w); v[7] = bfhi(w.w);
}
__device__ void pool_phase(const Params& p, int l, bool dry = false) {
  const int tid = opaque_tid(), c8 = tid & 63, tq = tid >> 6;
  const int g = c8 >> 4, hw = 1 << g;
  const float* sc = p.pool_scale + l * 512 + c8 * 8;
  float scl[8];
#pragma unroll
  for (int e = 0; e < 8; ++e) scl[e] = sc[e];
  for (int ch = blockIdx.x; ch < T_TOK / 128; ch += gridDim.x) {
    const int t0 = ch * 128 + tq * 16;
    const int S = t0 < TP ? S_P : S_S, pos0 = t0 & (S - 1), s0 = t0 - pos0;
    const bf16_t* ub = p.proj + (size_t)s0 * NPROJ + C_U + c8 * 8;
    float sum[8] = {0, 0, 0, 0, 0, 0, 0, 0};
#pragma unroll
    for (int j = 0; j < 16; ++j) {
      const int r = pos0 - hw + j; const bool ok = (j < 2 * hw) && r >= 0 && r < S; const int rc = min(max(r, 0), S - 1);
      float v[8]; bf8_to_f(*(const u32x4*)(ub + (size_t)rc * NPROJ), v); const float m = ok ? 1.f : 0.f;
#pragma unroll
      for (int e = 0; e < 8; ++e) sum[e] = fmaf(m, v[e], sum[e]);
    }
#pragma unroll
    for (int i4 = 0; i4 < 16; i4 += 4) {
      u32x4 wu[4], wz[4], wa[4], wsb[4];
#pragma unroll
      for (int q = 0; q < 4; ++q) {
        const int pos = pos0 + i4 + q, ra = pos + hw, rs = pos - hw;
        wu[q] = *(const u32x4*)(ub + (size_t)pos * NPROJ);
        wz[q] = *(const u32x4*)(p.proj + (size_t)(t0 + i4 + q) * NPROJ + C_ZP + c8 * 8);
        wa[q] = *(const u32x4*)(ub + (size_t)min(ra, S - 1) * NPROJ); wsb[q] = *(const u32x4*)(ub + (size_t)max(rs, 0) * NPROJ);
      }
#pragma unroll
      for (int q = 0; q < 4; ++q) {
        const int pos = pos0 + i4 + q, t = t0 + i4 + q;
        const int lo = max(pos - hw, 0), hi = min(pos + hw, S);
        const float inv = 1.f / (float)(hi - lo);
        float uc[8], z[8], va[8], vs[8], o[8];
        bf8_to_f(wu[q], uc); bf8_to_f(wz[q], z);
#pragma unroll
        for (int e = 0; e < 8; ++e) o[e] = (sum[e] * inv - uc[e]) * scl[e] * silu(z[e]);
        const u32x4 w = {cvtpk(o[0], o[1]), cvtpk(o[2], o[3]), cvtpk(o[4], o[5]), cvtpk(o[6], o[7])};
        if (!dry) *(u32x4*)(p.proj + (size_t)t * NPROJ + C_ZP + c8 * 8) = w;
        const int ra = pos + hw, rs = pos - hw; const float ma = ra < S ? 1.f : 0.f, ms = rs >= 0 ? 1.f : 0.f;
        bf8_to_f(wa[q], va); bf8_to_f(wsb[q], vs);
#pragma unroll
        for (int e = 0; e < 8; ++e) sum[e] = fmaf(ma, va[e], fmaf(-ms, vs[e], sum[e]));
      }
    }
  }
}

namespace at {
constexpr int KVBLK = 64, LDK = NPROJ;
constexpr size_t SHM_V = KVBLK * 128 * 2, SHM_K = KVBLK * 128 * 2;
constexpr float THRL = 11.5f;
#define KSWZ(row, colB) ((row) * 256 + ((colB) ^ (((row) & 7) << 4)))
__device__ __forceinline__ int crow(int r, int hi) { return (r & 3) + 8 * (r >> 2) + 4 * hi; }
template <bool SH> __device__ __forceinline__ void partialSM(f32x16& p0, f32x16& p1, float& m_reg, float& mn, float& alpha) {
  if constexpr (!SH) {
    alpha = 1.f;
    return;
  }
  float pmax = p0[0];
#pragma unroll
  for (int r = 1; r < 16; ++r) pmax = fmaxf(pmax, p0[r]);
#pragma unroll
  for (int r = 0; r < 16; ++r) pmax = fmaxf(pmax, p1[r]);
  { auto rr = __builtin_amdgcn_permlane32_swap(__float_as_uint(pmax), __float_as_uint(pmax), false, false);
    pmax = fmaxf(__uint_as_float(rr[0]), __uint_as_float(rr[1])); }
  if (__builtin_expect(__all(pmax - m_reg <= THRL), 1)) { mn = m_reg; alpha = 1.f; }
  else { mn = fmaxf(m_reg, pmax); alpha = __builtin_amdgcn_exp2f(m_reg - mn); m_reg = mn; }
#pragma unroll
  for (int r = 0; r < 16; ++r) p0[r] = p0[r] - mn;
#pragma unroll
  for (int r = 0; r < 16; ++r) p1[r] = p1[r] - mn;
#pragma unroll
  for (int r = 0; r < 16; ++r) { p0[r] = __builtin_amdgcn_exp2f(p0[r]); p1[r] = __builtin_amdgcn_exp2f(p1[r]); }
}
template <bool SH> __device__ __forceinline__ void finishSM(f32x16& p0, f32x16& p1, float alpha, float& l_reg, bf16x8& pa0, bf16x8& pa1, bf16x8& pa2, bf16x8& pa3) {
  if constexpr (!SH) {
#pragma unroll
    for (int r = 0; r < 16; ++r) { p0[r] = __builtin_amdgcn_exp2f(p0[r]); p1[r] = __builtin_amdgcn_exp2f(p1[r]); }
  }
  float ps = 0;
#pragma unroll
  for (int r = 0; r < 16; ++r) ps += p0[r];
#pragma unroll
  for (int r = 0; r < 16; ++r) ps += p1[r];
  if constexpr (SH) l_reg = l_reg * alpha + ps; else l_reg += ps;
#define PK4(P, BASE, OUT) do { u32x4 w = {cvtpk_b(P[BASE + 0], P[BASE + 1]), cvtpk_b(P[BASE + 2], P[BASE + 3]), cvtpk_b(P[BASE + 4], P[BASE + 5]), cvtpk_b(P[BASE + 6], P[BASE + 7])}; \
    OUT = *reinterpret_cast<bf16x8*>(&w); } while (0)
  PK4(p0, 0, pa0); PK4(p0, 8, pa1); PK4(p1, 0, pa2); PK4(p1, 8, pa3);
#undef PK4
}
__device__ __forceinline__ void qkt(f32x16& p0, f32x16& p1, const char* Ks, const bf16x8* qr, int r32, int hi, int mapB) {
  p0 = f32x16{}; p1 = f32x16{};
#pragma unroll
  for (int d0 = 0; d0 < 4; ++d0) { const int cb = (d0 * 16 + hi * 8) * 2 + mapB;
    bf16x8 b0 = *reinterpret_cast<const bf16x8*>(Ks + KSWZ(r32, cb));
    bf16x8 b1 = *reinterpret_cast<const bf16x8*>(Ks + KSWZ(32 + r32, cb));
    p0 = __builtin_amdgcn_mfma_f32_32x32x16_bf16(b0, qr[d0], p0, 0, 0, 0);
    p1 = __builtin_amdgcn_mfma_f32_32x32x16_bf16(b1, qr[d0], p1, 0, 0, 0); }
}
__device__ __forceinline__ int v_st(int k, int c) { const int kk = (k & ~0xC) | ((k & 4) << 1) | ((k & 8) >> 1); return ((kk >> 3) * 4 + (c >> 5)) * 512 + ((kk & 7) * 32 + (c & 31)) * 2; }
__device__ __forceinline__ int v_rd_base(int lane) { return ((lane & 3) << 3) | (((lane >> 2) & 3) << 6) | (((lane >> 4) & 1) << 5) | (((lane >> 5) & 1) << 8); }
constexpr int v_rd_off(int d0, int ks, int half) { return d0 * 512 + ks * 4096 + half * 2048; }
template <int OFF> __device__ __forceinline__ s16x4 tr_read(int vb) {
  s16x4 r; asm volatile("ds_read_b64_tr_b16 %0, %1 offset:%2" : "=&v"(r) : "v"(vb), "i"(OFF) : "memory"); return r;
}
template <int D0> __device__ __forceinline__ void pv_one(f32x16& od, int vb, bf16x8 pa0, bf16x8 pa1, bf16x8 pa2, bf16x8 pa3) {
  const s16x4 l0 = tr_read<v_rd_off(D0, 0, 0)>(vb), h0 = tr_read<v_rd_off(D0, 0, 1)>(vb), l1 = tr_read<v_rd_off(D0, 1, 0)>(vb), h1 = tr_read<v_rd_off(D0, 1, 1)>(vb);
  const s16x4 l2 = tr_read<v_rd_off(D0, 2, 0)>(vb), h2 = tr_read<v_rd_off(D0, 2, 1)>(vb), l3 = tr_read<v_rd_off(D0, 3, 0)>(vb), h3 = tr_read<v_rd_off(D0, 3, 1)>(vb);
  asm volatile("s_waitcnt lgkmcnt(0)" ::: "memory"); SBAR();
#define PK(L, H) (bf16x8){L[0], L[1], L[2], L[3], H[0], H[1], H[2], H[3]}
  od = __builtin_amdgcn_mfma_f32_32x32x16_bf16(pa0, PK(l0, h0), od, 0, 0, 0);
  od = __builtin_amdgcn_mfma_f32_32x32x16_bf16(pa1, PK(l1, h1), od, 0, 0, 0);
  od = __builtin_amdgcn_mfma_f32_32x32x16_bf16(pa2, PK(l2, h2), od, 0, 0, 0);
  od = __builtin_amdgcn_mfma_f32_32x32x16_bf16(pa3, PK(l3, h3), od, 0, 0, 0);
#undef PK
}
__device__ __forceinline__ void pv_d0(f32x16* o, int vb, bf16x8 pa0, bf16x8 pa1, bf16x8 pa2, bf16x8 pa3) {
  pv_one<0>(o[0], vb, pa0, pa1, pa2, pa3); pv_one<1>(o[1], vb, pa0, pa1, pa2, pa3); pv_one<2>(o[2], vb, pa0, pa1, pa2, pa3); pv_one<3>(o[3], vb, pa0, pa1, pa2, pa3);
}

struct VFrag { s16x4 l0, h0, l1, h1, l2, h2, l3, h3; };
template <int D0> __device__ __forceinline__ void v_frag_read(VFrag& f, int vb) {
  f.l0 = tr_read<v_rd_off(D0, 0, 0)>(vb); f.h0 = tr_read<v_rd_off(D0, 0, 1)>(vb); f.l1 = tr_read<v_rd_off(D0, 1, 0)>(vb); f.h1 = tr_read<v_rd_off(D0, 1, 1)>(vb);
  f.l2 = tr_read<v_rd_off(D0, 2, 0)>(vb); f.h2 = tr_read<v_rd_off(D0, 2, 1)>(vb); f.l3 = tr_read<v_rd_off(D0, 3, 0)>(vb); f.h3 = tr_read<v_rd_off(D0, 3, 1)>(vb);
}
__device__ __forceinline__ void v_frag_mma(f32x16& od, const VFrag& f, bf16x8 pa0, bf16x8 pa1, bf16x8 pa2, bf16x8 pa3) {
#define PK(L, H) (bf16x8){L[0], L[1], L[2], L[3], H[0], H[1], H[2], H[3]}
  od = __builtin_amdgcn_mfma_f32_32x32x16_bf16(pa0, PK(f.l0, f.h0), od, 0, 0, 0);
  od = __builtin_amdgcn_mfma_f32_32x32x16_bf16(pa1, PK(f.l1, f.h1), od, 0, 0, 0);
  od = __builtin_amdgcn_mfma_f32_32x32x16_bf16(pa2, PK(f.l2, f.h2), od, 0, 0, 0);
  od = __builtin_amdgcn_mfma_f32_32x32x16_bf16(pa3, PK(f.l3, f.h3), od, 0, 0, 0);
#undef PK
}
template <bool PRE> __device__ __forceinline__ void pv_d0_pipe(f32x16* o, int vb, bf16x8 pa0, bf16x8 pa1, bf16x8 pa2, bf16x8 pa3, VFrag& fa) {
  VFrag fb;
  if constexpr (!PRE) v_frag_read<0>(fa, vb);
  asm volatile("s_waitcnt lgkmcnt(0)" ::: "memory"); SBAR();
  v_frag_read<1>(fb, vb); SBAR(); v_frag_mma(o[0], fa, pa0, pa1, pa2, pa3); SBAR(); asm volatile("s_waitcnt lgkmcnt(0)" ::: "memory"); SBAR();
  v_frag_read<2>(fa, vb); SBAR(); v_frag_mma(o[1], fb, pa0, pa1, pa2, pa3); SBAR(); asm volatile("s_waitcnt lgkmcnt(0)" ::: "memory"); SBAR();
  v_frag_read<3>(fb, vb); SBAR(); v_frag_mma(o[2], fa, pa0, pa1, pa2, pa3); SBAR(); asm volatile("s_waitcnt lgkmcnt(0)" ::: "memory"); SBAR();
  v_frag_mma(o[3], fb, pa0, pa1, pa2, pa3);
}

template <bool SH> __device__ __forceinline__ void attn_unit(bf16_t* __restrict__ proj, int tok0, int kv0, int seq, int h, float lam, float oscale, const float* __restrict__ subg, char* lds, bool dry) {
  const int tid = opaque_tid(), wid = __builtin_amdgcn_readfirstlane(tid >> 6), lane = tid & 63, r32 = lane & 31, hi = lane >> 5;
  const int wq = wid & 3, mp = wid >> 2, mapB = mp * 128;
  constexpr int RING = 32768, NRING = 4;
  LAS char* ldsl = (LAS char*)lds;
  float* ws = (float*)(lds + NRING * RING) + wid * 64; float* li_l = ws; float* al_l = ws + 32;
  const bf16_t* Kh = proj + (size_t)kv0 * NPROJ + C_K + h * 128;
  const bf16_t* Vh = proj + (size_t)kv0 * NPROJ + C_V + h * 128;
  float m_reg = -1e30f, l_reg = 0; f32x16 o[4] = {}; bf16x8 qr[4];
  const bf16_t* Qw = proj + (size_t)(tok0 + wq * 32 + r32) * NPROJ + C_Q + h * 128 + mp * 64 + hi * 8;
#pragma unroll
  for (int d0 = 0; d0 < 4; ++d0) qr[d0] = *reinterpret_cast<const bf16x8*>(Qw + d0 * 16);
  unsigned vk0, vv0;
  { const int c = tid;
    { const int row = c >> 4, pc = c & 15, scn = pc ^ (row & 7); vk0 = (unsigned)(row * LDK + scn * 8) * 2u; }
    { const int sub = c >> 5, kk = (sub >> 2) * 8 + ((c >> 2) & 7), col = (sub & 3) * 32 + (c & 3) * 8; vv0 = (unsigned)(kk * LDK + col) * 2u; } }
  const unsigned ldsb = (unsigned)(uintptr_t)ldsl;
  const int vbb = (int)(uintptr_t)ldsl + 16384 + v_rd_base(lane);
#define GLDS16(src, dst) __builtin_amdgcn_global_load_lds((const unsigned*)(src), (LAS unsigned*)(dst), 16, 0, 0)
#define DMA(t, b) do { const char* kg_ = (const char*)(Kh + (size_t)(t) * (KVBLK * LDK)); const char* vg_ = (const char*)(Vh + (size_t)(t) * (KVBLK * LDK)); \
    const char* kg1_ = kg_ + 32 * LDK * 2; const char* vg1_ = vg_ + 32 * LDK * 2; const unsigned d_ = ldsb + (b) * RING + wid * 1024; unsigned keep_; \
    asm volatile("s_mov_b32 %0, m0\n\t" \
                 "s_mov_b32 m0, %1\n\ts_nop 0\n\tglobal_load_lds_dwordx4 %5, %7\n\t" \
                 "s_mov_b32 m0, %2\n\ts_nop 0\n\tglobal_load_lds_dwordx4 %5, %8\n\t" \
                 "s_mov_b32 m0, %3\n\ts_nop 0\n\tglobal_load_lds_dwordx4 %6, %9\n\t" \
                 "s_mov_b32 m0, %4\n\ts_nop 0\n\tglobal_load_lds_dwordx4 %6, %10\n\t" \
                 "s_mov_b32 m0, %0" \
                 : "=&s"(keep_) : "s"(d_), "s"(d_ + 8192u), "s"(d_ + 16384u), "s"(d_ + 16384u + 8192u), "v"(vk0), "v"(vv0), "s"(kg_), "s"(kg1_), "s"(vg_), "s"(vg1_) : "memory"); } while (0)
#define DMA1X(t, b, q, ws) do { const char* g_ = (const char*)(((q) < 2 ? Kh : Vh) + (size_t)(t) * (KVBLK * LDK)) + (((q) & 1) ? 32 * LDK * 2 : 0) + ((ws) - wid) * (4 * LDK * 2); \
    const unsigned d_ = ldsb + (b) * RING + (ws) * 1024 + (q) * 8192u; unsigned keep_; \
    asm volatile("s_mov_b32 %0, m0\n\ts_mov_b32 m0, %1\n\ts_nop 0\n\tglobal_load_lds_dwordx4 %2, %3\n\ts_mov_b32 m0, %0" \
                 : "=&s"(keep_) : "s"(d_), "v"((q) < 2 ? vk0 : vv0), "s"(g_) : "memory"); } while (0)
#define DMA1(t, b, q) DMA1X(t, b, q, wid)
#define DMAV(t, b) do { DMA1(t, b, 2); DMA1(t, b, 3); } while (0)
#define KBUF(b) ((const char*)lds + (b) * RING)
#define VBUF(b) (vbb + (b) * RING)
#define LANDED() do { asm volatile("s_waitcnt vmcnt(0)" ::: "memory"); __syncthreads(); } while (0)
#define RESC(a) do { if (SH && __any((a) < 1.f)) { if (hi == 0) al_l[r32] = (a); asm volatile("s_waitcnt lgkmcnt(0)" ::: "memory"); \
    _Pragma("unroll") for (int d = 0; d < 4; ++d) _Pragma("unroll") for (int r = 0; r < 16; ++r) o[d][r] *= al_l[crow(r, hi)]; } } while (0)
  f32x16 pA0, pA1, pB0, pB1; float mnA, mnB, alA, alB; bf16x8 pa0, pa1, pa2, pa3; const int NT = seq / KVBLK;
#define BLK_X(N0, N1, P0, P1, alP, t) do { SBAR(); __builtin_amdgcn_s_setprio(1); qkt(N0, N1, KBUF((t) & 3), qr, r32, hi, mapB); \
    if constexpr (!SH) v_frag_read<0>(vfa, VBUF(((t) - 1) & 3)); \
    finishSM<SH>(P0, P1, alP, l_reg, pa0, pa1, pa2, pa3); __builtin_amdgcn_s_setprio(0); SBAR(); } while (0)
#define BLK_Y(C0, C1, mnC, alC, t) do { if constexpr (SH) pv_d0(o, VBUF((t) & 3), pa0, pa1, pa2, pa3); else pv_d0_pipe<true>(o, VBUF((t) & 3), pa0, pa1, pa2, pa3, vfa); partialSM<SH>(C0, C1, m_reg, mnC, alC); RESC(alC); } while (0)
#define BLK_Y1(C0, C1, mnC, alC, t, td) do { if constexpr (SH) { DMA(td, (td) & 3); DMA1X(td, (td) & 3, 0, wid - 4); DMA1X(td, (td) & 3, 1, wid - 4); pv_d0(o, VBUF((t) & 3), pa0, pa1, pa2, pa3); } else { \
      const int vb_ = VBUF((t) & 3); VFrag fb_; \
      asm volatile("s_waitcnt lgkmcnt(0)" ::: "memory"); SBAR(); \
      v_frag_read<1>(fb_, vb_); SBAR(); v_frag_mma(o[0], vfa, pa0, pa1, pa2, pa3); DMA1(td, (td) & 3, 0); DMA1X(td, (td) & 3, 0, wid - 4); SBAR(); asm volatile("s_waitcnt lgkmcnt(0)" ::: "memory"); SBAR(); \
      v_frag_read<2>(vfa, vb_); SBAR(); v_frag_mma(o[1], fb_, pa0, pa1, pa2, pa3); DMA1(td, (td) & 3, 1); DMA1X(td, (td) & 3, 1, wid - 4); SBAR(); asm volatile("s_waitcnt lgkmcnt(0)" ::: "memory"); SBAR(); \
      v_frag_read<3>(fb_, vb_); SBAR(); v_frag_mma(o[2], vfa, pa0, pa1, pa2, pa3); DMA1(td, (td) & 3, 2); SBAR(); asm volatile("s_waitcnt lgkmcnt(0)" ::: "memory"); SBAR(); \
      v_frag_mma(o[3], fb_, pa0, pa1, pa2, pa3); DMA1(td, (td) & 3, 3); SBAR(); } \
    partialSM<SH>(C0, C1, m_reg, mnC, alC); RESC(alC); } while (0)
  const int ty = STAGGER_MAP ? mp : (wid & 1);
  VFrag vfa;
  DMA(0, 0); LANDED();
  DMA(1, 1);
  if (ty == 0) {
    qkt(pA0, pA1, KBUF(0), qr, r32, hi, mapB); partialSM<SH>(pA0, pA1, m_reg, mnA, alA);
    LANDED();
    for (int j = 1; j + 1 < NT; j += 2) {
      BLK_X(pB0, pB1, pA0, pA1, alA, j); DMAV(j + 1, (j + 1) & 3); BLK_Y(pB0, pB1, mnB, alB, j - 1); LANDED();
      BLK_X(pA0, pA1, pB0, pB1, alB, j + 1); DMAV(j + 2, (j + 2) & 3); BLK_Y(pA0, pA1, mnA, alA, j); LANDED();
    }
    BLK_X(pB0, pB1, pA0, pA1, alA, NT - 1); BLK_Y(pB0, pB1, mnB, alB, NT - 2);
    finishSM<SH>(pB0, pB1, alB, l_reg, pa0, pa1, pa2, pa3); SBAR();
    if constexpr (SH) pv_d0(o, VBUF((NT - 1) & 3), pa0, pa1, pa2, pa3); else pv_d0_pipe<false>(o, VBUF((NT - 1) & 3), pa0, pa1, pa2, pa3, vfa);
  } else {
    qkt(pA0, pA1, KBUF(0), qr, r32, hi, mapB);
    LANDED();
    DMA(2, 2); DMA1X(2, 2, 0, wid - 4); DMA1X(2, 2, 1, wid - 4); partialSM<SH>(pA0, pA1, m_reg, mnA, alA); BLK_X(pB0, pB1, pA0, pA1, alA, 1); LANDED();
    for (int j = 2; j + 2 < NT; j += 2) {
      BLK_Y1(pB0, pB1, mnB, alB, j - 2, j + 1); BLK_X(pA0, pA1, pB0, pB1, alB, j); LANDED();
      BLK_Y1(pA0, pA1, mnA, alA, j - 1, j + 2); BLK_X(pB0, pB1, pA0, pA1, alA, j + 1); LANDED();
    }
    BLK_Y1(pB0, pB1, mnB, alB, NT - 4, NT - 1); BLK_X(pA0, pA1, pB0, pB1, alB, NT - 2); LANDED();
    BLK_Y(pA0, pA1, mnA, alA, NT - 3); BLK_X(pB0, pB1, pA0, pA1, alA, NT - 1);
    BLK_Y(pB0, pB1, mnB, alB, NT - 2);
    finishSM<SH>(pB0, pB1, alB, l_reg, pa0, pa1, pa2, pa3); SBAR();
    if constexpr (SH) pv_d0(o, VBUF((NT - 1) & 3), pa0, pa1, pa2, pa3); else pv_d0_pipe<false>(o, VBUF((NT - 1) & 3), pa0, pa1, pa2, pa3, vfa);
  }
#undef BLK_X
#undef BLK_Y
#undef BLK_Y1
#undef DMA1
#undef DMA1X
#undef DMAV
  u32x4 zg[4];
  bf16_t* zp = proj + (size_t)(tok0 + (tid >> 2)) * NPROJ + C_ZA + h * 128 + (tid & 3) * 32;
#pragma unroll
  for (int i = 0; i < 4; ++i) zg[i] = *(const u32x4*)(zp + i * 8);
  l_reg += __shfl_xor(l_reg, 32);
  if (hi == 0) li_l[r32] = l_reg; asm volatile("s_waitcnt lgkmcnt(0)" ::: "memory");
  float rli[16];
#pragma unroll
  for (int r = 0; r < 16; ++r) rli[r] = __builtin_amdgcn_rcpf(li_l[crow(r, hi)]);
  __syncthreads();
  float* X = (float*)lds;
  if (mp == 1) {
#pragma unroll
    for (int d = 0; d < 4; ++d)
#pragma unroll
      for (int r = 0; r < 16; ++r) X[(wq * 64 + d * 16 + r) * 64 + lane] = o[d][r] * rli[r] * lam;
  }
  __syncthreads();
  if (mp == 0) {
#pragma unroll
    for (int d = 0; d < 4; ++d)
#pragma unroll
      for (int r = 0; r < 16; ++r) { const int ix = (wq * 64 + d * 16 + r) * 64 + lane; X[ix] = o[d][r] * rli[r] - X[ix]; }
  }
  __syncthreads();
  {
    const int row = tid >> 2, dq = tid & 3, rl = row & 31, w = row >> 5, hh = (rl >> 2) & 1, r = (rl & 3) + 4 * (rl >> 3);
    const float* xb = X + (w * 64 + dq * 16 + r) * 64 + hh * 32;
    f32x4 a[8]; float ss = 0.f;
#pragma unroll
    for (int i = 0; i < 8; ++i) { a[i] = *(const f32x4*)(xb + i * 4); ss += a[i][0] * a[i][0] + a[i][1] * a[i][1] + a[i][2] * a[i][2] + a[i][3] * a[i][3]; }
    ss += __shfl_xor(ss, 1); ss += __shfl_xor(ss, 2);
    const float rn = __builtin_amdgcn_rsqf(ss * (1.f / 128.f) + 1e-5f) * oscale;
    const float* gg = subg + dq * 32;
#pragma unroll
    for (int i = 0; i < 4; ++i) {
      const u32x4 z = zg[i];
      const f32x4 a0 = a[2 * i], a1 = a[2 * i + 1]; const f32x4 g0 = *(const f32x4*)(gg + i * 8), g1 = *(const f32x4*)(gg + i * 8 + 4);
      u32x4 wv;
      wv.x = cvtpk(a0[0] * rn * g0[0] * silu(bflo(z.x)), a0[1] * rn * g0[1] * silu(bfhi(z.x)));
      wv.y = cvtpk(a0[2] * rn * g0[2] * silu(bflo(z.y)), a0[3] * rn * g0[3] * silu(bfhi(z.y)));
      wv.z = cvtpk(a1[0] * rn * g1[0] * silu(bflo(z.z)), a1[1] * rn * g1[1] * silu(bfhi(z.z)));
      wv.w = cvtpk(a1[2] * rn * g1[2] * silu(bflo(z.w)), a1[3] * rn * g1[3] * silu(bfhi(z.w)));
      if (!dry) *(u32x4*)(zp + i * 8) = wv;
    }
  }
  __syncthreads();
#undef DMA
#undef GLDS16
#undef KBUF
#undef VBUF
#undef LANDED
#undef RESC
}

__device__ void attn_phase(const Params& p, int l, char* lds, bool dry = false) {
  const float lam = p.lam[l];
  const float oscale = 1.f - (0.8f - 0.6f * expf(-0.3f * (float)l));
  const float* subg = p.subln_g + l * 128;
  for (int u = blockIdx.x; u < 2048; u += gridDim.x) {
    int tok0, kv0, seq, h;
    if (u < 1024) { const int x = u & 7, j = u >> 3; const int b = x >> 2; h = x & 3; seq = S_P; kv0 = b * S_P; tok0 = kv0 + j * 128; }
    else { const int v = u - 1024, x = v & 7, j = v >> 3; const int pr = x * 4 + (j >> 5), b = pr >> 2; h = pr & 3; seq = S_S; kv0 = TP + b * S_S; tok0 = kv0 + (j & 31) * 128; }
    bool need;
    { const int tid = opaque_tid(), wid = tid >> 6, lane = tid & 63, r32 = lane & 31, hi = lane >> 5, wq = wid & 3, mp = wid >> 2;
      const int sq = tok0 < TP ? (tok0 >> 14) : 2 + ((tok0 - TP) >> 12);
      const float* km = p.kmax2 + ((l * 10 + sq) * 4 + h) * 4 + mp * 2;
      const float kmx = sqrtf(km[0] + km[1]) * 1.01f;
      const bf16_t* Qw = p.proj + (size_t)(tok0 + wq * 32 + r32) * NPROJ + C_Q + h * 128 + mp * 64 + hi * 8;
      float ss = 0.f;
#pragma unroll
      for (int d0 = 0; d0 < 4; ++d0) { const u32x4 w = *(const u32x4*)(Qw + d0 * 16);
        ss += bflo(w.x) * bflo(w.x) + bfhi(w.x) * bfhi(w.x) + bflo(w.y) * bflo(w.y) + bfhi(w.y) * bfhi(w.y) + bflo(w.z) * bflo(w.z) + bfhi(w.z) * bfhi(w.z) + bflo(w.w) * bflo(w.w) + bfhi(w.w) * bfhi(w.w); }
      ss += __shfl_xor(ss, 32);
      need = __any(!(sqrtf(ss) * kmx < 100.f)) != 0; }
    if (need) attn_unit<true>(p.proj, tok0, kv0, seq, h, lam, oscale, subg, lds, dry);
    else attn_unit<false>(p.proj, tok0, kv0, seq, h, lam, oscale, subg, lds, dry);
  }
}
}

__device__ void post_phase(const Params& p, int l) {
  const int tid = opaque_tid(), wid = tid >> 6, lane = tid & 63, nw = blockDim.x >> 6;
  const float* pg = p.post_g + l * DM;
  constexpr int R = 2;
  for (int row0 = (blockIdx.x * nw + wid) * R; row0 < T_TOK; row0 += gridDim.x * nw * R) {
    f32x4 y[R][4], x[R][4]; u32x2 xh[R][4], xl[R][4], yb[R][4];
#pragma unroll
    for (int q = 0; q < R; ++q) {
      const int row = row0 + q;
      const bf16_t* yr = p.proj + (size_t)row * NPROJ + C_U;
#pragma unroll
      for (int i = 0; i < 4; ++i) yb[q][i] = __builtin_nontemporal_load((const u32x2*)(yr + i * 256 + lane * 4));
      if (l == 0) {
        const float* xr = row < TP ? p.xp + (size_t)row * DM : p.xs + (size_t)(row - TP) * DM;
#pragma unroll
        for (int i = 0; i < 4; ++i) x[q][i] = __builtin_nontemporal_load((const f32x4*)(xr + i * 256 + lane * 4));
      } else {
        const bf16_t* xo = (const bf16_t*)p.out + (size_t)row * LDX;
#pragma unroll
        for (int i = 0; i < 4; ++i) { xh[q][i] = __builtin_nontemporal_load((const u32x2*)(xo + i * 256 + lane * 4)); xl[q][i] = __builtin_nontemporal_load((const u32x2*)(xo + DM + i * 256 + lane * 4)); }
      }
    }
#pragma unroll
    for (int q = 0; q < R; ++q) {
      const int row = row0 + q;
      bf16_t* xo = (bf16_t*)p.out + (size_t)row * LDX;
      float ss = 0.f;
#pragma unroll
      for (int i = 0; i < 4; ++i) { y[q][i] = (f32x4){bflo(yb[q][i].x), bfhi(yb[q][i].x), bflo(yb[q][i].y), bfhi(yb[q][i].y)};
        ss += y[q][i][0] * y[q][i][0] + y[q][i][1] * y[q][i][1] + y[q][i][2] * y[q][i][2] + y[q][i][3] * y[q][i][3]; }
      if (l != 0) {
#pragma unroll
        for (int i = 0; i < 4; ++i) {
          const u32x2 h = xh[q][i], lo = xl[q][i];
          x[q][i][0] = bflo(h.x) + bflo(lo.x); x[q][i][1] = bfhi(h.x) + bfhi(lo.x); x[q][i][2] = bflo(h.y) + bflo(lo.y); x[q][i][3] = bfhi(h.y) + bfhi(lo.y);
        }
      }
      ss = wave_sum(ss);
      const float ry = __builtin_amdgcn_rsqf(ss * (1.f / DM) + 1e-6f);
      float s2 = 0.f;
#pragma unroll
      for (int i = 0; i < 4; ++i) {
        const f32x4 g = *(const f32x4*)(pg + i * 256 + lane * 4);
#pragma unroll
        for (int e = 0; e < 4; ++e) { x[q][i][e] = x[q][i][e] + y[q][i][e] * ry * g[e]; s2 += x[q][i][e] * x[q][i][e]; }
      }
      if (l == DEPTH - 1) {
        float* orow = p.out + (size_t)row * DM;
#pragma unroll
        for (int i = 0; i < 4; ++i) __builtin_nontemporal_store(x[q][i], (f32x4*)(orow + i * 256 + lane * 4));
      } else {
        s2 = wave_sum(s2);
        if (lane == 0) p.rinv[row] = __builtin_amdgcn_rsqf(s2 * (1.f / DM) + 1e-6f);
#pragma unroll
        for (int i = 0; i < 4; ++i) {
          const unsigned h0 = cvtpk(x[q][i][0], x[q][i][1]), h1 = cvtpk(x[q][i][2], x[q][i][3]);
          const unsigned l0 = cvtpk(x[q][i][0] - bflo(h0), x[q][i][1] - bfhi(h0)), l1 = cvtpk(x[q][i][2] - bflo(h1), x[q][i][3] - bfhi(h1));
          *(u32x2*)(xo + i * 256 + lane * 4) = (u32x2){h0, h1}; *(u32x2*)(xo + DM + i * 256 + lane * 4) = (u32x2){l0, l1};
        }
      }
    }
  }
}

#define XB_TMO      128
#define XB_XCNT(j)  (256  + 64 * (j))
#define XB_XSUB(j)  (1280 + 64 * (j))
#define XB_XGEN(j)  (2304 + 64 * (j))
#define XB_TOP      3328
#define XB_TOPGEN   3392
#define XB_SPIN_CAP (1u << 22)
#define XLAS __attribute__((address_space(3)))
__device__ __forceinline__ unsigned xb_ld(unsigned* p)              { return __hip_atomic_load(p, __ATOMIC_RELAXED, __HIP_MEMORY_SCOPE_AGENT); }
__device__ __forceinline__ unsigned xb_add(unsigned* p, unsigned v) { return __hip_atomic_fetch_add(p, v, __ATOMIC_RELAXED, __HIP_MEMORY_SCOPE_AGENT); }
__device__ __forceinline__ unsigned xb_xcc_id() { return (unsigned)__builtin_amdgcn_s_getreg((3 << 11) | 20) & 0xFu; }
#define XB_SPIN(cond, bar) do { unsigned _sp = 0; while (cond) { __builtin_amdgcn_s_sleep(1); \
    if ((++_sp & 255u) == 0u) { if (xb_ld(&(bar)[XB_TMO])) break; if (_sp > XB_SPIN_CAP) { atomicAdd(&(bar)[XB_TMO], 1u); break; } } } } while (0)
struct XcdBarrier { unsigned* bar; unsigned x; volatile XLAS unsigned* st; };
__device__ __forceinline__ XcdBarrier xcd_barrier_post(unsigned* bar, volatile XLAS unsigned* st) {
  XcdBarrier b; b.bar = bar; b.x = xb_xcc_id(); b.st = st;
  if (threadIdx.x == 0) (void)xb_add(&bar[XB_XCNT(b.x)], 1u);
  return b;
}
__device__ __forceinline__ void xcd_barrier_complete(unsigned* bar, unsigned x, unsigned& nloc, unsigned& nx) {
  const unsigned G = gridDim.x * gridDim.y * gridDim.z;
  unsigned sum, cnt, mine, sp = 0u;
  for (;;) {
    sum = 0u; cnt = 0u; mine = 0u;
#pragma unroll
    for (unsigned j = 0; j < 16; ++j) { const unsigned c = xb_ld(&bar[XB_XCNT(j)]); sum += c; cnt += (c > 0u) ? 1u : 0u; mine = (j == x) ? c : mine; }
    if (sum == G) break;
    __builtin_amdgcn_s_sleep(1);
    if ((++sp & 255u) == 0u) { if (xb_ld(&bar[XB_TMO])) break; if (sp > XB_SPIN_CAP) { atomicAdd(&bar[XB_TMO], 1u); break; } }
  }
  nloc = mine > 0u ? mine : 1u; nx = cnt > 0u ? cnt : 1u;
}
__device__ __forceinline__ void xcd_barrier(const XcdBarrier& b) {
  asm volatile("s_waitcnt vmcnt(0)" ::: "memory");
  __syncthreads();
  if (threadIdx.x == 0) {
    unsigned* bar = b.bar;
    __builtin_amdgcn_s_waitcnt(0);
    unsigned nloc = b.st[0], nx = b.st[1];
    if (nloc == 0u) { xcd_barrier_complete(bar, b.x, nloc, nx); b.st[0] = nloc; b.st[1] = nx; }
    const unsigned old = xb_add(&bar[XB_XSUB(b.x)], 1u);
    const unsigned gen = old / nloc;
    if (old + 1u == (gen + 1u) * nloc) {
      __builtin_amdgcn_fence(__ATOMIC_RELEASE, "agent");
      asm volatile("s_waitcnt vmcnt(0)" ::: "memory");
      const unsigned og = xb_add(&bar[XB_TOP], 1u);
      const unsigned tg = og / nx;
      if (og + 1u == (tg + 1u) * nx) xb_add(&bar[XB_TOPGEN], 1u);
      else XB_SPIN(xb_ld(&bar[XB_TOPGEN]) == tg, bar);
      __builtin_amdgcn_fence(__ATOMIC_ACQUIRE, "agent");
      xb_add(&bar[XB_XGEN(b.x)], 1u);
      asm volatile("s_waitcnt vmcnt(0)" ::: "memory");
    } else {
      XB_SPIN(xb_ld(&bar[XB_XGEN(b.x)]) == gen, bar);
      __builtin_amdgcn_fence(__ATOMIC_ACQUIRE, "agent");
      asm volatile("s_waitcnt vmcnt(0)" ::: "memory");
    }
  }
  __syncthreads();
}

__device__ __forceinline__ void run_phase(const Params& p, int ph, char* shm) {
  if (ph == 0) { phase0(p, shm); return; }
  const int l = (ph - 1) >> 2, s = (ph - 1) & 3;
  if (s == 0) { gm::EpiIn e{p.rinv, p.rope, p.proj, p.kmax2 + l * 160}; gm::gemm_phase(( const bf16_t*)p.out, LDX, p.WinT + (size_t)l * NPROJ * DM, NPROJ, e, shm); }
  else if (s == 1) { pool_phase(p, l); at::attn_phase(p, l, shm); }
  else if (s == 2) { gm::EpiOut e{p.proj}; gm::gemm_phase(p.proj, NPROJ, p.WoutT + (size_t)l * DM * DM, DM, e, shm); }
  else post_phase(p, l);
}

#if MK_MULTI
template <int S> __global__ void __launch_bounds__(NT_THREADS, 1) k_phase(Params p, int l) {
  extern __shared__ __attribute__((aligned(16))) char shm[];
  if (S == 0) phase0(p, shm); else run_phase(p, 1 + 4 * l + (S - 1), shm);
}
#else
__global__ void __launch_bounds__(NT_THREADS, 1) k_mega(Params p) {
  extern __shared__ __attribute__((aligned(16))) char shm[];
  cg::grid_group grid = cg::this_grid();
  volatile XLAS unsigned* xst = (volatile XLAS unsigned*)(XLAS char*)(shm + 131072 + 3072);
  if (threadIdx.x == 0) { xst[0] = 0u; xst[1] = 0u; xst[2] = 0u; xst[3] = 0u; }
  phase0(p, shm);
  grid.sync();
  (void)xcd_barrier_post(p.bar, xst);
#define GSYNC() do { XcdBarrier xb_; xb_.bar = p.bar; xb_.x = xb_xcc_id(); xb_.st = xst; xcd_barrier(xb_); } while (0)
  for (int l = 0; l < DEPTH; ++l) {
#if REP_GEMM
    { gm::EpiIn e{p.rinv, p.rope, p.proj, p.kmax2 + l * 160}; gm::gemm_phase((const bf16_t*)p.out, LDX, p.WinT + (size_t)l * NPROJ * DM, NPROJ, e, shm); }
    GSYNC();
#endif
    { gm::EpiIn e{p.rinv, p.rope, p.proj, p.kmax2 + l * 160}; gm::gemm_phase((const bf16_t*)p.out, LDX, p.WinT + (size_t)l * NPROJ * DM, NPROJ, e, shm); }
    GSYNC();
    pool_phase(p, l);
#if REP_ATT
    at::attn_phase(p, l, shm, true); GSYNC();
#endif
    at::attn_phase(p, l, shm);
    GSYNC();
#if REP_GEMM
    { gm::EpiOut e{p.proj}; gm::gemm_phase(p.proj, NPROJ, p.WoutT + (size_t)l * DM * DM, DM, e, shm); }
    GSYNC();
#endif
    { gm::EpiOut e{p.proj}; gm::gemm_phase(p.proj, NPROJ, p.WoutT + (size_t)l * DM * DM, DM, e, shm); }
    GSYNC();
#if REP_POST
    if (l == 0) { post_phase(p, l); GSYNC(); }
#endif
    post_phase(p, l);
    if (l + 1 < DEPTH) GSYNC();
  }
}
#endif

extern "C" void kernel_launch(void* const* d_in, const int* in_sizes, int n_in, void* d_out, int out_size, void* d_ws, size_t ws_size, hipStream_t stream) {
  Params p{};
  p.xp = (const float*)d_in[0]; p.xs = (const float*)d_in[1]; p.pre_g = (const float*)d_in[2]; p.w_in = (const float*)d_in[3];
  p.pool_w = (const float*)d_in[4]; p.pool_scale = (const float*)d_in[5]; p.lq1 = (const float*)d_in[6]; p.lk1 = (const float*)d_in[7];
  p.lq2 = (const float*)d_in[8]; p.lk2 = (const float*)d_in[9]; p.subln_g = (const float*)d_in[10]; p.w_out = (const float*)d_in[11]; p.post_g = (const float*)d_in[12];
  p.out = (float*)d_out;
  char* w = (char*)d_ws; size_t off = 0;
  p.proj = (bf16_t*)(w + off); off += (size_t)T_TOK * NPROJ * 2;
  p.WinT = (bf16_t*)(w + off); off += (size_t)DEPTH * NPROJ * DM * 2;
  p.WoutT = (bf16_t*)(w + off); off += (size_t)DEPTH * DM * DM * 2;
  p.rinv = (float*)(w + off); off += (size_t)T_TOK * 4;
  p.rope = (float*)(w + off); off += 256;
  p.lam = (float*)(w + off); off += 256;
  p.kmax2 = (float*)(w + off); off += 2048;
  p.bar = (unsigned*)(w + off); off += 16384;
  if (off > ws_size) { fprintf(stderr, "kernel_launch: workspace too small (%zu > %zu)\n", off, ws_size); return; }
#if MK_MULTI
  static int ok = 0;
  if (!ok) {
    (void)hipFuncSetAttribute((const void*)k_phase<0>, hipFuncAttributeMaxDynamicSharedMemorySize, (int)SHM_BYTES);
    (void)hipFuncSetAttribute((const void*)k_phase<1>, hipFuncAttributeMaxDynamicSharedMemorySize, (int)SHM_BYTES);
    (void)hipFuncSetAttribute((const void*)k_phase<2>, hipFuncAttributeMaxDynamicSharedMemorySize, (int)SHM_BYTES);
    (void)hipFuncSetAttribute((const void*)k_phase<3>, hipFuncAttributeMaxDynamicSharedMemorySize, (int)SHM_BYTES);
    (void)hipFuncSetAttribute((const void*)k_phase<4>, hipFuncAttributeMaxDynamicSharedMemorySize, (int)SHM_BYTES);
    ok = 1; }
  hipLaunchKernelGGL(k_phase<0>, dim3(256), dim3(NT_THREADS), SHM_BYTES, stream, p, 0);
  for (int l = 0; l < DEPTH; ++l) {
    hipLaunchKernelGGL(k_phase<1>, dim3(256), dim3(NT_THREADS), SHM_BYTES, stream, p, l);
    hipLaunchKernelGGL(k_phase<2>, dim3(256), dim3(NT_THREADS), SHM_BYTES, stream, p, l);
    hipLaunchKernelGGL(k_phase<3>, dim3(256), dim3(NT_THREADS), SHM_BYTES, stream, p, l);
    hipLaunchKernelGGL(k_phase<4>, dim3(256), dim3(NT_THREADS), SHM_BYTES, stream, p, l);
  }
#else
  static int grid_blocks = 0;
  if (!grid_blocks) {
    (void)hipFuncSetAttribute((const void*)k_mega, hipFuncAttributeMaxDynamicSharedMemorySize, (int)SHM_BYTES);
    int dev = 0, cus = 0, per_cu = 0;
    (void)hipGetDevice(&dev);
    (void)hipDeviceGetAttribute(&cus, hipDeviceAttributeMultiprocessorCount, dev);
    (void)hipOccupancyMaxActiveBlocksPerMultiprocessor(&per_cu, k_mega, NT_THREADS, SHM_BYTES);
    if (per_cu > 1) per_cu = 1;
    grid_blocks = cus * per_cu;
  }
  void* args[] = {&p};
  hipError_t e = hipLaunchCooperativeKernel((void*)k_mega, dim3(grid_blocks), dim3(NT_THREADS), args, SHM_BYTES, stream);
  if (e != hipSuccess) fprintf(stderr, "cooperative launch failed: %s (grid %d)\n", hipGetErrorString(e), grid_blocks);
#endif
}
```

```cpp
#include <hip/hip_runtime.h>
#include <hip/hip_cooperative_groups.h>
#include <cstdio>
#include <cstdint>
namespace cg = cooperative_groups;

#ifndef REP_ATT
#define REP_ATT 0
#endif
#ifndef STAGGER_MAP
#define STAGGER_MAP 1
#endif
#ifndef REP_POST
#define REP_POST 0
#endif
#ifndef REP_GEMM
#define REP_GEMM 0
#endif
#ifndef MK_MULTI
#define MK_MULTI 0
#endif

typedef unsigned short bf16_t;
using bf16x8 = __attribute__((ext_vector_type(8))) short;
using s16x4  = __attribute__((ext_vector_type(4))) short;
using f32x16 = __attribute__((ext_vector_type(16))) float;
using f32x4  = __attribute__((ext_vector_type(4))) float;
using u32x4  = __attribute__((ext_vector_type(4))) unsigned;
using u32x2  = __attribute__((ext_vector_type(2))) unsigned;

#define XCD_BAR_WORDS 3456
constexpr int NT_THREADS = 512;
constexpr int T_TOK = 65536, TP = 32768, DM = 1024, NPROJ = 3072, DEPTH = 2;
constexpr int S_P = 16384, S_S = 4096;
constexpr int C_ZP = 0, C_ZA = 512, C_U = 1024, C_Q = 1536, C_K = 2048, C_V = 2560;
constexpr int LDX = 2048;
constexpr float QSCALE = 0.125f * 1.4426950408889634f;
constexpr size_t SHM_BYTES = 131072 + 4096;

struct Params {
  const float* xp; const float* xs; const float* pre_g; const float* w_in; const float* pool_w; const float* pool_scale;
  const float* lq1; const float* lk1; const float* lq2; const float* lk2; const float* subln_g; const float* w_out; const float* post_g;
  float* out; bf16_t* WinT; bf16_t* WoutT; bf16_t* proj; float* rinv; float* rope; float* lam; float* kmax2; unsigned* bar;
};

#define SBAR() __builtin_amdgcn_sched_barrier(0)
__device__ __forceinline__ unsigned cvtpk(float lo, float hi) {
  unsigned r; asm volatile("v_cvt_pk_bf16_f32 %0, %1, %2" : "=v"(r) : "v"(lo), "v"(hi)); return r;
}
typedef __bf16 bf16x2_t __attribute__((ext_vector_type(2)));
typedef float f32x2_t __attribute__((ext_vector_type(2)));
__device__ __forceinline__ unsigned cvtpk_b(float lo, float hi) { const f32x2_t v = {lo, hi}; const bf16x2_t b = __builtin_convertvector(v, bf16x2_t); return *reinterpret_cast<const unsigned*>(&b); }
__device__ __forceinline__ float bf2f(unsigned short b) { return __uint_as_float(((unsigned)b) << 16); }
__device__ __forceinline__ float bflo(unsigned w) { return __uint_as_float(w << 16); }
__device__ __forceinline__ float bfhi(unsigned w) { return __uint_as_float(w & 0xffff0000u); }
__device__ __forceinline__ bf16_t f2bf(float f) { return (bf16_t)(cvtpk(f, 0.f) & 0xffffu); }
__host__ __device__ __forceinline__ int perm32(int rho) { const int n = rho >> 4, i = rho & 15; return 8 * (i >> 2) + 4 * n + (i & 3); }
__device__ __forceinline__ float silu(float z) { return z * __builtin_amdgcn_rcpf(1.f + __builtin_amdgcn_exp2f(-1.4426950408889634f * z)); }
__device__ __forceinline__ int opaque_tid() { int t = threadIdx.x; asm volatile("" : "+v"(t)); return t; }
__device__ __forceinline__ float wave_sum(float v) {
#pragma unroll
  for (int o = 32; o >= 1; o >>= 1) v += __shfl_xor(v, o);
  return v;
}

__device__ __forceinline__ int src_col_in(int s) {
  const int type = s >> 9, within = s & 511;
  if (type == 0) return 512 + within;
  if (type == 1) return 2560 + within;
  if (type == 5) return 2048 + within;
  const int p = within & 63, wcl = p >> 5, fq = (p >> 3) & 3, n = (p >> 2) & 1, jj = p & 3;
  const int d = wcl * 16 + fq * 4 + jj + 32 * n;
  return (type == 3 ? 1024 : 1536) + (within & ~63) + d;
}

__device__ void phase0(const Params& p, char* shm) {
  const int tid = opaque_tid(), nth = blockDim.x;
  float* tile = (float*)shm;
  float* Wt = tile + 64 * 65 + 32;
  float* Pw = Wt + 64 * 128;
  constexpr int NT_U = DEPTH * 8 * 16, NT_IN = DEPTH * 40 * 16, NT_OUT = DEPTH * 16 * 16;
  for (int it = blockIdx.x; it < NT_U + NT_IN + NT_OUT; it += gridDim.x) {
    __syncthreads();
    if (it < NT_U + NT_IN) {
      int l, n0, k0; const bool isu = it < NT_U;
      if (isu) { l = it / 128; const int r = it % 128; n0 = C_U + (r / 16) * 64; k0 = (r % 16) * 64; }
      else { const int i2 = it - NT_U; l = i2 / 640; const int r = i2 % 640; int nt = r / 16; if (nt >= 16) nt += 8; n0 = nt * 64; k0 = (r % 16) * 64; }
      const float* W = p.w_in + (size_t)l * DM * NPROJ; const float* g = p.pre_g + l * DM;
      if (isu) {
        const int gi = (n0 - C_U) >> 7, d0 = (n0 - C_U) & 127;
        for (int e = tid; e < 64 * 128; e += nth) { const int c = e & 127, kk = e >> 7; Wt[e] = W[(size_t)(k0 + kk) * NPROJ + gi * 128 + c]; }
        for (int e = tid; e < 128 * 64; e += nth) { const int d = e & 63, c = e >> 6; Pw[e] = p.pool_w[((size_t)(l * 4 + gi) * 128 + c) * 128 + d0 + d]; }
        __syncthreads();
        for (int e = tid; e < 4096; e += nth) {
          const int nn = e & 63, kk = e >> 6, nrow = n0 + nn; const int s = (nrow & ~31) + perm32(nrow & 31), dl = s - n0;
          float a = 0.f;
#pragma unroll 8
          for (int c = 0; c < 128; ++c) a = fmaf(Wt[kk * 128 + c], Pw[c * 64 + dl], a);
          tile[kk * 65 + nn] = a * g[k0 + kk];
        }
      } else {
        for (int e = tid; e < 4096; e += nth) {
          const int nn = e & 63, kk = e >> 6, k = k0 + kk, nrow = n0 + nn;
          const int s = (nrow & ~31) + perm32(nrow & 31);
          tile[kk * 65 + nn] = W[(size_t)k * NPROJ + src_col_in(s)] * g[k];
        }
      }
      __syncthreads();
      bf16_t* O = p.WinT + (size_t)l * NPROJ * DM;
      for (int e = tid; e < 4096; e += nth) { const int kk = e & 63, nn = e >> 6; O[(size_t)(n0 + nn) * DM + k0 + kk] = f2bf(tile[kk * 65 + nn]); }
    } else {
      const int it2 = it - NT_U - NT_IN, l = it2 / 256, r = it2 % 256, n0 = (r / 16) * 64, k0 = (r % 16) * 64;
      const float* W = p.w_out + (size_t)l * DM * DM;
      for (int e = tid; e < 4096; e += nth) {
        const int nn = e & 63, kk = e >> 6, nrow = n0 + nn; const int s = (nrow & ~31) + perm32(nrow & 31);
        tile[kk * 65 + nn] = W[(size_t)(k0 + kk) * DM + s];
      }
      __syncthreads();
      bf16_t* O = p.WoutT + (size_t)l * DM * DM;
      for (int e = tid; e < 4096; e += nth) { const int kk = e & 63, nn = e >> 6; O[(size_t)(n0 + nn) * DM + k0 + kk] = f2bf(tile[kk * 65 + nn]); }
    }
  }
  if (blockIdx.x == 0) {
    for (int i = tid; i < XCD_BAR_WORDS; i += nth) p.bar[i] = 0u;
    if (tid < DEPTH * 160) p.kmax2[tid] = 0.f;
    if (tid < 32) { const double c = exp(-(double)tid * (9.210340371976184 / 32.0)) * 0.15915494309189535; const float h = (float)c; p.rope[2 * tid] = h; p.rope[2 * tid + 1] = (float)(c - (double)h); }
    if (tid >= 64 && tid < 64 + 64 * DEPTH) {
      const int l = (tid >> 6) - 1, i = tid & 63;
      float a = p.lq1[l * 64 + i] * p.lk1[l * 64 + i], b = p.lq2[l * 64 + i] * p.lk2[l * 64 + i];
      a = wave_sum(a); b = wave_sum(b);
      const float li = 0.8f - 0.6f * expf(-0.3f * (float)l);
      if (i == 0) p.lam[l] = expf(a) - expf(b) + li;
    }
  }
  const int wid = tid >> 6, lane = tid & 63, nw = nth >> 6;
  for (int row0 = (blockIdx.x * nw + wid) * 2; row0 < T_TOK; row0 += gridDim.x * nw * 2) {
    f32x4 v[2][4];
#pragma unroll
    for (int q = 0; q < 2; ++q) {
      const int row = row0 + q;
      const float* xr = row < TP ? p.xp + (size_t)row * DM : p.xs + (size_t)(row - TP) * DM;
#pragma unroll
      for (int i = 0; i < 4; ++i) v[q][i] = __builtin_nontemporal_load((const f32x4*)(xr + i * 256 + lane * 4));
    }
#pragma unroll
    for (int q = 0; q < 2; ++q) {
      const int row = row0 + q;
      bf16_t* xo = (bf16_t*)p.out + (size_t)row * LDX;
      float ss = 0.f;
#pragma unroll
      for (int i = 0; i < 4; ++i) {
        ss += v[q][i][0] * v[q][i][0] + v[q][i][1] * v[q][i][1] + v[q][i][2] * v[q][i][2] + v[q][i][3] * v[q][i][3];
        u32x2 w = {cvtpk(v[q][i][0], v[q][i][1]), cvtpk(v[q][i][2], v[q][i][3])};
        *(u32x2*)(xo + i * 256 + lane * 4) = w;
      }
      ss = wave_sum(ss);
      if (lane == 0) p.rinv[row] = __builtin_amdgcn_rsqf(ss * (1.f / DM) + 1e-6f);
    }
  }
}

namespace gm {
constexpr int BM = 256, BK = 64, HALF = 128, NXCD = 8, WGM = 8, HT = HALF * BK;
__device__ __forceinline__ int lds_byte(int r, int c) { int st = (r >> 4) * 2 + (c >> 5), rr = r & 15, cc = c & 31, ob = rr * 64 + cc * 2; return st * 1024 + (ob ^ (((ob >> 9) & 1) << 5)); }
__device__ __forceinline__ void stage_rc(int b, int& R, int& C) { int st = b / 1024, sb = b % 1024, swz = sb ^ (((sb >> 9) & 1) << 5); R = (st >> 1) * 16 + swz / 64; C = (st & 1) * 32 + (swz % 64) / 2; }

#define LAS __attribute__((address_space(3)))
template <class Epi>
__device__ __forceinline__ void gemm_phase(const bf16_t* __restrict__ A, const int lda, const bf16_t* __restrict__ Bt, const int N, const Epi& E, char* shmc) {
  constexpr int K = 1024, nt = K / BK, HTB = HALF * BK * 2;
  LAS unsigned char* lds = (LAS unsigned char*)shmc;
  const int tid = opaque_tid(), wid = __builtin_amdgcn_readfirstlane(tid >> 6), lane = tid & 63, wr = wid >> 2, wc = wid & 3, fr = lane & 15, fq = lane >> 4;
  unsigned voffA[2], voffB[2];
#pragma unroll
  for (int i = 0; i < 2; ++i) { int R, C; stage_rc(tid * 16 + i * 8192, R, C); voffA[i] = (unsigned)(R * lda + C) * 2u; voffB[i] = (unsigned)(R * K + C) * 2u; }
  const size_t kstep = (size_t)(BK * 2);
  const size_t hstepA = (size_t)HALF * lda * 2, hstepB = (size_t)HALF * K * 2;
  const size_t tstepA = 2 * hstepA, tstepB = 2 * hstepB;
  const unsigned ldsw = (unsigned)wid * 1024u;
  const int aoff = lds_byte(wr * 64 + fr, fq * 8), boff = lds_byte(wc * 32 + fr, fq * 8);
#define PG8_SA(b, h) (((b) * 2 + (h)) * HTB)
#define PG8_SB(b, h) ((4 + (b) * 2 + (h)) * HTB)
#define PG8_STAGE(bufoff, gbase, voff) do { _Pragma("unroll") for (int _i = 0; _i < 2; ++_i) \
        __builtin_amdgcn_global_load_lds((const unsigned*)((const char*)(gbase) + (voff)[_i]), (LAS unsigned*)(lds + (bufoff) + ldsw + _i * 8192), 16, 0, 0); } while (0)
#define PG8_LDA(dst, b, h) do { _Pragma("unroll") for (int m = 0; m < 4; ++m) _Pragma("unroll") for (int k = 0; k < 2; ++k) dst[m][k] = *(const LAS bf16x8*)(lds + PG8_SA(b, h) + aoff + m * 2048 + k * 1024); } while (0)
#define PG8_LDB(dst, b, h) do { _Pragma("unroll") for (int n = 0; n < 2; ++n) _Pragma("unroll") for (int k = 0; k < 2; ++k) dst[n][k] = *(const LAS bf16x8*)(lds + PG8_SB(b, h) + boff + n * 2048 + k * 1024); } while (0)
#define PG8_MMA(ai, bj, At, Bx) do { __builtin_amdgcn_s_setprio(1); _Pragma("unroll") for (int m = 0; m < 4; ++m) _Pragma("unroll") for (int n = 0; n < 2; ++n) _Pragma("unroll") for (int k = 0; k < 2; ++k) \
        acc[ai][bj][m][n] = __builtin_amdgcn_mfma_f32_16x16x32_bf16(Bx[n][k], At[m][k], acc[ai][bj][m][n], 0, 0, 0); __builtin_amdgcn_s_setprio(0); } while (0)
#define PG8_WAIT_V(n) asm volatile("s_waitcnt vmcnt(" #n ")" ::: "memory")
#define PG8_WAIT_L(n) asm volatile("s_waitcnt lgkmcnt(" #n ")" ::: "memory")
#define PG8_BAR __builtin_amdgcn_s_barrier()
#define PG8_SCHED __builtin_amdgcn_sched_barrier(0)
  const int nM = T_TOK / BM, nN = N / BM, nwg = nM * nN, G = gridDim.x, cblk = blockIdx.x;
  auto next_unit = [&](int i, int& pm, int& pn) -> bool {
    const long L = (long)i * G + cblk; if (L >= nwg) return false;
    int wgid = (int)L; { const int q = nwg / NXCD, r = nwg % NXCD, xcd = wgid % NXCD, off = wgid / NXCD; wgid = (xcd < r ? xcd * (q + 1) : r * (q + 1) + (xcd - r) * q) + off; }
    const int nig = WGM * nN, gid = wgid / nig, fm = gid * WGM, gsz = (nM - fm) < WGM ? (nM - fm) : WGM;
    pm = fm + ((wgid % nig) % gsz); pn = (wgid % nig) / gsz; return true;
  };
  int cpm, cpn, npm = 0, npn = 0, ui = 0;
  if (!next_unit(0, cpm, cpn)) return;
  f32x4 acc[2][2][4][2];
#pragma unroll
  for (int a = 0; a < 2; ++a)
#pragma unroll
    for (int b = 0; b < 2; ++b)
#pragma unroll
      for (int m = 0; m < 4; ++m)
#pragma unroll
        for (int n = 0; n < 2; ++n) acc[a][b][m][n] = (f32x4){0.f, 0.f, 0.f, 0.f};
  bf16x8 At[4][2], B0[2][2], B1[2][2];
  const char* cA = (const char*)A + (size_t)cpm * tstepA; const char* cB = (const char*)Bt + (size_t)cpn * tstepB;
  PG8_STAGE(PG8_SB(0, 0), cB, voffB); PG8_STAGE(PG8_SB(0, 1), cB + hstepB, voffB); PG8_STAGE(PG8_SA(0, 0), cA, voffA); PG8_STAGE(PG8_SA(0, 1), cA + hstepA, voffA);
  if (wr == 1) PG8_BAR;
  PG8_WAIT_V(2); PG8_BAR;
  PG8_STAGE(PG8_SB(1, 0), cB + kstep, voffB); PG8_STAGE(PG8_SA(1, 0), cA + kstep, voffA); PG8_STAGE(PG8_SB(1, 1), cB + hstepB + kstep, voffB);
  PG8_WAIT_V(6); PG8_BAR;
  for (;;) {
    const bool has_next = next_unit(ui + 1, npm, npn);
    const char* nA = has_next ? (const char*)A + (size_t)npm * tstepA : cA; const char* nB = has_next ? (const char*)Bt + (size_t)npn * tstepB : cB;
    for (int t = 0; t < nt; t += 2) {
      const bool last = (t == nt - 2);
      const char* a1 = cA + (size_t)(t + 1) * kstep;
      const char* a2 = last ? nA : cA + (size_t)(t + 2) * kstep; const char* b2 = last ? nB : cB + (size_t)(t + 2) * kstep;
      const char* a3 = a2 + kstep; const char* b3 = b2 + kstep;
      PG8_LDB(B0, 0, 0); PG8_LDB(B1, 0, 1); PG8_SCHED; PG8_LDA(At, 0, 0); PG8_STAGE(PG8_SA(1, 1), a1 + hstepA, voffA);
      PG8_WAIT_V(8); PG8_WAIT_L(0); PG8_BAR; PG8_MMA(0, 0, At, B0); PG8_MMA(0, 1, At, B1); PG8_BAR; PG8_SCHED;
      PG8_LDA(At, 0, 1); PG8_STAGE(PG8_SB(0, 0), b2, voffB); PG8_STAGE(PG8_SB(0, 1), b2 + hstepB, voffB); PG8_STAGE(PG8_SA(0, 0), a2, voffA);
      PG8_WAIT_V(8); PG8_WAIT_L(0); PG8_BAR; PG8_MMA(1, 0, At, B0); PG8_MMA(1, 1, At, B1); PG8_BAR; PG8_SCHED;
      PG8_LDB(B0, 1, 0); PG8_LDB(B1, 1, 1); PG8_SCHED; PG8_LDA(At, 1, 0); PG8_STAGE(PG8_SA(0, 1), a2 + hstepA, voffA);
      PG8_WAIT_V(8); PG8_WAIT_L(0); PG8_BAR; PG8_MMA(0, 0, At, B0); PG8_MMA(0, 1, At, B1); PG8_BAR; PG8_SCHED;
      PG8_LDA(At, 1, 1); PG8_STAGE(PG8_SB(1, 0), b3, voffB); PG8_STAGE(PG8_SB(1, 1), b3 + hstepB, voffB); PG8_STAGE(PG8_SA(1, 0), a3, voffA);
      PG8_WAIT_V(8); PG8_WAIT_L(0); PG8_BAR; PG8_MMA(1, 0, At, B0); PG8_MMA(1, 1, At, B1); PG8_BAR; PG8_SCHED;
    }
    if (wr == 0) PG8_BAR;
    E(acc, cpm, cpn, wr, wc, fr, fq);
    if (!has_next) break;
#pragma unroll
    for (int a = 0; a < 2; ++a)
#pragma unroll
      for (int b = 0; b < 2; ++b)
#pragma unroll
        for (int m = 0; m < 4; ++m)
#pragma unroll
          for (int n = 0; n < 2; ++n) acc[a][b][m][n] = (f32x4){0.f, 0.f, 0.f, 0.f};
    cpm = npm; cpn = npn; cA = nA; cB = nB; ++ui;
    if (wr == 1) PG8_BAR;
  }
  PG8_WAIT_V(0);
  PG8_BAR;
#undef PG8_SA
#undef PG8_SB
#undef PG8_STAGE
#undef PG8_LDA
#undef PG8_LDB
#undef PG8_MMA
}

struct EpiIn {
  const float* rinv; const float* rope; bf16_t* proj; float* kmax2;
  __device__ __forceinline__ void operator()(const f32x4 (&acc)[2][2][4][2], int pm, int pn, int wr, int wc, int fr, int fq) const {
    const bool isrope = (pn >= 6 && pn <= 9); const float qs = (pn == 6 || pn == 7) ? QSCALE : 1.f;
    const bool isk = (pn == 8 || pn == 9);
    float kmx[2] = {0.f, 0.f};
    float ch[4], cl[4];
    if (isrope) {
#pragma unroll
      for (int jj = 0; jj < 4; ++jj) { const int i = (wc & 1) * 16 + fq * 4 + jj; ch[jj] = rope[2 * i]; cl[jj] = rope[2 * i + 1]; }
    }
    float riv[2][4];
#pragma unroll
    for (int ai = 0; ai < 2; ++ai)
#pragma unroll
      for (int m = 0; m < 4; ++m) riv[ai][m] = rinv[pm * BM + ai * HALF + wr * 64 + m * 16 + fr];
#pragma unroll
    for (int ai = 0; ai < 2; ++ai)
#pragma unroll
      for (int m = 0; m < 4; ++m) {
        const int row = pm * BM + ai * HALF + wr * 64 + m * 16 + fr;
        const float ri = riv[ai][m];
        float cs[4], sn[4];
        if (isrope) {
          const float pos = (float)(row < TP ? (row & (S_P - 1)) : (row & (S_S - 1)));
#pragma unroll
          for (int jj = 0; jj < 4; ++jj) {
            const float h = pos * ch[jj], e = fmaf(pos, ch[jj], -h) + pos * cl[jj];
            const float rev = (h - floorf(h)) + e;
            sn[jj] = __builtin_amdgcn_sinf(rev); cs[jj] = __builtin_amdgcn_cosf(rev);
          }
        }
        bf16_t* rowp = proj + (size_t)row * NPROJ + pn * BM + wc * 32 + 8 * fq;
#pragma unroll
        for (int bj = 0; bj < 2; ++bj) {
          f32x4 v0 = acc[ai][bj][m][0] * ri, v1 = acc[ai][bj][m][1] * ri;
          if (isrope) {
#pragma unroll
            for (int jj = 0; jj < 4; ++jj) { const float a = v0[jj], b = v1[jj]; v0[jj] = (a * cs[jj] - b * sn[jj]) * qs; v1[jj] = (b * cs[jj] + a * sn[jj]) * qs; }
          }
          u32x4 w; w.x = cvtpk(v0[0], v0[1]); w.y = cvtpk(v0[2], v0[3]); w.z = cvtpk(v1[0], v1[1]); w.w = cvtpk(v1[2], v1[3]);
          *(u32x4*)(rowp + bj * HALF) = w;
          if (isk) { float ss = v0[0] * v0[0] + v0[1] * v0[1] + v0[2] * v0[2] + v0[3] * v0[3] + v1[0] * v1[0] + v1[1] * v1[1] + v1[2] * v1[2] + v1[3] * v1[3];
            ss += __shfl_xor(ss, 16); ss += __shfl_xor(ss, 32); kmx[bj] = fmaxf(kmx[bj], ss); }
        }
      }
    if (isk) {
      const int row0 = pm * BM, sq = row0 < TP ? (row0 >> 14) : 2 + ((row0 - TP) >> 12);
#pragma unroll
      for (int bj = 0; bj < 2; ++bj) { float v = kmx[bj];
        v = fmaxf(v, __shfl_xor(v, 1)); v = fmaxf(v, __shfl_xor(v, 2)); v = fmaxf(v, __shfl_xor(v, 4)); v = fmaxf(v, __shfl_xor(v, 8));
        if ((fr | fq) == 0) atomicMax((unsigned*)(kmax2 + (sq * 4 + (pn - 8) * 2 + bj) * 4 + wc), __float_as_uint(v)); }
    }
  }
};
struct EpiOut {
  bf16_t* proj;
  __device__ __forceinline__ void operator()(const f32x4 (&acc)[2][2][4][2], int pm, int pn, int wr, int wc, int fr, int fq) const {
#pragma unroll
    for (int ai = 0; ai < 2; ++ai)
#pragma unroll
      for (int m = 0; m < 4; ++m) {
        const int row = pm * BM + ai * HALF + wr * 64 + m * 16 + fr;
        bf16_t* rowp = proj + (size_t)row * NPROJ + C_U + pn * BM + wc * 32 + 8 * fq;
#pragma unroll
        for (int bj = 0; bj < 2; ++bj) { const f32x4 v0 = acc[ai][bj][m][0], v1 = acc[ai][bj][m][1];
          u32x4 w; w.x = cvtpk(v0[0], v0[1]); w.y = cvtpk(v0[2], v0[3]); w.z = cvtpk(v1[0], v1[1]); w.w = cvtpk(v1[2], v1[3]);
          *(u32x4*)(rowp + bj * HALF) = w; }
      }
  }
};
}

__device__ __forceinline__ void bf8_to_f(const u32x4 w, float* v) {
  v[0] = bflo(w.x); v[1] = bfhi(w.x); v[2] = bflo(w.y); v[3] = bfhi(w.y); v[4] = bflo(w.z); v[5] = bfhi(w.z); v[6] = bflo(w.w); v[7] = bfhi(w.w);
}
__device__ void pool_phase(const Params& p, int l, bool dry = false) {
  const int tid = opaque_tid(), c8 = tid & 63, tq = tid >> 6;
  const int g = c8 >> 4, hw = 1 << g;
  const float* sc = p.pool_scale + l * 512 + c8 * 8;
  float scl[8];
#pragma unroll
  for (int e = 0; e < 8; ++e) scl[e] = sc[e];
  for (int ch = blockIdx.x; ch < T_TOK / 128; ch += gridDim.x) {
    const int t0 = ch * 128 + tq * 16;
    const int S = t0 < TP ? S_P : S_S, pos0 = t0 & (S - 1), s0 = t0 - pos0;
    const bf16_t* ub = p.proj + (size_t)s0 * NPROJ + C_U + c8 * 8;
    float sum[8] = {0, 0, 0, 0, 0, 0, 0, 0};
#pragma unroll
    for (int j = 0; j < 16; ++j) {
      const int r = pos0 - hw + j; const bool ok = (j < 2 * hw) && r >= 0 && r < S; const int rc = min(max(r, 0), S - 1);
      float v[8]; bf8_to_f(*(const u32x4*)(ub + (size_t)rc * NPROJ), v); const float m = ok ? 1.f : 0.f;
#pragma unroll
      for (int e = 0; e < 8; ++e) sum[e] = fmaf(m, v[e], sum[e]);
    }
#pragma unroll
    for (int i4 = 0; i4 < 16; i4 += 4) {
      u32x4 wu[4], wz[4], wa[4], wsb[4];
#pragma unroll
      for (int q = 0; q < 4; ++q) {
        const int pos = pos0 + i4 + q, ra = pos + hw, rs = pos - hw;
        wu[q] = *(const u32x4*)(ub + (size_t)pos * NPROJ);
        wz[q] = *(const u32x4*)(p.proj + (size_t)(t0 + i4 + q) * NPROJ + C_ZP + c8 * 8);
        wa[q] = *(const u32x4*)(ub + (size_t)min(ra, S - 1) * NPROJ); wsb[q] = *(const u32x4*)(ub + (size_t)max(rs, 0) * NPROJ);
      }
#pragma unroll
      for (int q = 0; q < 4; ++q) {
        const int pos = pos0 + i4 + q, t = t0 + i4 + q;
        const int lo = max(pos - hw, 0), hi = min(pos + hw, S);
        const float inv = 1.f / (float)(hi - lo);
        float uc[8], z[8], va[8], vs[8], o[8];
        bf8_to_f(wu[q], uc); bf8_to_f(wz[q], z);
#pragma unroll
        for (int e = 0; e < 8; ++e) o[e] = (sum[e] * inv - uc[e]) * scl[e] * silu(z[e]);
        const u32x4 w = {cvtpk(o[0], o[1]), cvtpk(o[2], o[3]), cvtpk(o[4], o[5]), cvtpk(o[6], o[7])};
        if (!dry) *(u32x4*)(p.proj + (size_t)t * NPROJ + C_ZP + c8 * 8) = w;
        const int ra = pos + hw, rs = pos - hw; const float ma = ra < S ? 1.f : 0.f, ms = rs >= 0 ? 1.f : 0.f;
        bf8_to_f(wa[q], va); bf8_to_f(wsb[q], vs);
#pragma unroll
        for (int e = 0; e < 8; ++e) sum[e] = fmaf(ma, va[e], fmaf(-ms, vs[e], sum[e]));
      }
    }
  }
}

namespace at {
constexpr int KVBLK = 64, LDK = NPROJ;
constexpr size_t SHM_V = KVBLK * 128 * 2, SHM_K = KVBLK * 128 * 2;
constexpr float THRL = 11.5f;
#define KSWZ(row, colB) ((row) * 256 + ((colB) ^ (((row) & 7) << 4)))
__device__ __forceinline__ int crow(int r, int hi) { return (r & 3) + 8 * (r >> 2) + 4 * hi; }
template <bool SH> __device__ __forceinline__ void partialSM(f32x16& p0, f32x16& p1, float& m_reg, float& mn, float& alpha) {
  if constexpr (!SH) {
    alpha = 1.f;
    return;
  }
  float pmax = p0[0];
#pragma unroll
  for (int r = 1; r < 16; ++r) pmax = fmaxf(pmax, p0[r]);
#pragma unroll
  for (int r = 0; r < 16; ++r) pmax = fmaxf(pmax, p1[r]);
  { auto rr = __builtin_amdgcn_permlane32_swap(__float_as_uint(pmax), __float_as_uint(pmax), false, false);
    pmax = fmaxf(__uint_as_float(rr[0]), __uint_as_float(rr[1])); }
  if (__builtin_expect(__all(pmax - m_reg <= THRL), 1)) { mn = m_reg; alpha = 1.f; }
  else { mn = fmaxf(m_reg, pmax); alpha = __builtin_amdgcn_exp2f(m_reg - mn); m_reg = mn; }
#pragma unroll
  for (int r = 0; r < 16; ++r) p0[r] = p0[r] - mn;
#pragma unroll
  for (int r = 0; r < 16; ++r) p1[r] = p1[r] - mn;
#pragma unroll
  for (int r = 0; r < 16; ++r) { p0[r] = __builtin_amdgcn_exp2f(p0[r]); p1[r] = __builtin_amdgcn_exp2f(p1[r]); }
}
template <bool SH> __device__ __forceinline__ void finishSM(f32x16& p0, f32x16& p1, float alpha, float& l_reg, bf16x8& pa0, bf16x8& pa1, bf16x8& pa2, bf16x8& pa3) {
  if constexpr (!SH) {
#pragma unroll
    for (int r = 0; r < 16; ++r) { p0[r] = __builtin_amdgcn_exp2f(p0[r]); p1[r] = __builtin_amdgcn_exp2f(p1[r]); }
  }
  float ps = 0;
#pragma unroll
  for (int r = 0; r < 16; ++r) ps += p0[r];
#pragma unroll
  for (int r = 0; r < 16; ++r) ps += p1[r];
  if constexpr (SH) l_reg = l_reg * alpha + ps; else l_reg += ps;
#define PK4(P, BASE, OUT) do { u32x4 w = {cvtpk_b(P[BASE + 0], P[BASE + 1]), cvtpk_b(P[BASE + 2], P[BASE + 3]), cvtpk_b(P[BASE + 4], P[BASE + 5]), cvtpk_b(P[BASE + 6], P[BASE + 7])}; \
    OUT = *reinterpret_cast<bf16x8*>(&w); } while (0)
  PK4(p0, 0, pa0); PK4(p0, 8, pa1); PK4(p1, 0, pa2); PK4(p1, 8, pa3);
#undef PK4
}
__device__ __forceinline__ void qkt(f32x16& p0, f32x16& p1, const char* Ks, const bf16x8* qr, int r32, int hi, int mapB) {
  p0 = f32x16{}; p1 = f32x16{};
#pragma unroll
  for (int d0 = 0; d0 < 4; ++d0) { const int cb = (d0 * 16 + hi * 8) * 2 + mapB;
    bf16x8 b0 = *reinterpret_cast<const bf16x8*>(Ks + KSWZ(r32, cb));
    bf16x8 b1 = *reinterpret_cast<const bf16x8*>(Ks + KSWZ(32 + r32, cb));
    p0 = __builtin_amdgcn_mfma_f32_32x32x16_bf16(b0, qr[d0], p0, 0, 0, 0);
    p1 = __builtin_amdgcn_mfma_f32_32x32x16_bf16(b1, qr[d0], p1, 0, 0, 0); }
}
__device__ __forceinline__ int v_st(int k, int c) { const int kk = (k & ~0xC) | ((k & 4) << 1) | ((k & 8) >> 1); return ((kk >> 3) * 4 + (c >> 5)) * 512 + ((kk & 7) * 32 + (c & 31)) * 2; }
__device__ __forceinline__ int v_rd_base(int lane) { return ((lane & 3) << 3) | (((lane >> 2) & 3) << 6) | (((lane >> 4) & 1) << 5) | (((lane >> 5) & 1) << 8); }
constexpr int v_rd_off(int d0, int ks, int half) { return d0 * 512 + ks * 4096 + half * 2048; }
template <int OFF> __device__ __forceinline__ s16x4 tr_read(int vb) {
  s16x4 r; asm volatile("ds_read_b64_tr_b16 %0, %1 offset:%2" : "=&v"(r) : "v"(vb), "i"(OFF) : "memory"); return r;
}
template <int D0> __device__ __forceinline__ void pv_one(f32x16& od, int vb, bf16x8 pa0, bf16x8 pa1, bf16x8 pa2, bf16x8 pa3) {
  const s16x4 l0 = tr_read<v_rd_off(D0, 0, 0)>(vb), h0 = tr_read<v_rd_off(D0, 0, 1)>(vb), l1 = tr_read<v_rd_off(D0, 1, 0)>(vb), h1 = tr_read<v_rd_off(D0, 1, 1)>(vb);
  const s16x4 l2 = tr_read<v_rd_off(D0, 2, 0)>(vb), h2 = tr_read<v_rd_off(D0, 2, 1)>(vb), l3 = tr_read<v_rd_off(D0, 3, 0)>(vb), h3 = tr_read<v_rd_off(D0, 3, 1)>(vb);
  asm volatile("s_waitcnt lgkmcnt(0)" ::: "memory"); SBAR();
#define PK(L, H) (bf16x8){L[0], L[1], L[2], L[3], H[0], H[1], H[2], H[3]}
  od = __builtin_amdgcn_mfma_f32_32x32x16_bf16(pa0, PK(l0, h0), od, 0, 0, 0);
  od = __builtin_amdgcn_mfma_f32_32x32x16_bf16(pa1, PK(l1, h1), od, 0, 0, 0);
  od = __builtin_amdgcn_mfma_f32_32x32x16_bf16(pa2, PK(l2, h2), od, 0, 0, 0);
  od = __builtin_amdgcn_mfma_f32_32x32x16_bf16(pa3, PK(l3, h3), od, 0, 0, 0);
#undef PK
}
__device__ __forceinline__ void pv_d0(f32x16* o, int vb, bf16x8 pa0, bf16x8 pa1, bf16x8 pa2, bf16x8 pa3) {
  pv_one<0>(o[0], vb, pa0, pa1, pa2, pa3); pv_one<1>(o[1], vb, pa0, pa1, pa2, pa3); pv_one<2>(o[2], vb, pa0, pa1, pa2, pa3); pv_one<3>(o[3], vb, pa0, pa1, pa2, pa3);
}

struct VFrag { s16x4 l0, h0, l1, h1, l2, h2, l3, h3; };
template <int D0> __device__ __forceinline__ void v_frag_read(VFrag& f, int vb) {
  f.l0 = tr_read<v_rd_off(D0, 0, 0)>(vb); f.h0 = tr_read<v_rd_off(D0, 0, 1)>(vb); f.l1 = tr_read<v_rd_off(D0, 1, 0)>(vb); f.h1 = tr_read<v_rd_off(D0, 1, 1)>(vb);
  f.l2 = tr_read<v_rd_off(D0, 2, 0)>(vb); f.h2 = tr_read<v_rd_off(D0, 2, 1)>(vb); f.l3 = tr_read<v_rd_off(D0, 3, 0)>(vb); f.h3 = tr_read<v_rd_off(D0, 3, 1)>(vb);
}
__device__ __forceinline__ void v_frag_mma(f32x16& od, const VFrag& f, bf16x8 pa0, bf16x8 pa1, bf16x8 pa2, bf16x8 pa3) {
#define PK(L, H) (bf16x8){L[0], L[1], L[2], L[3], H[0], H[1], H[2], H[3]}
  od = __builtin_amdgcn_mfma_f32_32x32x16_bf16(pa0, PK(f.l0, f.h0), od, 0, 0, 0);
  od = __builtin_amdgcn_mfma_f32_32x32x16_bf16(pa1, PK(f.l1, f.h1), od, 0, 0, 0);
  od = __builtin_amdgcn_mfma_f32_32x32x16_bf16(pa2, PK(f.l2, f.h2), od, 0, 0, 0);
  od = __builtin_amdgcn_mfma_f32_32x32x16_bf16(pa3, PK(f.l3, f.h3), od, 0, 0, 0);
#undef PK
}
template <bool PRE> __device__ __forceinline__ void pv_d0_pipe(f32x16* o, int vb, bf16x8 pa0, bf16x8 pa1, bf16x8 pa2, bf16x8 pa3, VFrag& fa) {
  VFrag fb;
  if constexpr (!PRE) v_frag_read<0>(fa, vb);
  asm volatile("s_waitcnt lgkmcnt(0)" ::: "memory"); SBAR();
  v_frag_read<1>(fb, vb); SBAR(); v_frag_mma(o[0], fa, pa0, pa1, pa2, pa3); SBAR(); asm volatile("s_waitcnt lgkmcnt(0)" ::: "memory"); SBAR();
  v_frag_read<2>(fa, vb); SBAR(); v_frag_mma(o[1], fb, pa0, pa1, pa2, pa3); SBAR(); asm volatile("s_waitcnt lgkmcnt(0)" ::: "memory"); SBAR();
  v_frag_read<3>(fb, vb); SBAR(); v_frag_mma(o[2], fa, pa0, pa1, pa2, pa3); SBAR(); asm volatile("s_waitcnt lgkmcnt(0)" ::: "memory"); SBAR();
  v_frag_mma(o[3], fb, pa0, pa1, pa2, pa3);
}

template <bool SH> __device__ __forceinline__ void attn_unit(bf16_t* __restrict__ proj, int tok0, int kv0, int seq, int h, float lam, float oscale, const float* __restrict__ subg, char* lds, bool dry) {
  const int tid = opaque_tid(), wid = __builtin_amdgcn_readfirstlane(tid >> 6), lane = tid & 63, r32 = lane & 31, hi = lane >> 5;
  const int wq = wid & 3, mp = wid >> 2, mapB = mp * 128;
  constexpr int RING = 32768, NRING = 4;
  LAS char* ldsl = (LAS char*)lds;
  float* ws = (float*)(lds + NRING * RING) + wid * 64; float* li_l = ws; float* al_l = ws + 32;
  const bf16_t* Kh = proj + (size_t)kv0 * NPROJ + C_K + h * 128;
  const bf16_t* Vh = proj + (size_t)kv0 * NPROJ + C_V + h * 128;
  float m_reg = -1e30f, l_reg = 0; f32x16 o[4] = {}; bf16x8 qr[4];
  const bf16_t* Qw = proj + (size_t)(tok0 + wq * 32 + r32) * NPROJ + C_Q + h * 128 + mp * 64 + hi * 8;
#pragma unroll
  for (int d0 = 0; d0 < 4; ++d0) qr[d0] = *reinterpret_cast<const bf16x8*>(Qw + d0 * 16);
  unsigned vk0, vv0;
  { const int c = tid;
    { const int row = c >> 4, pc = c & 15, scn = pc ^ (row & 7); vk0 = (unsigned)(row * LDK + scn * 8) * 2u; }
    { const int sub = c >> 5, kk = (sub >> 2) * 8 + ((c >> 2) & 7), col = (sub & 3) * 32 + (c & 3) * 8; vv0 = (unsigned)(kk * LDK + col) * 2u; } }
  const unsigned ldsb = (unsigned)(uintptr_t)ldsl;
  const int vbb = (int)(uintptr_t)ldsl + 16384 + v_rd_base(lane);
#define GLDS16(src, dst) __builtin_amdgcn_global_load_lds((const unsigned*)(src), (LAS unsigned*)(dst), 16, 0, 0)
#define DMA(t, b) do { const char* kg_ = (const char*)(Kh + (size_t)(t) * (KVBLK * LDK)); const char* vg_ = (const char*)(Vh + (size_t)(t) * (KVBLK * LDK)); \
    const char* kg1_ = kg_ + 32 * LDK * 2; const char* vg1_ = vg_ + 32 * LDK * 2; const unsigned d_ = ldsb + (b) * RING + wid * 1024; unsigned keep_; \
    asm volatile("s_mov_b32 %0, m0\n\t" \
                 "s_mov_b32 m0, %1\n\ts_nop 0\n\tglobal_load_lds_dwordx4 %5, %7\n\t" \
                 "s_mov_b32 m0, %2\n\ts_nop 0\n\tglobal_load_lds_dwordx4 %5, %8\n\t" \
                 "s_mov_b32 m0, %3\n\ts_nop 0\n\tglobal_load_lds_dwordx4 %6, %9\n\t" \
                 "s_mov_b32 m0, %4\n\ts_nop 0\n\tglobal_load_lds_dwordx4 %6, %10\n\t" \
                 "s_mov_b32 m0, %0" \
                 : "=&s"(keep_) : "s"(d_), "s"(d_ + 8192u), "s"(d_ + 16384u), "s"(d_ + 16384u + 8192u), "v"(vk0), "v"(vv0), "s"(kg_), "s"(kg1_), "s"(vg_), "s"(vg1_) : "memory"); } while (0)
#define DMA1X(t, b, q, ws) do { const char* g_ = (const char*)(((q) < 2 ? Kh : Vh) + (size_t)(t) * (KVBLK * LDK)) + (((q) & 1) ? 32 * LDK * 2 : 0) + ((ws) - wid) * (4 * LDK * 2); \
    const unsigned d_ = ldsb + (b) * RING + (ws) * 1024 + (q) * 8192u; unsigned keep_; \
    asm volatile("s_setprio 3\n\ts_mov_b32 %0, m0\n\ts_mov_b32 m0, %1\n\ts_nop 0\n\tglobal_load_lds_dwordx4 %2, %3\n\ts_mov_b32 m0, %0\n\ts_setprio 0" \
                 : "=&s"(keep_) : "s"(d_), "v"((q) < 2 ? vk0 : vv0), "s"(g_) : "memory"); } while (0)
#define DMA1(t, b, q) DMA1X(t, b, q, wid)
#define DMAV(t, b) do { DMA1(t, b, 2); DMA1(t, b, 3); } while (0)
#define KBUF(b) ((const char*)lds + (b) * RING)
#define VBUF(b) (vbb + (b) * RING)
#define LANDED() do { asm volatile("s_waitcnt vmcnt(0)" ::: "memory"); __syncthreads(); } while (0)
#define RESC(a) do { if (SH && __any((a) < 1.f)) { if (hi == 0) al_l[r32] = (a); asm volatile("s_waitcnt lgkmcnt(0)" ::: "memory"); \
    _Pragma("unroll") for (int d = 0; d < 4; ++d) _Pragma("unroll") for (int r = 0; r < 16; ++r) o[d][r] *= al_l[crow(r, hi)]; } } while (0)
  f32x16 pA0, pA1, pB0, pB1; float mnA, mnB, alA, alB; bf16x8 pa0, pa1, pa2, pa3; const int NT = seq / KVBLK;
#define BLK_X(N0, N1, P0, P1, alP, t) do { SBAR(); __builtin_amdgcn_s_setprio(1); qkt(N0, N1, KBUF((t) & 3), qr, r32, hi, mapB); \
    if constexpr (!SH) v_frag_read<0>(vfa, VBUF(((t) - 1) & 3)); \
    finishSM<SH>(P0, P1, alP, l_reg, pa0, pa1, pa2, pa3); __builtin_amdgcn_s_setprio(0); SBAR(); } while (0)
#define BLK_Y(C0, C1, mnC, alC, t) do { if constexpr (SH) pv_d0(o, VBUF((t) & 3), pa0, pa1, pa2, pa3); else pv_d0_pipe<true>(o, VBUF((t) & 3), pa0, pa1, pa2, pa3, vfa); partialSM<SH>(C0, C1, m_reg, mnC, alC); RESC(alC); } while (0)
#define BLK_Y1(C0, C1, mnC, alC, t, td) do { if constexpr (SH) { DMA(td, (td) & 3); DMA1X(td, (td) & 3, 0, wid - 4); DMA1X(td, (td) & 3, 1, wid - 4); pv_d0(o, VBUF((t) & 3), pa0, pa1, pa2, pa3); } else { \
      const int vb_ = VBUF((t) & 3); VFrag fb_; \
      asm volatile("s_waitcnt lgkmcnt(0)" ::: "memory"); SBAR(); \
      v_frag_read<1>(fb_, vb_); SBAR(); v_frag_mma(o[0], vfa, pa0, pa1, pa2, pa3); DMA1(td, (td) & 3, 0); DMA1X(td, (td) & 3, 0, wid - 4); SBAR(); asm volatile("s_waitcnt lgkmcnt(0)" ::: "memory"); SBAR(); \
      v_frag_read<2>(vfa, vb_); SBAR(); v_frag_mma(o[1], fb_, pa0, pa1, pa2, pa3); DMA1(td, (td) & 3, 1); DMA1X(td, (td) & 3, 1, wid - 4); SBAR(); asm volatile("s_waitcnt lgkmcnt(0)" ::: "memory"); SBAR(); \
      v_frag_read<3>(fb_, vb_); SBAR(); v_frag_mma(o[2], vfa, pa0, pa1, pa2, pa3); DMA1(td, (td) & 3, 2); SBAR(); asm volatile("s_waitcnt lgkmcnt(0)" ::: "memory"); SBAR(); \
      v_frag_mma(o[3], fb_, pa0, pa1, pa2, pa3); DMA1(td, (td) & 3, 3); SBAR(); } \
    partialSM<SH>(C0, C1, m_reg, mnC, alC); RESC(alC); } while (0)
  const int ty = STAGGER_MAP ? mp : (wid & 1);
  VFrag vfa;
  DMA(0, 0); LANDED();
  DMA(1, 1);
  if (ty == 0) {
    qkt(pA0, pA1, KBUF(0), qr, r32, hi, mapB); partialSM<SH>(pA0, pA1, m_reg, mnA, alA);
    LANDED();
    for (int j = 1; j + 1 < NT; j += 2) {
      BLK_X(pB0, pB1, pA0, pA1, alA, j); DMAV(j + 1, (j + 1) & 3); BLK_Y(pB0, pB1, mnB, alB, j - 1); LANDED();
      BLK_X(pA0, pA1, pB0, pB1, alB, j + 1); DMAV(j + 2, (j + 2) & 3); BLK_Y(pA0, pA1, mnA, alA, j); LANDED();
    }
    BLK_X(pB0, pB1, pA0, pA1, alA, NT - 1); BLK_Y(pB0, pB1, mnB, alB, NT - 2);
    finishSM<SH>(pB0, pB1, alB, l_reg, pa0, pa1, pa2, pa3); SBAR();
    if constexpr (SH) pv_d0(o, VBUF((NT - 1) & 3), pa0, pa1, pa2, pa3); else pv_d0_pipe<false>(o, VBUF((NT - 1) & 3), pa0, pa1, pa2, pa3, vfa);
  } else {
    qkt(pA0, pA1, KBUF(0), qr, r32, hi, mapB);
    LANDED();
    DMA(2, 2); DMA1X(2, 2, 0, wid - 4); DMA1X(2, 2, 1, wid - 4); partialSM<SH>(pA0, pA1, m_reg, mnA, alA); BLK_X(pB0, pB1, pA0, pA1, alA, 1); LANDED();
    for (int j = 2; j + 2 < NT; j += 2) {
      BLK_Y1(pB0, pB1, mnB, alB, j - 2, j + 1); BLK_X(pA0, pA1, pB0, pB1, alB, j); LANDED();
      BLK_Y1(pA0, pA1, mnA, alA, j - 1, j + 2); BLK_X(pB0, pB1, pA0, pA1, alA, j + 1); LANDED();
    }
    BLK_Y1(pB0, pB1, mnB, alB, NT - 4, NT - 1); BLK_X(pA0, pA1, pB0, pB1, alB, NT - 2); LANDED();
    BLK_Y(pA0, pA1, mnA, alA, NT - 3); BLK_X(pB0, pB1, pA0, pA1, alA, NT - 1);
    BLK_Y(pB0, pB1, mnB, alB, NT - 2);
    finishSM<SH>(pB0, pB1, alB, l_reg, pa0, pa1, pa2, pa3); SBAR();
    if constexpr (SH) pv_d0(o, VBUF((NT - 1) & 3), pa0, pa1, pa2, pa3); else pv_d0_pipe<false>(o, VBUF((NT - 1) & 3), pa0, pa1, pa2, pa3, vfa);
  }
#undef BLK_X
#undef BLK_Y
#undef BLK_Y1
#undef DMA1
#undef DMA1X
#undef DMAV
  u32x4 zg[4];
  bf16_t* zp = proj + (size_t)(tok0 + (tid >> 2)) * NPROJ + C_ZA + h * 128 + (tid & 3) * 32;
#pragma unroll
  for (int i = 0; i < 4; ++i) zg[i] = *(const u32x4*)(zp + i * 8);
  l_reg += __shfl_xor(l_reg, 32);
  if (hi == 0) li_l[r32] = l_reg; asm volatile("s_waitcnt lgkmcnt(0)" ::: "memory");
  float rli[16];
#pragma unroll
  for (int r = 0; r < 16; ++r) rli[r] = __builtin_amdgcn_rcpf(li_l[crow(r, hi)]);
  __syncthreads();
  float* X = (float*)lds;
  if (mp == 1) {
#pragma unroll
    for (int d = 0; d < 4; ++d)
#pragma unroll
      for (int r = 0; r < 16; ++r) X[(wq * 64 + d * 16 + r) * 64 + lane] = o[d][r] * rli[r] * lam;
  }
  __syncthreads();
  if (mp == 0) {
#pragma unroll
    for (int d = 0; d < 4; ++d)
#pragma unroll
      for (int r = 0; r < 16; ++r) { const int ix = (wq * 64 + d * 16 + r) * 64 + lane; X[ix] = o[d][r] * rli[r] - X[ix]; }
  }
  __syncthreads();
  {
    const int row = tid >> 2, dq = tid & 3, rl = row & 31, w = row >> 5, hh = (rl >> 2) & 1, r = (rl & 3) + 4 * (rl >> 3);
    const float* xb = X + (w * 64 + dq * 16 + r) * 64 + hh * 32;
    f32x4 a[8]; float ss = 0.f;
#pragma unroll
    for (int i = 0; i < 8; ++i) { a[i] = *(const f32x4*)(xb + i * 4); ss += a[i][0] * a[i][0] + a[i][1] * a[i][1] + a[i][2] * a[i][2] + a[i][3] * a[i][3]; }
    ss += __shfl_xor(ss, 1); ss += __shfl_xor(ss, 2);
    const float rn = __builtin_amdgcn_rsqf(ss * (1.f / 128.f) + 1e-5f) * oscale;
    const float* gg = subg + dq * 32;
#pragma unroll
    for (int i = 0; i < 4; ++i) {
      const u32x4 z = zg[i];
      const f32x4 a0 = a[2 * i], a1 = a[2 * i + 1]; const f32x4 g0 = *(const f32x4*)(gg + i * 8), g1 = *(const f32x4*)(gg + i * 8 + 4);
      u32x4 wv;
      wv.x = cvtpk(a0[0] * rn * g0[0] * silu(bflo(z.x)), a0[1] * rn * g0[1] * silu(bfhi(z.x)));
      wv.y = cvtpk(a0[2] * rn * g0[2] * silu(bflo(z.y)), a0[3] * rn * g0[3] * silu(bfhi(z.y)));
      wv.z = cvtpk(a1[0] * rn * g1[0] * silu(bflo(z.z)), a1[1] * rn * g1[1] * silu(bfhi(z.z)));
      wv.w = cvtpk(a1[2] * rn * g1[2] * silu(bflo(z.w)), a1[3] * rn * g1[3] * silu(bfhi(z.w)));
      if (!dry) *(u32x4*)(zp + i * 8) = wv;
    }
  }
  __syncthreads();
#undef DMA
#undef GLDS16
#undef KBUF
#undef VBUF
#undef LANDED
#undef RESC
}

__device__ void attn_phase(const Params& p, int l, char* lds, bool dry = false) {
  const float lam = p.lam[l];
  const float oscale = 1.f - (0.8f - 0.6f * expf(-0.3f * (float)l));
  const float* subg = p.subln_g + l * 128;
  for (int u = blockIdx.x; u < 2048; u += gridDim.x) {
    int tok0, kv0, seq, h;
    if (u < 1024) { const int x = u & 7, j = u >> 3; const int b = x >> 2; h = x & 3; seq = S_P; kv0 = b * S_P; tok0 = kv0 + j * 128; }
    else { const int v = u - 1024, x = v & 7, j = v >> 3; const int pr = x * 4 + (j >> 5), b = pr >> 2; h = pr & 3; seq = S_S; kv0 = TP + b * S_S; tok0 = kv0 + (j & 31) * 128; }
    bool need;
    { const int tid = opaque_tid(), wid = tid >> 6, lane = tid & 63, r32 = lane & 31, hi = lane >> 5, wq = wid & 3, mp = wid >> 2;
      const int sq = tok0 < TP ? (tok0 >> 14) : 2 + ((tok0 - TP) >> 12);
      const float* km = p.kmax2 + ((l * 10 + sq) * 4 + h) * 4 + mp * 2;
      const float kmx = sqrtf(km[0] + km[1]) * 1.01f;
      const bf16_t* Qw = p.proj + (size_t)(tok0 + wq * 32 + r32) * NPROJ + C_Q + h * 128 + mp * 64 + hi * 8;
      float ss = 0.f;
#pragma unroll
      for (int d0 = 0; d0 < 4; ++d0) { const u32x4 w = *(const u32x4*)(Qw + d0 * 16);
        ss += bflo(w.x) * bflo(w.x) + bfhi(w.x) * bfhi(w.x) + bflo(w.y) * bflo(w.y) + bfhi(w.y) * bfhi(w.y) + bflo(w.z) * bflo(w.z) + bfhi(w.z) * bfhi(w.z) + bflo(w.w) * bflo(w.w) + bfhi(w.w) * bfhi(w.w); }
      ss += __shfl_xor(ss, 32);
      need = __any(!(sqrtf(ss) * kmx < 100.f)) != 0; }
    if (need) attn_unit<true>(p.proj, tok0, kv0, seq, h, lam, oscale, subg, lds, dry);
    else attn_unit<false>(p.proj, tok0, kv0, seq, h, lam, oscale, subg, lds, dry);
  }
}
}

__device__ void post_phase(const Params& p, int l) {
  const int tid = opaque_tid(), wid = tid >> 6, lane = tid & 63, nw = blockDim.x >> 6;
  const float* pg = p.post_g + l * DM;
  constexpr int R = 2;
  for (int row0 = (blockIdx.x * nw + wid) * R; row0 < T_TOK; row0 += gridDim.x * nw * R) {
    f32x4 y[R][4], x[R][4]; u32x2 xh[R][4], xl[R][4], yb[R][4];
#pragma unroll
    for (int q = 0; q < R; ++q) {
      const int row = row0 + q;
      const bf16_t* yr = p.proj + (size_t)row * NPROJ + C_U;
#pragma unroll
      for (int i = 0; i < 4; ++i) yb[q][i] = __builtin_nontemporal_load((const u32x2*)(yr + i * 256 + lane * 4));
      if (l == 0) {
        const float* xr = row < TP ? p.xp + (size_t)row * DM : p.xs + (size_t)(row - TP) * DM;
#pragma unroll
        for (int i = 0; i < 4; ++i) x[q][i] = __builtin_nontemporal_load((const f32x4*)(xr + i * 256 + lane * 4));
      } else {
        const bf16_t* xo = (const bf16_t*)p.out + (size_t)row * LDX;
#pragma unroll
        for (int i = 0; i < 4; ++i) { xh[q][i] = __builtin_nontemporal_load((const u32x2*)(xo + i * 256 + lane * 4)); xl[q][i] = __builtin_nontemporal_load((const u32x2*)(xo + DM + i * 256 + lane * 4)); }
      }
    }
#pragma unroll
    for (int q = 0; q < R; ++q) {
      const int row = row0 + q;
      bf16_t* xo = (bf16_t*)p.out + (size_t)row * LDX;
      float ss = 0.f;
#pragma unroll
      for (int i = 0; i < 4; ++i) { y[q][i] = (f32x4){bflo(yb[q][i].x), bfhi(yb[q][i].x), bflo(yb[q][i].y), bfhi(yb[q][i].y)};
        ss += y[q][i][0] * y[q][i][0] + y[q][i][1] * y[q][i][1] + y[q][i][2] * y[q][i][2] + y[q][i][3] * y[q][i][3]; }
      if (l != 0) {
#pragma unroll
        for (int i = 0; i < 4; ++i) {
          const u32x2 h = xh[q][i], lo = xl[q][i];
          x[q][i][0] = bflo(h.x) + bflo(lo.x); x[q][i][1] = bfhi(h.x) + bfhi(lo.x); x[q][i][2] = bflo(h.y) + bflo(lo.y); x[q][i][3] = bfhi(h.y) + bfhi(lo.y);
        }
      }
      ss = wave_sum(ss);
      const float ry = __builtin_amdgcn_rsqf(ss * (1.f / DM) + 1e-6f);
      float s2 = 0.f;
#pragma unroll
      for (int i = 0; i < 4; ++i) {
        const f32x4 g = *(const f32x4*)(pg + i * 256 + lane * 4);
#pragma unroll
        for (int e = 0; e < 4; ++e) { x[q][i][e] = x[q][i][e] + y[q][i][e] * ry * g[e]; s2 += x[q][i][e] * x[q][i][e]; }
      }
      if (l == DEPTH - 1) {
        float* orow = p.out + (size_t)row * DM;
#pragma unroll
        for (int i = 0; i < 4; ++i) __builtin_nontemporal_store(x[q][i], (f32x4*)(orow + i * 256 + lane * 4));
      } else {
        s2 = wave_sum(s2);
        if (lane == 0) p.rinv[row] = __builtin_amdgcn_rsqf(s2 * (1.f / DM) + 1e-6f);
#pragma unroll
        for (int i = 0; i < 4; ++i) {
          const unsigned h0 = cvtpk(x[q][i][0], x[q][i][1]), h1 = cvtpk(x[q][i][2], x[q][i][3]);
          const unsigned l0 = cvtpk(x[q][i][0] - bflo(h0), x[q][i][1] - bfhi(h0)), l1 = cvtpk(x[q][i][2] - bflo(h1), x[q][i][3] - bfhi(h1));
          *(u32x2*)(xo + i * 256 + lane * 4) = (u32x2){h0, h1}; *(u32x2*)(xo + DM + i * 256 + lane * 4) = (u32x2){l0, l1};
        }
      }
    }
  }
}

#define XB_TMO      128
#define XB_XCNT(j)  (256  + 64 * (j))
#define XB_XSUB(j)  (1280 + 64 * (j))
#define XB_XGEN(j)  (2304 + 64 * (j))
#define XB_TOP      3328
#define XB_TOPGEN   3392
#define XB_SPIN_CAP (1u << 22)
#define XLAS __attribute__((address_space(3)))
__device__ __forceinline__ unsigned xb_ld(unsigned* p)              { return __hip_atomic_load(p, __ATOMIC_RELAXED, __HIP_MEMORY_SCOPE_AGENT); }
__device__ __forceinline__ unsigned xb_add(unsigned* p, unsigned v) { return __hip_atomic_fetch_add(p, v, __ATOMIC_RELAXED, __HIP_MEMORY_SCOPE_AGENT); }
__device__ __forceinline__ unsigned xb_xcc_id() { return (unsigned)__builtin_amdgcn_s_getreg((3 << 11) | 20) & 0xFu; }
#define XB_SPIN(cond, bar) do { unsigned _sp = 0; while (cond) { __builtin_amdgcn_s_sleep(1); \
    if ((++_sp & 255u) == 0u) { if (xb_ld(&(bar)[XB_TMO])) break; if (_sp > XB_SPIN_CAP) { atomicAdd(&(bar)[XB_TMO], 1u); break; } } } } while (0)
struct XcdBarrier { unsigned* bar; unsigned x; volatile XLAS unsigned* st; };
__device__ __forceinline__ XcdBarrier xcd_barrier_post(unsigned* bar, volatile XLAS unsigned* st) {
  XcdBarrier b; b.bar = bar; b.x = xb_xcc_id(); b.st = st;
  if (threadIdx.x == 0) (void)xb_add(&bar[XB_XCNT(b.x)], 1u);
  return b;
}
__device__ __forceinline__ void xcd_barrier_complete(unsigned* bar, unsigned x, unsigned& nloc, unsigned& nx) {
  const unsigned G = gridDim.x * gridDim.y * gridDim.z;
  unsigned sum, cnt, mine, sp = 0u;
  for (;;) {
    sum = 0u; cnt = 0u; mine = 0u;
#pragma unroll
    for (unsigned j = 0; j < 16; ++j) { const unsigned c = xb_ld(&bar[XB_XCNT(j)]); sum += c; cnt += (c > 0u) ? 1u : 0u; mine = (j == x) ? c : mine; }
    if (sum == G) break;
    __builtin_amdgcn_s_sleep(1);
    if ((++sp & 255u) == 0u) { if (xb_ld(&bar[XB_TMO])) break; if (sp > XB_SPIN_CAP) { atomicAdd(&bar[XB_TMO], 1u); break; } }
  }
  nloc = mine > 0u ? mine : 1u; nx = cnt > 0u ? cnt : 1u;
}
__device__ __forceinline__ void xcd_barrier(const XcdBarrier& b) {
  asm volatile("s_waitcnt vmcnt(0)" ::: "memory");
  __syncthreads();
  if (threadIdx.x == 0) {
    unsigned* bar = b.bar;
    __builtin_amdgcn_s_waitcnt(0);
    unsigned nloc = b.st[0], nx = b.st[1];
    if (nloc == 0u) { xcd_barrier_complete(bar, b.x, nloc, nx); b.st[0] = nloc; b.st[1] = nx; }
    const unsigned old = xb_add(&bar[XB_XSUB(b.x)], 1u);
    const unsigned gen = old / nloc;
    if (old + 1u == (gen + 1u) * nloc) {
      __builtin_amdgcn_fence(__ATOMIC_RELEASE, "agent");
      asm volatile("s_waitcnt vmcnt(0)" ::: "memory");
      const unsigned og = xb_add(&bar[XB_TOP], 1u);
      const unsigned tg = og / nx;
      if (og + 1u == (tg + 1u) * nx) xb_add(&bar[XB_TOPGEN], 1u);
      else XB_SPIN(xb_ld(&bar[XB_TOPGEN]) == tg, bar);
      __builtin_amdgcn_fence(__ATOMIC_ACQUIRE, "agent");
      xb_add(&bar[XB_XGEN(b.x)], 1u);
      asm volatile("s_waitcnt vmcnt(0)" ::: "memory");
    } else {
      XB_SPIN(xb_ld(&bar[XB_XGEN(b.x)]) == gen, bar);
      __builtin_amdgcn_fence(__ATOMIC_ACQUIRE, "agent");
      asm volatile("s_waitcnt vmcnt(0)" ::: "memory");
    }
  }
  __syncthreads();
}

__device__ __forceinline__ void run_phase(const Params& p, int ph, char* shm) {
  if (ph == 0) { phase0(p, shm); return; }
  const int l = (ph - 1) >> 2, s = (ph - 1) & 3;
  if (s == 0) { gm::EpiIn e{p.rinv, p.rope, p.proj, p.kmax2 + l * 160}; gm::gemm_phase(( const bf16_t*)p.out, LDX, p.WinT + (size_t)l * NPROJ * DM, NPROJ, e, shm); }
  else if (s == 1) { pool_phase(p, l); at::attn_phase(p, l, shm); }
  else if (s == 2) { gm::EpiOut e{p.proj}; gm::gemm_phase(p.proj, NPROJ, p.WoutT + (size_t)l * DM * DM, DM, e, shm); }
  else post_phase(p, l);
}

#if MK_MULTI
template <int S> __global__ void __launch_bounds__(NT_THREADS, 1) k_phase(Params p, int l) {
  extern __shared__ __attribute__((aligned(16))) char shm[];
  if (S == 0) phase0(p, shm); else run_phase(p, 1 + 4 * l + (S - 1), shm);
}
#else
__global__ void __launch_bounds__(NT_THREADS, 1) k_mega(Params p) {
  extern __shared__ __attribute__((aligned(16))) char shm[];
  cg::grid_group grid = cg::this_grid();
  volatile XLAS unsigned* xst = (volatile XLAS unsigned*)(XLAS char*)(shm + 131072 + 3072);
  if (threadIdx.x == 0) { xst[0] = 0u; xst[1] = 0u; xst[2] = 0u; xst[3] = 0u; }
  phase0(p, shm);
  grid.sync();
  (void)xcd_barrier_post(p.bar, xst);
#define GSYNC() do { XcdBarrier xb_; xb_.bar = p.bar; xb_.x = xb_xcc_id(); xb_.st = xst; xcd_barrier(xb_); } while (0)
  for (int l = 0; l < DEPTH; ++l) {
#if REP_GEMM
    { gm::EpiIn e{p.rinv, p.rope, p.proj, p.kmax2 + l * 160}; gm::gemm_phase((const bf16_t*)p.out, LDX, p.WinT + (size_t)l * NPROJ * DM, NPROJ, e, shm); }
    GSYNC();
#endif
    { gm::EpiIn e{p.rinv, p.rope, p.proj, p.kmax2 + l * 160}; gm::gemm_phase((const bf16_t*)p.out, LDX, p.WinT + (size_t)l * NPROJ * DM, NPROJ, e, shm); }
    GSYNC();
    pool_phase(p, l);
#if REP_ATT
    at::attn_phase(p, l, shm, true); GSYNC();
#endif
    at::attn_phase(p, l, shm);
    GSYNC();
#if REP_GEMM
    { gm::EpiOut e{p.proj}; gm::gemm_phase(p.proj, NPROJ, p.WoutT + (size_t)l * DM * DM, DM, e, shm); }
    GSYNC();
#endif
    { gm::EpiOut e{p.proj}; gm::gemm_phase(p.proj, NPROJ, p.WoutT + (size_t)l * DM * DM, DM, e, shm); }
    GSYNC();
#if REP_POST
    if (l == 0) { post_phase(p, l); GSYNC(); }
#endif
    post_phase(p, l);
    if (l + 1 < DEPTH) GSYNC();
  }
}
#endif

extern "C" void kernel_launch(void* const* d_in, const int* in_sizes, int n_in, void* d_out, int out_size, void* d_ws, size_t ws_size, hipStream_t stream) {
  Params p{};
  p.xp = (const float*)d_in[0]; p.xs = (const float*)d_in[1]; p.pre_g = (const float*)d_in[2]; p.w_in = (const float*)d_in[3];
  p.pool_w = (const float*)d_in[4]; p.pool_scale = (const float*)d_in[5]; p.lq1 = (const float*)d_in[6]; p.lk1 = (const float*)d_in[7];
  p.lq2 = (const float*)d_in[8]; p.lk2 = (const float*)d_in[9]; p.subln_g = (const float*)d_in[10]; p.w_out = (const float*)d_in[11]; p.post_g = (const float*)d_in[12];
  p.out = (float*)d_out;
  char* w = (char*)d_ws; size_t off = 0;
  p.proj = (bf16_t*)(w + off); off += (size_t)T_TOK * NPROJ * 2;
  p.WinT = (bf16_t*)(w + off); off += (size_t)DEPTH * NPROJ * DM * 2;
  p.WoutT = (bf16_t*)(w + off); off += (size_t)DEPTH * DM * DM * 2;
  p.rinv = (float*)(w + off); off += (size_t)T_TOK * 4;
  p.rope = (float*)(w + off); off += 256;
  p.lam = (float*)(w + off); off += 256;
  p.kmax2 = (float*)(w + off); off += 2048;
  p.bar = (unsigned*)(w + off); off += 16384;
  if (off > ws_size) { fprintf(stderr, "kernel_launch: workspace too small (%zu > %zu)\n", off, ws_size); return; }
#if MK_MULTI
  static int ok = 0;
  if (!ok) {
    (void)hipFuncSetAttribute((const void*)k_phase<0>, hipFuncAttributeMaxDynamicSharedMemorySize, (int)SHM_BYTES);
    (void)hipFuncSetAttribute((const void*)k_phase<1>, hipFuncAttributeMaxDynamicSharedMemorySize, (int)SHM_BYTES);
    (void)hipFuncSetAttribute((const void*)k_phase<2>, hipFuncAttributeMaxDynamicSharedMemorySize, (int)SHM_BYTES);
    (void)hipFuncSetAttribute((const void*)k_phase<3>, hipFuncAttributeMaxDynamicSharedMemorySize, (int)SHM_BYTES);
    (void)hipFuncSetAttribute((const void*)k_phase<4>, hipFuncAttributeMaxDynamicSharedMemorySize, (int)SHM_BYTES);
    ok = 1; }
  hipLaunchKernelGGL(k_phase<0>, dim3(256), dim3(NT_THREADS), SHM_BYTES, stream, p, 0);
  for (int l = 0; l < DEPTH; ++l) {
    hipLaunchKernelGGL(k_phase<1>, dim3(256), dim3(NT_THREADS), SHM_BYTES, stream, p, l);
    hipLaunchKernelGGL(k_phase<2>, dim3(256), dim3(NT_THREADS), SHM_BYTES, stream, p, l);
    hipLaunchKernelGGL(k_phase<3>, dim3(256), dim3(NT_THREADS), SHM_BYTES, stream, p, l);
    hipLaunchKernelGGL(k_phase<4>, dim3(256), dim3(NT_THREADS), SHM_BYTES, stream, p, l);
  }
#else
  static int grid_blocks = 0;
  if (!grid_blocks) {
    (void)hipFuncSetAttribute((const void*)k_mega, hipFuncAttributeMaxDynamicSharedMemorySize, (int)SHM_BYTES);
    int dev = 0, cus = 0, per_cu = 0;
    (void)hipGetDevice(&dev);
    (void)hipDeviceGetAttribute(&cus, hipDeviceAttributeMultiprocessorCount, dev);
    (void)hipOccupancyMaxActiveBlocksPerMultiprocessor(&per_cu, k_mega, NT_THREADS, SHM_BYTES);
    if (per_cu > 1) per_cu = 1;
    grid_blocks = cus * per_cu;
  }
  void* args[] = {&p};
  hipError_t e = hipLaunchCooperativeKernel((void*)k_mega, dim3(grid_blocks), dim3(NT_THREADS), args, SHM_BYTES, stream);
  if (e != hipSuccess) fprintf(stderr, "cooperative launch failed: %s (grid %d)\n", hipGetErrorString(e), grid_blocks);
#endif
}
```
